# Optimizing an MI355X kernel written in HIP

```python
import math
import jax, jax.numpy as jnp
from jax import lax
import numpy as np

D_MODEL = 1024
BATCH = 8
SEQ = 4096
DEPTH = 2

N_A = DEPTH // 2
N_B = DEPTH - N_A
HEAD_DIM = 64
ROPE_DIM = HEAD_DIM // 4
ROPE_THETA = 500000.0
RMS_EPS = 1e-6
NEG_INF = -1e30
MEM_HEADS = 4
MEM_WIDTH = MEM_HEADS * HEAD_DIM
MIX_WIDTH = D_MODEL
LRU_WIDTH = MIX_WIDTH - MEM_WIDTH
LRU_BLOCKS = LRU_WIDTH // HEAD_DIM
CONV_WIDTH = 4
LRU_C = 8.0
NSA_WIDTH = MIX_WIDTH - MEM_WIDTH
NSA_HEADS = NSA_WIDTH // HEAD_DIM
NSA_KV_HEADS = 2
N_BRANCH = 3
CMP_LEN = 32
CMP_STRIDE = 16
CMP_HIDDEN = 256
SEL_LEN = 64
SEL_TOP = 16
SEL_FORCE_SCORE = 1e4
WINDOW = 512
Q_CHUNK = 64
N_KEYS = 128
N_EXPERTS = N_KEYS * N_KEYS
PEER_HEADS = 8
PEER_KEY_DIM = 256
PEER_TOPK = 16
PEER_CHUNK_MAX = 512

kernel_name = "hybrid_rglru_nsa_peer_yoco"


def rmsnorm(x, g):
    xf = x.astype(jnp.float32)
    y = xf * lax.rsqrt(jnp.mean(xf * xf, axis=-1, keepdims=True) + RMS_EPS)
    return (y * g.astype(jnp.float32)).astype(x.dtype)


def rope(x, pos):
    half = ROPE_DIM // 2
    freqs = ROPE_THETA ** (-jnp.arange(half, dtype=jnp.float32) / half)
    ang = pos.astype(jnp.float32)[:, None] * freqs[None, :]
    cos = jnp.cos(ang)[:, None, :]
    sin = jnp.sin(ang)[:, None, :]
    xf = x.astype(jnp.float32)
    x1, x2, rest = xf[..., :half], xf[..., half:ROPE_DIM], xf[..., ROPE_DIM:]
    out = jnp.concatenate([x1 * cos - x2 * sin, x2 * cos + x1 * sin, rest], axis=-1)
    return out.astype(x.dtype)


def masked_softmax(s, mask):
    s = jnp.where(mask, s.astype(jnp.float32), NEG_INF)
    p = jax.nn.softmax(s, axis=-1)
    return jnp.where(mask, p, 0.0)


def causal_conv(x, w, b):
    K, C = w.shape
    y = lax.conv_general_dilated(x, w[:, None, :].astype(x.dtype), window_strides=(1,),
                                 padding=[(K - 1, 0)], dimension_numbers=('NWC', 'WIO', 'NWC'),
                                 feature_group_count=C)
    return y + b.astype(x.dtype)


def rg_lru(x, gate_w, gate_b, lam):
    B, S, C = x.shape
    xb = x.reshape(B, S, LRU_BLOCKS, HEAD_DIM)
    gates = jnp.einsum('bsnd,gnde->gbsne', xb, gate_w).reshape(2, B, S, C).astype(jnp.float32)
    gates = gates + gate_b.astype(jnp.float32)[:, None, None, :]
    r = jax.nn.sigmoid(gates[0])
    i = jax.nn.sigmoid(gates[1])
    log_a = -LRU_C * r * jax.nn.softplus(-lam.astype(jnp.float32))
    a = jnp.exp(log_a)
    u = jnp.sqrt(-jnp.expm1(2.0 * log_a)) * (i * x.astype(jnp.float32))

    def combine(left, right):
        a1, b1 = left
        a2, b2 = right
        return a1 * a2, a2 * b1 + b2

    _, h = lax.associative_scan(combine, (a, u), axis=1)
    return h.astype(x.dtype)


def memory_attention(qm, mem, norm_g, w_kv, q_gain, k_gain):
    B, S, _ = qm.shape
    M = mem.shape[1]
    kv = (rmsnorm(mem, norm_g) @ w_kv).reshape(B, M, 2, MEM_HEADS, HEAD_DIM)
    q = rmsnorm(qm.reshape(B, S, MEM_HEADS, HEAD_DIM), q_gain)
    k = rmsnorm(kv[:, :, 0], k_gain)
    v = kv[:, :, 1]
    s = jnp.einsum('bshd,bmhd->bhsm', q, k) * (HEAD_DIM ** -0.5)
    p = jax.nn.softmax(s.astype(jnp.float32), axis=-1).astype(v.dtype)
    return jnp.einsum('bhsm,bmhd->bshd', p, v).reshape(B, S, MEM_WIDTH)


def nsa_shared_kv(x, positions, kv_norm, w_kv_shared, k_gain_shared, cmp_pos, cmp_w1, cmp_b1, cmp_w2):
    B, S, _ = x.shape
    G, dh = NSA_KV_HEADS, HEAD_DIM
    kv = (rmsnorm(x, kv_norm) @ w_kv_shared).reshape(B, S, N_BRANCH, 2, G, dh)
    n_cmp = (S - CMP_LEN) // CMP_STRIDE + 1
    idx = np.arange(n_cmp)[:, None] * CMP_STRIDE + np.arange(CMP_LEN)[None, :]

    def compress(tok, j):
        blk = tok[:, idx] + cmp_pos[j][None, None, :, None, :]
        blk = blk.transpose(0, 1, 3, 2, 4).reshape(B, n_cmp, G, CMP_LEN * dh)
        hid = jax.nn.gelu(blk @ cmp_w1[j] + cmp_b1[j])
        return hid @ cmp_w2[j]

    kc = rope(rmsnorm(compress(kv[:, :, 0, 0], 0), k_gain_shared[0]), positions[idx[:, -1]])
    vc = compress(kv[:, :, 0, 1], 1)
    ks = rope(rmsnorm(kv[:, :, 1, 0], k_gain_shared[1]), positions)
    vs = kv[:, :, 1, 1]
    kw = rope(rmsnorm(kv[:, :, 2, 0], k_gain_shared[2]), positions)
    vw = kv[:, :, 2, 1]
    t = lambda a: a.transpose(0, 2, 1, 3)
    return (t(kc), t(vc), t(ks), t(vs), t(kw), t(vw))


def _cmp_sel_overlap(n_cmp, n_sel):
    c0 = np.arange(n_cmp)[:, None] * CMP_STRIDE
    s0 = np.arange(n_sel)[None, :] * SEL_LEN
    ov = np.minimum(c0 + CMP_LEN, s0 + SEL_LEN) - np.maximum(c0, s0)
    return (np.clip(ov, 0, None) / CMP_LEN).astype(np.float32)


def nsa_attention(q, kc, vc, ks, vs, kw, vw):
    B, S, H, dh = q.shape
    G = kc.shape[1]
    R = H // G
    C = Q_CHUNK
    NQ = S // C
    n_cmp = kc.shape[2]
    n_sel = S // SEL_LEN
    top = min(SEL_TOP, n_sel)
    scale = dh ** -0.5
    cmp_end = jnp.arange(n_cmp) * CMP_STRIDE + CMP_LEN - 1
    overlap = jnp.asarray(_cmp_sel_overlap(n_cmp, n_sel))
    ks_blk = ks.reshape(B, G, n_sel, SEL_LEN, dh)
    vs_blk = vs.reshape(B, G, n_sel, SEL_LEN, dh)
    kw_pad = jnp.pad(kw, ((0, 0), (0, 0), (WINDOW, 0), (0, 0)))
    vw_pad = jnp.pad(vw, ((0, 0), (0, 0), (WINDOW, 0), (0, 0)))
    q_chunks = q.reshape(B, NQ, C, G, R, dh).transpose(1, 0, 3, 4, 2, 5)
    b_ix = jnp.arange(B)[:, None, None, None]
    g_ix = jnp.arange(G)[None, :, None, None]
    blk_ids = jnp.arange(n_sel)

    def chunk(args):
        qc, c = args
        t = c * C + jnp.arange(C)
        s = jnp.einsum('bgrqd,bgnd->bgrqn', qc, kc) * scale
        p_cmp = masked_softmax(s, cmp_end[None, :] <= t[:, None]).astype(vc.dtype)
        o_cmp = jnp.einsum('bgrqn,bgnd->bgrqd', p_cmp, vc)
        imp = jnp.einsum('bgrqn,nj->bgqj', p_cmp, overlap.astype(p_cmp.dtype)).astype(jnp.float32)
        cur = t // SEL_LEN
        valid = blk_ids[None, :] <= cur[:, None]
        forced = (blk_ids[None, :] == 0) | (blk_ids[None, :] == cur[:, None]) | (blk_ids[None, :] == cur[:, None] - 1)
        imp = jnp.where(forced, SEL_FORCE_SCORE, imp)
        imp = jnp.where(valid, imp, -1.0)
        vals, idx = lax.top_k(imp, top)
        kg = ks_blk[b_ix, g_ix, idx]
        vg = vs_blk[b_ix, g_ix, idx].reshape(B, G, C, top * SEL_LEN, dh)
        s = jnp.einsum('bgrqd,bgqkld->bgrqkl', qc, kg) * scale
        kpos = idx[..., None] * SEL_LEN + jnp.arange(SEL_LEN)
        m = (vals >= 0.0)[..., None] & (kpos <= t[None, None, :, None, None])
        p_sel = masked_softmax(s.reshape(B, G, R, C, top * SEL_LEN),
                               m.reshape(B, G, 1, C, top * SEL_LEN)).astype(vg.dtype)
        o_sel = jnp.einsum('bgrqk,bgqkd->bgrqd', p_sel, vg)
        kwin = lax.dynamic_slice_in_dim(kw_pad, c * C, WINDOW + C, axis=2)
        vwin = lax.dynamic_slice_in_dim(vw_pad, c * C, WINDOW + C, axis=2)
        wpos = c * C - WINDOW + jnp.arange(WINDOW + C)
        m = (wpos[None, :] <= t[:, None]) & (wpos[None, :] > t[:, None] - WINDOW) & (wpos[None, :] >= 0)
        s = jnp.einsum('bgrqd,bgkd->bgrqk', qc, kwin) * scale
        p_win = masked_softmax(s, m).astype(vwin.dtype)
        o_win = jnp.einsum('bgrqk,bgkd->bgrqd', p_win, vwin)
        return (o_cmp, o_sel, o_win)

    outs = lax.map(chunk, (q_chunks, jnp.arange(NQ)))
    back = lambda o: o.transpose(1, 0, 4, 2, 3, 5).reshape(B, S, H, dh)
    return (back(outs[0]), back(outs[1]), back(outs[2]))


def peer(h, w_q, sub_keys, u_tab, v_tab):
    B, S, D = h.shape
    T = B * S
    ch = math.gcd(T, PEER_CHUNK_MAX)
    half = PEER_KEY_DIM // 2

    def chunk(xc):
        q = (xc @ w_q).reshape(ch, PEER_HEADS, 2, half)
        s = jnp.einsum('thpd,hpnd->thpn', q, sub_keys).astype(jnp.float32)
        v1, i1 = lax.top_k(s[:, :, 0], PEER_TOPK)
        v2, i2 = lax.top_k(s[:, :, 1], PEER_TOPK)
        cand = (v1[..., :, None] + v2[..., None, :]).reshape(ch, PEER_HEADS, PEER_TOPK * PEER_TOPK)
        vals, ci = lax.top_k(cand, PEER_TOPK)
        e = (jnp.take_along_axis(i1, ci // PEER_TOPK, axis=-1) * N_KEYS
             + jnp.take_along_axis(i2, ci % PEER_TOPK, axis=-1))
        g = jax.nn.softmax(vals, axis=-1).astype(xc.dtype)
        u = u_tab[e]
        act = jax.nn.gelu(jnp.einsum('td,thkd->thk', xc, u)) * g
        return jnp.einsum('thk,thkd->td', act, v_tab[e])

    return lax.map(chunk, h.reshape(T // ch, ch, D)).reshape(B, S, D)


def setup_inputs(seed: int = 0) -> dict:
    key = jax.random.key(seed)
    counter = [0]

    def nk():
        counter[0] += 1
        return jax.random.fold_in(key, counter[0])

    def nrm(shape, scale):
        return scale * jax.random.normal(nk(), shape, jnp.float32)

    def gain(shape):
        return 1.0 + 0.02 * jax.random.normal(nk(), shape, jnp.float32)

    D = D_MODEL
    u = jax.random.uniform(nk(), (N_A, LRU_WIDTH), jnp.float32, minval=0.9, maxval=0.999)
    a0 = u ** (1.0 / LRU_C)
    a_lambda = jnp.log(a0) - jnp.log1p(-a0)
    return {
        "x": nrm((BATCH, SEQ, D), 1.0),
        "mem": nrm((BATCH, 256, D), 1.0),
        "positions": jnp.arange(SEQ, dtype=jnp.int32),
        "norm_mix": gain((DEPTH, D)),
        "norm_ffn": gain((DEPTH, D)),
        "norm_mem": gain((DEPTH, D)),
        "w_out": nrm((DEPTH, MIX_WIDTH, D), MIX_WIDTH ** -0.5),
        "w_mem_kv": nrm((DEPTH, D, 2 * MEM_WIDTH), D ** -0.5),
        "mem_q_gain": gain((DEPTH, HEAD_DIM)),
        "mem_k_gain": gain((DEPTH, HEAD_DIM)),
        "a_w_in": nrm((N_A, D, 2 * LRU_WIDTH + MEM_WIDTH), D ** -0.5),
        "a_conv_w": nrm((N_A, CONV_WIDTH, LRU_WIDTH), CONV_WIDTH ** -0.5),
        "a_conv_b": nrm((N_A, LRU_WIDTH), 0.02),
        "a_gate_w": nrm((N_A, 2, LRU_BLOCKS, HEAD_DIM, HEAD_DIM), HEAD_DIM ** -0.5),
        "a_gate_b": nrm((N_A, 2, LRU_WIDTH), 0.02),
        "a_lambda": a_lambda,
        "b_w_in": nrm((N_B, D, NSA_WIDTH + N_BRANCH * NSA_HEADS + MEM_WIDTH), D ** -0.5),
        "b_gate_b": nrm((N_B, N_BRANCH * NSA_HEADS), 0.02),
        "b_q_gain": gain((N_B, HEAD_DIM)),
        "kv_norm": gain((D,)),
        "w_kv_shared": nrm((D, N_BRANCH * 2 * NSA_KV_HEADS * HEAD_DIM), D ** -0.5),
        "k_gain_shared": gain((N_BRANCH, HEAD_DIM)),
        "cmp_pos": nrm((2, CMP_LEN, HEAD_DIM), 0.1),
        "cmp_w1": nrm((2, CMP_LEN * HEAD_DIM, CMP_HIDDEN), (CMP_LEN * HEAD_DIM) ** -0.5),
        "cmp_b1": nrm((2, CMP_HIDDEN), 0.02),
        "cmp_w2": nrm((2, CMP_HIDDEN, HEAD_DIM), CMP_HIDDEN ** -0.5),
        "peer_wq": nrm((DEPTH, D, PEER_HEADS * PEER_KEY_DIM), D ** -0.5),
        "peer_subkeys": nrm((DEPTH, PEER_HEADS, 2, N_KEYS, PEER_KEY_DIM // 2), (PEER_KEY_DIM // 2) ** -0.5),
        "peer_u": nrm((DEPTH, N_EXPERTS, D), D ** -0.5),
        "peer_v": nrm((DEPTH, N_EXPERTS, D), PEER_HEADS ** -0.5),
    }


def reference(x, mem, positions, norm_mix, norm_ffn, norm_mem, w_out, w_mem_kv, mem_q_gain, mem_k_gain,
              a_w_in, a_conv_w, a_conv_b, a_gate_w, a_gate_b, a_lambda, b_w_in, b_gate_b, b_q_gain,
              kv_norm, w_kv_shared, k_gain_shared, cmp_pos, cmp_w1, cmp_b1, cmp_w2,
              peer_wq, peer_subkeys, peer_u, peer_v):
    B, S, _ = x.shape
    shared = None
    for l in range(DEPTH):
        h = rmsnorm(x, norm_mix[l])
        if l < N_A:
            proj = h @ a_w_in[l]
            xb = causal_conv(proj[..., :LRU_WIDTH], a_conv_w[l], a_conv_b[l])
            yb = proj[..., LRU_WIDTH:2 * LRU_WIDTH]
            qm = proj[..., 2 * LRU_WIDTH:]
            mix = rg_lru(xb, a_gate_w[l], a_gate_b[l], a_lambda[l]) * jax.nn.gelu(yb)
        else:
            j = l - N_A
            proj = h @ b_w_in[j]
            q = proj[..., :NSA_WIDTH].reshape(B, S, NSA_HEADS, HEAD_DIM)
            gl = (proj[..., NSA_WIDTH:NSA_WIDTH + N_BRANCH * NSA_HEADS].reshape(B, S, NSA_HEADS, N_BRANCH)
                  + b_gate_b[j].reshape(NSA_HEADS, N_BRANCH))
            qm = proj[..., NSA_WIDTH + N_BRANCH * NSA_HEADS:]
            q = rope(rmsnorm(q, b_q_gain[j]), positions)
            o_cmp, o_sel, o_win = nsa_attention(q, shared[0], shared[1], shared[2], shared[3], shared[4], shared[5])
            g = jax.nn.sigmoid(gl.astype(jnp.float32)).astype(q.dtype)
            mix = (g[..., 0:1] * o_cmp + g[..., 1:2] * o_sel + g[..., 2:3] * o_win).reshape(B, S, NSA_WIDTH)
        mo = memory_attention(qm, mem, norm_mem[l], w_mem_kv[l], mem_q_gain[l], mem_k_gain[l])
        x = x + jnp.concatenate([mix, mo], axis=-1) @ w_out[l]
        x = x + peer(rmsnorm(x, norm_ffn[l]), peer_wq[l], peer_subkeys[l], peer_u[l], peer_v[l])
        if l == N_A - 1:
            shared = nsa_shared_kv(x, positions, kv_norm, w_kv_shared, k_gain_shared,
                                   cmp_pos, cmp_w1, cmp_b1, cmp_w2)
    return x
```

```cpp
#include <hip/hip_runtime.h>
#include <hip/hip_cooperative_groups.h>
#include <cstdio>
#include <cstdint>
namespace cg = cooperative_groups;

constexpr int NB = 8, S = 4096, D = 1024, T = NB * S;
constexpr int MEMN = 256;
constexpr int LRUW = 768, NBLK = 12;
constexpr int NCMP = 255;
constexpr int PP = 2048;
constexpr int NTHR = 512;
constexpr float EPS = 1e-6f;

constexpr size_t MiB = 1ull << 20;
constexpr size_t WS_P = 0;
constexpr size_t WS_Q = 256 * MiB;
constexpr size_t WS_R = 384 * MiB;
constexpr size_t WS_E = WS_R;
constexpr size_t WS_GT = WS_R + 16 * MiB;
constexpr size_t WS_KS = WS_R + 32 * MiB;
constexpr size_t WS_KW = WS_R + 48 * MiB;
constexpr size_t WS_WF = WS_R + 64 * MiB;
constexpr size_t WS_MEMKV = WS_R + 80 * MiB;
constexpr size_t WS_HID = WS_R + 88 * MiB;
constexpr size_t WS_KC = WS_R + 97 * MiB;
constexpr size_t WS_VC = WS_R + 98 * MiB;
constexpr size_t WS_RSTD = WS_R + 100 * MiB;
constexpr size_t WS_ROPE = WS_R + 101 * MiB;
constexpr size_t WS_END = 512 * MiB;

struct Params {
    const float* in[30];
    float* out;
    unsigned char* ws;
    int ph_lo, ph_hi;
};

__device__ __forceinline__ float wave_sum(float v) {
#pragma unroll
    for (int o = 1; o < 64; o <<= 1) v += __shfl_xor(v, o);
    return v;
}
__device__ __forceinline__ float wave_max(float v) {
#pragma unroll
    for (int o = 1; o < 64; o <<= 1) v = fmaxf(v, __shfl_xor(v, o));
    return v;
}
__device__ __forceinline__ float gelu_tanh(float x) {
    const float k0 = 0.7978845608028654f, k1 = 0.044715f;
    float u = k0 * (x + k1 * x * x * x);
    return 0.5f * x * (1.f + tanhf(u));
}
__device__ __forceinline__ float sigmoidf_(float x) { return 1.f / (1.f + expf(-x)); }

template <class AF, class EF>
__device__ __forceinline__ void gemm_f32(float* smem, int M, int N, int K, const float* __restrict__ W, int ldw, AF af, EF ef) {
    float* As = smem;
    float* Bs = smem + 16 * 132;
    const int tid = threadIdx.x;
    const int ntn = (N + 127) / 128, ntm = M / 128;
    const int ty = tid >> 5, tx = tid & 31;
    const int ar = tid >> 2, ac = (tid & 3) * 4;
    const int br = tid >> 5, bc = (tid & 31) * 4;
    for (int tile = blockIdx.x; tile < ntm * ntn; tile += gridDim.x) {
        const int tm = tile / ntn, tn = tile % ntn;
        const int m0 = tm * 128, n0 = tn * 128;
        float acc[8][4];
#pragma unroll
        for (int i = 0; i < 8; ++i)
#pragma unroll
            for (int j = 0; j < 4; ++j) acc[i][j] = 0.f;
        for (int k0 = 0; k0 < K; k0 += 16) {
            float4 a4 = af(m0 + ar, k0 + ac);
            float4 b4 = make_float4(0.f, 0.f, 0.f, 0.f);
            if (n0 + bc < N) b4 = *(const float4*)(W + (size_t)(k0 + br) * ldw + n0 + bc);
            __syncthreads();
            As[(ac + 0) * 132 + ar] = a4.x; As[(ac + 1) * 132 + ar] = a4.y; As[(ac + 2) * 132 + ar] = a4.z; As[(ac + 3) * 132 + ar] = a4.w;
            *(float4*)(Bs + br * 128 + bc) = b4;
            __syncthreads();
#pragma unroll
            for (int k = 0; k < 16; ++k) {
                float4 a0 = *(const float4*)(As + k * 132 + ty * 8);
                float4 a1 = *(const float4*)(As + k * 132 + ty * 8 + 4);
                float4 b = *(const float4*)(Bs + k * 128 + tx * 4);
                float av[8] = {a0.x, a0.y, a0.z, a0.w, a1.x, a1.y, a1.z, a1.w};
                float bv[4] = {b.x, b.y, b.z, b.w};
#pragma unroll
                for (int i = 0; i < 8; ++i)
#pragma unroll
                    for (int j = 0; j < 4; ++j) acc[i][j] = fmaf(av[i], bv[j], acc[i][j]);
            }
        }
        const int n = n0 + tx * 4;
        if (n < N) {
#pragma unroll
            for (int i = 0; i < 8; ++i) ef(m0 + ty * 8 + i, n, make_float4(acc[i][0], acc[i][1], acc[i][2], acc[i][3]));
        }
    }
}

__device__ __forceinline__ void rows_rstd(const float* __restrict__ X, int nrows, float* __restrict__ rstd) {
    const int lane = threadIdx.x & 63, gw = blockIdx.x * (NTHR / 64) + (threadIdx.x >> 6), ngw = gridDim.x * (NTHR / 64);
    for (int r = gw; r < nrows; r += ngw) {
        const float4* p = (const float4*)(X + (size_t)r * D) + lane;
        float s = 0.f;
#pragma unroll
        for (int j = 0; j < 4; ++j) { float4 v = p[64 * j]; s += v.x * v.x + v.y * v.y + v.z * v.z + v.w * v.w; }
        s = wave_sum(s);
        if (lane == 0) rstd[r] = rsqrtf(s * (1.f / D) + EPS);
    }
}

__device__ __forceinline__ float half_sum(float v) {
#pragma unroll
    for (int o = 1; o < 32; o <<= 1) v += __shfl_xor(v, o);
    return v;
}
__device__ __forceinline__ float half_max(float v) {
#pragma unroll
    for (int o = 1; o < 32; o <<= 1) v = fmaxf(v, __shfl_xor(v, o));
    return v;
}
__device__ __forceinline__ void attend_key(const float* q, const float* __restrict__ kp, const float* __restrict__ vp, float& m, float& l, float (&o)[32]) {
    float s = 0.f;
#pragma unroll
    for (int c = 0; c < 4; ++c) {
#pragma unroll
        for (int i = 4 * c; i < 4 * c + 4; ++i) { float4 k4 = ((const float4*)kp)[i]; float4 q4 = ((const float4*)q)[i]; s += q4.x * k4.x + q4.y * k4.y + q4.z * k4.z + q4.w * k4.w; }
        __builtin_amdgcn_sched_barrier(0);
    }
    float mn = fmaxf(m, s), a = __expf(m - mn), p = __expf(s - mn);
    l = l * a + p;
#pragma unroll
    for (int c = 0; c < 2; ++c) {
#pragma unroll
        for (int i = 4 * c; i < 4 * c + 4; ++i) { float4 v4 = ((const float4*)vp)[i];
            o[4 * i] = o[4 * i] * a + p * v4.x; o[4 * i + 1] = o[4 * i + 1] * a + p * v4.y; o[4 * i + 2] = o[4 * i + 2] * a + p * v4.z; o[4 * i + 3] = o[4 * i + 3] * a + p * v4.w; }
        __builtin_amdgcn_sched_barrier(0);
    }
    m = mn;
}
__device__ __forceinline__ float merge_streams(float m, float l, float (&o)[32], int lane) {
    float M = half_max(m);
    float w = (m == -INFINITY) ? 0.f : __expf(m - M);
    float L = half_sum(l * w);
    float res = 0.f;
#pragma unroll
    for (int d = 0; d < 32; ++d) { float v = half_sum(o[d] * w); if ((lane & 31) == d) res = v; if ((d & 3) == 3) __builtin_amdgcn_sched_barrier(0); }
    return (L > 0.f) ? res / L : 0.f;
}

__device__ __forceinline__ void mem_attention(const float* __restrict__ qsrc, int qpitch, int qoff, const float* __restrict__ memkv  ,
                                              const float* __restrict__ q_gain, float* __restrict__ Qo, float* q  ) {
    const int lane = threadIdx.x & 63, gw = blockIdx.x * (NTHR / 64) + (threadIdx.x >> 6), ngw = gridDim.x * (NTHR / 64);
    const int li = lane & 31, hd = (lane >> 5) * 32;
    for (int item = gw; item < T * 4; item += ngw) {
        const int row = item >> 2, h = item & 3, b = row / S;
        {
            float v = qsrc[(size_t)row * qpitch + qoff + h * 64 + lane];
            const float ss = wave_sum(v * v);
            v = v * rsqrtf(ss * (1.f / 64.f) + EPS) * 0.125f * q_gain[lane];
            __builtin_amdgcn_wave_barrier();
            q[lane] = v;
            __builtin_amdgcn_s_waitcnt(0);
            __builtin_amdgcn_wave_barrier();
        }
        float m = -INFINITY, l = 0.f, o[32];
#pragma unroll
        for (int d = 0; d < 32; ++d) o[d] = 0.f;
        for (int i = 0; i < 8; ++i) {
            const float* kr = memkv + (size_t)(b * MEMN + i * 32 + li) * 512 + h * 64;
            attend_key(q, kr, kr + 256 + hd, m, l, o);
        }
        float r = merge_streams(m, l, o, lane);
        Qo[(size_t)row * D + 768 + h * 64 + lane] = r;
    }
}

__device__ __forceinline__ void peer_topk(const float* __restrict__ P, int* __restrict__ E, float* __restrict__ Gt, float* smem) {
    const int lane = threadIdx.x & 63, wv = threadIdx.x >> 6, gw = blockIdx.x * (NTHR / 64) + wv, ngw = gridDim.x * (NTHR / 64);
    float* sv = smem + wv * 128;
    float* v1 = sv; float* v2 = sv + 16; float* vals = sv + 32;
    int* i1 = (int*)(sv + 48); int* i2 = (int*)(sv + 64); int* cis = (int*)(sv + 80);
    for (int item = gw; item < T * 8; item += ngw) {
        const int t = item >> 3, h = item & 7;
        const float* sp = P + (size_t)t * PP + h * 256;
#pragma unroll
        for (int p = 0; p < 2; ++p) {
            const float sa = sp[p * 128 + lane], sb = sp[p * 128 + 64 + lane];
            int ra = 0, rb = 0;
            for (int j = 0; j < 64; ++j) {
                const float va = __shfl(sa, j), vb = __shfl(sb, j);
                ra += (va > sa || (va == sa && j < lane)) ? 1 : 0;
                ra += (vb > sa) ? 1 : 0;
                rb += (va >= sb) ? 1 : 0;
                rb += (vb > sb || (vb == sb && j < lane)) ? 1 : 0;
            }
            float* vv = p ? v2 : v1; int* ii = p ? i2 : i1;
            if (ra < 16) { vv[ra] = sa; ii[ra] = lane; }
            if (rb < 16) { vv[rb] = sb; ii[rb] = lane + 64; }
        }
        __builtin_amdgcn_s_waitcnt(0);
        __builtin_amdgcn_wave_barrier();
        float c[4]; int rk[4];
#pragma unroll
        for (int i = 0; i < 4; ++i) { const int ci = i * 64 + lane; c[i] = v1[ci >> 4] + v2[ci & 15]; rk[i] = 0; }
        for (int j = 0; j < 64; ++j) {
#pragma unroll
            for (int ii = 0; ii < 4; ++ii) {
                const float v = __shfl(c[ii], j); const int cj = ii * 64 + j;
#pragma unroll
                for (int i = 0; i < 4; ++i) { const int ci = i * 64 + lane; rk[i] += (v > c[i] || (v == c[i] && cj < ci)) ? 1 : 0; }
            }
        }
#pragma unroll
        for (int i = 0; i < 4; ++i) if (rk[i] < 16) { vals[rk[i]] = c[i]; cis[rk[i]] = i * 64 + lane; }
        __builtin_amdgcn_s_waitcnt(0);
        __builtin_amdgcn_wave_barrier();
        {
            const int l16 = lane & 15;
            const float v = vals[l16]; const int ci = cis[l16];
            float mx = v;
#pragma unroll
            for (int o = 1; o < 16; o <<= 1) mx = fmaxf(mx, __shfl_xor(mx, o));
            const float ex = expf(v - mx);
            float sm = ex;
#pragma unroll
            for (int o = 1; o < 16; o <<= 1) sm += __shfl_xor(sm, o);
            const int e = i1[ci >> 4] * 128 + i2[ci & 15];
            if (lane < 16) { E[(size_t)t * 128 + h * 16 + lane] = e; Gt[(size_t)t * 128 + h * 16 + lane] = ex / sm; }
        }
        __builtin_amdgcn_s_waitcnt(0);
        __builtin_amdgcn_wave_barrier();
    }
}

__device__ __forceinline__ void peer_gather(float* __restrict__ out, const float* __restrict__ rstd, const float* __restrict__ gain,
                                            const float* __restrict__ U, const float* __restrict__ V, const int* __restrict__ E, const float* __restrict__ Gt,
                                            float* __restrict__ rstd_next) {
    const int lane = threadIdx.x & 63, gw = blockIdx.x * (NTHR / 64) + (threadIdx.x >> 6), ngw = gridDim.x * (NTHR / 64);
    for (int t = gw; t < T; t += ngw) {
        float4 x1[4], h2[4], acc[4];
        const float rs = rstd[t];
#pragma unroll
        for (int j = 0; j < 4; ++j) {
            x1[j] = ((const float4*)(out + (size_t)t * D))[64 * j + lane];
            float4 g = ((const float4*)gain)[64 * j + lane];
            h2[j] = make_float4(x1[j].x * rs * g.x, x1[j].y * rs * g.y, x1[j].z * rs * g.z, x1[j].w * rs * g.w);
            acc[j] = make_float4(0.f, 0.f, 0.f, 0.f);
        }
        for (int idx = 0; idx < 128; ++idx) {
            const int e = E[(size_t)t * 128 + idx]; const float gt = Gt[(size_t)t * 128 + idx];
            const float4* up = (const float4*)(U + (size_t)e * D) + lane;
            const float4* vp = (const float4*)(V + (size_t)e * D) + lane;
            float4 u[4], v[4];
#pragma unroll
            for (int j = 0; j < 4; ++j) { u[j] = up[64 * j]; v[j] = vp[64 * j]; }
            float d = 0.f;
#pragma unroll
            for (int j = 0; j < 4; ++j) d += u[j].x * h2[j].x + u[j].y * h2[j].y + u[j].z * h2[j].z + u[j].w * h2[j].w;
            d = wave_sum(d);
            const float a = gelu_tanh(d) * gt;
#pragma unroll
            for (int j = 0; j < 4; ++j) { acc[j].x += a * v[j].x; acc[j].y += a * v[j].y; acc[j].z += a * v[j].z; acc[j].w += a * v[j].w; }
        }
        float ss = 0.f;
#pragma unroll
        for (int j = 0; j < 4; ++j) {
            float4 r = make_float4(x1[j].x + acc[j].x, x1[j].y + acc[j].y, x1[j].z + acc[j].z, x1[j].w + acc[j].w);
            ((float4*)(out + (size_t)t * D))[64 * j + lane] = r;
            ss += r.x * r.x + r.y * r.y + r.z * r.z + r.w * r.w;
        }
        ss = wave_sum(ss);
        if (lane == 0 && rstd_next) rstd_next[t] = rsqrtf(ss * (1.f / D) + EPS);
    }
}

__device__ __forceinline__ void load_q(float* q, const float* __restrict__ P, size_t row, int hq, const float* __restrict__ qgain, const float* __restrict__ rope_row, int lane) {
    float v = P[row * PP + 768 + hq * 64 + lane];
    const float ss = wave_sum(v * v);
    v = v * rsqrtf(ss * (1.f / 64.f) + EPS) * qgain[lane];
    const float partner = __shfl_xor(v, 8);
    if (lane < 16) { const int i = lane & 7; const float cs = rope_row[i], sn = rope_row[8 + i];
        v = (lane < 8) ? (v * cs - partner * sn) : (v * cs + partner * sn); }
    __builtin_amdgcn_wave_barrier();
    q[lane] = v * 0.125f;
    __builtin_amdgcn_s_waitcnt(0);
    __builtin_amdgcn_wave_barrier();
}

__device__ __forceinline__ void nsa_attention(const float* __restrict__ P, const float* __restrict__ KC, const float* __restrict__ VC, const float* __restrict__ KS,
                                              const float* __restrict__ KW, const float* __restrict__ rope, const float* __restrict__ qgain,
                                              const float* __restrict__ gate_b, float* __restrict__ Qo, float* q, float* pbuf) {
    const int lane = threadIdx.x & 63, gw = blockIdx.x * (NTHR / 64) + (threadIdx.x >> 6), ngw = gridDim.x * (NTHR / 64);
    const int li = lane & 31, hd = (lane >> 5) * 32;
    for (int item = gw; item < NB * 2 * S; item += ngw) {
        const int t = item % S, g = (item / S) & 1, b = item / (2 * S);
        const size_t row = (size_t)b * S + t;
        const int c = t >> 6;
        const float* rope_row = rope + (size_t)t * 16;
        const float* kc = KC + (size_t)(b * 2 + g) * NCMP * 64;
        const float* vc = VC + (size_t)(b * 2 + g) * NCMP * 64;
        float ocmp[6];
        float imp = 0.f;
#pragma unroll 1
        for (int r = 0; r < 6; ++r) {
            load_q(q, P, row, g * 6 + r, qgain, rope_row, lane);
            float sc[8];
            float mx = -INFINITY;
#pragma unroll
            for (int i = 0; i < 8; ++i) {
                const int n = li + 32 * i;
                const bool ok = (n < NCMP) && (16 * n + 31 <= t);
                float a = -INFINITY;
                if (ok) {
                    a = 0.f;
                    const float4* kp = (const float4*)(kc + (size_t)n * 64);
#pragma unroll
                    for (int k = 0; k < 16; ++k) { float4 k4 = kp[k]; float4 q4 = ((const float4*)q)[k]; a += q4.x * k4.x + q4.y * k4.y + q4.z * k4.z + q4.w * k4.w;
                        if ((k & 3) == 3) __builtin_amdgcn_sched_barrier(0); }
                }
                sc[i] = a;
                mx = fmaxf(mx, a);
            }
            mx = half_max(mx);
            float ls = 0.f;
#pragma unroll
            for (int i = 0; i < 8; ++i) { sc[i] = (sc[i] == -INFINITY) ? 0.f : __expf(sc[i] - mx); ls += sc[i]; }
            ls = half_sum(ls);
            const float inv = (ls > 0.f) ? 1.f / ls : 0.f;
            float ol[32];
#pragma unroll
            for (int d = 0; d < 32; ++d) ol[d] = 0.f;
            __builtin_amdgcn_wave_barrier();
#pragma unroll
            for (int i = 0; i < 8; ++i) {
                const int n = li + 32 * i;
                const float pn = sc[i] * inv;
                if (lane < 32) pbuf[n] = pn;
                if (pn != 0.f) {
                    const float4* vp = (const float4*)(vc + (size_t)n * 64 + hd);
#pragma unroll
                    for (int k = 0; k < 8; ++k) { float4 v4 = vp[k]; ol[4 * k] += pn * v4.x; ol[4 * k + 1] += pn * v4.y; ol[4 * k + 2] += pn * v4.z; ol[4 * k + 3] += pn * v4.w;
                        if ((k & 3) == 3) __builtin_amdgcn_sched_barrier(0); }
                }
            }
            float res = 0.f;
#pragma unroll
            for (int d = 0; d < 32; ++d) { float v = half_sum(ol[d]); if (li == d) res = v; if ((d & 3) == 3) __builtin_amdgcn_sched_barrier(0); }
            ocmp[r] = res;
            __builtin_amdgcn_s_waitcnt(0);
            __builtin_amdgcn_wave_barrier();
            {
                const float4 p4 = ((const float4*)pbuf)[lane];
                const float pprev = (lane > 0) ? pbuf[4 * lane - 1] : 0.f;
                imp += p4.x + p4.y + p4.z + 0.5f * p4.w + 0.5f * pprev;
            }
            __builtin_amdgcn_s_waitcnt(0);
            __builtin_amdgcn_wave_barrier();
        }
        unsigned long long selmask;
        {
            const int j = lane;
            const bool valid = j <= c;
            const bool forced = (j == 0) || (j == c) || (j == c - 1);
            float v = forced ? 1e4f : imp;
            v = valid ? v : -1.f;
            int rank = 0;
            for (int jj = 0; jj < 64; ++jj) { const float o = __shfl(v, jj); rank += (o > v || (o == v && jj < j)) ? 1 : 0; }
            selmask = __ballot(rank < 16 && v >= 0.f);
        }
        const float* ks = KS + (size_t)(b * 2 + g) * S * 64;
        const float* kw = KW + (size_t)(b * 2 + g) * S * 64;
        const float* vs = P + (size_t)b * S * PP + 1 * 256 + 128 + g * 64 + hd;
        const float* vw = P + (size_t)b * S * PP + 2 * 256 + 128 + g * 64 + hd;
#pragma unroll 1
        for (int r = 0; r < 6; ++r) {
            const int hq = g * 6 + r;
            load_q(q, P, row, hq, qgain, rope_row, lane);
            float o[32];
            float m = -INFINITY, l = 0.f;
#pragma unroll
            for (int d = 0; d < 32; ++d) o[d] = 0.f;
            for (int jb = 0; jb <= c; ++jb) {
                if ((selmask >> jb) & 1ull) {
#pragma unroll 1
                    for (int sub = 0; sub < 2; ++sub) {
                        const int sidx = jb * 64 + sub * 32 + li;
                        if (sidx <= t) attend_key(q, ks + (size_t)sidx * 64, vs + (size_t)sidx * PP, m, l, o);
                    }
                }
            }
            const float osel = merge_streams(m, l, o, lane);
            m = -INFINITY; l = 0.f;
#pragma unroll
            for (int d = 0; d < 32; ++d) o[d] = 0.f;
            {
                const int s0 = (t - 511 > 0) ? (t - 511) : 0;
                for (int sidx = s0 + li; sidx <= t; sidx += 32) attend_key(q, kw + (size_t)sidx * 64, vw + (size_t)sidx * PP, m, l, o);
            }
            const float owin = merge_streams(m, l, o, lane);
            const float* gl = P + row * PP + 1536 + hq * 3;
            const float g0 = sigmoidf_(gl[0] + gate_b[hq * 3 + 0]), g1 = sigmoidf_(gl[1] + gate_b[hq * 3 + 1]), g2 = sigmoidf_(gl[2] + gate_b[hq * 3 + 2]);
            Qo[row * D + hq * 64 + lane] = g0 * ocmp[r] + g1 * osel + g2 * owin;
        }
    }
}

template <int LO, int HI>
__global__ void __launch_bounds__(NTHR) fwd_kernel(Params p) {
    cg::grid_group grid = cg::this_grid();
    extern __shared__ __attribute__((aligned(16))) float smem[];
    const int tid = threadIdx.x, lane = tid & 63, wv = tid >> 6;
    const int gw = blockIdx.x * (NTHR / 64) + wv, ngw = gridDim.x * (NTHR / 64);
    const int gtid = blockIdx.x * NTHR + tid, ngt = gridDim.x * NTHR;

    const float* x = p.in[0]; const float* mem = p.in[1]; const int* positions = (const int*)p.in[2];
    const float* norm_mix = p.in[3]; const float* norm_ffn = p.in[4]; const float* norm_mem = p.in[5];
    const float* w_out = p.in[6]; const float* w_mem_kv = p.in[7]; const float* mem_q_gain = p.in[8]; const float* mem_k_gain = p.in[9];
    const float* a_w_in = p.in[10]; const float* a_conv_w = p.in[11]; const float* a_conv_b = p.in[12]; const float* a_gate_w = p.in[13];
    const float* a_gate_b = p.in[14]; const float* a_lambda = p.in[15]; const float* b_w_in = p.in[16]; const float* b_gate_b = p.in[17];
    const float* b_q_gain = p.in[18]; const float* kv_norm = p.in[19]; const float* w_kv_shared = p.in[20]; const float* k_gain_shared = p.in[21];
    const float* cmp_pos = p.in[22]; const float* cmp_w1 = p.in[23]; const float* cmp_b1 = p.in[24]; const float* cmp_w2 = p.in[25];
    const float* peer_wq = p.in[26]; const float* peer_subkeys = p.in[27]; const float* peer_u = p.in[28]; const float* peer_v = p.in[29];
    float* out = p.out;
    unsigned char* ws = p.ws;
    float* P = (float*)(ws + WS_P); float* Q = (float*)(ws + WS_Q);
    int* E = (int*)(ws + WS_E); float* Gt = (float*)(ws + WS_GT);
    float* KS = (float*)(ws + WS_KS); float* KW = (float*)(ws + WS_KW);
    float* WF = (float*)(ws + WS_WF); float* MEMKV = (float*)(ws + WS_MEMKV);
    float* HID = (float*)(ws + WS_HID); float* KC = (float*)(ws + WS_KC); float* VC = (float*)(ws + WS_VC);
    float* RSTD = (float*)(ws + WS_RSTD); float* ROPE = (float*)(ws + WS_ROPE);
    float* rstd0 = RSTD, *rstd1 = RSTD + T, *rstd2 = RSTD + 2 * T, *rstd3 = RSTD + 3 * T, *rstdm = RSTD + 4 * T;

    constexpr int lo = LO, hi = HI;
    int ph = 0;
#define PHASE_BEGIN if (ph >= lo && ph < hi) {
#define PHASE_END } ++ph; if (ph > lo && ph < hi) grid.sync();

    PHASE_BEGIN
        rows_rstd(x, T, rstd0);
        rows_rstd(mem, NB * MEMN, rstdm);
        for (int i = gtid; i < S * 8; i += ngt) {
            const int s = i >> 3, k = i & 7;
            const float freq = powf(500000.0f, -(float)k / 8.0f);
            const float ang = (float)positions[s] * freq;
            ROPE[s * 16 + k] = cosf(ang); ROPE[s * 16 + 8 + k] = sinf(ang);
        }
        for (int item = blockIdx.x; item < 2 * 16 * 16; item += gridDim.x) {
            const int l = item >> 8, hp = (item >> 4) & 15, kt = item & 15;
            const float* sk = peer_subkeys + ((size_t)l * 16 + hp) * 128 * 128;
            __syncthreads();
            for (int i = tid; i < 128 * 128; i += NTHR) smem[(i >> 7) * 129 + (i & 127)] = sk[i];
            __syncthreads();
            const int n = tid & 127, ksub = tid >> 7;
#pragma unroll 1
            for (int kk = 0; kk < 16; ++kk) {
                const int k = kt * 64 + kk * 4 + ksub;
                const float* wq = peer_wq + ((size_t)l * D + k) * 2048 + hp * 128;
                float acc = 0.f;
#pragma unroll 8
                for (int d = 0; d < 128; ++d) acc = fmaf(wq[d], smem[n * 129 + d], acc);
                WF[((size_t)l * D + k) * 2048 + hp * 128 + n] = acc * norm_ffn[l * D + k];
            }
        }
    PHASE_END

    PHASE_BEGIN
        gemm_f32(smem, T, 1792, D, a_w_in, 1792,
            [&](int m, int k) { float4 v = *(const float4*)(x + (size_t)m * D + k); float4 g = *(const float4*)(norm_mix + k); float r = rstd0[m];
                                return make_float4(v.x * r * g.x, v.y * r * g.y, v.z * r * g.z, v.w * r * g.w); },
            [&](int m, int n, float4 v) { *(float4*)(P + (size_t)m * PP + n) = v; });
        for (int l = 0; l < 2; ++l)
            gemm_f32(smem, NB * MEMN, 512, D, w_mem_kv + (size_t)l * D * 512, 512,
                [&](int m, int k) { float4 v = *(const float4*)(mem + (size_t)m * D + k); float4 g = *(const float4*)(norm_mem + l * D + k); float r = rstdm[m];
                                    return make_float4(v.x * r * g.x, v.y * r * g.y, v.z * r * g.z, v.w * r * g.w); },
                [&](int m, int n, float4 v) { *(float4*)(MEMKV + ((size_t)l * 2048 + m) * 512 + n) = v; });
    PHASE_END

    PHASE_BEGIN
        for (size_t i = gtid; i < (size_t)T * LRUW; i += ngt) {
            const int row = (int)(i / LRUW), c = (int)(i % LRUW), s = row % S;
            float acc = a_conv_b[c];
#pragma unroll
            for (int k = 0; k < 4; ++k) { const int ss = s - 3 + k; if (ss >= 0) acc += a_conv_w[k * LRUW + c] * P[(size_t)(row - 3 + k) * PP + c]; }
            Q[(size_t)row * D + c] = acc;
        }
        for (int item = gw; item < 2 * 2048 * 4; item += ngw) {
            const int l = item / (2048 * 4), rem = item % (2048 * 4), m = rem >> 2, h = rem & 3;
            float* kp = MEMKV + ((size_t)l * 2048 + m) * 512 + h * 64;
            const float v = kp[lane];
            const float ss = wave_sum(v * v);
            kp[lane] = v * rsqrtf(ss * (1.f / 64.f) + EPS) * mem_k_gain[l * 64 + lane];
        }
    PHASE_END

    PHASE_BEGIN
        for (int item = gw; item < NB * NBLK; item += ngw) {
            const int b = item / NBLK, n = item % NBLK, c = n * 64 + lane;
            float wr[64], wi[64];
#pragma unroll
            for (int d = 0; d < 64; ++d) { wr[d] = a_gate_w[((size_t)(0 * NBLK + n) * 64 + d) * 64 + lane]; wi[d] = a_gate_w[((size_t)(1 * NBLK + n) * 64 + d) * 64 + lane]; }
            const float brr = a_gate_b[c], bii = a_gate_b[LRUW + c];
            const float lam = a_lambda[c];
            const float sp = (-lam > 20.f) ? -lam : log1pf(expf(-lam));
            float h = 0.f;
            for (int s = 0; s < S; ++s) {
                const size_t row = (size_t)b * S + s;
                const float4* xr = (const float4*)(Q + row * D + n * 64);
                float gr = brr, gi = bii;
#pragma unroll
                for (int k = 0; k < 16; ++k) { float4 v = xr[k];
                    gr += v.x * wr[4 * k] + v.y * wr[4 * k + 1] + v.z * wr[4 * k + 2] + v.w * wr[4 * k + 3];
                    gi += v.x * wi[4 * k] + v.y * wi[4 * k + 1] + v.z * wi[4 * k + 2] + v.w * wi[4 * k + 3];
                    if ((k & 3) == 3) __builtin_amdgcn_sched_barrier(0); }
                const float xt = Q[row * D + c];
                const float rg = sigmoidf_(gr), ig = sigmoidf_(gi);
                const float log_a = -8.0f * rg * sp;
                const float a = expf(log_a);
                const float mult = sqrtf(-expm1f(2.0f * log_a));
                h = a * h + mult * (ig * xt);
                const float yb = P[row * PP + 768 + c];
                P[row * PP + c] = h * gelu_tanh(yb);
            }
        }
        mem_attention(P, PP, 1536, MEMKV, mem_q_gain, Q, smem + wv * 64);
    PHASE_END

    PHASE_BEGIN
        gemm_f32(smem, T, D, D, w_out, D,
            [&](int m, int k) { return (k < 768) ? *(const float4*)(P + (size_t)m * PP + k) : *(const float4*)(Q + (size_t)m * D + k); },
            [&](int m, int n, float4 v) { float4 r = *(const float4*)(x + (size_t)m * D + n); *(float4*)(out + (size_t)m * D + n) = make_float4(r.x + v.x, r.y + v.y, r.z + v.z, r.w + v.w); });
    PHASE_END

    PHASE_BEGIN
        rows_rstd(out, T, rstd1);
    PHASE_END

    PHASE_BEGIN
        gemm_f32(smem, T, 2048, D, WF, 2048,
            [&](int m, int k) { float4 v = *(const float4*)(out + (size_t)m * D + k); float r = rstd1[m]; return make_float4(v.x * r, v.y * r, v.z * r, v.w * r); },
            [&](int m, int n, float4 v) { *(float4*)(P + (size_t)m * PP + n) = v; });
    PHASE_END

    PHASE_BEGIN
        peer_topk(P, E, Gt, smem);
    PHASE_END

    PHASE_BEGIN
        peer_gather(out, rstd1, norm_ffn, peer_u, peer_v, E, Gt, rstd2);
    PHASE_END

    PHASE_BEGIN
        gemm_f32(smem, T, 768, D, w_kv_shared, 768,
            [&](int m, int k) { float4 v = *(const float4*)(out + (size_t)m * D + k); float4 g = *(const float4*)(kv_norm + k); float r = rstd2[m];
                                return make_float4(v.x * r * g.x, v.y * r * g.y, v.z * r * g.z, v.w * r * g.w); },
            [&](int m, int n, float4 v) { *(float4*)(P + (size_t)m * PP + n) = v; });
        gemm_f32(smem, T, 1060, D, b_w_in, 1060,
            [&](int m, int k) { float4 v = *(const float4*)(out + (size_t)m * D + k); float4 g = *(const float4*)(norm_mix + D + k); float r = rstd2[m];
                                return make_float4(v.x * r * g.x, v.y * r * g.y, v.z * r * g.z, v.w * r * g.w); },
            [&](int m, int n, float4 v) { *(float4*)(P + (size_t)m * PP + 768 + n) = v; });
    PHASE_END

    PHASE_BEGIN
        for (int item = gw; item < T * 4; item += ngw) {
            const int row = item >> 2, g = (item >> 1) & 1, br = 1 + (item & 1);
            const int b = row / S, s = row % S;
            float v = P[(size_t)row * PP + br * 256 + g * 64 + lane];
            const float ss = wave_sum(v * v);
            v = v * rsqrtf(ss * (1.f / 64.f) + EPS) * k_gain_shared[br * 64 + lane];
            const float partner = __shfl_xor(v, 8);
            if (lane < 16) { const int i = lane & 7; const float cs = ROPE[s * 16 + i], sn = ROPE[s * 16 + 8 + i];
                v = (lane < 8) ? (v * cs - partner * sn) : (v * cs + partner * sn); }
            float* dst = (br == 1) ? KS : KW;
            dst[((size_t)(b * 2 + g) * S + s) * 64 + lane] = v;
        }
        {
            const int slot = tid >> 8, cch = tid & 255;
            float* blk = smem + slot * 4 * 2048;
            const int ngroups = 2 * NB * 2 * 64;
            for (int grp = blockIdx.x * 2 + slot; grp < ngroups + 2; grp += gridDim.x * 2) {
                const bool active = grp < ngroups;
                const int j = grp / (NB * 2 * 64), rem = grp % (NB * 2 * 64), b = rem / 128, g = (rem / 64) & 1, n0 = (rem & 63) * 4;
                __syncthreads();
                if (active) {
                    for (int i = cch; i < 4 * 2048; i += 256) {
                        const int q = i >> 11, k = i & 2047, l = k >> 6, d = k & 63, n = n0 + q;
                        float v = 0.f;
                        if (n < NCMP) v = P[(size_t)(b * S + 16 * n + l) * PP + 0 * 256 + j * 128 + g * 64 + d] + cmp_pos[(j * 32 + l) * 64 + d];
                        blk[i] = v;
                    }
                }
                __syncthreads();
                if (active) {
                    float acc[4] = {0.f, 0.f, 0.f, 0.f};
                    const float* w1 = cmp_w1 + (size_t)j * 2048 * 256 + cch;
                    for (int k = 0; k < 2048; ++k) { const float w = w1[(size_t)k * 256];
#pragma unroll
                        for (int q = 0; q < 4; ++q) acc[q] = fmaf(blk[q * 2048 + k], w, acc[q]); }
                    const float bb = cmp_b1[j * 256 + cch];
#pragma unroll
                    for (int q = 0; q < 4; ++q) { const int n = n0 + q; if (n < NCMP) HID[((size_t)j * 4080 + (size_t)(b * NCMP + n) * 2 + g) * 256 + cch] = gelu_tanh(acc[q] + bb); }
                }
            }
        }
    PHASE_END

    PHASE_BEGIN
        for (int item = gw; item < 2 * 4080; item += ngw) {
            const int j = item / 4080, it = item % 4080, g = it & 1, bn = it >> 1, b = bn / NCMP, n = bn % NCMP;
            const float* hp = HID + ((size_t)j * 4080 + it) * 256;
            const float* w2 = cmp_w2 + (size_t)j * 256 * 64 + lane;
            float acc = 0.f;
            for (int cc = 0; cc < 256; ++cc) acc = fmaf(hp[cc], w2[cc * 64], acc);
            if (j == 0) {
                const float ss = wave_sum(acc * acc);
                float v = acc * rsqrtf(ss * (1.f / 64.f) + EPS) * k_gain_shared[0 * 64 + lane];
                const float partner = __shfl_xor(v, 8);
                const int sp = 16 * n + 31;
                if (lane < 16) { const int i = lane & 7; const float cs = ROPE[sp * 16 + i], sn = ROPE[sp * 16 + 8 + i];
                    v = (lane < 8) ? (v * cs - partner * sn) : (v * cs + partner * sn); }
                KC[((size_t)(b * 2 + g) * NCMP + n) * 64 + lane] = v;
            } else {
                VC[((size_t)(b * 2 + g) * NCMP + n) * 64 + lane] = acc;
            }
        }
    PHASE_END

    PHASE_BEGIN
        nsa_attention(P, KC, VC, KS, KW, ROPE, b_q_gain, b_gate_b, Q, smem + wv * 64, smem + 512 + wv * 256);
        mem_attention(P, PP, 768 + 804, MEMKV + (size_t)2048 * 512, mem_q_gain + 64, Q, smem + wv * 64);
    PHASE_END

    PHASE_BEGIN
        gemm_f32(smem, T, D, D, w_out + (size_t)D * D, D,
            [&](int m, int k) { return *(const float4*)(Q + (size_t)m * D + k); },
            [&](int m, int n, float4 v) { float4 r = *(const float4*)(out + (size_t)m * D + n); *(float4*)(out + (size_t)m * D + n) = make_float4(r.x + v.x, r.y + v.y, r.z + v.z, r.w + v.w); });
    PHASE_END

    PHASE_BEGIN
        rows_rstd(out, T, rstd3);
    PHASE_END

    PHASE_BEGIN
        gemm_f32(smem, T, 2048, D, WF + (size_t)D * 2048, 2048,
            [&](int m, int k) { float4 v = *(const float4*)(out + (size_t)m * D + k); float r = rstd3[m]; return make_float4(v.x * r, v.y * r, v.z * r, v.w * r); },
            [&](int m, int n, float4 v) { *(float4*)(P + (size_t)m * PP + n) = v; });
    PHASE_END

    PHASE_BEGIN
        peer_topk(P, E, Gt, smem);
    PHASE_END

    PHASE_BEGIN
        peer_gather(out, rstd3, norm_ffn + D, peer_u + (size_t)16384 * D, peer_v + (size_t)16384 * D, E, Gt, nullptr);
    PHASE_END
#undef PHASE_BEGIN
#undef PHASE_END
}

constexpr int N_PHASES = 18;
constexpr int LDS_BYTES = 24576 * 4;

template <int PH>
static void launch_phases(const Params& p, int grid, hipStream_t stream) {
    if constexpr (PH < N_PHASES) {
        static bool attr_set = false;
        if (!attr_set) { (void)hipFuncSetAttribute((const void*)fwd_kernel<PH, PH + 1>, hipFuncAttributeMaxDynamicSharedMemorySize, LDS_BYTES); attr_set = true; }
        hipLaunchKernelGGL((fwd_kernel<PH, PH + 1>), dim3(grid), dim3(NTHR), LDS_BYTES, stream, p);
        launch_phases<PH + 1>(p, grid, stream);
    }
}

extern "C" void kernel_launch(void* const* d_in, const int* in_sizes, int n_in, void* d_out, int out_size, void* d_ws, size_t ws_size, hipStream_t stream) {
    static int grid = 0;
    if (grid == 0) {
        if (n_in != 30 || out_size != T * D || ws_size < WS_END) { fprintf(stderr, "kernel_launch: unexpected shapes n_in %d out %d ws %zu\n", n_in, out_size, ws_size); grid = -1; return; }
        int dev = 0, cus = 0;
        (void)hipGetDevice(&dev);
        (void)hipDeviceGetAttribute(&cus, hipDeviceAttributeMultiprocessorCount, dev);
        grid = cus > 0 ? cus : 256;
    }
    if (grid < 0) return;
    Params p{};
    for (int i = 0; i < 30; ++i) p.in[i] = (const float*)d_in[i];
    p.out = (float*)d_out; p.ws = (unsigned char*)d_ws; p.ph_lo = 0; p.ph_hi = N_PHASES;
    launch_phases<0>(p, grid, stream);
}
```

```cpp
#include <hip/hip_runtime.h>
#include <hip/hip_cooperative_groups.h>
#include <cstdio>
#include <cstdint>
namespace cg = cooperative_groups;

constexpr int NB = 8, S = 4096, D = 1024, T = NB * S;
constexpr int MEMN = 256;
constexpr int LRUW = 768, NBLK = 12;
constexpr int NCMP = 255;
constexpr int PP = 2048;
constexpr int NTHR = 512;
constexpr float EPS = 1e-6f;
constexpr int NCHUNK = 64, CHL = 64;

typedef unsigned short bf16;
typedef unsigned u32x4 __attribute__((ext_vector_type(4)));
typedef unsigned u32x2 __attribute__((ext_vector_type(2)));
typedef __bf16 bf16x2_t __attribute__((ext_vector_type(2)));
typedef __bf16 bf16x8_t __attribute__((ext_vector_type(8)));
#define LAS __attribute__((address_space(3)))

constexpr size_t MiB = 1ull << 20;
constexpr size_t WS_CTL = 0;
constexpr size_t WS_RSTD = 1 * MiB;
constexpr size_t WS_ROPE = 2 * MiB;
constexpr size_t WS_BIAS2 = 2 * MiB + 512 * 1024;
constexpr size_t WS_WIN0 = 3 * MiB;
constexpr size_t WS_WOUT = 7 * MiB;
constexpr size_t WS_WF = 11 * MiB;
constexpr size_t WS_WKVB = 19 * MiB;
constexpr size_t WS_WMEM = 23 * MiB;
constexpr size_t WS_WC1 = 25 * MiB;
constexpr size_t WS_MEMB = 27 * MiB;
constexpr size_t WS_MEMKV = 31 * MiB;
constexpr size_t WS_SSQ1 = 35 * MiB;
constexpr size_t WS_SSQ3 = 37 * MiB;
constexpr size_t WS_SCAN = 39 * MiB;
constexpr size_t WS_HID = 42 * MiB;
constexpr size_t WS_KC = 46 * MiB;
constexpr size_t WS_VC = 47 * MiB;
constexpr size_t WS_CA = 48 * MiB;
constexpr size_t WS_E = 80 * MiB;
constexpr size_t WS_GT = 96 * MiB;
constexpr size_t WS_KS = 80 * MiB;
constexpr size_t WS_KW = 88 * MiB;
constexpr size_t WS_XB = 112 * MiB;
constexpr size_t WS_AIN = 176 * MiB;
constexpr size_t WS_P = 240 * MiB;
constexpr size_t WS_UT = 368 * MiB;
constexpr size_t WS_VT = 432 * MiB;
constexpr size_t WS_END = 496 * MiB;

struct Params {
    const float* in[30];
    float* out;
    unsigned char* ws;
    int ph_lo, ph_hi;
};

__device__ __forceinline__ float wave_sum(float v) {
#pragma unroll
    for (int o = 1; o < 64; o <<= 1) v += __shfl_xor(v, o);
    return v;
}
__device__ __forceinline__ float half_sum(float v) {
#pragma unroll
    for (int o = 1; o < 32; o <<= 1) v += __shfl_xor(v, o);
    return v;
}
__device__ __forceinline__ float half_max(float v) {
#pragma unroll
    for (int o = 1; o < 32; o <<= 1) v = fmaxf(v, __shfl_xor(v, o));
    return v;
}
__device__ __forceinline__ float gelu_tanh(float x) {
    const float k0 = 0.7978845608028654f, k1 = 0.044715f;
    float u = k0 * (x + k1 * x * x * x);
    float e = __expf(2.f * u);
    float th = 1.f - 2.f / (e + 1.f);
    return 0.5f * x * (1.f + th);
}
__device__ __forceinline__ float sigmoidf_(float x) { return 1.f / (1.f + __expf(-x)); }
__device__ __forceinline__ unsigned f2bf(float f) { unsigned u = __builtin_bit_cast(unsigned, f); return (u + 0x7fffu + ((u >> 16) & 1u)) >> 16; }
__device__ __forceinline__ unsigned pk2(float lo, float hi) { return f2bf(lo) | (f2bf(hi) << 16); }
__device__ __forceinline__ float bf2f(unsigned h) { return __builtin_bit_cast(float, h << 16); }
__device__ __forceinline__ float bflo(unsigned w) { return __builtin_bit_cast(float, w << 16); }
__device__ __forceinline__ float bfhi(unsigned w) { return __builtin_bit_cast(float, w & 0xffff0000u); }
__device__ __forceinline__ float ldbf(const bf16* p) { return bf2f((unsigned)*p); }
__device__ __forceinline__ float rstd_from_parts(const float* ssq16) {
    const float4 a = ((const float4*)ssq16)[0], b = ((const float4*)ssq16)[1], c = ((const float4*)ssq16)[2], d = ((const float4*)ssq16)[3];
    const float s = ((a.x + a.y) + (a.z + a.w)) + ((b.x + b.y) + (b.z + b.w)) + ((c.x + c.y) + (c.z + c.w)) + ((d.x + d.y) + (d.z + d.w));
    return rsqrtf(s * (1.f / 1024.f) + EPS);
}
namespace pg8 {
#define PG8_LAS __attribute__((address_space(3)))
typedef unsigned short bf16_t;
typedef short bf16x8 __attribute__((ext_vector_type(8)));
typedef float f32x4 __attribute__((ext_vector_type(4)));
typedef unsigned u32x4 __attribute__((ext_vector_type(4)));
constexpr int BM = 256, BK = 64, HALF = 128, HTB = HALF * BK * 2  , STAGE_BYTES = 8 * HTB, NXCD = 8, WGM = 8;

__host__ __device__ __forceinline__ int lds_byte(int r, int c) { const int st = (r >> 4) * 2 + (c >> 5), rr = r & 15, cc = c & 31, ob = rr * 64 + cc * 2; return st * 1024 + (ob ^ (((ob >> 9) & 1) << 5)); }
__host__ __device__ __forceinline__ void stage_rc(int b, int& R, int& C) { const int st = b / 1024, sb = b % 1024, swz = sb ^ (((sb >> 9) & 1) << 5); R = (st >> 1) * 16 + swz / 64; C = (st & 1) * 32 + (swz % 64) / 2; }
__host__ __device__ __forceinline__ int perm32(int rho) { const int n = rho >> 4, i = rho & 15; return 8 * (i >> 2) + 4 * n + (i & 3); }

struct Unit { int pm, pn; };
struct Gemm { const bf16_t* A; const bf16_t* Bt; int M, N, K; };

struct StaticOrder {
    int nM, nN, nwg, G, c;
    __host__ __device__ void init(int M, int N, int G_, int c_) { nM = M / BM; nN = N / BM; nwg = nM * nN; G = G_; c = c_; }
    __host__ __device__ bool next(int i, Unit& u) const {
        const long L = (long)i * G + c; if (L >= nwg) return false;
        int wgid = (int)L; { const int q = nwg / NXCD, r = nwg % NXCD, xcd = wgid % NXCD, off = wgid / NXCD; wgid = (xcd < r ? xcd * (q + 1) : r * (q + 1) + (xcd - r) * q) + off; }
        const int nig = WGM * nN, gid = wgid / nig, fm = gid * WGM, gsz = (nM - fm) < WGM ? (nM - fm) : WGM;
        u.pm = fm + ((wgid % nig) % gsz); u.pn = (wgid % nig) / gsz; return true;
    }
    __device__ __forceinline__ void a_ready(const Unit&) const {}
    __device__ __forceinline__ void done(const Unit&) const {}
};

__device__ __forceinline__ unsigned cvt_pk_bf16(float lo, float hi) { unsigned r; asm volatile("v_cvt_pk_bf16_f32 %0, %1, %2" : "=v"(r) : "v"(lo), "v"(hi)); return r; }
typedef float f32x2 __attribute__((ext_vector_type(2)));
template <class Epi, class Sched, bool ALIGN_EPI = false, bool SP2 = false>
__device__ __forceinline__ void gemm_phase(PG8_LAS unsigned char* lds, const Gemm g, const Sched& S, const Epi& E) {
    const int tid = threadIdx.x, wid = __builtin_amdgcn_readfirstlane(tid >> 6), lane = tid & 63, wr = wid >> 2, wc = wid & 3, fr = lane & 15, fq = lane >> 4;
    const int K = g.K, nt = K / BK;
    unsigned voffA[2], voffB[2];
#pragma unroll
    for (int i = 0; i < 2; ++i) { int R, C; stage_rc(tid * 16 + i * 8192, R, C); const int Rb = Epi::PERM ? ((R & ~31) + perm32(R & 31)) : R;
        voffA[i] = (unsigned)(R * K + C) * 2u; voffB[i] = (unsigned)(Rb * K + C) * 2u; }
    const size_t kstep = (size_t)(BK * 2);
    const size_t hstep = (size_t)HALF * K * 2;
    const size_t tstep = 2 * hstep;
    const unsigned ldsw = (unsigned)wid * 1024u;
    const int aoff = lds_byte(wr * 64 + fr, fq * 8), boff = lds_byte(wc * 32 + fr, fq * 8);
#define PG8_SA(b, h) (((b) * 2 + (h)) * HTB)
#define PG8_SB(b, h) ((4 + (b) * 2 + (h)) * HTB)
#define PG8_STAGE(bufoff, gbase, voff) do { _Pragma("unroll") for (int _i = 0; _i < 2; ++_i) \
        __builtin_amdgcn_global_load_lds((const unsigned*)((const char*)(gbase) + (voff)[_i]), (PG8_LAS unsigned*)(lds + (bufoff) + ldsw + _i * 8192), 16, 0, 0); } while (0)
#define PG8_LDA(dst, b, h) do { _Pragma("unroll") for (int m = 0; m < 4; ++m) _Pragma("unroll") for (int k = 0; k < 2; ++k) dst[m][k] = *(const PG8_LAS bf16x8*)(lds + PG8_SA(b, h) + aoff + m * 2048 + k * 1024); } while (0)
#define PG8_LDB(dst, b, h) do { _Pragma("unroll") for (int n = 0; n < 2; ++n) _Pragma("unroll") for (int k = 0; k < 2; ++k) dst[n][k] = *(const PG8_LAS bf16x8*)(lds + PG8_SB(b, h) + boff + n * 2048 + k * 1024); } while (0)
#define PG8_MMA(ai, bj, At, Bt) do { __builtin_amdgcn_s_setprio(1); _Pragma("unroll") for (int m = 0; m < 4; ++m) _Pragma("unroll") for (int n = 0; n < 2; ++n) _Pragma("unroll") for (int k = 0; k < 2; ++k) \
        acc[ai][bj][m][n] = __builtin_amdgcn_mfma_f32_16x16x32_bf16(Bt[n][k], At[m][k], acc[ai][bj][m][n], 0, 0, 0); __builtin_amdgcn_s_setprio(0); } while (0)
#define PG8_WAIT_V(n) asm volatile("s_waitcnt vmcnt(" #n ")" ::: "memory")
#define PG8_WAIT_L(n) asm volatile("s_waitcnt lgkmcnt(" #n ")" ::: "memory")
#define PG8_BAR __builtin_amdgcn_s_barrier()
#define PG8_SCHED __builtin_amdgcn_sched_barrier(0)
    Unit cur, nxt; int ui = 0;
    if (!S.next(0, cur)) return;
    f32x4 acc[2][2][4][2];
#pragma unroll
    for (int a = 0; a < 2; ++a)
#pragma unroll
        for (int b = 0; b < 2; ++b)
#pragma unroll
            for (int m = 0; m < 4; ++m)
#pragma unroll
                for (int n = 0; n < 2; ++n) acc[a][b][m][n] = (f32x4){0.f, 0.f, 0.f, 0.f};
    bf16x8 At[4][2], B0[2][2], B1[2][2];
    const char* cA = (const char*)g.A + (size_t)cur.pm * tstep; const char* cB = (const char*)g.Bt + (size_t)cur.pn * tstep;
    S.a_ready(cur);
    if constexpr (SP2) {
        PG8_STAGE(PG8_SB(0, 0), cB, voffB); PG8_STAGE(PG8_SB(0, 1), cB + hstep, voffB); PG8_STAGE(PG8_SA(0, 0), cA, voffA); PG8_STAGE(PG8_SA(0, 1), cA + hstep, voffA);
        if (wr == 1) PG8_BAR;
        PG8_WAIT_V(2); PG8_BAR;
        PG8_STAGE(PG8_SB(1, 0), cB + kstep, voffB); PG8_STAGE(PG8_SA(1, 0), cA + kstep, voffA); PG8_STAGE(PG8_SB(1, 1), cB + hstep + kstep, voffB);
        PG8_WAIT_V(6); PG8_BAR;
    } else {
        PG8_STAGE(PG8_SB(0, 0), cB, voffB); PG8_STAGE(PG8_SA(0, 0), cA, voffA); PG8_STAGE(PG8_SB(0, 1), cB + hstep, voffB); PG8_STAGE(PG8_SA(0, 1), cA + hstep, voffA);
        if (wr == 1) PG8_BAR;
        PG8_WAIT_V(4); PG8_BAR;
        PG8_STAGE(PG8_SB(1, 0), cB + kstep, voffB); PG8_STAGE(PG8_SA(1, 0), cA + kstep, voffA); PG8_STAGE(PG8_SB(1, 1), cB + hstep + kstep, voffB);
        PG8_WAIT_V(6); PG8_BAR;
    }
    for (;;) {
        const bool has_next = S.next(ui + 1, nxt);
        const char* nA = has_next ? (const char*)g.A + (size_t)nxt.pm * tstep : cA; const char* nB = has_next ? (const char*)g.Bt + (size_t)nxt.pn * tstep : cB;
        for (int t = 0; t < nt; t += 2) {
            const bool last = (t == nt - 2);
            const char* a1 = cA + (size_t)(t + 1) * kstep;
            const char* a2 = last ? nA : cA + (size_t)(t + 2) * kstep; const char* b2 = last ? nB : cB + (size_t)(t + 2) * kstep;
            const char* a3 = a2 + kstep; const char* b3 = b2 + kstep;
            if (last && has_next) S.a_ready(nxt);
            if constexpr (SP2) {
            PG8_LDB(B0, 0, 0); PG8_LDB(B1, 0, 1); PG8_SCHED; PG8_LDA(At, 0, 0); PG8_STAGE(PG8_SA(1, 1), a1 + hstep, voffA);
            PG8_WAIT_V(8); PG8_WAIT_L(0); PG8_BAR; PG8_MMA(0, 0, At, B0); PG8_MMA(0, 1, At, B1); PG8_BAR; PG8_SCHED;
            PG8_LDA(At, 0, 1); PG8_STAGE(PG8_SB(0, 0), b2, voffB); PG8_STAGE(PG8_SB(0, 1), b2 + hstep, voffB); PG8_STAGE(PG8_SA(0, 0), a2, voffA);
            PG8_WAIT_V(8); PG8_WAIT_L(0); PG8_BAR; PG8_MMA(1, 0, At, B0); PG8_MMA(1, 1, At, B1); PG8_BAR; PG8_SCHED;
            PG8_LDB(B0, 1, 0); PG8_LDB(B1, 1, 1); PG8_SCHED; PG8_LDA(At, 1, 0); PG8_STAGE(PG8_SA(0, 1), a2 + hstep, voffA);
            PG8_WAIT_V(8); PG8_WAIT_L(0); PG8_BAR; PG8_MMA(0, 0, At, B0); PG8_MMA(0, 1, At, B1); PG8_BAR; PG8_SCHED;
            PG8_LDA(At, 1, 1); PG8_STAGE(PG8_SB(1, 0), b3, voffB); PG8_STAGE(PG8_SB(1, 1), b3 + hstep, voffB); PG8_STAGE(PG8_SA(1, 0), a3, voffA);
            PG8_WAIT_V(8); PG8_WAIT_L(0); PG8_BAR; PG8_MMA(1, 0, At, B0); PG8_MMA(1, 1, At, B1); PG8_BAR; PG8_SCHED;
            } else {
            PG8_LDB(B0, 0, 0); PG8_SCHED; PG8_LDA(At, 0, 0); PG8_STAGE(PG8_SA(1, 1), a1 + hstep, voffA);
            PG8_WAIT_L(8); PG8_BAR; PG8_WAIT_L(0); PG8_MMA(0, 0, At, B0); PG8_BAR; PG8_SCHED;
            PG8_LDB(B1, 0, 1); PG8_STAGE(PG8_SB(0, 0), b2, voffB);
            PG8_BAR; PG8_WAIT_L(0); PG8_MMA(0, 1, At, B1); PG8_BAR;
            PG8_LDA(At, 0, 1); PG8_STAGE(PG8_SA(0, 0), a2, voffA);
            PG8_BAR; PG8_WAIT_L(0); PG8_MMA(1, 0, At, B0); PG8_BAR; PG8_SCHED;
            PG8_STAGE(PG8_SB(0, 1), b2 + hstep, voffB);
            PG8_WAIT_V(6); PG8_BAR; PG8_MMA(1, 1, At, B1); PG8_BAR;
            PG8_LDB(B0, 1, 0); PG8_SCHED; PG8_LDA(At, 1, 0); PG8_STAGE(PG8_SA(0, 1), a2 + hstep, voffA);
            PG8_WAIT_L(8); PG8_BAR; PG8_WAIT_L(0); PG8_MMA(0, 0, At, B0); PG8_BAR; PG8_SCHED;
            PG8_LDB(B1, 1, 1); PG8_STAGE(PG8_SB(1, 0), b3, voffB);
            PG8_BAR; PG8_WAIT_L(0); PG8_MMA(0, 1, At, B1); PG8_BAR;
            PG8_LDA(At, 1, 1); PG8_STAGE(PG8_SA(1, 0), a3, voffA);
            PG8_BAR; PG8_WAIT_L(0); PG8_MMA(1, 0, At, B0); PG8_BAR; PG8_SCHED;
            PG8_STAGE(PG8_SB(1, 1), b3 + hstep, voffB);
            PG8_WAIT_V(6); PG8_BAR; PG8_MMA(1, 1, At, B1); PG8_BAR;
            }
        }
        if constexpr (ALIGN_EPI) { if (wr == 0) PG8_BAR; }
        if constexpr (!Epi::AFTER_DRAIN) { E(acc, cur, wr, wc, fr, fq); S.done(cur); }
        if (!has_next) break;
#pragma unroll
        for (int a = 0; a < 2; ++a)
#pragma unroll
            for (int b = 0; b < 2; ++b)
#pragma unroll
                for (int m = 0; m < 4; ++m)
#pragma unroll
                    for (int n = 0; n < 2; ++n) acc[a][b][m][n] = (f32x4){0.f, 0.f, 0.f, 0.f};
        cur = nxt; cA = nA; cB = nB; ++ui;
        if constexpr (ALIGN_EPI) { if (wr == 1) PG8_BAR; }
    }
    PG8_WAIT_V(0);
    if constexpr (!ALIGN_EPI) { if (wr == 0) PG8_BAR; }
    PG8_BAR;
    if constexpr (Epi::AFTER_DRAIN) { E.fused(acc, cur, wr, wc, fr, fq, lds, wid, lane); S.done(cur); }
#undef PG8_SA
#undef PG8_SB
#undef PG8_STAGE
#undef PG8_LDA
#undef PG8_LDB
#undef PG8_MMA
#undef PG8_WAIT_V
#undef PG8_WAIT_L
#undef PG8_BAR
#undef PG8_SCHED
}
}

namespace pg8 {
struct OneUnit {
    Unit u;
    __device__ __forceinline__ bool next(int i, Unit& o) const { if (i > 0) return false; o = u; return true; }
    __device__ __forceinline__ void a_ready(const Unit&) const {}
    __device__ __forceinline__ void done(const Unit&) const {}
};
struct EpiRowScaleBf16 {
    static constexpr bool PERM = true, AFTER_DRAIN = false;
    bf16_t* O; int ldc; const float* rs;
    __device__ __forceinline__ void operator()(const f32x4 (&acc)[2][2][4][2], const Unit& u, int wr, int wc, int fr, int fq) const {
        const int row0 = u.pm * BM + wr * 64 + fr, col0 = u.pn * BM + wc * 32 + 8 * fq;
#pragma unroll
        for (int ai = 0; ai < 2; ++ai)
#pragma unroll
            for (int m = 0; m < 4; ++m) {
                const int row = row0 + ai * HALF + m * 16;
                const float sc = rs ? rs[row] : 1.f;
                bf16_t* rowp = O + (size_t)row * ldc + col0;
#pragma unroll
                for (int bj = 0; bj < 2; ++bj) {
                    const f32x4 v0 = acc[ai][bj][m][0] * sc, v1 = acc[ai][bj][m][1] * sc;
                    u32x4 w; w.x = cvt_pk_bf16(v0[0], v0[1]); w.y = cvt_pk_bf16(v0[2], v0[3]); w.z = cvt_pk_bf16(v1[0], v1[1]); w.w = cvt_pk_bf16(v1[2], v1[3]);
                    *(u32x4*)(rowp + bj * HALF) = w;
                }
            }
    }
};
struct EpiGeluBiasBf16 {
    static constexpr bool PERM = true, AFTER_DRAIN = false;
    bf16_t* O; int ldc; const float* bias;
    __device__ __forceinline__ void operator()(const f32x4 (&acc)[2][2][4][2], const Unit& u, int wr, int wc, int fr, int fq) const {
        const int row0 = u.pm * BM + wr * 64 + fr, col0 = u.pn * BM + wc * 32 + 8 * fq;
#pragma unroll
        for (int bj = 0; bj < 2; ++bj) {
            const f32x4 b0 = *(const f32x4*)(bias + col0 + bj * HALF), b1 = *(const f32x4*)(bias + col0 + bj * HALF + 4);
#pragma unroll
            for (int ai = 0; ai < 2; ++ai)
#pragma unroll
                for (int m = 0; m < 4; ++m) {
                    bf16_t* rowp = O + (size_t)(row0 + ai * HALF + m * 16) * ldc + col0 + bj * HALF;
                    const f32x4 v0 = acc[ai][bj][m][0] + b0, v1 = acc[ai][bj][m][1] + b1;
                    u32x4 w; w.x = cvt_pk_bf16(gelu_tanh(v0[0]), gelu_tanh(v0[1])); w.y = cvt_pk_bf16(gelu_tanh(v0[2]), gelu_tanh(v0[3]));
                    w.z = cvt_pk_bf16(gelu_tanh(v1[0]), gelu_tanh(v1[1])); w.w = cvt_pk_bf16(gelu_tanh(v1[2]), gelu_tanh(v1[3]));
                    *(u32x4*)rowp = w;
                }
        }
    }
};
struct EpiResidual {
    static constexpr bool PERM = true, AFTER_DRAIN = false;
    const float* base; float* out; bf16_t* xb; float* sumsq;
    __device__ __forceinline__ void operator()(const f32x4 (&acc)[2][2][4][2], const Unit& u, int wr, int wc, int fr, int fq) const {
        const int row0 = u.pm * BM + wr * 64 + fr, col0 = u.pn * BM + wc * 32 + 8 * fq;
#pragma unroll
        for (int ai = 0; ai < 2; ++ai)
#pragma unroll
            for (int m = 0; m < 4; ++m) {
                const int row = row0 + ai * HALF + m * 16;
                float ss = 0.f;
#pragma unroll
                for (int bj = 0; bj < 2; ++bj) {
                    const size_t off = (size_t)row * 1024 + col0 + bj * HALF;
                    const f32x4 r0 = *(const f32x4*)(base + off), r1 = *(const f32x4*)(base + off + 4);
                    const f32x4 v0 = acc[ai][bj][m][0] + r0, v1 = acc[ai][bj][m][1] + r1;
                    *(f32x4*)(out + off) = v0; *(f32x4*)(out + off + 4) = v1;
                    u32x4 w; w.x = cvt_pk_bf16(v0[0], v0[1]); w.y = cvt_pk_bf16(v0[2], v0[3]); w.z = cvt_pk_bf16(v1[0], v1[1]); w.w = cvt_pk_bf16(v1[2], v1[3]);
                    *(u32x4*)(xb + off) = w;
                    ss += v0[0] * v0[0] + v0[1] * v0[1] + v0[2] * v0[2] + v0[3] * v0[3] + v1[0] * v1[0] + v1[1] * v1[1] + v1[2] * v1[2] + v1[3] * v1[3];
                }
                ss += __shfl_xor(ss, 16); ss += __shfl_xor(ss, 32);
                if (fq == 0) sumsq[(size_t)row * 16 + u.pn * 4 + wc] = ss;
            }
    }
};
struct EpiScoreScratch {
    static constexpr bool PERM = true, AFTER_DRAIN = false;
    float* scr; const float* sumsq;
    __device__ __forceinline__ void operator()(const f32x4 (&acc)[2][2][4][2], const Unit& u, int wr, int wc, int fr, int fq) const {
        const int rl0 = wr * 64 + fr, cl0 = wc * 32 + 8 * fq;
#pragma unroll
        for (int ai = 0; ai < 2; ++ai)
#pragma unroll
            for (int m = 0; m < 4; ++m) {
                const int rl = rl0 + ai * HALF + m * 16;
                const float sc = rstd_from_parts(sumsq + (size_t)(u.pm * BM + rl) * 16);
#pragma unroll
                for (int bj = 0; bj < 2; ++bj) {
                    float* p = scr + rl * 256 + cl0 + bj * HALF;
                    *(f32x4*)p = acc[ai][bj][m][0] * sc; *(f32x4*)(p + 4) = acc[ai][bj][m][1] * sc;
                }
            }
    }
};
}

__device__ __forceinline__ void transpose_item(const float* __restrict__ W, int K, int N, const float* __restrict__ gain, bf16* __restrict__ WT, int row_off, float* scr, int item, int lane) {
    const int nblk = (N + 31) / 32, kb = item / nblk, nb = item % nblk, k0 = 64 * kb, n0 = 32 * nb;
    const int nn = n0 + (lane & 31);
#pragma unroll 8
    for (int i = 0; i < 32; ++i) { const int kk = 2 * i + (lane >> 5);
        float v = 0.f; if (nn < N) { v = W[(size_t)(k0 + kk) * N + nn]; if (gain) v *= gain[k0 + kk]; }
        scr[kk * 33 + (lane & 31)] = v; }
    __builtin_amdgcn_s_waitcnt(0); __builtin_amdgcn_wave_barrier();
    const int c = lane & 7;
#pragma unroll
    for (int j = 0; j < 4; ++j) { const int n = (lane >> 3) + 8 * j; const float* s = scr + (8 * c) * 33 + n;
        if (n0 + n < N) { u32x4 o; o.x = pk2(s[0 * 33], s[1 * 33]); o.y = pk2(s[2 * 33], s[3 * 33]); o.z = pk2(s[4 * 33], s[5 * 33]); o.w = pk2(s[6 * 33], s[7 * 33]);
            *(u32x4*)(WT + (size_t)(row_off + n0 + n) * K + k0 + 8 * c) = o; } }
    __builtin_amdgcn_s_waitcnt(0); __builtin_amdgcn_wave_barrier();
}
__device__ __forceinline__ void row_to_bf16(const float* __restrict__ xrow, bf16* __restrict__ orow, float* __restrict__ rstd, int lane) {
    const float4* xr = (const float4*)xrow + lane;
    float4 v[4]; float s = 0.f;
#pragma unroll
    for (int j = 0; j < 4; ++j) { v[j] = xr[64 * j]; s += v[j].x * v[j].x + v[j].y * v[j].y + v[j].z * v[j].z + v[j].w * v[j].w; }
    s = wave_sum(s);
    if (lane == 0) *rstd = rsqrtf(s * (1.f / D) + EPS);
    u32x2* o8 = (u32x2*)orow + lane;
#pragma unroll
    for (int j = 0; j < 4; ++j) { u32x2 w; w.x = pk2(v[j].x, v[j].y); w.y = pk2(v[j].z, v[j].w); o8[64 * j] = w; }
}

template <bool APPLY>
__device__ __forceinline__ void scan_pass(const bf16* __restrict__ P, const float* __restrict__ conv_w, const float* __restrict__ conv_b, const float* __restrict__ gate_w,
                                          const float* __restrict__ gate_b, const float* __restrict__ lam_p, float* __restrict__ AGG, bf16* __restrict__ AIN, float* xs  ) {
    const int lane = threadIdx.x & 63, gw = blockIdx.x * (NTHR / 64) + (threadIdx.x >> 6), ngw = gridDim.x * (NTHR / 64);
    for (int item = gw; item < NB * NCHUNK * NBLK; item += ngw) {
        const int n = item % NBLK, ci = (item / NBLK) % NCHUNK, b = item / (NBLK * NCHUNK);
        const int c = n * 64 + lane;
        float wr[64], wi[64];
#pragma unroll
        for (int d = 0; d < 64; ++d) { wr[d] = gate_w[((size_t)(0 * NBLK + n) * 64 + d) * 64 + lane]; wi[d] = gate_w[((size_t)(1 * NBLK + n) * 64 + d) * 64 + lane]; }
        const float brr = gate_b[c], bii = gate_b[LRUW + c];
        const float lam = lam_p[c];
        const float sp = (-lam > 20.f) ? -lam : log1pf(expf(-lam));
        const float cw0 = conv_w[0 * LRUW + c], cw1 = conv_w[1 * LRUW + c], cw2 = conv_w[2 * LRUW + c], cw3 = conv_w[3 * LRUW + c], cb = conv_b[c];
        const int s0 = ci * CHL;
        const bf16* xp = P + ((size_t)b * S + s0) * PP + c;
        float xm3 = (s0 >= 3) ? ldbf(xp - 3 * PP) : 0.f, xm2 = (s0 >= 2) ? ldbf(xp - 2 * PP) : 0.f, xm1 = (s0 >= 1) ? ldbf(xp - 1 * PP) : 0.f;
        __builtin_amdgcn_wave_barrier();
#pragma unroll 4
        for (int tt = 0; tt < CHL; ++tt) {
            const float x0 = ldbf(xp + (size_t)tt * PP);
            xs[tt * 64 + lane] = cb + cw0 * xm3 + cw1 * xm2 + cw2 * xm1 + cw3 * x0;
            xm3 = xm2; xm2 = xm1; xm1 = x0;
        }
        __builtin_amdgcn_s_waitcnt(0); __builtin_amdgcn_wave_barrier();
        float h = 0.f, Ap = 1.f;
        if (APPLY) {
            for (int k = 0; k < ci; ++k) { const float2 ah = *(const float2*)(AGG + (((size_t)b * NCHUNK + k) * LRUW + c) * 2); h = ah.x * h + ah.y; }
        }
#pragma unroll 1
        for (int tt = 0; tt < CHL; ++tt) {
            const float4* xr = (const float4*)(xs + tt * 64);
            float gr = brr, gi = bii;
#pragma unroll
            for (int k = 0; k < 16; ++k) { const float4 v = xr[k];
                gr += v.x * wr[4 * k] + v.y * wr[4 * k + 1] + v.z * wr[4 * k + 2] + v.w * wr[4 * k + 3];
                gi += v.x * wi[4 * k] + v.y * wi[4 * k + 1] + v.z * wi[4 * k + 2] + v.w * wi[4 * k + 3];
                if ((k & 3) == 3) __builtin_amdgcn_sched_barrier(0); }
            const float xt = xs[tt * 64 + lane];
            const float rg = sigmoidf_(gr), ig = sigmoidf_(gi);
            const float log_a = -8.0f * rg * sp;
            const float a = __expf(log_a);
            const float mult = sqrtf(-expm1f(2.0f * log_a));
            h = a * h + mult * (ig * xt);
            if (APPLY) {
                const size_t row = (size_t)b * S + s0 + tt;
                const float yb = ldbf(P + row * PP + 768 + c);
                AIN[row * D + c] = (bf16)f2bf(h * gelu_tanh(yb));
            } else Ap *= a;
        }
        if (!APPLY) *(float2*)(AGG + (((size_t)b * NCHUNK + ci) * LRUW + c) * 2) = make_float2(Ap, h);
        __builtin_amdgcn_s_waitcnt(0); __builtin_amdgcn_wave_barrier();
    }
}

__device__ __forceinline__ void attend_key(const float* q, const bf16* __restrict__ kp, const bf16* __restrict__ vp, float& m, float& l, float (&o)[32]) {
    float s = 0.f;
#pragma unroll
    for (int i = 0; i < 8; ++i) { const u32x4 k4 = ((const u32x4*)kp)[i]; const float4 qa = ((const float4*)q)[2 * i], qb = ((const float4*)q)[2 * i + 1];
        s += qa.x * bflo(k4.x) + qa.y * bfhi(k4.x) + qa.z * bflo(k4.y) + qa.w * bfhi(k4.y) + qb.x * bflo(k4.z) + qb.y * bfhi(k4.z) + qb.z * bflo(k4.w) + qb.w * bfhi(k4.w);
        if ((i & 1) == 1) __builtin_amdgcn_sched_barrier(0); }
    const float mn = fmaxf(m, s), a = __expf(m - mn), p = __expf(s - mn);
    l = l * a + p;
#pragma unroll
    for (int i = 0; i < 4; ++i) { const u32x4 v4 = ((const u32x4*)vp)[i];
        o[8 * i + 0] = o[8 * i + 0] * a + p * bflo(v4.x); o[8 * i + 1] = o[8 * i + 1] * a + p * bfhi(v4.x);
        o[8 * i + 2] = o[8 * i + 2] * a + p * bflo(v4.y); o[8 * i + 3] = o[8 * i + 3] * a + p * bfhi(v4.y);
        o[8 * i + 4] = o[8 * i + 4] * a + p * bflo(v4.z); o[8 * i + 5] = o[8 * i + 5] * a + p * bfhi(v4.z);
        o[8 * i + 6] = o[8 * i + 6] * a + p * bflo(v4.w); o[8 * i + 7] = o[8 * i + 7] * a + p * bfhi(v4.w);
        if ((i & 1) == 1) __builtin_amdgcn_sched_barrier(0); }
    m = mn;
}
__device__ __forceinline__ float merge_streams(float m, float l, float (&o)[32], int lane) {
    const float M = half_max(m);
    const float w = (m == -INFINITY) ? 0.f : __expf(m - M);
    const float L = half_sum(l * w);
    float res = 0.f;
#pragma unroll
    for (int d = 0; d < 32; ++d) { const float v = half_sum(o[d] * w); if ((lane & 31) == d) res = v; if ((d & 3) == 3) __builtin_amdgcn_sched_barrier(0); }
    return (L > 0.f) ? res / L : 0.f;
}
__device__ __forceinline__ void mem_attention(const bf16* __restrict__ P, int qoff, const bf16* __restrict__ memkv, int lc, const float* __restrict__ q_gain, bf16* __restrict__ AIN, float* q) {
    const int lane = threadIdx.x & 63, gw = blockIdx.x * (NTHR / 64) + (threadIdx.x >> 6), ngw = gridDim.x * (NTHR / 64);
    const int li = lane & 31, hd = (lane >> 5) * 32;
    for (int item = gw; item < T * 4; item += ngw) {
        const int row = item >> 2, h = item & 3, b = row / S;
        {
            float v = ldbf(P + (size_t)row * PP + qoff + h * 64 + lane);
            const float ss = wave_sum(v * v);
            v = v * rsqrtf(ss * (1.f / 64.f) + EPS) * 0.125f * q_gain[lane];
            __builtin_amdgcn_wave_barrier();
            q[lane] = v;
            __builtin_amdgcn_s_waitcnt(0); __builtin_amdgcn_wave_barrier();
        }
        float m = -INFINITY, l = 0.f, o[32];
#pragma unroll
        for (int d = 0; d < 32; ++d) o[d] = 0.f;
        for (int i = 0; i < 8; ++i) {
            const bf16* kr = memkv + (size_t)(b * MEMN + i * 32 + li) * 1024 + lc + h * 64;
            attend_key(q, kr, kr + 256 + hd, m, l, o);
        }
        const float r = merge_streams(m, l, o, lane);
        AIN[(size_t)row * D + 768 + h * 64 + lane] = (bf16)f2bf(r);
    }
}
__device__ __forceinline__ void load_q(float* q, const bf16* __restrict__ P, size_t row, int hq, const float* __restrict__ qgain, const float* __restrict__ rope_row, int lane) {
    float v = ldbf(P + row * PP + 768 + hq * 64 + lane);
    const float ss = wave_sum(v * v);
    v = v * rsqrtf(ss * (1.f / 64.f) + EPS) * qgain[lane];
    const float partner = __shfl_xor(v, 8);
    if (lane < 16) { const int i = lane & 7; const float cs = rope_row[i], sn = rope_row[8 + i];
        v = (lane < 8) ? (v * cs - partner * sn) : (v * cs + partner * sn); }
    __builtin_amdgcn_wave_barrier();
    q[lane] = v * 0.125f;
    __builtin_amdgcn_s_waitcnt(0); __builtin_amdgcn_wave_barrier();
}
__device__ __forceinline__ void nsa_attention(const bf16* __restrict__ P, const bf16* __restrict__ KC, const bf16* __restrict__ VC, const bf16* __restrict__ KS,
                                              const bf16* __restrict__ KW, const float* __restrict__ rope, const float* __restrict__ qgain,
                                              const float* __restrict__ gate_b, bf16* __restrict__ AIN, float* q, float* pbuf) {
    const int lane = threadIdx.x & 63, gw = blockIdx.x * (NTHR / 64) + (threadIdx.x >> 6), ngw = gridDim.x * (NTHR / 64);
    const int li = lane & 31, hd = (lane >> 5) * 32;
    for (int item = gw; item < NB * 2 * S; item += ngw) {
        const int t = item % S, g = (item / S) & 1, b = item / (2 * S);
        const size_t row = (size_t)b * S + t;
        const int c = t >> 6;
        const float* rope_row = rope + (size_t)t * 16;
        const bf16* kc = KC + (size_t)(b * 2 + g) * 256 * 64;
        const bf16* vc = VC + (size_t)(b * 2 + g) * 256 * 64;
        float ocmp[6];
        float imp = 0.f;
#pragma unroll 1
        for (int r = 0; r < 6; ++r) {
            load_q(q, P, row, g * 6 + r, qgain, rope_row, lane);
            float sc[8];
            float mx = -INFINITY;
#pragma unroll
            for (int i = 0; i < 8; ++i) {
                const int n = li + 32 * i;
                const bool ok = (n < NCMP) && (16 * n + 31 <= t);
                float a = -INFINITY;
                if (ok) {
                    a = 0.f;
                    const u32x4* kp = (const u32x4*)(kc + (size_t)n * 64);
#pragma unroll
                    for (int k = 0; k < 8; ++k) { const u32x4 k4 = kp[k]; const float4 qa = ((const float4*)q)[2 * k], qb = ((const float4*)q)[2 * k + 1];
                        a += qa.x * bflo(k4.x) + qa.y * bfhi(k4.x) + qa.z * bflo(k4.y) + qa.w * bfhi(k4.y) + qb.x * bflo(k4.z) + qb.y * bfhi(k4.z) + qb.z * bflo(k4.w) + qb.w * bfhi(k4.w);
                        if ((k & 1) == 1) __builtin_amdgcn_sched_barrier(0); }
                }
                sc[i] = a;
                mx = fmaxf(mx, a);
            }
            mx = half_max(mx);
            float ls = 0.f;
#pragma unroll
            for (int i = 0; i < 8; ++i) { sc[i] = (sc[i] == -INFINITY) ? 0.f : __expf(sc[i] - mx); ls += sc[i]; }
            ls = half_sum(ls);
            const float inv = (ls > 0.f) ? 1.f / ls : 0.f;
            float ol[32];
#pragma unroll
            for (int d = 0; d < 32; ++d) ol[d] = 0.f;
            __builtin_amdgcn_wave_barrier();
#pragma unroll
            for (int i = 0; i < 8; ++i) {
                const int n = li + 32 * i;
                const float pn = sc[i] * inv;
                if (lane < 32) pbuf[n] = pn;
                if (pn != 0.f) {
                    const u32x4* vp = (const u32x4*)(vc + (size_t)n * 64 + hd);
#pragma unroll
                    for (int k = 0; k < 4; ++k) { const u32x4 v4 = vp[k];
                        ol[8 * k + 0] += pn * bflo(v4.x); ol[8 * k + 1] += pn * bfhi(v4.x); ol[8 * k + 2] += pn * bflo(v4.y); ol[8 * k + 3] += pn * bfhi(v4.y);
                        ol[8 * k + 4] += pn * bflo(v4.z); ol[8 * k + 5] += pn * bfhi(v4.z); ol[8 * k + 6] += pn * bflo(v4.w); ol[8 * k + 7] += pn * bfhi(v4.w);
                        if ((k & 1) == 1) __builtin_amdgcn_sched_barrier(0); }
                }
            }
            float res = 0.f;
#pragma unroll
            for (int d = 0; d < 32; ++d) { const float v = half_sum(ol[d]); if (li == d) res = v; if ((d & 3) == 3) __builtin_amdgcn_sched_barrier(0); }
            ocmp[r] = res;
            __builtin_amdgcn_s_waitcnt(0); __builtin_amdgcn_wave_barrier();
            {
                const float4 p4 = ((const float4*)pbuf)[lane];
                const float pprev = (lane > 0) ? pbuf[4 * lane - 1] : 0.f;
                imp += p4.x + p4.y + p4.z + 0.5f * p4.w + 0.5f * pprev;
            }
            __builtin_amdgcn_s_waitcnt(0); __builtin_amdgcn_wave_barrier();
        }
        unsigned long long selmask;
        {
            const int j = lane;
            const bool valid = j <= c;
            const bool forced = (j == 0) || (j == c) || (j == c - 1);
            float v = forced ? 1e4f : imp;
            v = valid ? v : -1.f;
            int rank = 0;
            for (int jj = 0; jj < 64; ++jj) { const float o = __shfl(v, jj); rank += (o > v || (o == v && jj < j)) ? 1 : 0; }
            selmask = __ballot(rank < 16 && v >= 0.f);
        }
        const bf16* ks = KS + (size_t)(b * 2 + g) * S * 64;
        const bf16* kw = KW + (size_t)(b * 2 + g) * S * 64;
        const bf16* vs = P + (size_t)b * S * PP + 1 * 256 + 128 + g * 64 + hd;
        const bf16* vw = P + (size_t)b * S * PP + 2 * 256 + 128 + g * 64 + hd;
#pragma unroll 1
        for (int r = 0; r < 6; ++r) {
            const int hq = g * 6 + r;
            load_q(q, P, row, hq, qgain, rope_row, lane);
            float o[32];
            float m = -INFINITY, l = 0.f;
#pragma unroll
            for (int d = 0; d < 32; ++d) o[d] = 0.f;
            for (int jb = 0; jb <= c; ++jb) {
                if ((selmask >> jb) & 1ull) {
#pragma unroll 1
                    for (int sub = 0; sub < 2; ++sub) {
                        const int sidx = jb * 64 + sub * 32 + li;
                        if (sidx <= t) attend_key(q, ks + (size_t)sidx * 64, vs + (size_t)sidx * PP, m, l, o);
                    }
                }
            }
            const float osel = merge_streams(m, l, o, lane);
            m = -INFINITY; l = 0.f;
#pragma unroll
            for (int d = 0; d < 32; ++d) o[d] = 0.f;
            {
                const int s0 = (t - 511 > 0) ? (t - 511) : 0;
                for (int sidx = s0 + li; sidx <= t; sidx += 32) attend_key(q, kw + (size_t)sidx * 64, vw + (size_t)sidx * PP, m, l, o);
            }
            const float owin = merge_streams(m, l, o, lane);
            const bf16* gl = P + row * PP + 1536 + hq * 3;
            const float g0 = sigmoidf_(ldbf(gl) + gate_b[hq * 3 + 0]), g1 = sigmoidf_(ldbf(gl + 1) + gate_b[hq * 3 + 1]), g2 = sigmoidf_(ldbf(gl + 2) + gate_b[hq * 3 + 2]);
            AIN[row * D + hq * 64 + lane] = (bf16)f2bf(g0 * ocmp[r] + g1 * osel + g2 * owin);
        }
    }
}

__device__ __forceinline__ float pack_key(float v, unsigned idx, unsigned nbits_mask) {
    unsigned u = __builtin_bit_cast(unsigned, v);
    const unsigned tag = (u >> 31) ? idx : (nbits_mask - idx);
    u = (u & ~nbits_mask) | tag;
    return __builtin_bit_cast(float, u);
}
__device__ __forceinline__ void insert16(float (&L)[16], float x) {
#pragma unroll
    for (int i = 0; i < 16; ++i) { const float hi = fmaxf(L[i], x); x = fminf(L[i], x); L[i] = hi; }
}
__device__ __forceinline__ void topk_tile(float* scr, int t0, int h, int* __restrict__ E, float* __restrict__ Gt) {
    const int tid = threadIdx.x;
    {
        const int row = tid & 255, p = tid >> 8;
        float* sp = scr + row * 256 + p * 128;
        float L[16];
#pragma unroll
        for (int i = 0; i < 16; ++i) L[i] = -INFINITY;
#pragma unroll 2
        for (int k = 0; k < 32; ++k) {
            const float4 v = ((const float4*)sp)[k];
            insert16(L, pack_key(v.x, 4 * k + 0, 127u)); insert16(L, pack_key(v.y, 4 * k + 1, 127u));
            insert16(L, pack_key(v.z, 4 * k + 2, 127u)); insert16(L, pack_key(v.w, 4 * k + 3, 127u));
        }
#pragma unroll
        for (int i = 0; i < 4; ++i) ((float4*)sp)[i] = make_float4(L[4 * i], L[4 * i + 1], L[4 * i + 2], L[4 * i + 3]);
    }
    __syncthreads();
    if (tid < 256) {
        const int row = tid;
        const float* s1 = scr + row * 256, *s2 = s1 + 128;
        float v1[16], v2[16];
#pragma unroll
        for (int i = 0; i < 4; ++i) { const float4 a = ((const float4*)s1)[i], b = ((const float4*)s2)[i];
            v1[4 * i] = a.x; v1[4 * i + 1] = a.y; v1[4 * i + 2] = a.z; v1[4 * i + 3] = a.w; v2[4 * i] = b.x; v2[4 * i + 1] = b.y; v2[4 * i + 2] = b.z; v2[4 * i + 3] = b.w; }
        float L[16];
#pragma unroll
        for (int i = 0; i < 16; ++i) L[i] = -INFINITY;
#pragma unroll
        for (int a = 0; a < 16; ++a)
#pragma unroll
            for (int b = 0; b < 16; ++b)
                if ((a + 1) * (b + 1) <= 16) insert16(L, pack_key(v1[a] + v2[b], a * 16 + b, 255u));
        float mx = L[0], sm = 0.f, ex[16];
#pragma unroll
        for (int i = 0; i < 16; ++i) { ex[i] = __expf(L[i] - mx); sm += ex[i]; }
        const float inv = 1.f / sm;
        int* eo = E + (size_t)(t0 + row) * 128 + h * 16;
        float* go = Gt + (size_t)(t0 + row) * 128 + h * 16;
#pragma unroll
        for (int i = 0; i < 16; ++i) {
            const unsigned u = __builtin_bit_cast(unsigned, L[i]);
            const unsigned ci = (u >> 31) ? (u & 255u) : (255u - (u & 255u));
            const unsigned ua = __builtin_bit_cast(unsigned, s1[ci >> 4]), ub = __builtin_bit_cast(unsigned, s2[ci & 15]);
            const unsigned i1 = (ua >> 31) ? (ua & 127u) : (127u - (ua & 127u)), i2 = (ub >> 31) ? (ub & 127u) : (127u - (ub & 127u));
            eo[i] = (int)(i1 * 128u + i2); go[i] = ex[i] * inv;
        }
    }
    __syncthreads();
}

__device__ __forceinline__ void peer_gather(float* __restrict__ out, bf16* __restrict__ XB, const float* __restrict__ sumsq, const bf16* __restrict__ UT, const bf16* __restrict__ VT,
                                            const int* __restrict__ E, const float* __restrict__ Gt, float* __restrict__ rstd_next, float* actbuf  ) {
    const int lane = threadIdx.x & 63, gw = blockIdx.x * (NTHR / 64) + (threadIdx.x >> 6), ngw = gridDim.x * (NTHR / 64);
    const int g4 = lane >> 4, li = lane & 15;
    for (int t = gw; t < T; t += ngw) {
        const float rs = rstd_from_parts(sumsq + (size_t)t * 16);
        bf16x8_t hx[8];
#pragma unroll
        for (int j = 0; j < 8; ++j) hx[j] = *(const bf16x8_t*)(XB + (size_t)t * D + li * 8 + 128 * j);
        const int* ep = E + (size_t)t * 128; const float* gp = Gt + (size_t)t * 128;
#pragma unroll 2
        for (int step = 0; step < 32; ++step) {
            const int e = ep[4 * step + g4];
            const bf16* up = UT + (size_t)e * D + li * 8;
            bf16x8_t u[8];
#pragma unroll
            for (int j = 0; j < 8; ++j) u[j] = *(const bf16x8_t*)(up + 128 * j);
            float d = 0.f;
#pragma unroll
            for (int j = 0; j < 8; ++j) {
                d = __builtin_amdgcn_fdot2_f32_bf16(__builtin_shufflevector(u[j], u[j], 0, 1), __builtin_shufflevector(hx[j], hx[j], 0, 1), d, false);
                d = __builtin_amdgcn_fdot2_f32_bf16(__builtin_shufflevector(u[j], u[j], 2, 3), __builtin_shufflevector(hx[j], hx[j], 2, 3), d, false);
                d = __builtin_amdgcn_fdot2_f32_bf16(__builtin_shufflevector(u[j], u[j], 4, 5), __builtin_shufflevector(hx[j], hx[j], 4, 5), d, false);
                d = __builtin_amdgcn_fdot2_f32_bf16(__builtin_shufflevector(u[j], u[j], 6, 7), __builtin_shufflevector(hx[j], hx[j], 6, 7), d, false);
            }
            d += __shfl_xor(d, 1); d += __shfl_xor(d, 2); d += __shfl_xor(d, 4); d += __shfl_xor(d, 8);
            const float a = gelu_tanh(d * rs) * gp[4 * step + g4];
            if (li == 0) actbuf[4 * step + g4] = a;
        }
        __builtin_amdgcn_s_waitcnt(0); __builtin_amdgcn_wave_barrier();
        float acc[16];
#pragma unroll
        for (int i = 0; i < 16; ++i) acc[i] = 0.f;
        const int e_lo = ep[lane], e_hi = ep[64 + lane];
#pragma unroll 4
        for (int idx = 0; idx < 128; ++idx) {
            const int e = __builtin_amdgcn_readlane(idx < 64 ? e_lo : e_hi, idx & 63);
            const bf16* vp = VT + (size_t)e * D + lane * 8;
            const u32x4 va = *(const u32x4*)vp, vb = *(const u32x4*)(vp + 512);
            const float a = actbuf[idx];
            acc[0] += a * bflo(va.x); acc[1] += a * bfhi(va.x); acc[2] += a * bflo(va.y); acc[3] += a * bfhi(va.y);
            acc[4] += a * bflo(va.z); acc[5] += a * bfhi(va.z); acc[6] += a * bflo(va.w); acc[7] += a * bfhi(va.w);
            acc[8] += a * bflo(vb.x); acc[9] += a * bfhi(vb.x); acc[10] += a * bflo(vb.y); acc[11] += a * bfhi(vb.y);
            acc[12] += a * bflo(vb.z); acc[13] += a * bfhi(vb.z); acc[14] += a * bflo(vb.w); acc[15] += a * bfhi(vb.w);
        }
        float ss = 0.f;
#pragma unroll
        for (int hf = 0; hf < 2; ++hf) {
            float* op = out + (size_t)t * D + hf * 512 + lane * 8;
            const float4 x0 = *(const float4*)op, x1 = *(const float4*)(op + 4);
            const float4 r0 = make_float4(x0.x + acc[8 * hf + 0], x0.y + acc[8 * hf + 1], x0.z + acc[8 * hf + 2], x0.w + acc[8 * hf + 3]);
            const float4 r1 = make_float4(x1.x + acc[8 * hf + 4], x1.y + acc[8 * hf + 5], x1.z + acc[8 * hf + 6], x1.w + acc[8 * hf + 7]);
            *(float4*)op = r0; *(float4*)(op + 4) = r1;
            u32x4 w; w.x = pk2(r0.x, r0.y); w.y = pk2(r0.z, r0.w); w.z = pk2(r1.x, r1.y); w.w = pk2(r1.z, r1.w);
            *(u32x4*)(XB + (size_t)t * D + hf * 512 + lane * 8) = w;
            ss += r0.x * r0.x + r0.y * r0.y + r0.z * r0.z + r0.w * r0.w + r1.x * r1.x + r1.y * r1.y + r1.z * r1.z + r1.w * r1.w;
        }
        ss = wave_sum(ss);
        if (lane == 0 && rstd_next) rstd_next[t] = rsqrtf(ss * (1.f / D) + EPS);
        __builtin_amdgcn_s_waitcnt(0); __builtin_amdgcn_wave_barrier();
    }
}

__device__ __forceinline__ void peer_gather_naive(float* __restrict__ out, const float* __restrict__ sumsq, const float* __restrict__ gain,
                                            const float* __restrict__ U, const float* __restrict__ V, const int* __restrict__ E, const float* __restrict__ Gt) {
    const int lane = threadIdx.x & 63, gw = blockIdx.x * (NTHR / 64) + (threadIdx.x >> 6), ngw = gridDim.x * (NTHR / 64);
    for (int t = gw; t < T; t += ngw) {
        float4 x1[4], h2[4], acc[4];
        const float rs = rstd_from_parts(sumsq + (size_t)t * 16);
#pragma unroll
        for (int j = 0; j < 4; ++j) {
            x1[j] = ((const float4*)(out + (size_t)t * D))[64 * j + lane];
            float4 g = ((const float4*)gain)[64 * j + lane];
            h2[j] = make_float4(x1[j].x * rs * g.x, x1[j].y * rs * g.y, x1[j].z * rs * g.z, x1[j].w * rs * g.w);
            acc[j] = make_float4(0.f, 0.f, 0.f, 0.f);
        }
        for (int idx = 0; idx < 128; ++idx) {
            const int e = E[(size_t)t * 128 + idx]; const float gt = Gt[(size_t)t * 128 + idx];
            const float4* up = (const float4*)(U + (size_t)e * D) + lane;
            const float4* vp = (const float4*)(V + (size_t)e * D) + lane;
            float4 u[4], v[4];
#pragma unroll
            for (int j = 0; j < 4; ++j) { u[j] = up[64 * j]; v[j] = vp[64 * j]; }
            float d = 0.f;
#pragma unroll
            for (int j = 0; j < 4; ++j) d += u[j].x * h2[j].x + u[j].y * h2[j].y + u[j].z * h2[j].z + u[j].w * h2[j].w;
            d = wave_sum(d);
            const float a = gelu_tanh(d) * gt;
#pragma unroll
            for (int j = 0; j < 4; ++j) { acc[j].x += a * v[j].x; acc[j].y += a * v[j].y; acc[j].z += a * v[j].z; acc[j].w += a * v[j].w; }
        }
#pragma unroll
        for (int j = 0; j < 4; ++j) {
            float4 r = make_float4(x1[j].x + acc[j].x, x1[j].y + acc[j].y, x1[j].z + acc[j].z, x1[j].w + acc[j].w);
            ((float4*)(out + (size_t)t * D))[64 * j + lane] = r;
        }
    }
}

constexpr int N_PHASES = 15;
constexpr int LDS_BYTES = 147456;
#define PG8_SP2_ON true

template <int LO, int HI>
__global__ void __launch_bounds__(NTHR) fwd_kernel(Params p) {
    cg::grid_group grid = cg::this_grid();
    extern __shared__ __attribute__((aligned(16))) unsigned char lds_raw[];
    float* smem = (float*)lds_raw;
    PG8_LAS unsigned char* ldsp = (PG8_LAS unsigned char*)lds_raw;
    const int tid = threadIdx.x, lane = tid & 63, wv = tid >> 6;
    const int gw = blockIdx.x * (NTHR / 64) + wv, ngw = gridDim.x * (NTHR / 64);
    const int gtid = blockIdx.x * NTHR + tid, ngt = gridDim.x * NTHR;
    const int G = gridDim.x;

    const float* x = p.in[0]; const float* mem = p.in[1]; const int* positions = (const int*)p.in[2];
    const float* norm_mix = p.in[3]; const float* norm_ffn = p.in[4]; const float* norm_mem = p.in[5];
    const float* w_out = p.in[6]; const float* w_mem_kv = p.in[7]; const float* mem_q_gain = p.in[8]; const float* mem_k_gain = p.in[9];
    const float* a_w_in = p.in[10]; const float* a_conv_w = p.in[11]; const float* a_conv_b = p.in[12]; const float* a_gate_w = p.in[13];
    const float* a_gate_b = p.in[14]; const float* a_lambda = p.in[15]; const float* b_w_in = p.in[16]; const float* b_gate_b = p.in[17];
    const float* b_q_gain = p.in[18]; const float* kv_norm = p.in[19]; const float* w_kv_shared = p.in[20]; const float* k_gain_shared = p.in[21];
    const float* cmp_pos = p.in[22]; const float* cmp_w1 = p.in[23]; const float* cmp_b1 = p.in[24]; const float* cmp_w2 = p.in[25];
    const float* peer_wq = p.in[26]; const float* peer_subkeys = p.in[27]; const float* peer_u = p.in[28]; const float* peer_v = p.in[29];
    float* out = p.out;
    unsigned char* ws = p.ws;
    float* RSTD = (float*)(ws + WS_RSTD);
    float* rstd0 = RSTD, *rstd2 = RSTD + 2 * T, *rstdm = RSTD + 4 * T;
    float* sumsq1 = (float*)(ws + WS_SSQ1), *sumsq3 = (float*)(ws + WS_SSQ3);
    float* ROPE = (float*)(ws + WS_ROPE); float* BIAS2 = (float*)(ws + WS_BIAS2);
    bf16* WIN0 = (bf16*)(ws + WS_WIN0); bf16* WOUT = (bf16*)(ws + WS_WOUT); bf16* WFt = (bf16*)(ws + WS_WF); bf16* WKVB = (bf16*)(ws + WS_WKVB);
    bf16* WMEM = (bf16*)(ws + WS_WMEM); bf16* WC1 = (bf16*)(ws + WS_WC1); bf16* MEMB = (bf16*)(ws + WS_MEMB); bf16* MEMKV = (bf16*)(ws + WS_MEMKV);
    float* AGG = (float*)(ws + WS_SCAN); bf16* HID = (bf16*)(ws + WS_HID); bf16* KC = (bf16*)(ws + WS_KC); bf16* VC = (bf16*)(ws + WS_VC);
    bf16* CA = (bf16*)(ws + WS_CA); int* E = (int*)(ws + WS_E); float* Gt = (float*)(ws + WS_GT); bf16* KS = (bf16*)(ws + WS_KS); bf16* KW = (bf16*)(ws + WS_KW);
    bf16* XB = (bf16*)(ws + WS_XB); bf16* AIN = (bf16*)(ws + WS_AIN); bf16* P = (bf16*)(ws + WS_P);
    bf16* UT = (bf16*)(ws + WS_UT); bf16* VT = (bf16*)(ws + WS_VT);
    float* SCR = (float*)(ws + WS_AIN) + (size_t)blockIdx.x * 65536;

    constexpr int lo = LO, hi = HI;
    int ph = 0;
#define PHASE_BEGIN if (ph >= lo && ph < hi) {
#define PHASE_END } ++ph; if (ph > lo && ph < hi) grid.sync();

    PHASE_BEGIN
        for (int r = gw; r < T; r += ngw) row_to_bf16(x + (size_t)r * D, XB + (size_t)r * D, rstd0 + r, lane);
        for (int r = gw; r < NB * MEMN; r += ngw) row_to_bf16(mem + (size_t)r * D, MEMB + (size_t)r * D, rstdm + r, lane);
        for (int i = gtid; i < S * 8; i += ngt) {
            const int s = i >> 3, k = i & 7;
            const float freq = powf(500000.0f, -(float)k / 8.0f);
            const float ang = (float)positions[s] * freq;
            ROPE[s * 16 + k] = cosf(ang); ROPE[s * 16 + 8 + k] = sinf(ang);
        }
        {
            float* scr = smem + wv * (64 * 33);
            constexpr int I_IN0 = 16 * 56, I_OUT = 16 * 32, I_KV = 16 * 24, I_BIN = 16 * 34, I_MEM = 16 * 16, I_C1 = 32 * 8;
            constexpr int NIT = I_IN0 + 2 * I_OUT + I_KV + I_BIN + 2 * I_MEM + 2 * I_C1;
            for (int it = gw; it < NIT; it += ngw) {
                int r = it;
                if (r < I_IN0) { transpose_item(a_w_in, D, 1792, norm_mix, WIN0, 0, scr, r, lane); continue; } r -= I_IN0;
                if (r < I_OUT) { transpose_item(w_out, D, D, nullptr, WOUT, 0, scr, r, lane); continue; } r -= I_OUT;
                if (r < I_OUT) { transpose_item(w_out + (size_t)D * D, D, D, nullptr, WOUT + (size_t)D * D, 0, scr, r, lane); continue; } r -= I_OUT;
                if (r < I_KV) { transpose_item(w_kv_shared, D, 768, kv_norm, WKVB, 0, scr, r, lane); continue; } r -= I_KV;
                if (r < I_BIN) { transpose_item(b_w_in, D, 1060, norm_mix + D, WKVB, 768, scr, r, lane); continue; } r -= I_BIN;
                if (r < I_MEM) { transpose_item(w_mem_kv, D, 512, norm_mem, WMEM, 0, scr, r, lane); continue; } r -= I_MEM;
                if (r < I_MEM) { transpose_item(w_mem_kv + (size_t)D * 512, D, 512, norm_mem + D, WMEM, 512, scr, r, lane); continue; } r -= I_MEM;
                if (r < I_C1) { transpose_item(cmp_w1, 2048, 256, nullptr, WC1, 0, scr, r, lane); continue; } r -= I_C1;
                transpose_item(cmp_w1 + (size_t)2048 * 256, 2048, 256, nullptr, WC1 + (size_t)256 * 2048, 0, scr, r, lane);
            }
            for (int i = gtid; i < 220 * 1024 / 8; i += ngt) ((u32x4*)(WKVB + (size_t)1828 * 1024))[i] = (u32x4){0u, 0u, 0u, 0u};
        }
        for (int item = blockIdx.x; item < 2 * 16 * 2; item += gridDim.x) {
            const int l = item >> 5, hp = (item >> 1) & 15, kh = item & 1;
            const float* sk = peer_subkeys + ((size_t)l * 16 + hp) * 128 * 128;
            __syncthreads();
            for (int i = tid; i < 128 * 128; i += NTHR) smem[i] = sk[i];
            __syncthreads();
            const int k = kh * 512 + tid;
            const float4* wq = (const float4*)(peer_wq + ((size_t)l * D + k) * 2048 + hp * 128);
            float4 wr4[32];
#pragma unroll
            for (int i = 0; i < 32; ++i) wr4[i] = wq[i];
            const float gk = norm_ffn[l * D + k];
#pragma unroll 1
            for (int n = 0; n < 128; ++n) {
                const float4* sr = (const float4*)(smem + n * 128);
                float acc = 0.f;
#pragma unroll
                for (int i = 0; i < 32; ++i) { const float4 s4 = sr[i]; acc += wr4[i].x * s4.x + wr4[i].y * s4.y + wr4[i].z * s4.z + wr4[i].w * s4.w;
                    if ((i & 7) == 7) __builtin_amdgcn_sched_barrier(0); }
                WFt[((size_t)l * 2048 + hp * 128 + n) * 1024 + k] = (bf16)f2bf(acc * gk);
            }
        }
        for (int i = gtid; i < 512; i += ngt) {
            const int j = i >> 8, c = i & 255;
            float acc = cmp_b1[i];
            for (int k = 0; k < 2048; ++k) acc = fmaf(cmp_pos[j * 2048 + k], cmp_w1[((size_t)j * 2048 + k) * 256 + c], acc);
            BIAS2[i] = acc;
        }
        for (size_t i = gtid; i < (size_t)2 * 16384 * 128; i += ngt) {
            const size_t e8 = i * 8; const int l = (int)(e8 >> 24), k = (int)(e8 & 1023);
            const float4 a0 = *(const float4*)(peer_u + e8), a1 = *(const float4*)(peer_u + e8 + 4);
            const float4 g0 = *(const float4*)(norm_ffn + l * D + k), g1 = *(const float4*)(norm_ffn + l * D + k + 4);
            u32x4 w; w.x = pk2(a0.x * g0.x, a0.y * g0.y); w.y = pk2(a0.z * g0.z, a0.w * g0.w); w.z = pk2(a1.x * g1.x, a1.y * g1.y); w.w = pk2(a1.z * g1.z, a1.w * g1.w);
            *(u32x4*)(UT + e8) = w;
            const float4 b0 = *(const float4*)(peer_v + e8), b1 = *(const float4*)(peer_v + e8 + 4);
            u32x4 y; y.x = pk2(b0.x, b0.y); y.y = pk2(b0.z, b0.w); y.z = pk2(b1.x, b1.y); y.w = pk2(b1.z, b1.w);
            *(u32x4*)(VT + e8) = y;
        }
    PHASE_END

    PHASE_BEGIN
        { pg8::Gemm g{XB, WIN0, T, 1792, D}; pg8::StaticOrder So; So.init(T, 1792, G, (int)blockIdx.x);
          pg8::EpiRowScaleBf16 Ep{P, PP, rstd0};
          pg8::gemm_phase<pg8::EpiRowScaleBf16, pg8::StaticOrder, true, PG8_SP2_ON>(ldsp, g, So, Ep); }
        { pg8::Gemm g{MEMB, WMEM, NB * MEMN, 1024, D}; pg8::StaticOrder So; So.init(NB * MEMN, 1024, G, (int)blockIdx.x);
          pg8::EpiRowScaleBf16 Ep{MEMKV, 1024, rstdm};
          pg8::gemm_phase<pg8::EpiRowScaleBf16, pg8::StaticOrder, true, PG8_SP2_ON>(ldsp, g, So, Ep); }
    PHASE_END

    PHASE_BEGIN
        scan_pass<false>(P, a_conv_w, a_conv_b, a_gate_w, a_gate_b, a_lambda, AGG, AIN, smem + wv * 4096);
        for (int item = gw; item < 2 * 2048 * 4; item += ngw) {
            const int l = item / (2048 * 4), rem = item % (2048 * 4), m = rem >> 2, h = rem & 3;
            bf16* kp = MEMKV + (size_t)m * 1024 + l * 512 + h * 64;
            const float v = ldbf(kp + lane);
            const float ss = wave_sum(v * v);
            kp[lane] = (bf16)f2bf(v * rsqrtf(ss * (1.f / 64.f) + EPS) * mem_k_gain[l * 64 + lane]);
        }
    PHASE_END

    PHASE_BEGIN
        scan_pass<true>(P, a_conv_w, a_conv_b, a_gate_w, a_gate_b, a_lambda, AGG, AIN, smem + wv * 4096);
        __syncthreads();
        mem_attention(P, 1536, MEMKV, 0, mem_q_gain, AIN, smem + wv * 64);
    PHASE_END

    PHASE_BEGIN
        { pg8::Gemm g{AIN, WOUT, T, D, D}; pg8::StaticOrder So; So.init(T, D, G, (int)blockIdx.x);
          pg8::EpiResidual Ep{x, out, XB, sumsq1};
          pg8::gemm_phase<pg8::EpiResidual, pg8::StaticOrder, true, PG8_SP2_ON>(ldsp, g, So, Ep); }
    PHASE_END

    PHASE_BEGIN
        for (int tile = blockIdx.x; tile < (T / 256) * 8; tile += gridDim.x) {
            const int pm = tile >> 3, pn = tile & 7;
            pg8::Gemm g{XB, WFt, T, 2048, D}; pg8::OneUnit So; So.u.pm = pm; So.u.pn = pn;
            pg8::EpiScoreScratch Ep{SCR, sumsq1};
            pg8::gemm_phase<pg8::EpiScoreScratch, pg8::OneUnit, false, PG8_SP2_ON>(ldsp, g, So, Ep);
            __syncthreads();
            topk_tile(SCR, pm * 256, pn, E, Gt);
        }
    PHASE_END

    PHASE_BEGIN
#ifdef PROBE_NAIVE_GATHER
        peer_gather_naive(out, sumsq1, norm_ffn, peer_u, peer_v, E, Gt);
#else
        peer_gather(out, XB, sumsq1, UT, VT, E, Gt, rstd2, smem + wv * 128);
#endif
    PHASE_END

    PHASE_BEGIN
        { pg8::Gemm g{XB, WKVB, T, 2048, D}; pg8::StaticOrder So; So.init(T, 2048, G, (int)blockIdx.x);
          pg8::EpiRowScaleBf16 Ep{P, PP, rstd2};
          pg8::gemm_phase<pg8::EpiRowScaleBf16, pg8::StaticOrder, true, PG8_SP2_ON>(ldsp, g, So, Ep); }
    PHASE_END

    PHASE_BEGIN
        for (int item = gw; item < T * 4; item += ngw) {
            const int row = item >> 2, g = (item >> 1) & 1, br = 1 + (item & 1);
            const int b = row / S, s = row % S;
            float v = ldbf(P + (size_t)row * PP + br * 256 + g * 64 + lane);
            const float ss = wave_sum(v * v);
            v = v * rsqrtf(ss * (1.f / 64.f) + EPS) * k_gain_shared[br * 64 + lane];
            const float partner = __shfl_xor(v, 8);
            if (lane < 16) { const int i = lane & 7; const float cs = ROPE[s * 16 + i], sn = ROPE[s * 16 + 8 + i];
                v = (lane < 8) ? (v * cs - partner * sn) : (v * cs + partner * sn); }
            bf16* dst = (br == 1) ? KS : KW;
            dst[((size_t)(b * 2 + g) * S + s) * 64 + lane] = (bf16)f2bf(v);
        }
        for (int i = gtid; i < 2 * 4096 * 256; i += ngt) {
            const int d8 = i & 7, l = (i >> 3) & 31, r = (i >> 8) & 4095, j = i >> 20;
            u32x4 v = (u32x4){0u, 0u, 0u, 0u};
            if (r < 4080) { const int g = r & 1, bn = r >> 1, b = bn / NCMP, n = bn % NCMP;
                v = *(const u32x4*)(P + (size_t)(b * S + 16 * n + l) * PP + j * 128 + g * 64 + d8 * 8); }
            *(u32x4*)(CA + ((size_t)(j * 4096 + r) * 2048 + l * 64 + d8 * 8)) = v;
        }
    PHASE_END

    PHASE_BEGIN
        for (int j = 0; j < 2; ++j) {
            pg8::Gemm g{CA + (size_t)j * 4096 * 2048, WC1 + (size_t)j * 256 * 2048, 4096, 256, 2048}; pg8::StaticOrder So; So.init(4096, 256, G, (int)blockIdx.x);
            pg8::EpiGeluBiasBf16 Ep{HID + (size_t)j * 4096 * 256, 256, BIAS2 + j * 256};
            pg8::gemm_phase<pg8::EpiGeluBiasBf16, pg8::StaticOrder, true, PG8_SP2_ON>(ldsp, g, So, Ep);
        }
    PHASE_END

    PHASE_BEGIN
        for (int item = gw; item < 2 * 4080; item += ngw) {
            const int j = item / 4080, it = item % 4080, g = it & 1, bn = it >> 1, b = bn / NCMP, n = bn % NCMP;
            const bf16* hp = HID + ((size_t)j * 4096 + it) * 256;
            const float* w2 = cmp_w2 + (size_t)j * 256 * 64 + lane;
            float acc = 0.f;
            for (int cc = 0; cc < 256; ++cc) acc = fmaf(ldbf(hp + cc), w2[cc * 64], acc);
            if (j == 0) {
                const float ss = wave_sum(acc * acc);
                float v = acc * rsqrtf(ss * (1.f / 64.f) + EPS) * k_gain_shared[0 * 64 + lane];
                const float partner = __shfl_xor(v, 8);
                const int sp = 16 * n + 31;
                if (lane < 16) { const int i = lane & 7; const float cs = ROPE[sp * 16 + i], sn = ROPE[sp * 16 + 8 + i];
                    v = (lane < 8) ? (v * cs - partner * sn) : (v * cs + partner * sn); }
                KC[((size_t)(b * 2 + g) * 256 + n) * 64 + lane] = (bf16)f2bf(v);
            } else {
                VC[((size_t)(b * 2 + g) * 256 + n) * 64 + lane] = (bf16)f2bf(acc);
            }
        }
    PHASE_END

    PHASE_BEGIN
        nsa_attention(P, KC, VC, KS, KW, ROPE, b_q_gain, b_gate_b, AIN, smem + wv * 64, smem + 512 + wv * 256);
        mem_attention(P, 1572, MEMKV, 512, mem_q_gain + 64, AIN, smem + wv * 64);
    PHASE_END

    PHASE_BEGIN
        { pg8::Gemm g{AIN, WOUT + (size_t)D * D, T, D, D}; pg8::StaticOrder So; So.init(T, D, G, (int)blockIdx.x);
          pg8::EpiResidual Ep{out, out, XB, sumsq3};
          pg8::gemm_phase<pg8::EpiResidual, pg8::StaticOrder, true, PG8_SP2_ON>(ldsp, g, So, Ep); }
    PHASE_END

    PHASE_BEGIN
        for (int tile = blockIdx.x; tile < (T / 256) * 8; tile += gridDim.x) {
            const int pm = tile >> 3, pn = tile & 7;
            pg8::Gemm g{XB, WFt + (size_t)2048 * 1024, T, 2048, D}; pg8::OneUnit So; So.u.pm = pm; So.u.pn = pn;
            pg8::EpiScoreScratch Ep{SCR, sumsq3};
            pg8::gemm_phase<pg8::EpiScoreScratch, pg8::OneUnit, false, PG8_SP2_ON>(ldsp, g, So, Ep);
            __syncthreads();
            topk_tile(SCR, pm * 256, pn, E, Gt);
        }
    PHASE_END

    PHASE_BEGIN
        peer_gather(out, XB, sumsq3, UT + (size_t)16384 * D, VT + (size_t)16384 * D, E, Gt, nullptr, smem + wv * 128);
    PHASE_END
#undef PHASE_BEGIN
#undef PHASE_END
}

template <int PH>
static void launch_phases(const Params& p, int grid, hipStream_t stream) {
    if constexpr (PH < N_PHASES) {
        static bool attr_set = false;
        if (!attr_set) { (void)hipFuncSetAttribute((const void*)fwd_kernel<PH, PH + 1>, hipFuncAttributeMaxDynamicSharedMemorySize, LDS_BYTES); attr_set = true; }
        hipLaunchKernelGGL((fwd_kernel<PH, PH + 1>), dim3(grid), dim3(NTHR), LDS_BYTES, stream, p);
        launch_phases<PH + 1>(p, grid, stream);
    }
}

extern "C" void kernel_launch(void* const* d_in, const int* in_sizes, int n_in, void* d_out, int out_size, void* d_ws, size_t ws_size, hipStream_t stream) {
    static int grid = 0;
    if (grid == 0) {
        if (n_in != 30 || out_size != T * D || ws_size < WS_END) { fprintf(stderr, "kernel_launch: unexpected shapes n_in %d out %d ws %zu\n", n_in, out_size, ws_size); grid = -1; return; }
        int dev = 0, cus = 0;
        (void)hipGetDevice(&dev);
        (void)hipDeviceGetAttribute(&cus, hipDeviceAttributeMultiprocessorCount, dev);
        grid = cus > 0 ? cus : 256;
    }
    if (grid < 0) return;
    Params p{};
    for (int i = 0; i < 30; ++i) p.in[i] = (const float*)d_in[i];
    p.out = (float*)d_out; p.ws = (unsigned char*)d_ws; p.ph_lo = 0; p.ph_hi = N_PHASES;
    launch_phases<0>(p, grid, stream);
}
```

```cpp
#include <hip/hip_runtime.h>
#include <hip/hip_cooperative_groups.h>
#include <cstdio>
#include <cstdint>
namespace cg = cooperative_groups;

constexpr int NB = 8, S = 4096, D = 1024, T = NB * S;
constexpr int MEMN = 256;
constexpr int LRUW = 768, NBLK = 12;
constexpr int NCMP = 255;
constexpr int PP = 2048;
constexpr int NTHR = 512;
constexpr float EPS = 1e-6f;
constexpr int NCHUNK = 64, CHL = 64;

typedef unsigned short bf16;
typedef unsigned u32x4 __attribute__((ext_vector_type(4)));
typedef unsigned u32x2 __attribute__((ext_vector_type(2)));
typedef __bf16 bf16x2_t __attribute__((ext_vector_type(2)));
typedef __bf16 bf16x8_t __attribute__((ext_vector_type(8)));
#define LAS __attribute__((address_space(3)))

constexpr size_t MiB = 1ull << 20;
constexpr size_t WS_CTL = 0;
constexpr size_t WS_RSTD = 1 * MiB;
constexpr size_t WS_ROPE = 2 * MiB;
constexpr size_t WS_BIAS2 = 2 * MiB + 512 * 1024;
constexpr size_t WS_WIN0 = 3 * MiB;
constexpr size_t WS_WOUT = 7 * MiB;
constexpr size_t WS_WF = 11 * MiB;
constexpr size_t WS_WKVB = 19 * MiB;
constexpr size_t WS_WMEM = 23 * MiB;
constexpr size_t WS_WC1 = 25 * MiB;
constexpr size_t WS_MEMB = 27 * MiB;
constexpr size_t WS_MEMKV = 31 * MiB;
constexpr size_t WS_SSQ1 = 35 * MiB;
constexpr size_t WS_SSQ3 = 37 * MiB;
constexpr size_t WS_SCAN = 39 * MiB;
constexpr size_t WS_HID = 42 * MiB;
constexpr size_t WS_KC = 46 * MiB;
constexpr size_t WS_VC = 47 * MiB;
constexpr size_t WS_CA = 48 * MiB;
constexpr size_t WS_E = 80 * MiB;
constexpr size_t WS_GT = 96 * MiB;
constexpr size_t WS_KS = 80 * MiB;
constexpr size_t WS_KW = 88 * MiB;
constexpr size_t WS_VST = 96 * MiB;
constexpr size_t WS_VWT = 104 * MiB;
constexpr size_t WS_XB = 112 * MiB;
constexpr size_t WS_AIN = 176 * MiB;
constexpr size_t WS_P = 240 * MiB;
constexpr size_t WS_UT = 368 * MiB;
constexpr size_t WS_VT = 432 * MiB;
constexpr size_t WS_MEMK = 496 * MiB;
constexpr size_t WS_MEMVT = 498 * MiB;
constexpr size_t WS_END = 500 * MiB;

struct Params {
    const float* in[30];
    float* out;
    unsigned char* ws;
    int ph_lo, ph_hi;
};

__device__ __forceinline__ float wave_sum(float v) {
#pragma unroll
    for (int o = 1; o < 64; o <<= 1) v += __shfl_xor(v, o);
    return v;
}
__device__ __forceinline__ float half_sum(float v) {
#pragma unroll
    for (int o = 1; o < 32; o <<= 1) v += __shfl_xor(v, o);
    return v;
}
__device__ __forceinline__ float half_max(float v) {
#pragma unroll
    for (int o = 1; o < 32; o <<= 1) v = fmaxf(v, __shfl_xor(v, o));
    return v;
}
__device__ __forceinline__ float gelu_tanh(float x) {
    const float k0 = 0.7978845608028654f, k1 = 0.044715f;
    float u = k0 * (x + k1 * x * x * x);
    float e = __expf(2.f * u);
    float th = 1.f - 2.f / (e + 1.f);
    return 0.5f * x * (1.f + th);
}
__device__ __forceinline__ float sigmoidf_(float x) { return 1.f / (1.f + __expf(-x)); }
__device__ __forceinline__ unsigned f2bf(float f) { unsigned u = __builtin_bit_cast(unsigned, f); return (u + 0x7fffu + ((u >> 16) & 1u)) >> 16; }
__device__ __forceinline__ unsigned pk2(float lo, float hi) { return f2bf(lo) | (f2bf(hi) << 16); }
__device__ __forceinline__ float bf2f(unsigned h) { return __builtin_bit_cast(float, h << 16); }
__device__ __forceinline__ float bflo(unsigned w) { return __builtin_bit_cast(float, w << 16); }
__device__ __forceinline__ float bfhi(unsigned w) { return __builtin_bit_cast(float, w & 0xffff0000u); }
__device__ __forceinline__ float ldbf(const bf16* p) { return bf2f((unsigned)*p); }
__device__ __forceinline__ float rstd_from_parts(const float* ssq16) {
    const float4 a = ((const float4*)ssq16)[0], b = ((const float4*)ssq16)[1], c = ((const float4*)ssq16)[2], d = ((const float4*)ssq16)[3];
    const float s = ((a.x + a.y) + (a.z + a.w)) + ((b.x + b.y) + (b.z + b.w)) + ((c.x + c.y) + (c.z + c.w)) + ((d.x + d.y) + (d.z + d.w));
    return rsqrtf(s * (1.f / 1024.f) + EPS);
}
namespace pg8 {
#define PG8_LAS __attribute__((address_space(3)))
typedef unsigned short bf16_t;
typedef short bf16x8 __attribute__((ext_vector_type(8)));
typedef float f32x4 __attribute__((ext_vector_type(4)));
typedef unsigned u32x4 __attribute__((ext_vector_type(4)));
constexpr int BM = 256, BK = 64, HALF = 128, HTB = HALF * BK * 2  , STAGE_BYTES = 8 * HTB, NXCD = 8, WGM = 8;

__host__ __device__ __forceinline__ int lds_byte(int r, int c) { const int st = (r >> 4) * 2 + (c >> 5), rr = r & 15, cc = c & 31, ob = rr * 64 + cc * 2; return st * 1024 + (ob ^ (((ob >> 9) & 1) << 5)); }
__host__ __device__ __forceinline__ void stage_rc(int b, int& R, int& C) { const int st = b / 1024, sb = b % 1024, swz = sb ^ (((sb >> 9) & 1) << 5); R = (st >> 1) * 16 + swz / 64; C = (st & 1) * 32 + (swz % 64) / 2; }
__host__ __device__ __forceinline__ int perm32(int rho) { const int n = rho >> 4, i = rho & 15; return 8 * (i >> 2) + 4 * n + (i & 3); }

struct Unit { int pm, pn; };
struct Gemm { const bf16_t* A; const bf16_t* Bt; int M, N, K; };

struct StaticOrder {
    int nM, nN, nwg, G, c;
    __host__ __device__ void init(int M, int N, int G_, int c_) { nM = M / BM; nN = N / BM; nwg = nM * nN; G = G_; c = c_; }
    __host__ __device__ bool next(int i, Unit& u) const {
        const long L = (long)i * G + c; if (L >= nwg) return false;
        int wgid = (int)L; { const int q = nwg / NXCD, r = nwg % NXCD, xcd = wgid % NXCD, off = wgid / NXCD; wgid = (xcd < r ? xcd * (q + 1) : r * (q + 1) + (xcd - r) * q) + off; }
        const int nig = WGM * nN, gid = wgid / nig, fm = gid * WGM, gsz = (nM - fm) < WGM ? (nM - fm) : WGM;
        u.pm = fm + ((wgid % nig) % gsz); u.pn = (wgid % nig) / gsz; return true;
    }
    __device__ __forceinline__ void a_ready(const Unit&) const {}
    __device__ __forceinline__ void done(const Unit&) const {}
};

__device__ __forceinline__ unsigned cvt_pk_bf16(float lo, float hi) { unsigned r; asm volatile("v_cvt_pk_bf16_f32 %0, %1, %2" : "=v"(r) : "v"(lo), "v"(hi)); return r; }
typedef float f32x2 __attribute__((ext_vector_type(2)));
template <class Epi, class Sched, bool ALIGN_EPI = false, bool SP2 = false>
__device__ __forceinline__ void gemm_phase(PG8_LAS unsigned char* lds, const Gemm g, const Sched& S, const Epi& E) {
    const int tid = threadIdx.x, wid = __builtin_amdgcn_readfirstlane(tid >> 6), lane = tid & 63, wr = wid >> 2, wc = wid & 3, fr = lane & 15, fq = lane >> 4;
    const int K = g.K, nt = K / BK;
    unsigned voffA[2], voffB[2];
#pragma unroll
    for (int i = 0; i < 2; ++i) { int R, C; stage_rc(tid * 16 + i * 8192, R, C); const int Rb = Epi::PERM ? ((R & ~31) + perm32(R & 31)) : R;
        voffA[i] = (unsigned)(R * K + C) * 2u; voffB[i] = (unsigned)(Rb * K + C) * 2u; }
    const size_t kstep = (size_t)(BK * 2);
    const size_t hstep = (size_t)HALF * K * 2;
    const size_t tstep = 2 * hstep;
    const unsigned ldsw = (unsigned)wid * 1024u;
    const int aoff = lds_byte(wr * 64 + fr, fq * 8), boff = lds_byte(wc * 32 + fr, fq * 8);
#define PG8_SA(b, h) (((b) * 2 + (h)) * HTB)
#define PG8_SB(b, h) ((4 + (b) * 2 + (h)) * HTB)
#define PG8_STAGE(bufoff, gbase, voff) do { _Pragma("unroll") for (int _i = 0; _i < 2; ++_i) \
        __builtin_amdgcn_global_load_lds((const unsigned*)((const char*)(gbase) + (voff)[_i]), (PG8_LAS unsigned*)(lds + (bufoff) + ldsw + _i * 8192), 16, 0, 0); } while (0)
#define PG8_LDA(dst, b, h) do { _Pragma("unroll") for (int m = 0; m < 4; ++m) _Pragma("unroll") for (int k = 0; k < 2; ++k) dst[m][k] = *(const PG8_LAS bf16x8*)(lds + PG8_SA(b, h) + aoff + m * 2048 + k * 1024); } while (0)
#define PG8_LDB(dst, b, h) do { _Pragma("unroll") for (int n = 0; n < 2; ++n) _Pragma("unroll") for (int k = 0; k < 2; ++k) dst[n][k] = *(const PG8_LAS bf16x8*)(lds + PG8_SB(b, h) + boff + n * 2048 + k * 1024); } while (0)
#define PG8_MMA(ai, bj, At, Bt) do { __builtin_amdgcn_s_setprio(1); _Pragma("unroll") for (int m = 0; m < 4; ++m) _Pragma("unroll") for (int n = 0; n < 2; ++n) _Pragma("unroll") for (int k = 0; k < 2; ++k) \
        acc[ai][bj][m][n] = __builtin_amdgcn_mfma_f32_16x16x32_bf16(Bt[n][k], At[m][k], acc[ai][bj][m][n], 0, 0, 0); __builtin_amdgcn_s_setprio(0); } while (0)
#define PG8_WAIT_V(n) asm volatile("s_waitcnt vmcnt(" #n ")" ::: "memory")
#define PG8_WAIT_L(n) asm volatile("s_waitcnt lgkmcnt(" #n ")" ::: "memory")
#define PG8_BAR __builtin_amdgcn_s_barrier()
#define PG8_SCHED __builtin_amdgcn_sched_barrier(0)
    Unit cur, nxt; int ui = 0;
    if (!S.next(0, cur)) return;
    f32x4 acc[2][2][4][2];
#pragma unroll
    for (int a = 0; a < 2; ++a)
#pragma unroll
        for (int b = 0; b < 2; ++b)
#pragma unroll
            for (int m = 0; m < 4; ++m)
#pragma unroll
                for (int n = 0; n < 2; ++n) acc[a][b][m][n] = (f32x4){0.f, 0.f, 0.f, 0.f};
    bf16x8 At[4][2], B0[2][2], B1[2][2];
    const char* cA = (const char*)g.A + (size_t)cur.pm * tstep; const char* cB = (const char*)g.Bt + (size_t)cur.pn * tstep;
    S.a_ready(cur);
    if constexpr (SP2) {
        PG8_STAGE(PG8_SB(0, 0), cB, voffB); PG8_STAGE(PG8_SB(0, 1), cB + hstep, voffB); PG8_STAGE(PG8_SA(0, 0), cA, voffA); PG8_STAGE(PG8_SA(0, 1), cA + hstep, voffA);
        if (wr == 1) PG8_BAR;
        PG8_WAIT_V(2); PG8_BAR;
        PG8_STAGE(PG8_SB(1, 0), cB + kstep, voffB); PG8_STAGE(PG8_SA(1, 0), cA + kstep, voffA); PG8_STAGE(PG8_SB(1, 1), cB + hstep + kstep, voffB);
        PG8_WAIT_V(6); PG8_BAR;
    } else {
        PG8_STAGE(PG8_SB(0, 0), cB, voffB); PG8_STAGE(PG8_SA(0, 0), cA, voffA); PG8_STAGE(PG8_SB(0, 1), cB + hstep, voffB); PG8_STAGE(PG8_SA(0, 1), cA + hstep, voffA);
        if (wr == 1) PG8_BAR;
        PG8_WAIT_V(4); PG8_BAR;
        PG8_STAGE(PG8_SB(1, 0), cB + kstep, voffB); PG8_STAGE(PG8_SA(1, 0), cA + kstep, voffA); PG8_STAGE(PG8_SB(1, 1), cB + hstep + kstep, voffB);
        PG8_WAIT_V(6); PG8_BAR;
    }
    for (;;) {
        const bool has_next = S.next(ui + 1, nxt);
        const char* nA = has_next ? (const char*)g.A + (size_t)nxt.pm * tstep : cA; const char* nB = has_next ? (const char*)g.Bt + (size_t)nxt.pn * tstep : cB;
        for (int t = 0; t < nt; t += 2) {
            const bool last = (t == nt - 2);
            const char* a1 = cA + (size_t)(t + 1) * kstep;
            const char* a2 = last ? nA : cA + (size_t)(t + 2) * kstep; const char* b2 = last ? nB : cB + (size_t)(t + 2) * kstep;
            const char* a3 = a2 + kstep; const char* b3 = b2 + kstep;
            if (last && has_next) S.a_ready(nxt);
            if constexpr (SP2) {
            PG8_LDB(B0, 0, 0); PG8_LDB(B1, 0, 1); PG8_SCHED; PG8_LDA(At, 0, 0); PG8_STAGE(PG8_SA(1, 1), a1 + hstep, voffA);
            PG8_WAIT_V(8); PG8_WAIT_L(0); PG8_BAR; PG8_MMA(0, 0, At, B0); PG8_MMA(0, 1, At, B1); PG8_BAR; PG8_SCHED;
            PG8_LDA(At, 0, 1); PG8_STAGE(PG8_SB(0, 0), b2, voffB); PG8_STAGE(PG8_SB(0, 1), b2 + hstep, voffB); PG8_STAGE(PG8_SA(0, 0), a2, voffA);
            PG8_WAIT_V(8); PG8_WAIT_L(0); PG8_BAR; PG8_MMA(1, 0, At, B0); PG8_MMA(1, 1, At, B1); PG8_BAR; PG8_SCHED;
            PG8_LDB(B0, 1, 0); PG8_LDB(B1, 1, 1); PG8_SCHED; PG8_LDA(At, 1, 0); PG8_STAGE(PG8_SA(0, 1), a2 + hstep, voffA);
            PG8_WAIT_V(8); PG8_WAIT_L(0); PG8_BAR; PG8_MMA(0, 0, At, B0); PG8_MMA(0, 1, At, B1); PG8_BAR; PG8_SCHED;
            PG8_LDA(At, 1, 1); PG8_STAGE(PG8_SB(1, 0), b3, voffB); PG8_STAGE(PG8_SB(1, 1), b3 + hstep, voffB); PG8_STAGE(PG8_SA(1, 0), a3, voffA);
            PG8_WAIT_V(8); PG8_WAIT_L(0); PG8_BAR; PG8_MMA(1, 0, At, B0); PG8_MMA(1, 1, At, B1); PG8_BAR; PG8_SCHED;
            } else {
            PG8_LDB(B0, 0, 0); PG8_SCHED; PG8_LDA(At, 0, 0); PG8_STAGE(PG8_SA(1, 1), a1 + hstep, voffA);
            PG8_WAIT_L(8); PG8_BAR; PG8_WAIT_L(0); PG8_MMA(0, 0, At, B0); PG8_BAR; PG8_SCHED;
            PG8_LDB(B1, 0, 1); PG8_STAGE(PG8_SB(0, 0), b2, voffB);
            PG8_BAR; PG8_WAIT_L(0); PG8_MMA(0, 1, At, B1); PG8_BAR;
            PG8_LDA(At, 0, 1); PG8_STAGE(PG8_SA(0, 0), a2, voffA);
            PG8_BAR; PG8_WAIT_L(0); PG8_MMA(1, 0, At, B0); PG8_BAR; PG8_SCHED;
            PG8_STAGE(PG8_SB(0, 1), b2 + hstep, voffB);
            PG8_WAIT_V(6); PG8_BAR; PG8_MMA(1, 1, At, B1); PG8_BAR;
            PG8_LDB(B0, 1, 0); PG8_SCHED; PG8_LDA(At, 1, 0); PG8_STAGE(PG8_SA(0, 1), a2 + hstep, voffA);
            PG8_WAIT_L(8); PG8_BAR; PG8_WAIT_L(0); PG8_MMA(0, 0, At, B0); PG8_BAR; PG8_SCHED;
            PG8_LDB(B1, 1, 1); PG8_STAGE(PG8_SB(1, 0), b3, voffB);
            PG8_BAR; PG8_WAIT_L(0); PG8_MMA(0, 1, At, B1); PG8_BAR;
            PG8_LDA(At, 1, 1); PG8_STAGE(PG8_SA(1, 0), a3, voffA);
            PG8_BAR; PG8_WAIT_L(0); PG8_MMA(1, 0, At, B0); PG8_BAR; PG8_SCHED;
            PG8_STAGE(PG8_SB(1, 1), b3 + hstep, voffB);
            PG8_WAIT_V(6); PG8_BAR; PG8_MMA(1, 1, At, B1); PG8_BAR;
            }
        }
        if constexpr (ALIGN_EPI) { if (wr == 0) PG8_BAR; }
        if constexpr (!Epi::AFTER_DRAIN) { E(acc, cur, wr, wc, fr, fq); S.done(cur); }
        if (!has_next) break;
#pragma unroll
        for (int a = 0; a < 2; ++a)
#pragma unroll
            for (int b = 0; b < 2; ++b)
#pragma unroll
                for (int m = 0; m < 4; ++m)
#pragma unroll
                    for (int n = 0; n < 2; ++n) acc[a][b][m][n] = (f32x4){0.f, 0.f, 0.f, 0.f};
        cur = nxt; cA = nA; cB = nB; ++ui;
        if constexpr (ALIGN_EPI) { if (wr == 1) PG8_BAR; }
    }
    PG8_WAIT_V(0);
    if constexpr (!ALIGN_EPI) { if (wr == 0) PG8_BAR; }
    PG8_BAR;
    if constexpr (Epi::AFTER_DRAIN) { E.fused(acc, cur, wr, wc, fr, fq, lds, wid, lane); S.done(cur); }
#undef PG8_SA
#undef PG8_SB
#undef PG8_STAGE
#undef PG8_LDA
#undef PG8_LDB
#undef PG8_MMA
#undef PG8_WAIT_V
#undef PG8_WAIT_L
#undef PG8_BAR
#undef PG8_SCHED
}
}

namespace pg8 {
struct OneUnit {
    Unit u;
    __device__ __forceinline__ bool next(int i, Unit& o) const { if (i > 0) return false; o = u; return true; }
    __device__ __forceinline__ void a_ready(const Unit&) const {}
    __device__ __forceinline__ void done(const Unit&) const {}
};
struct EpiRowScaleBf16 {
    static constexpr bool PERM = true, AFTER_DRAIN = false;
    bf16_t* O; int ldc; const float* rs;
    __device__ __forceinline__ void operator()(const f32x4 (&acc)[2][2][4][2], const Unit& u, int wr, int wc, int fr, int fq) const {
        const int row0 = u.pm * BM + wr * 64 + fr, col0 = u.pn * BM + wc * 32 + 8 * fq;
#pragma unroll
        for (int ai = 0; ai < 2; ++ai)
#pragma unroll
            for (int m = 0; m < 4; ++m) {
                const int row = row0 + ai * HALF + m * 16;
                const float sc = rs ? rs[row] : 1.f;
                bf16_t* rowp = O + (size_t)row * ldc + col0;
#pragma unroll
                for (int bj = 0; bj < 2; ++bj) {
                    const f32x4 v0 = acc[ai][bj][m][0] * sc, v1 = acc[ai][bj][m][1] * sc;
                    u32x4 w; w.x = cvt_pk_bf16(v0[0], v0[1]); w.y = cvt_pk_bf16(v0[2], v0[3]); w.z = cvt_pk_bf16(v1[0], v1[1]); w.w = cvt_pk_bf16(v1[2], v1[3]);
                    *(u32x4*)(rowp + bj * HALF) = w;
                }
            }
    }
};
struct EpiGeluBiasBf16 {
    static constexpr bool PERM = true, AFTER_DRAIN = false;
    bf16_t* O; int ldc; const float* bias;
    __device__ __forceinline__ void operator()(const f32x4 (&acc)[2][2][4][2], const Unit& u, int wr, int wc, int fr, int fq) const {
        const int row0 = u.pm * BM + wr * 64 + fr, col0 = u.pn * BM + wc * 32 + 8 * fq;
#pragma unroll
        for (int bj = 0; bj < 2; ++bj) {
            const f32x4 b0 = *(const f32x4*)(bias + col0 + bj * HALF), b1 = *(const f32x4*)(bias + col0 + bj * HALF + 4);
#pragma unroll
            for (int ai = 0; ai < 2; ++ai)
#pragma unroll
                for (int m = 0; m < 4; ++m) {
                    bf16_t* rowp = O + (size_t)(row0 + ai * HALF + m * 16) * ldc + col0 + bj * HALF;
                    const f32x4 v0 = acc[ai][bj][m][0] + b0, v1 = acc[ai][bj][m][1] + b1;
                    u32x4 w; w.x = cvt_pk_bf16(gelu_tanh(v0[0]), gelu_tanh(v0[1])); w.y = cvt_pk_bf16(gelu_tanh(v0[2]), gelu_tanh(v0[3]));
                    w.z = cvt_pk_bf16(gelu_tanh(v1[0]), gelu_tanh(v1[1])); w.w = cvt_pk_bf16(gelu_tanh(v1[2]), gelu_tanh(v1[3]));
                    *(u32x4*)rowp = w;
                }
        }
    }
};
struct EpiResidual {
    static constexpr bool PERM = true, AFTER_DRAIN = false;
    const float* base; float* out; bf16_t* xb; float* sumsq;
    __device__ __forceinline__ void operator()(const f32x4 (&acc)[2][2][4][2], const Unit& u, int wr, int wc, int fr, int fq) const {
        const int row0 = u.pm * BM + wr * 64 + fr, col0 = u.pn * BM + wc * 32 + 8 * fq;
#pragma unroll
        for (int ai = 0; ai < 2; ++ai)
#pragma unroll
            for (int m = 0; m < 4; ++m) {
                const int row = row0 + ai * HALF + m * 16;
                float ss = 0.f;
#pragma unroll
                for (int bj = 0; bj < 2; ++bj) {
                    const size_t off = (size_t)row * 1024 + col0 + bj * HALF;
                    const f32x4 r0 = *(const f32x4*)(base + off), r1 = *(const f32x4*)(base + off + 4);
                    const f32x4 v0 = acc[ai][bj][m][0] + r0, v1 = acc[ai][bj][m][1] + r1;
                    *(f32x4*)(out + off) = v0; *(f32x4*)(out + off + 4) = v1;
                    u32x4 w; w.x = cvt_pk_bf16(v0[0], v0[1]); w.y = cvt_pk_bf16(v0[2], v0[3]); w.z = cvt_pk_bf16(v1[0], v1[1]); w.w = cvt_pk_bf16(v1[2], v1[3]);
                    *(u32x4*)(xb + off) = w;
                    ss += v0[0] * v0[0] + v0[1] * v0[1] + v0[2] * v0[2] + v0[3] * v0[3] + v1[0] * v1[0] + v1[1] * v1[1] + v1[2] * v1[2] + v1[3] * v1[3];
                }
                ss += __shfl_xor(ss, 16); ss += __shfl_xor(ss, 32);
                if (fq == 0) sumsq[(size_t)row * 16 + u.pn * 4 + wc] = ss;
            }
    }
};
struct EpiScoreScratch {
    static constexpr bool PERM = true, AFTER_DRAIN = false;
    float* scr; const float* sumsq;
    __device__ __forceinline__ void operator()(const f32x4 (&acc)[2][2][4][2], const Unit& u, int wr, int wc, int fr, int fq) const {
        const int rl0 = wr * 64 + fr, cl0 = wc * 32 + 8 * fq;
#pragma unroll
        for (int ai = 0; ai < 2; ++ai)
#pragma unroll
            for (int m = 0; m < 4; ++m) {
                const int rl = rl0 + ai * HALF + m * 16;
                const float sc = rstd_from_parts(sumsq + (size_t)(u.pm * BM + rl) * 16);
#pragma unroll
                for (int bj = 0; bj < 2; ++bj) {
                    float* p = scr + rl * 256 + cl0 + bj * HALF;
                    *(f32x4*)p = acc[ai][bj][m][0] * sc; *(f32x4*)(p + 4) = acc[ai][bj][m][1] * sc;
                }
            }
    }
};
}

__device__ __forceinline__ void transpose_item(const float* __restrict__ W, int K, int N, const float* __restrict__ gain, bf16* __restrict__ WT, int row_off, float* scr, int item, int lane) {
    const int nblk = (N + 31) / 32, kb = item / nblk, nb = item % nblk, k0 = 64 * kb, n0 = 32 * nb;
    const int nn = n0 + (lane & 31);
#pragma unroll 8
    for (int i = 0; i < 32; ++i) { const int kk = 2 * i + (lane >> 5);
        float v = 0.f; if (nn < N) { v = W[(size_t)(k0 + kk) * N + nn]; if (gain) v *= gain[k0 + kk]; }
        scr[kk * 33 + (lane & 31)] = v; }
    __builtin_amdgcn_s_waitcnt(0); __builtin_amdgcn_wave_barrier();
    const int c = lane & 7;
#pragma unroll
    for (int j = 0; j < 4; ++j) { const int n = (lane >> 3) + 8 * j; const float* s = scr + (8 * c) * 33 + n;
        if (n0 + n < N) { u32x4 o; o.x = pk2(s[0 * 33], s[1 * 33]); o.y = pk2(s[2 * 33], s[3 * 33]); o.z = pk2(s[4 * 33], s[5 * 33]); o.w = pk2(s[6 * 33], s[7 * 33]);
            *(u32x4*)(WT + (size_t)(row_off + n0 + n) * K + k0 + 8 * c) = o; } }
    __builtin_amdgcn_s_waitcnt(0); __builtin_amdgcn_wave_barrier();
}
__device__ __forceinline__ void row_to_bf16(const float* __restrict__ xrow, bf16* __restrict__ orow, float* __restrict__ rstd, int lane) {
    const float4* xr = (const float4*)xrow + lane;
    float4 v[4]; float s = 0.f;
#pragma unroll
    for (int j = 0; j < 4; ++j) { v[j] = xr[64 * j]; s += v[j].x * v[j].x + v[j].y * v[j].y + v[j].z * v[j].z + v[j].w * v[j].w; }
    s = wave_sum(s);
    if (lane == 0) *rstd = rsqrtf(s * (1.f / D) + EPS);
    u32x2* o8 = (u32x2*)orow + lane;
#pragma unroll
    for (int j = 0; j < 4; ++j) { u32x2 w; w.x = pk2(v[j].x, v[j].y); w.y = pk2(v[j].z, v[j].w); o8[64 * j] = w; }
}

template <bool APPLY>
__device__ __forceinline__ void scan_pass(const bf16* __restrict__ P, const float* __restrict__ conv_w, const float* __restrict__ conv_b, const float* __restrict__ gate_w,
                                          const float* __restrict__ gate_b, const float* __restrict__ lam_p, float* __restrict__ AGG, bf16* __restrict__ AIN, float* xs  ) {
    const int lane = threadIdx.x & 63, gw = blockIdx.x * (NTHR / 64) + (threadIdx.x >> 6), ngw = gridDim.x * (NTHR / 64);
    for (int item = gw; item < NB * NCHUNK * NBLK; item += ngw) {
        const int n = item % NBLK, ci = (item / NBLK) % NCHUNK, b = item / (NBLK * NCHUNK);
        const int c = n * 64 + lane;
        float wr[64], wi[64];
#pragma unroll
        for (int d = 0; d < 64; ++d) { wr[d] = gate_w[((size_t)(0 * NBLK + n) * 64 + d) * 64 + lane]; wi[d] = gate_w[((size_t)(1 * NBLK + n) * 64 + d) * 64 + lane]; }
        const float brr = gate_b[c], bii = gate_b[LRUW + c];
        const float lam = lam_p[c];
        const float sp = (-lam > 20.f) ? -lam : log1pf(expf(-lam));
        const float cw0 = conv_w[0 * LRUW + c], cw1 = conv_w[1 * LRUW + c], cw2 = conv_w[2 * LRUW + c], cw3 = conv_w[3 * LRUW + c], cb = conv_b[c];
        const int s0 = ci * CHL;
        const bf16* xp = P + ((size_t)b * S + s0) * PP + c;
        float xm3 = (s0 >= 3) ? ldbf(xp - 3 * PP) : 0.f, xm2 = (s0 >= 2) ? ldbf(xp - 2 * PP) : 0.f, xm1 = (s0 >= 1) ? ldbf(xp - 1 * PP) : 0.f;
        __builtin_amdgcn_wave_barrier();
#pragma unroll 4
        for (int tt = 0; tt < CHL; ++tt) {
            const float x0 = ldbf(xp + (size_t)tt * PP);
            xs[tt * 64 + lane] = cb + cw0 * xm3 + cw1 * xm2 + cw2 * xm1 + cw3 * x0;
            xm3 = xm2; xm2 = xm1; xm1 = x0;
        }
        __builtin_amdgcn_s_waitcnt(0); __builtin_amdgcn_wave_barrier();
        float h = 0.f, Ap = 1.f;
        if (APPLY) {
            for (int k = 0; k < ci; ++k) { const float2 ah = *(const float2*)(AGG + (((size_t)b * NCHUNK + k) * LRUW + c) * 2); h = ah.x * h + ah.y; }
        }
#pragma unroll 1
        for (int tt = 0; tt < CHL; ++tt) {
            const float4* xr = (const float4*)(xs + tt * 64);
            float gr = brr, gi = bii;
#pragma unroll
            for (int k = 0; k < 16; ++k) { const float4 v = xr[k];
                gr += v.x * wr[4 * k] + v.y * wr[4 * k + 1] + v.z * wr[4 * k + 2] + v.w * wr[4 * k + 3];
                gi += v.x * wi[4 * k] + v.y * wi[4 * k + 1] + v.z * wi[4 * k + 2] + v.w * wi[4 * k + 3];
                if ((k & 3) == 3) __builtin_amdgcn_sched_barrier(0); }
            const float xt = xs[tt * 64 + lane];
            const float rg = sigmoidf_(gr), ig = sigmoidf_(gi);
            const float log_a = -8.0f * rg * sp;
            const float a = __expf(log_a);
            const float mult = sqrtf(-expm1f(2.0f * log_a));
            h = a * h + mult * (ig * xt);
            if (APPLY) {
                const size_t row = (size_t)b * S + s0 + tt;
                const float yb = ldbf(P + row * PP + 768 + c);
                AIN[row * D + c] = (bf16)f2bf(h * gelu_tanh(yb));
            } else Ap *= a;
        }
        if (!APPLY) *(float2*)(AGG + (((size_t)b * NCHUNK + ci) * LRUW + c) * 2) = make_float2(Ap, h);
        __builtin_amdgcn_s_waitcnt(0); __builtin_amdgcn_wave_barrier();
    }
}

__device__ __forceinline__ void attend_key(const float* q, const bf16* __restrict__ kp, const bf16* __restrict__ vp, float& m, float& l, float (&o)[32]) {
    float s = 0.f;
#pragma unroll
    for (int i = 0; i < 8; ++i) { const u32x4 k4 = ((const u32x4*)kp)[i]; const float4 qa = ((const float4*)q)[2 * i], qb = ((const float4*)q)[2 * i + 1];
        s += qa.x * bflo(k4.x) + qa.y * bfhi(k4.x) + qa.z * bflo(k4.y) + qa.w * bfhi(k4.y) + qb.x * bflo(k4.z) + qb.y * bfhi(k4.z) + qb.z * bflo(k4.w) + qb.w * bfhi(k4.w);
        if ((i & 1) == 1) __builtin_amdgcn_sched_barrier(0); }
    const float mn = fmaxf(m, s), a = __expf(m - mn), p = __expf(s - mn);
    l = l * a + p;
#pragma unroll
    for (int i = 0; i < 4; ++i) { const u32x4 v4 = ((const u32x4*)vp)[i];
        o[8 * i + 0] = o[8 * i + 0] * a + p * bflo(v4.x); o[8 * i + 1] = o[8 * i + 1] * a + p * bfhi(v4.x);
        o[8 * i + 2] = o[8 * i + 2] * a + p * bflo(v4.y); o[8 * i + 3] = o[8 * i + 3] * a + p * bfhi(v4.y);
        o[8 * i + 4] = o[8 * i + 4] * a + p * bflo(v4.z); o[8 * i + 5] = o[8 * i + 5] * a + p * bfhi(v4.z);
        o[8 * i + 6] = o[8 * i + 6] * a + p * bflo(v4.w); o[8 * i + 7] = o[8 * i + 7] * a + p * bfhi(v4.w);
        if ((i & 1) == 1) __builtin_amdgcn_sched_barrier(0); }
    m = mn;
}
__device__ __forceinline__ float merge_streams(float m, float l, float (&o)[32], int lane) {
    const float M = half_max(m);
    const float w = (m == -INFINITY) ? 0.f : __expf(m - M);
    const float L = half_sum(l * w);
    float res = 0.f;
#pragma unroll
    for (int d = 0; d < 32; ++d) { const float v = half_sum(o[d] * w); if ((lane & 31) == d) res = v; if ((d & 3) == 3) __builtin_amdgcn_sched_barrier(0); }
    return (L > 0.f) ? res / L : 0.f;
}
__device__ __forceinline__ void mem_attention(const bf16* __restrict__ P, int qoff, const bf16* __restrict__ memkv, int lc, const float* __restrict__ q_gain, bf16* __restrict__ AIN, float* q) {
    const int lane = threadIdx.x & 63, gw = blockIdx.x * (NTHR / 64) + (threadIdx.x >> 6), ngw = gridDim.x * (NTHR / 64);
    const int li = lane & 31, hd = (lane >> 5) * 32;
    for (int item = gw; item < T * 4; item += ngw) {
        const int row = item >> 2, h = item & 3, b = row / S;
        {
            float v = ldbf(P + (size_t)row * PP + qoff + h * 64 + lane);
            const float ss = wave_sum(v * v);
            v = v * rsqrtf(ss * (1.f / 64.f) + EPS) * 0.125f * q_gain[lane];
            __builtin_amdgcn_wave_barrier();
            q[lane] = v;
            __builtin_amdgcn_s_waitcnt(0); __builtin_amdgcn_wave_barrier();
        }
        float m = -INFINITY, l = 0.f, o[32];
#pragma unroll
        for (int d = 0; d < 32; ++d) o[d] = 0.f;
        for (int i = 0; i < 8; ++i) {
            const bf16* kr = memkv + (size_t)(b * MEMN + i * 32 + li) * 1024 + lc + h * 64;
            attend_key(q, kr, kr + 256 + hd, m, l, o);
        }
        const float r = merge_streams(m, l, o, lane);
        AIN[(size_t)row * D + 768 + h * 64 + lane] = (bf16)f2bf(r);
    }
}
__device__ __forceinline__ void load_q(float* q, const bf16* __restrict__ P, size_t row, int hq, const float* __restrict__ qgain, const float* __restrict__ rope_row, int lane) {
    float v = ldbf(P + row * PP + 768 + hq * 64 + lane);
    const float ss = wave_sum(v * v);
    v = v * rsqrtf(ss * (1.f / 64.f) + EPS) * qgain[lane];
    const float partner = __shfl_xor(v, 8);
    if (lane < 16) { const int i = lane & 7; const float cs = rope_row[i], sn = rope_row[8 + i];
        v = (lane < 8) ? (v * cs - partner * sn) : (v * cs + partner * sn); }
    __builtin_amdgcn_wave_barrier();
    q[lane] = v * 0.125f;
    __builtin_amdgcn_s_waitcnt(0); __builtin_amdgcn_wave_barrier();
}
__device__ __forceinline__ void nsa_attention(const bf16* __restrict__ P, const bf16* __restrict__ KC, const bf16* __restrict__ VC, const bf16* __restrict__ KS,
                                              const bf16* __restrict__ KW, const float* __restrict__ rope, const float* __restrict__ qgain,
                                              const float* __restrict__ gate_b, bf16* __restrict__ AIN, float* q, float* pbuf) {
    const int lane = threadIdx.x & 63, gw = blockIdx.x * (NTHR / 64) + (threadIdx.x >> 6), ngw = gridDim.x * (NTHR / 64);
    const int li = lane & 31, hd = (lane >> 5) * 32;
    for (int item = gw; item < NB * 2 * S; item += ngw) {
        const int t = item % S, g = (item / S) & 1, b = item / (2 * S);
        const size_t row = (size_t)b * S + t;
        const int c = t >> 6;
        const float* rope_row = rope + (size_t)t * 16;
        const bf16* kc = KC + (size_t)(b * 2 + g) * 256 * 64;
        const bf16* vc = VC + (size_t)(b * 2 + g) * 256 * 64;
        float ocmp[6];
        float imp = 0.f;
#pragma unroll 1
        for (int r = 0; r < 6; ++r) {
            load_q(q, P, row, g * 6 + r, qgain, rope_row, lane);
            float sc[8];
            float mx = -INFINITY;
#pragma unroll
            for (int i = 0; i < 8; ++i) {
                const int n = li + 32 * i;
                const bool ok = (n < NCMP) && (16 * n + 31 <= t);
                float a = -INFINITY;
                if (ok) {
                    a = 0.f;
                    const u32x4* kp = (const u32x4*)(kc + (size_t)n * 64);
#pragma unroll
                    for (int k = 0; k < 8; ++k) { const u32x4 k4 = kp[k]; const float4 qa = ((const float4*)q)[2 * k], qb = ((const float4*)q)[2 * k + 1];
                        a += qa.x * bflo(k4.x) + qa.y * bfhi(k4.x) + qa.z * bflo(k4.y) + qa.w * bfhi(k4.y) + qb.x * bflo(k4.z) + qb.y * bfhi(k4.z) + qb.z * bflo(k4.w) + qb.w * bfhi(k4.w);
                        if ((k & 1) == 1) __builtin_amdgcn_sched_barrier(0); }
                }
                sc[i] = a;
                mx = fmaxf(mx, a);
            }
            mx = half_max(mx);
            float ls = 0.f;
#pragma unroll
            for (int i = 0; i < 8; ++i) { sc[i] = (sc[i] == -INFINITY) ? 0.f : __expf(sc[i] - mx); ls += sc[i]; }
            ls = half_sum(ls);
            const float inv = (ls > 0.f) ? 1.f / ls : 0.f;
            float ol[32];
#pragma unroll
            for (int d = 0; d < 32; ++d) ol[d] = 0.f;
            __builtin_amdgcn_wave_barrier();
#pragma unroll
            for (int i = 0; i < 8; ++i) {
                const int n = li + 32 * i;
                const float pn = sc[i] * inv;
                if (lane < 32) pbuf[n] = pn;
                if (pn != 0.f) {
                    const u32x4* vp = (const u32x4*)(vc + (size_t)n * 64 + hd);
#pragma unroll
                    for (int k = 0; k < 4; ++k) { const u32x4 v4 = vp[k];
                        ol[8 * k + 0] += pn * bflo(v4.x); ol[8 * k + 1] += pn * bfhi(v4.x); ol[8 * k + 2] += pn * bflo(v4.y); ol[8 * k + 3] += pn * bfhi(v4.y);
                        ol[8 * k + 4] += pn * bflo(v4.z); ol[8 * k + 5] += pn * bfhi(v4.z); ol[8 * k + 6] += pn * bflo(v4.w); ol[8 * k + 7] += pn * bfhi(v4.w);
                        if ((k & 1) == 1) __builtin_amdgcn_sched_barrier(0); }
                }
            }
            float res = 0.f;
#pragma unroll
            for (int d = 0; d < 32; ++d) { const float v = half_sum(ol[d]); if (li == d) res = v; if ((d & 3) == 3) __builtin_amdgcn_sched_barrier(0); }
            ocmp[r] = res;
            __builtin_amdgcn_s_waitcnt(0); __builtin_amdgcn_wave_barrier();
            {
                const float4 p4 = ((const float4*)pbuf)[lane];
                const float pprev = (lane > 0) ? pbuf[4 * lane - 1] : 0.f;
                imp += p4.x + p4.y + p4.z + 0.5f * p4.w + 0.5f * pprev;
            }
            __builtin_amdgcn_s_waitcnt(0); __builtin_amdgcn_wave_barrier();
        }
        unsigned long long selmask;
        {
            const int j = lane;
            const bool valid = j <= c;
            const bool forced = (j == 0) || (j == c) || (j == c - 1);
            float v = forced ? 1e4f : imp;
            v = valid ? v : -1.f;
            int rank = 0;
            for (int jj = 0; jj < 64; ++jj) { const float o = __shfl(v, jj); rank += (o > v || (o == v && jj < j)) ? 1 : 0; }
            selmask = __ballot(rank < 16 && v >= 0.f);
        }
        const bf16* ks = KS + (size_t)(b * 2 + g) * S * 64;
        const bf16* kw = KW + (size_t)(b * 2 + g) * S * 64;
        const bf16* vs = P + (size_t)b * S * PP + 1 * 256 + 128 + g * 64 + hd;
        const bf16* vw = P + (size_t)b * S * PP + 2 * 256 + 128 + g * 64 + hd;
#pragma unroll 1
        for (int r = 0; r < 6; ++r) {
            const int hq = g * 6 + r;
            load_q(q, P, row, hq, qgain, rope_row, lane);
            float o[32];
            float m = -INFINITY, l = 0.f;
#pragma unroll
            for (int d = 0; d < 32; ++d) o[d] = 0.f;
            for (int jb = 0; jb <= c; ++jb) {
                if ((selmask >> jb) & 1ull) {
#pragma unroll 1
                    for (int sub = 0; sub < 2; ++sub) {
                        const int sidx = jb * 64 + sub * 32 + li;
                        if (sidx <= t) attend_key(q, ks + (size_t)sidx * 64, vs + (size_t)sidx * PP, m, l, o);
                    }
                }
            }
            const float osel = merge_streams(m, l, o, lane);
            m = -INFINITY; l = 0.f;
#pragma unroll
            for (int d = 0; d < 32; ++d) o[d] = 0.f;
            {
                const int s0 = (t - 511 > 0) ? (t - 511) : 0;
                for (int sidx = s0 + li; sidx <= t; sidx += 32) attend_key(q, kw + (size_t)sidx * 64, vw + (size_t)sidx * PP, m, l, o);
            }
            const float owin = merge_streams(m, l, o, lane);
            const bf16* gl = P + row * PP + 1536 + hq * 3;
            const float g0 = sigmoidf_(ldbf(gl) + gate_b[hq * 3 + 0]), g1 = sigmoidf_(ldbf(gl + 1) + gate_b[hq * 3 + 1]), g2 = sigmoidf_(ldbf(gl + 2) + gate_b[hq * 3 + 2]);
            AIN[row * D + hq * 64 + lane] = (bf16)f2bf(g0 * ocmp[r] + g1 * osel + g2 * owin);
        }
    }
}

__device__ __forceinline__ float pack_key(float v, unsigned idx, unsigned nbits_mask) {
    unsigned u = __builtin_bit_cast(unsigned, v);
    const unsigned tag = (u >> 31) ? idx : (nbits_mask - idx);
    u = (u & ~nbits_mask) | tag;
    return __builtin_bit_cast(float, u);
}
__device__ __forceinline__ void insert16(float (&L)[16], float x) {
#pragma unroll
    for (int i = 0; i < 16; ++i) { const float hi = fmaxf(L[i], x); x = fminf(L[i], x); L[i] = hi; }
}
__device__ __forceinline__ void topk_tile(float* scr, int t0, int h, int* __restrict__ E, float* __restrict__ Gt) {
    const int tid = threadIdx.x;
    {
        const int row = tid & 255, p = tid >> 8;
        float* sp = scr + row * 256 + p * 128;
        float L[16];
#pragma unroll
        for (int i = 0; i < 16; ++i) L[i] = -INFINITY;
#pragma unroll 2
        for (int k = 0; k < 32; ++k) {
            const float4 v = ((const float4*)sp)[k];
            insert16(L, pack_key(v.x, 4 * k + 0, 127u)); insert16(L, pack_key(v.y, 4 * k + 1, 127u));
            insert16(L, pack_key(v.z, 4 * k + 2, 127u)); insert16(L, pack_key(v.w, 4 * k + 3, 127u));
        }
#pragma unroll
        for (int i = 0; i < 4; ++i) ((float4*)sp)[i] = make_float4(L[4 * i], L[4 * i + 1], L[4 * i + 2], L[4 * i + 3]);
    }
    __syncthreads();
    if (tid < 256) {
        const int row = tid;
        const float* s1 = scr + row * 256, *s2 = s1 + 128;
        float v1[16], v2[16];
#pragma unroll
        for (int i = 0; i < 4; ++i) { const float4 a = ((const float4*)s1)[i], b = ((const float4*)s2)[i];
            v1[4 * i] = a.x; v1[4 * i + 1] = a.y; v1[4 * i + 2] = a.z; v1[4 * i + 3] = a.w; v2[4 * i] = b.x; v2[4 * i + 1] = b.y; v2[4 * i + 2] = b.z; v2[4 * i + 3] = b.w; }
        float L[16];
#pragma unroll
        for (int i = 0; i < 16; ++i) L[i] = -INFINITY;
#pragma unroll
        for (int a = 0; a < 16; ++a)
#pragma unroll
            for (int b = 0; b < 16; ++b)
                if ((a + 1) * (b + 1) <= 16) insert16(L, pack_key(v1[a] + v2[b], a * 16 + b, 255u));
        float mx = L[0], sm = 0.f, ex[16];
#pragma unroll
        for (int i = 0; i < 16; ++i) { ex[i] = __expf(L[i] - mx); sm += ex[i]; }
        const float inv = 1.f / sm;
        int* eo = E + (size_t)(t0 + row) * 128 + h * 16;
        float* go = Gt + (size_t)(t0 + row) * 128 + h * 16;
#pragma unroll
        for (int i = 0; i < 16; ++i) {
            const unsigned u = __builtin_bit_cast(unsigned, L[i]);
            const unsigned ci = (u >> 31) ? (u & 255u) : (255u - (u & 255u));
            const unsigned ua = __builtin_bit_cast(unsigned, s1[ci >> 4]), ub = __builtin_bit_cast(unsigned, s2[ci & 15]);
            const unsigned i1 = (ua >> 31) ? (ua & 127u) : (127u - (ua & 127u)), i2 = (ub >> 31) ? (ub & 127u) : (127u - (ub & 127u));
            eo[i] = (int)(i1 * 128u + i2); go[i] = ex[i] * inv;
        }
    }
    __syncthreads();
}

__device__ __forceinline__ void peer_gather(float* __restrict__ out, bf16* __restrict__ XB, const float* __restrict__ sumsq, const bf16* __restrict__ UT, const bf16* __restrict__ VT,
                                            const int* __restrict__ E, const float* __restrict__ Gt, float* __restrict__ rstd_next, float* actbuf  ) {
    const int lane = threadIdx.x & 63, gw = blockIdx.x * (NTHR / 64) + (threadIdx.x >> 6), ngw = gridDim.x * (NTHR / 64);
    const int g4 = lane >> 4, li = lane & 15;
    for (int t = gw; t < T; t += ngw) {
        const float rs = rstd_from_parts(sumsq + (size_t)t * 16);
        bf16x8_t hx[8];
#pragma unroll
        for (int j = 0; j < 8; ++j) hx[j] = *(const bf16x8_t*)(XB + (size_t)t * D + li * 8 + 128 * j);
        const int* ep = E + (size_t)t * 128; const float* gp = Gt + (size_t)t * 128;
#pragma unroll 2
        for (int step = 0; step < 32; ++step) {
            const int e = ep[4 * step + g4];
            const bf16* up = UT + (size_t)e * D + li * 8;
            bf16x8_t u[8];
#pragma unroll
            for (int j = 0; j < 8; ++j) u[j] = *(const bf16x8_t*)(up + 128 * j);
            float d = 0.f;
#pragma unroll
            for (int j = 0; j < 8; ++j) {
                d = __builtin_amdgcn_fdot2_f32_bf16(__builtin_shufflevector(u[j], u[j], 0, 1), __builtin_shufflevector(hx[j], hx[j], 0, 1), d, false);
                d = __builtin_amdgcn_fdot2_f32_bf16(__builtin_shufflevector(u[j], u[j], 2, 3), __builtin_shufflevector(hx[j], hx[j], 2, 3), d, false);
                d = __builtin_amdgcn_fdot2_f32_bf16(__builtin_shufflevector(u[j], u[j], 4, 5), __builtin_shufflevector(hx[j], hx[j], 4, 5), d, false);
                d = __builtin_amdgcn_fdot2_f32_bf16(__builtin_shufflevector(u[j], u[j], 6, 7), __builtin_shufflevector(hx[j], hx[j], 6, 7), d, false);
            }
            d += __shfl_xor(d, 1); d += __shfl_xor(d, 2); d += __shfl_xor(d, 4); d += __shfl_xor(d, 8);
            const float a = gelu_tanh(d * rs) * gp[4 * step + g4];
            if (li == 0) actbuf[4 * step + g4] = a;
        }
        __builtin_amdgcn_s_waitcnt(0); __builtin_amdgcn_wave_barrier();
        float acc[16];
#pragma unroll
        for (int i = 0; i < 16; ++i) acc[i] = 0.f;
        const int e_lo = ep[lane], e_hi = ep[64 + lane];
#pragma unroll 4
        for (int idx = 0; idx < 128; ++idx) {
            const int e = __builtin_amdgcn_readlane(idx < 64 ? e_lo : e_hi, idx & 63);
            const bf16* vp = VT + (size_t)e * D + lane * 8;
            const u32x4 va = *(const u32x4*)vp, vb = *(const u32x4*)(vp + 512);
            const float a = actbuf[idx];
            acc[0] += a * bflo(va.x); acc[1] += a * bfhi(va.x); acc[2] += a * bflo(va.y); acc[3] += a * bfhi(va.y);
            acc[4] += a * bflo(va.z); acc[5] += a * bfhi(va.z); acc[6] += a * bflo(va.w); acc[7] += a * bfhi(va.w);
            acc[8] += a * bflo(vb.x); acc[9] += a * bfhi(vb.x); acc[10] += a * bflo(vb.y); acc[11] += a * bfhi(vb.y);
            acc[12] += a * bflo(vb.z); acc[13] += a * bfhi(vb.z); acc[14] += a * bflo(vb.w); acc[15] += a * bfhi(vb.w);
        }
        float ss = 0.f;
#pragma unroll
        for (int hf = 0; hf < 2; ++hf) {
            float* op = out + (size_t)t * D + hf * 512 + lane * 8;
            const float4 x0 = *(const float4*)op, x1 = *(const float4*)(op + 4);
            const float4 r0 = make_float4(x0.x + acc[8 * hf + 0], x0.y + acc[8 * hf + 1], x0.z + acc[8 * hf + 2], x0.w + acc[8 * hf + 3]);
            const float4 r1 = make_float4(x1.x + acc[8 * hf + 4], x1.y + acc[8 * hf + 5], x1.z + acc[8 * hf + 6], x1.w + acc[8 * hf + 7]);
            *(float4*)op = r0; *(float4*)(op + 4) = r1;
            u32x4 w; w.x = pk2(r0.x, r0.y); w.y = pk2(r0.z, r0.w); w.z = pk2(r1.x, r1.y); w.w = pk2(r1.z, r1.w);
            *(u32x4*)(XB + (size_t)t * D + hf * 512 + lane * 8) = w;
            ss += r0.x * r0.x + r0.y * r0.y + r0.z * r0.z + r0.w * r0.w + r1.x * r1.x + r1.y * r1.y + r1.z * r1.z + r1.w * r1.w;
        }
        ss = wave_sum(ss);
        if (lane == 0 && rstd_next) rstd_next[t] = rsqrtf(ss * (1.f / D) + EPS);
        __builtin_amdgcn_s_waitcnt(0); __builtin_amdgcn_wave_barrier();
    }
}

__device__ __forceinline__ void peer_gather_naive(float* __restrict__ out, const float* __restrict__ sumsq, const float* __restrict__ gain,
                                            const float* __restrict__ U, const float* __restrict__ V, const int* __restrict__ E, const float* __restrict__ Gt) {
    const int lane = threadIdx.x & 63, gw = blockIdx.x * (NTHR / 64) + (threadIdx.x >> 6), ngw = gridDim.x * (NTHR / 64);
    for (int t = gw; t < T; t += ngw) {
        float4 x1[4], h2[4], acc[4];
        const float rs = rstd_from_parts(sumsq + (size_t)t * 16);
#pragma unroll
        for (int j = 0; j < 4; ++j) {
            x1[j] = ((const float4*)(out + (size_t)t * D))[64 * j + lane];
            float4 g = ((const float4*)gain)[64 * j + lane];
            h2[j] = make_float4(x1[j].x * rs * g.x, x1[j].y * rs * g.y, x1[j].z * rs * g.z, x1[j].w * rs * g.w);
            acc[j] = make_float4(0.f, 0.f, 0.f, 0.f);
        }
        for (int idx = 0; idx < 128; ++idx) {
            const int e = E[(size_t)t * 128 + idx]; const float gt = Gt[(size_t)t * 128 + idx];
            const float4* up = (const float4*)(U + (size_t)e * D) + lane;
            const float4* vp = (const float4*)(V + (size_t)e * D) + lane;
            float4 u[4], v[4];
#pragma unroll
            for (int j = 0; j < 4; ++j) { u[j] = up[64 * j]; v[j] = vp[64 * j]; }
            float d = 0.f;
#pragma unroll
            for (int j = 0; j < 4; ++j) d += u[j].x * h2[j].x + u[j].y * h2[j].y + u[j].z * h2[j].z + u[j].w * h2[j].w;
            d = wave_sum(d);
            const float a = gelu_tanh(d) * gt;
#pragma unroll
            for (int j = 0; j < 4; ++j) { acc[j].x += a * v[j].x; acc[j].y += a * v[j].y; acc[j].z += a * v[j].z; acc[j].w += a * v[j].w; }
        }
#pragma unroll
        for (int j = 0; j < 4; ++j) {
            float4 r = make_float4(x1[j].x + acc[j].x, x1[j].y + acc[j].y, x1[j].z + acc[j].z, x1[j].w + acc[j].w);
            ((float4*)(out + (size_t)t * D))[64 * j + lane] = r;
        }
    }
}

namespace att {
typedef short bf16x8 __attribute__((ext_vector_type(8)));
typedef short bf16x4 __attribute__((ext_vector_type(4)));
typedef float f32x4 __attribute__((ext_vector_type(4)));
constexpr int TROW = 144;
constexpr int TILE_B = 64 * TROW;
constexpr int OFF_K = 0, OFF_V = 2 * TILE_B, OFF_IMP = 4 * TILE_B  , OFF_SEL = OFF_IMP + 16384, OFF_ANY = OFF_SEL + 512, OFF_STAGE = OFF_ANY + 512;
constexpr int STAGE_ROW = 68;
constexpr int LDS_NEED = OFF_STAGE + 384 * STAGE_ROW * 4;
constexpr float QSCALE = 0.125f * 1.4426950408889634f;

__device__ __forceinline__ unsigned cvt_pk(float lo, float hi) { unsigned r; asm volatile("v_cvt_pk_bf16_f32 %0, %1, %2" : "=v"(r) : "v"(lo), "v"(hi)); return r; }

__device__ __forceinline__ void load_qfrag(bf16x8 (&qf)[2], const bf16* __restrict__ rowp, const float* __restrict__ gain, const float* __restrict__ rope_row, int g4) {
    const u32x4 w0 = *(const u32x4*)(rowp + 8 * g4), w1 = *(const u32x4*)(rowp + 32 + 8 * g4);
    float f0[8] = {bflo(w0.x), bfhi(w0.x), bflo(w0.y), bfhi(w0.y), bflo(w0.z), bfhi(w0.z), bflo(w0.w), bfhi(w0.w)};
    float f1[8] = {bflo(w1.x), bfhi(w1.x), bflo(w1.y), bfhi(w1.y), bflo(w1.z), bfhi(w1.z), bflo(w1.w), bfhi(w1.w)};
    float ss = 0.f;
#pragma unroll
    for (int j = 0; j < 8; ++j) ss += f0[j] * f0[j] + f1[j] * f1[j];
    ss += __shfl_xor(ss, 16); ss += __shfl_xor(ss, 32);
    const float rs = rsqrtf(ss * (1.f / 64.f) + EPS);
#pragma unroll
    for (int j = 0; j < 8; ++j) { f0[j] *= rs * gain[8 * g4 + j]; f1[j] *= rs * gain[32 + 8 * g4 + j]; }
    if (rope_row) {
#pragma unroll
        for (int j = 0; j < 8; ++j) {
            const float partner = __shfl_xor(f0[j], 16);
            const float cs = rope_row[j], sn = rope_row[8 + j];
            if (g4 == 0) f0[j] = f0[j] * cs - partner * sn;
            else if (g4 == 1) f0[j] = f0[j] * cs + partner * sn;
        }
    }
    u32x4 o0, o1;
    o0.x = cvt_pk(f0[0] * QSCALE, f0[1] * QSCALE); o0.y = cvt_pk(f0[2] * QSCALE, f0[3] * QSCALE); o0.z = cvt_pk(f0[4] * QSCALE, f0[5] * QSCALE); o0.w = cvt_pk(f0[6] * QSCALE, f0[7] * QSCALE);
    o1.x = cvt_pk(f1[0] * QSCALE, f1[1] * QSCALE); o1.y = cvt_pk(f1[2] * QSCALE, f1[3] * QSCALE); o1.z = cvt_pk(f1[4] * QSCALE, f1[5] * QSCALE); o1.w = cvt_pk(f1[6] * QSCALE, f1[7] * QSCALE);
    qf[0] = __builtin_bit_cast(bf16x8, o0); qf[1] = __builtin_bit_cast(bf16x8, o1);
}

template <int NU>
__device__ __forceinline__ void qk_tile(const unsigned char* Kt, const bf16x8 (&qf)[NU][2], f32x4 (&Sv)[NU][4], int c16, int g4) {
#pragma unroll
    for (int rt = 0; rt < 4; ++rt) {
        const bf16x8 k0 = *(const bf16x8*)(Kt + (16 * rt + c16) * TROW + 16 * g4);
        const bf16x8 k1 = *(const bf16x8*)(Kt + (16 * rt + c16) * TROW + 64 + 16 * g4);
#pragma unroll
        for (int u = 0; u < NU; ++u) {
            f32x4 a = {0.f, 0.f, 0.f, 0.f};
            a = __builtin_amdgcn_mfma_f32_16x16x32_bf16(k0, qf[u][0], a, 0, 0, 0);
            a = __builtin_amdgcn_mfma_f32_16x16x32_bf16(k1, qf[u][1], a, 0, 0, 0);
            Sv[u][rt] = a;
        }
        if (rt & 1) __builtin_amdgcn_sched_barrier(0);
    }
}
template <int NU>
__device__ __forceinline__ void pv_tile(const unsigned char* Vt, const f32x4 (&Sv)[NU][4], f32x4 (&O)[NU][4], int c16, int g4) {
    bf16x8 pf[NU][2];
#pragma unroll
    for (int u = 0; u < NU; ++u)
#pragma unroll
        for (int kk = 0; kk < 2; ++kk) {
            u32x4 w; w.x = cvt_pk(Sv[u][2 * kk][0], Sv[u][2 * kk][1]); w.y = cvt_pk(Sv[u][2 * kk][2], Sv[u][2 * kk][3]);
            w.z = cvt_pk(Sv[u][2 * kk + 1][0], Sv[u][2 * kk + 1][1]); w.w = cvt_pk(Sv[u][2 * kk + 1][2], Sv[u][2 * kk + 1][3]);
            pf[u][kk] = __builtin_bit_cast(bf16x8, w);
        }
#pragma unroll
    for (int dt = 0; dt < 4; ++dt)
#pragma unroll
        for (int kk = 0; kk < 2; ++kk) {
            const unsigned char* vr = Vt + (16 * dt + c16) * TROW + (32 * kk + 4 * g4) * 2;
            const u32x2 lo = *(const u32x2*)vr, hi = *(const u32x2*)(vr + 32);
            u32x4 w; w.x = lo.x; w.y = lo.y; w.z = hi.x; w.w = hi.y;
            const bf16x8 vf = __builtin_bit_cast(bf16x8, w);
#pragma unroll
            for (int u = 0; u < NU; ++u) O[u][dt] = __builtin_amdgcn_mfma_f32_16x16x32_bf16(vf, pf[u][kk], O[u][dt], 0, 0, 0);
            if (kk == 1 && (dt & 1)) __builtin_amdgcn_sched_barrier(0);
        }
}
template <int NU>
__device__ __forceinline__ void softmax_update(f32x4 (&Sv)[NU][4], float (&m)[NU], float (&l)[NU], f32x4 (&O)[NU][4], bool scaleO) {
#pragma unroll
    for (int u = 0; u < NU; ++u) {
        float mx = -INFINITY;
#pragma unroll
        for (int rt = 0; rt < 4; ++rt) mx = fmaxf(fmaxf(mx, fmaxf(Sv[u][rt][0], Sv[u][rt][1])), fmaxf(Sv[u][rt][2], Sv[u][rt][3]));
        mx = fmaxf(mx, __shfl_xor(mx, 16)); mx = fmaxf(mx, __shfl_xor(mx, 32));
        const float mn = fmaxf(m[u], mx);
        const float mu = (mn == -INFINITY) ? 0.f : mn;
        const float alpha = __builtin_amdgcn_exp2f(m[u] - mu);
        float ps = 0.f;
#pragma unroll
        for (int rt = 0; rt < 4; ++rt)
#pragma unroll
            for (int jj = 0; jj < 4; ++jj) { const float p = __builtin_amdgcn_exp2f(Sv[u][rt][jj] - mu); Sv[u][rt][jj] = p; ps += p; }
        l[u] = l[u] * alpha + ps;
        m[u] = mn;
        if (scaleO) {
#pragma unroll
            for (int dt = 0; dt < 4; ++dt) O[u][dt] = O[u][dt] * alpha;
        }
    }
}

__device__ __forceinline__ u32x4 tile_ld(const bf16* __restrict__ g, int tl) { return *(const u32x4*)(g + tl * 8); }
__device__ __forceinline__ void tile_st(unsigned char* lds_tile, u32x4 v, int tl) { *(u32x4*)(lds_tile + (tl >> 3) * TROW + (tl & 7) * 16) = v; }

__device__ __forceinline__ void mem_attention_mfma(const bf16* __restrict__ P, int qoff, const bf16* __restrict__ MK, const bf16* __restrict__ MVT, const float* __restrict__ q_gain,
                                                   bf16* __restrict__ AIN, unsigned char* lds) {
    const int lane = threadIdx.x & 63, wv = threadIdx.x >> 6, c16 = lane & 15, g4 = lane >> 4;
    for (int item = blockIdx.x; item < NB * 4 * 16; item += gridDim.x) {
        int tl = threadIdx.x; asm volatile("" : "+v"(tl));
        const int qt = item & 15, h = (item >> 4) & 3, b = item >> 6;
        const bf16* kb = MK + (size_t)(b * 4 + h) * 256 * 64;
        const bf16* vb = MVT + (size_t)(b * 4 + h) * 256 * 64;
        bf16x8 qf[2][2];
        size_t rowq[2];
#pragma unroll
        for (int u = 0; u < 2; ++u) { rowq[u] = (size_t)b * S + qt * 256 + wv * 32 + u * 16 + c16; load_qfrag(qf[u], P + rowq[u] * PP + qoff + h * 64, q_gain, nullptr, g4); }
        f32x4 O[2][4]; float m[2], l[2];
#pragma unroll
        for (int u = 0; u < 2; ++u) { m[u] = -INFINITY; l[u] = 0.f;
#pragma unroll
            for (int dt = 0; dt < 4; ++dt) O[u][dt] = (f32x4){0.f, 0.f, 0.f, 0.f}; }
        u32x4 kr = tile_ld(kb, tl), vr = tile_ld(vb, tl);
        __syncthreads();
        tile_st(lds + OFF_K, kr, tl); tile_st(lds + OFF_V, vr, tl);
        __syncthreads();
        for (int kt = 0; kt < 4; ++kt) {
            const int cur = kt & 1;
            if (kt + 1 < 4) { kr = tile_ld(kb + (size_t)(kt + 1) * 4096, tl); vr = tile_ld(vb + (size_t)(kt + 1) * 4096, tl); }
            f32x4 Sv[2][4];
            qk_tile<2>(lds + OFF_K + cur * TILE_B, qf, Sv, c16, g4);
            softmax_update<2>(Sv, m, l, O, true);
            pv_tile<2>(lds + OFF_V + cur * TILE_B, Sv, O, c16, g4);
            if (kt + 1 < 4) { tile_st(lds + OFF_K + (cur ^ 1) * TILE_B, kr, tl); tile_st(lds + OFF_V + (cur ^ 1) * TILE_B, vr, tl); }
            __syncthreads();
        }
#pragma unroll
        for (int u = 0; u < 2; ++u) {
            float lt = l[u]; lt += __shfl_xor(lt, 16); lt += __shfl_xor(lt, 32);
            const float inv = 1.f / lt;
#pragma unroll
            for (int dt = 0; dt < 4; ++dt) {
                u32x2 w; w.x = cvt_pk(O[u][dt][0] * inv, O[u][dt][1] * inv); w.y = cvt_pk(O[u][dt][2] * inv, O[u][dt][3] * inv);
                *(u32x2*)(AIN + rowq[u] * D + 768 + h * 64 + 16 * dt + 4 * g4) = w;
            }
        }
    }
}

__device__ __forceinline__ void nsa_attention_mfma(const bf16* __restrict__ P, const bf16* __restrict__ KC, const bf16* __restrict__ VCT, const bf16* __restrict__ KS, const bf16* __restrict__ VST,
                                                   const bf16* __restrict__ KW, const bf16* __restrict__ VWT, const float* __restrict__ rope, const float* __restrict__ qgain,
                                                   const float* __restrict__ gate_b, bf16* __restrict__ AIN, unsigned char* lds) {
    const int tid = threadIdx.x, lane = tid & 63, wv = tid >> 6, c16 = lane & 15, g4 = lane >> 4;
    int* imp = (int*)(lds + OFF_IMP);
    unsigned* selw = (unsigned*)(lds + OFF_SEL);
    unsigned* anyw = (unsigned*)(lds + OFF_ANY);
    float* stage = (float*)(lds + OFF_STAGE);
    const int nitems = NB * 2 * 64;
    for (int it = blockIdx.x; it < nitems; it += gridDim.x) {
        int tl = threadIdx.x; asm volatile("" : "+v"(tl));
        int b, g, c;
        if (gridDim.x == 256) { const int k = blockIdx.x, r = it >> 8, bg = k >> 4, s = k & 15; b = bg >> 1; g = bg & 1; c = (r == 0) ? s : (r == 1) ? 31 - s : (r == 2) ? 32 + s : 63 - s; }
        else { c = it & 63; g = (it >> 6) & 1; b = it >> 7; }
        const int bg2 = b * 2 + g;
        bf16x8 qf[3][2]; int qq[3], hq[3];
#pragma unroll
        for (int u = 0; u < 3; ++u) {
            const int U = 3 * wv + u; hq[u] = g * 6 + (U >> 2); qq[u] = (U & 3) * 16 + c16;
            const size_t row = (size_t)b * S + c * 64 + qq[u];
            load_qfrag(qf[u], P + row * PP + 768 + hq[u] * 64, qgain, rope + (size_t)(c * 64 + qq[u]) * 16, g4);
        }
        __syncthreads();
        for (int i = tid; i < 64 * 64; i += NTHR) imp[i] = 0;
        if (tid < 2) anyw[tid] = 0u;
        f32x4 O[3][4]; float m[3], l[3];
        const int ktmax = ((4 * c + 2) >> 6) > 3 ? 3 : ((4 * c + 2) >> 6);
        const bf16* kcb = KC + (size_t)bg2 * 256 * 64;
        const bf16* vcb = VCT + (size_t)bg2 * 256 * 64;
#pragma unroll
        for (int u = 0; u < 3; ++u) { m[u] = -INFINITY; l[u] = 0.f; }
        {
            u32x4 kr = tile_ld(kcb, tl);
            __syncthreads();
            tile_st(lds + OFF_K, kr, tl);
            __syncthreads();
            for (int kt = 0; kt <= ktmax; ++kt) {
                const int cur = kt & 1;
                if (kt + 1 <= ktmax) kr = tile_ld(kcb + (size_t)(kt + 1) * 4096, tl);
                f32x4 Sv[3][4];
                qk_tile<3>(lds + OFF_K + cur * TILE_B, qf, Sv, c16, g4);
#pragma unroll
                for (int u = 0; u < 3; ++u) { const int t = c * 64 + qq[u];
#pragma unroll
                    for (int rt = 0; rt < 4; ++rt)
#pragma unroll
                        for (int jj = 0; jj < 4; ++jj) { const int n = 64 * kt + 16 * rt + 4 * g4 + jj; if (!(n < NCMP && 16 * n + 31 <= t)) Sv[u][rt][jj] = -INFINITY; } }
                softmax_update<3>(Sv, m, l, O, false);
                if (kt + 1 <= ktmax) tile_st(lds + OFF_K + (cur ^ 1) * TILE_B, kr, tl);
                __syncthreads();
            }
        }
        float invl[3], mu[3];
#pragma unroll
        for (int u = 0; u < 3; ++u) { float lt = l[u]; lt += __shfl_xor(lt, 16); lt += __shfl_xor(lt, 32); invl[u] = (lt > 0.f) ? 1.f / lt : 0.f; mu[u] = (m[u] == -INFINITY) ? 0.f : m[u];
#pragma unroll
            for (int dt = 0; dt < 4; ++dt) O[u][dt] = (f32x4){0.f, 0.f, 0.f, 0.f}; }
        {
            u32x4 kr = tile_ld(kcb, tl), vr = tile_ld(vcb, tl);
            tile_st(lds + OFF_K, kr, tl); tile_st(lds + OFF_V, vr, tl);
            __syncthreads();
            for (int kt = 0; kt <= ktmax; ++kt) {
                const int cur = kt & 1;
                if (kt + 1 <= ktmax) { kr = tile_ld(kcb + (size_t)(kt + 1) * 4096, tl); vr = tile_ld(vcb + (size_t)(kt + 1) * 4096, tl); }
                f32x4 Sv[3][4];
                qk_tile<3>(lds + OFF_K + cur * TILE_B, qf, Sv, c16, g4);
#pragma unroll
                for (int u = 0; u < 3; ++u) { const int t = c * 64 + qq[u];
#pragma unroll
                    for (int rt = 0; rt < 4; ++rt) {
#pragma unroll
                        for (int jj = 0; jj < 4; ++jj) { const int n = 64 * kt + 16 * rt + 4 * g4 + jj; const bool ok = (n < NCMP && 16 * n + 31 <= t);
                            Sv[u][rt][jj] = ok ? __builtin_amdgcn_exp2f(Sv[u][rt][jj] - mu[u]) * invl[u] : 0.f; }
                        const int j = 16 * kt + 4 * rt + g4;
                        const float mainv = Sv[u][rt][0] + Sv[u][rt][1] + Sv[u][rt][2] + 0.5f * Sv[u][rt][3], spill = 0.5f * Sv[u][rt][3];
                        atomicAdd(&imp[qq[u] * 64 + j], (int)(mainv * 16777216.f + 0.5f));
                        if (j + 1 < 64) atomicAdd(&imp[qq[u] * 64 + j + 1], (int)(spill * 16777216.f + 0.5f));
                    } }
                pv_tile<3>(lds + OFF_V + cur * TILE_B, Sv, O, c16, g4);
                if (kt + 1 <= ktmax) { tile_st(lds + OFF_K + (cur ^ 1) * TILE_B, kr, tl); tile_st(lds + OFF_V + (cur ^ 1) * TILE_B, vr, tl); }
                __syncthreads();
            }
        }
#pragma unroll
        for (int u = 0; u < 3; ++u) { const float gcmp = sigmoidf_(ldbf(P + ((size_t)b * S + c * 64 + qq[u]) * PP + 1536 + hq[u] * 3 + 0) + gate_b[hq[u] * 3 + 0]);
#pragma unroll
            for (int dt = 0; dt < 4; ++dt) *(f32x4*)(stage + ((3 * wv + u) * 16 + c16) * STAGE_ROW + 16 * dt + 4 * g4) = O[u][dt] * gcmp; }
        {
#pragma unroll 1
            for (int i = 0; i < 8; ++i) {
                const int q = 8 * wv + i, j = lane;
                int v = imp[q * 64 + j];
                const bool valid = j <= c, forced = (j == 0) || (j == c) || (j == c - 1);
                v = forced ? 0x7fffffff : v;
                v = valid ? v : -1;
                int rank = 0;
#pragma unroll
                for (int jj = 0; jj < 64; ++jj) { const int o = __builtin_amdgcn_readlane(v, jj); rank += (o > v || (o == v && jj < j)) ? 1 : 0; }
                const unsigned long long msk = __ballot(rank < 16 && v >= 0);
                if (lane == 0) { selw[2 * q] = (unsigned)msk; selw[2 * q + 1] = (unsigned)(msk >> 32); atomicOr(&anyw[0], (unsigned)msk); atomicOr(&anyw[1], (unsigned)(msk >> 32)); }
            }
        }
        __syncthreads();
        unsigned long long anym = (unsigned long long)anyw[0] | ((unsigned long long)anyw[1] << 32);
        unsigned long long selm[3];
#pragma unroll
        for (int u = 0; u < 3; ++u) selm[u] = (unsigned long long)selw[2 * qq[u]] | ((unsigned long long)selw[2 * qq[u] + 1] << 32);
        {
            const bf16* ksb = KS + (size_t)bg2 * S * 64;
            const bf16* vsb = VST + (size_t)bg2 * S * 64;
#pragma unroll
            for (int u = 0; u < 3; ++u) { m[u] = -INFINITY; l[u] = 0.f;
#pragma unroll
                for (int dt = 0; dt < 4; ++dt) O[u][dt] = (f32x4){0.f, 0.f, 0.f, 0.f}; }
            int j = __builtin_ctzll(anym);
            u32x4 kr = tile_ld(ksb + (size_t)j * 4096, tl), vr = tile_ld(vsb + (size_t)j * 4096, tl);
            tile_st(lds + OFF_K, kr, tl); tile_st(lds + OFF_V, vr, tl);
            __syncthreads();
            int cur = 0;
            while (j >= 0) {
                const unsigned long long rest = (j < 63) ? (anym >> (j + 1)) : 0ull;
                const int jn = rest ? (j + 1 + __builtin_ctzll(rest)) : -1;
                if (jn >= 0) { kr = tile_ld(ksb + (size_t)jn * 4096, tl); vr = tile_ld(vsb + (size_t)jn * 4096, tl); }
                f32x4 Sv[3][4];
                qk_tile<3>(lds + OFF_K + cur * TILE_B, qf, Sv, c16, g4);
#pragma unroll
                for (int u = 0; u < 3; ++u) { const bool sel = (selm[u] >> j) & 1ull;
#pragma unroll
                    for (int rt = 0; rt < 4; ++rt)
#pragma unroll
                        for (int jj = 0; jj < 4; ++jj) { const int kk = 16 * rt + 4 * g4 + jj; if (!(sel && (j < c || kk <= qq[u]))) Sv[u][rt][jj] = -INFINITY; } }
                softmax_update<3>(Sv, m, l, O, true);
                pv_tile<3>(lds + OFF_V + cur * TILE_B, Sv, O, c16, g4);
                if (jn >= 0) { tile_st(lds + OFF_K + (cur ^ 1) * TILE_B, kr, tl); tile_st(lds + OFF_V + (cur ^ 1) * TILE_B, vr, tl); }
                __syncthreads();
                j = jn; cur ^= 1;
            }
#pragma unroll
            for (int u = 0; u < 3; ++u) { float lt = l[u]; lt += __shfl_xor(lt, 16); lt += __shfl_xor(lt, 32); const float sc = (lt > 0.f) ? sigmoidf_(ldbf(P + ((size_t)b * S + c * 64 + qq[u]) * PP + 1536 + hq[u] * 3 + 1) + gate_b[hq[u] * 3 + 1]) / lt : 0.f;
#pragma unroll
                for (int dt = 0; dt < 4; ++dt) { float* sp = stage + ((3 * wv + u) * 16 + c16) * STAGE_ROW + 16 * dt + 4 * g4; *(f32x4*)sp = *(f32x4*)sp + O[u][dt] * sc; } }
        }
        {
            const bf16* kwb = KW + (size_t)bg2 * S * 64;
            const bf16* vwb = VWT + (size_t)bg2 * S * 64;
#pragma unroll
            for (int u = 0; u < 3; ++u) { m[u] = -INFINITY; l[u] = 0.f;
#pragma unroll
                for (int dt = 0; dt < 4; ++dt) O[u][dt] = (f32x4){0.f, 0.f, 0.f, 0.f}; }
            const int j0 = (c >= 8) ? c - 8 : 0;
            u32x4 kr = tile_ld(kwb + (size_t)j0 * 4096, tl), vr = tile_ld(vwb + (size_t)j0 * 4096, tl);
            tile_st(lds + OFF_K, kr, tl); tile_st(lds + OFF_V, vr, tl);
            __syncthreads();
            int cur = 0;
            for (int j = j0; j <= c; ++j) {
                if (j + 1 <= c) { kr = tile_ld(kwb + (size_t)(j + 1) * 4096, tl); vr = tile_ld(vwb + (size_t)(j + 1) * 4096, tl); }
                f32x4 Sv[3][4];
                qk_tile<3>(lds + OFF_K + cur * TILE_B, qf, Sv, c16, g4);
                if (j == c || j == c - 8) {
#pragma unroll
                    for (int u = 0; u < 3; ++u)
#pragma unroll
                        for (int rt = 0; rt < 4; ++rt)
#pragma unroll
                            for (int jj = 0; jj < 4; ++jj) { const int kk = 16 * rt + 4 * g4 + jj; const bool ok = (j == c) ? (kk <= qq[u]) : (kk > qq[u]); if (!ok) Sv[u][rt][jj] = -INFINITY; }
                }
                softmax_update<3>(Sv, m, l, O, true);
                pv_tile<3>(lds + OFF_V + cur * TILE_B, Sv, O, c16, g4);
                if (j + 1 <= c) { tile_st(lds + OFF_K + (cur ^ 1) * TILE_B, kr, tl); tile_st(lds + OFF_V + (cur ^ 1) * TILE_B, vr, tl); }
                __syncthreads();
                cur ^= 1;
            }
#pragma unroll
            for (int u = 0; u < 3; ++u) { float lt = l[u]; lt += __shfl_xor(lt, 16); lt += __shfl_xor(lt, 32); const float sc = (lt > 0.f) ? sigmoidf_(ldbf(P + ((size_t)b * S + c * 64 + qq[u]) * PP + 1536 + hq[u] * 3 + 2) + gate_b[hq[u] * 3 + 2]) / lt : 0.f;
#pragma unroll
                for (int dt = 0; dt < 4; ++dt) { float* sp = stage + ((3 * wv + u) * 16 + c16) * STAGE_ROW + 16 * dt + 4 * g4; *(f32x4*)sp = *(f32x4*)sp + O[u][dt] * sc; } }
        }
        __syncthreads();
        for (int i = tid; i < 384 * 8; i += NTHR) {
            const int d8 = i & 7, col = i >> 3, r = col >> 6, q = col & 63;
            const float* sp = stage + col * STAGE_ROW + d8 * 8;
            const f32x4 a = *(const f32x4*)sp, bb = *(const f32x4*)(sp + 4);
            u32x4 w; w.x = cvt_pk(a[0], a[1]); w.y = cvt_pk(a[2], a[3]); w.z = cvt_pk(bb[0], bb[1]); w.w = cvt_pk(bb[2], bb[3]);
            *(u32x4*)(AIN + ((size_t)b * S + c * 64 + q) * D + (g * 6 + r) * 64 + d8 * 8) = w;
        }
    }
}
}

constexpr int N_PHASES = 15;
constexpr int LDS_BYTES = 163840;
static_assert(att::LDS_NEED <= LDS_BYTES, "attention LDS map");
#define PG8_SP2_ON true

template <int LO, int HI>
__global__ void __launch_bounds__(NTHR) fwd_kernel(Params p) {
    cg::grid_group grid = cg::this_grid();
    extern __shared__ __attribute__((aligned(16))) unsigned char lds_raw[];
    float* smem = (float*)lds_raw;
    PG8_LAS unsigned char* ldsp = (PG8_LAS unsigned char*)lds_raw;
    const int tid = threadIdx.x, lane = tid & 63, wv = tid >> 6;
    const int gw = blockIdx.x * (NTHR / 64) + wv, ngw = gridDim.x * (NTHR / 64);
    const int gtid = blockIdx.x * NTHR + tid, ngt = gridDim.x * NTHR;
    const int G = gridDim.x;

    const float* x = p.in[0]; const float* mem = p.in[1]; const int* positions = (const int*)p.in[2];
    const float* norm_mix = p.in[3]; const float* norm_ffn = p.in[4]; const float* norm_mem = p.in[5];
    const float* w_out = p.in[6]; const float* w_mem_kv = p.in[7]; const float* mem_q_gain = p.in[8]; const float* mem_k_gain = p.in[9];
    const float* a_w_in = p.in[10]; const float* a_conv_w = p.in[11]; const float* a_conv_b = p.in[12]; const float* a_gate_w = p.in[13];
    const float* a_gate_b = p.in[14]; const float* a_lambda = p.in[15]; const float* b_w_in = p.in[16]; const float* b_gate_b = p.in[17];
    const float* b_q_gain = p.in[18]; const float* kv_norm = p.in[19]; const float* w_kv_shared = p.in[20]; const float* k_gain_shared = p.in[21];
    const float* cmp_pos = p.in[22]; const float* cmp_w1 = p.in[23]; const float* cmp_b1 = p.in[24]; const float* cmp_w2 = p.in[25];
    const float* peer_wq = p.in[26]; const float* peer_subkeys = p.in[27]; const float* peer_u = p.in[28]; const float* peer_v = p.in[29];
    float* out = p.out;
    unsigned char* ws = p.ws;
    float* RSTD = (float*)(ws + WS_RSTD);
    float* rstd0 = RSTD, *rstd2 = RSTD + 2 * T, *rstdm = RSTD + 4 * T;
    float* sumsq1 = (float*)(ws + WS_SSQ1), *sumsq3 = (float*)(ws + WS_SSQ3);
    float* ROPE = (float*)(ws + WS_ROPE); float* BIAS2 = (float*)(ws + WS_BIAS2);
    bf16* WIN0 = (bf16*)(ws + WS_WIN0); bf16* WOUT = (bf16*)(ws + WS_WOUT); bf16* WFt = (bf16*)(ws + WS_WF); bf16* WKVB = (bf16*)(ws + WS_WKVB);
    bf16* WMEM = (bf16*)(ws + WS_WMEM); bf16* WC1 = (bf16*)(ws + WS_WC1); bf16* MEMB = (bf16*)(ws + WS_MEMB); bf16* MEMKV = (bf16*)(ws + WS_MEMKV);
    float* AGG = (float*)(ws + WS_SCAN); bf16* HID = (bf16*)(ws + WS_HID); bf16* KC = (bf16*)(ws + WS_KC); bf16* VC = (bf16*)(ws + WS_VC);
    bf16* CA = (bf16*)(ws + WS_CA); int* E = (int*)(ws + WS_E); float* Gt = (float*)(ws + WS_GT); bf16* KS = (bf16*)(ws + WS_KS); bf16* KW = (bf16*)(ws + WS_KW);
    bf16* XB = (bf16*)(ws + WS_XB); bf16* AIN = (bf16*)(ws + WS_AIN); bf16* P = (bf16*)(ws + WS_P);
    bf16* UT = (bf16*)(ws + WS_UT); bf16* VT = (bf16*)(ws + WS_VT);
    bf16* MEMK = (bf16*)(ws + WS_MEMK); bf16* MEMVT = (bf16*)(ws + WS_MEMVT); bf16* VST = (bf16*)(ws + WS_VST); bf16* VWT = (bf16*)(ws + WS_VWT);
    float* SCR = (float*)(ws + WS_AIN) + (size_t)blockIdx.x * 65536;

    constexpr int lo = LO, hi = HI;
    int ph = 0;
#define PHASE_BEGIN if (ph >= lo && ph < hi) {
#define PHASE_END } ++ph; if (ph > lo && ph < hi) grid.sync();

    PHASE_BEGIN
        for (int r = gw; r < T; r += ngw) row_to_bf16(x + (size_t)r * D, XB + (size_t)r * D, rstd0 + r, lane);
        for (int r = gw; r < NB * MEMN; r += ngw) row_to_bf16(mem + (size_t)r * D, MEMB + (size_t)r * D, rstdm + r, lane);
        for (int i = gtid; i < S * 8; i += ngt) {
            const int s = i >> 3, k = i & 7;
            const float freq = powf(500000.0f, -(float)k / 8.0f);
            const float ang = (float)positions[s] * freq;
            ROPE[s * 16 + k] = cosf(ang); ROPE[s * 16 + 8 + k] = sinf(ang);
        }
        {
            float* scr = smem + wv * (64 * 33);
            constexpr int I_IN0 = 16 * 56, I_OUT = 16 * 32, I_KV = 16 * 24, I_BIN = 16 * 34, I_MEM = 16 * 16, I_C1 = 32 * 8;
            constexpr int NIT = I_IN0 + 2 * I_OUT + I_KV + I_BIN + 2 * I_MEM + 2 * I_C1;
            for (int it = gw; it < NIT; it += ngw) {
                int r = it;
                if (r < I_IN0) { transpose_item(a_w_in, D, 1792, norm_mix, WIN0, 0, scr, r, lane); continue; } r -= I_IN0;
                if (r < I_OUT) { transpose_item(w_out, D, D, nullptr, WOUT, 0, scr, r, lane); continue; } r -= I_OUT;
                if (r < I_OUT) { transpose_item(w_out + (size_t)D * D, D, D, nullptr, WOUT + (size_t)D * D, 0, scr, r, lane); continue; } r -= I_OUT;
                if (r < I_KV) { transpose_item(w_kv_shared, D, 768, kv_norm, WKVB, 0, scr, r, lane); continue; } r -= I_KV;
                if (r < I_BIN) { transpose_item(b_w_in, D, 1060, norm_mix + D, WKVB, 768, scr, r, lane); continue; } r -= I_BIN;
                if (r < I_MEM) { transpose_item(w_mem_kv, D, 512, norm_mem, WMEM, 0, scr, r, lane); continue; } r -= I_MEM;
                if (r < I_MEM) { transpose_item(w_mem_kv + (size_t)D * 512, D, 512, norm_mem + D, WMEM, 512, scr, r, lane); continue; } r -= I_MEM;
                if (r < I_C1) { transpose_item(cmp_w1, 2048, 256, nullptr, WC1, 0, scr, r, lane); continue; } r -= I_C1;
                transpose_item(cmp_w1 + (size_t)2048 * 256, 2048, 256, nullptr, WC1 + (size_t)256 * 2048, 0, scr, r, lane);
            }
            for (int i = gtid; i < 220 * 1024 / 8; i += ngt) ((u32x4*)(WKVB + (size_t)1828 * 1024))[i] = (u32x4){0u, 0u, 0u, 0u};
        }
        for (int item = blockIdx.x; item < 2 * 16 * 2; item += gridDim.x) {
            const int l = item >> 5, hp = (item >> 1) & 15, kh = item & 1;
            const float* sk = peer_subkeys + ((size_t)l * 16 + hp) * 128 * 128;
            __syncthreads();
            for (int i = tid; i < 128 * 128; i += NTHR) smem[i] = sk[i];
            __syncthreads();
            const int k = kh * 512 + tid;
            const float4* wq = (const float4*)(peer_wq + ((size_t)l * D + k) * 2048 + hp * 128);
            float4 wr4[32];
#pragma unroll
            for (int i = 0; i < 32; ++i) wr4[i] = wq[i];
            const float gk = norm_ffn[l * D + k];
#pragma unroll 1
            for (int n = 0; n < 128; ++n) {
                const float4* sr = (const float4*)(smem + n * 128);
                float acc = 0.f;
#pragma unroll
                for (int i = 0; i < 32; ++i) { const float4 s4 = sr[i]; acc += wr4[i].x * s4.x + wr4[i].y * s4.y + wr4[i].z * s4.z + wr4[i].w * s4.w;
                    if ((i & 7) == 7) __builtin_amdgcn_sched_barrier(0); }
                WFt[((size_t)l * 2048 + hp * 128 + n) * 1024 + k] = (bf16)f2bf(acc * gk);
            }
        }
        for (int i = gtid; i < 512; i += ngt) {
            const int j = i >> 8, c = i & 255;
            float acc = cmp_b1[i];
            for (int k = 0; k < 2048; ++k) acc = fmaf(cmp_pos[j * 2048 + k], cmp_w1[((size_t)j * 2048 + k) * 256 + c], acc);
            BIAS2[i] = acc;
        }
        for (size_t i = gtid; i < (size_t)2 * 16384 * 128; i += ngt) {
            const size_t e8 = i * 8; const int l = (int)(e8 >> 24), k = (int)(e8 & 1023);
            const float4 a0 = *(const float4*)(peer_u + e8), a1 = *(const float4*)(peer_u + e8 + 4);
            const float4 g0 = *(const float4*)(norm_ffn + l * D + k), g1 = *(const float4*)(norm_ffn + l * D + k + 4);
            u32x4 w; w.x = pk2(a0.x * g0.x, a0.y * g0.y); w.y = pk2(a0.z * g0.z, a0.w * g0.w); w.z = pk2(a1.x * g1.x, a1.y * g1.y); w.w = pk2(a1.z * g1.z, a1.w * g1.w);
            *(u32x4*)(UT + e8) = w;
            const float4 b0 = *(const float4*)(peer_v + e8), b1 = *(const float4*)(peer_v + e8 + 4);
            u32x4 y; y.x = pk2(b0.x, b0.y); y.y = pk2(b0.z, b0.w); y.z = pk2(b1.x, b1.y); y.w = pk2(b1.z, b1.w);
            *(u32x4*)(VT + e8) = y;
        }
    PHASE_END

    PHASE_BEGIN
        { pg8::Gemm g{XB, WIN0, T, 1792, D}; pg8::StaticOrder So; So.init(T, 1792, G, (int)blockIdx.x);
          pg8::EpiRowScaleBf16 Ep{P, PP, rstd0};
          pg8::gemm_phase<pg8::EpiRowScaleBf16, pg8::StaticOrder, true, PG8_SP2_ON>(ldsp, g, So, Ep); }
        { pg8::Gemm g{MEMB, WMEM, NB * MEMN, 1024, D}; pg8::StaticOrder So; So.init(NB * MEMN, 1024, G, (int)blockIdx.x);
          pg8::EpiRowScaleBf16 Ep{MEMKV, 1024, rstdm};
          pg8::gemm_phase<pg8::EpiRowScaleBf16, pg8::StaticOrder, true, PG8_SP2_ON>(ldsp, g, So, Ep); }
    PHASE_END

    PHASE_BEGIN
        scan_pass<false>(P, a_conv_w, a_conv_b, a_gate_w, a_gate_b, a_lambda, AGG, AIN, smem + wv * 4096);
        for (int item = gw; item < 2 * 2048 * 4; item += ngw) {
            const int l = item / (2048 * 4), rem = item % (2048 * 4), row = rem >> 2, h = rem & 3, b = row >> 8, mm = row & 255;
            const bf16* kp = MEMKV + (size_t)row * 1024 + l * 512 + h * 64;
            const float v = ldbf(kp + lane);
            const float ss = wave_sum(v * v);
            const size_t hb = (size_t)((l * NB + b) * 4 + h);
            MEMK[(hb * 256 + mm) * 64 + lane] = (bf16)f2bf(v * rsqrtf(ss * (1.f / 64.f) + EPS) * mem_k_gain[l * 64 + lane]);
            MEMVT[(hb * 4 + (mm >> 6)) * 4096 + lane * 64 + (mm & 63)] = kp[256 + lane];
        }
    PHASE_END

    PHASE_BEGIN
        scan_pass<true>(P, a_conv_w, a_conv_b, a_gate_w, a_gate_b, a_lambda, AGG, AIN, smem + wv * 4096);
        __syncthreads();
        att::mem_attention_mfma(P, 1536, MEMK, MEMVT, mem_q_gain, AIN, lds_raw);
    PHASE_END

    PHASE_BEGIN
        { pg8::Gemm g{AIN, WOUT, T, D, D}; pg8::StaticOrder So; So.init(T, D, G, (int)blockIdx.x);
          pg8::EpiResidual Ep{x, out, XB, sumsq1};
          pg8::gemm_phase<pg8::EpiResidual, pg8::StaticOrder, true, PG8_SP2_ON>(ldsp, g, So, Ep); }
    PHASE_END

    PHASE_BEGIN
        for (int tile = blockIdx.x; tile < (T / 256) * 8; tile += gridDim.x) {
            const int pm = tile >> 3, pn = tile & 7;
            pg8::Gemm g{XB, WFt, T, 2048, D}; pg8::OneUnit So; So.u.pm = pm; So.u.pn = pn;
            pg8::EpiScoreScratch Ep{SCR, sumsq1};
            pg8::gemm_phase<pg8::EpiScoreScratch, pg8::OneUnit, false, PG8_SP2_ON>(ldsp, g, So, Ep);
            __syncthreads();
            topk_tile(SCR, pm * 256, pn, E, Gt);
        }
    PHASE_END

    PHASE_BEGIN
#ifdef PROBE_NAIVE_GATHER
        peer_gather_naive(out, sumsq1, norm_ffn, peer_u, peer_v, E, Gt);
#else
        peer_gather(out, XB, sumsq1, UT, VT, E, Gt, rstd2, smem + wv * 128);
#endif
    PHASE_END

    PHASE_BEGIN
        { pg8::Gemm g{XB, WKVB, T, 2048, D}; pg8::StaticOrder So; So.init(T, 2048, G, (int)blockIdx.x);
          pg8::EpiRowScaleBf16 Ep{P, PP, rstd2};
          pg8::gemm_phase<pg8::EpiRowScaleBf16, pg8::StaticOrder, true, PG8_SP2_ON>(ldsp, g, So, Ep); }
    PHASE_END

    PHASE_BEGIN
        for (int item = gw; item < T * 4; item += ngw) {
            const int row = item >> 2, g = (item >> 1) & 1, br = 1 + (item & 1);
            const int b = row / S, s = row % S;
            float v = ldbf(P + (size_t)row * PP + br * 256 + g * 64 + lane);
            const float ss = wave_sum(v * v);
            v = v * rsqrtf(ss * (1.f / 64.f) + EPS) * k_gain_shared[br * 64 + lane];
            const float partner = __shfl_xor(v, 8);
            if (lane < 16) { const int i = lane & 7; const float cs = ROPE[s * 16 + i], sn = ROPE[s * 16 + 8 + i];
                v = (lane < 8) ? (v * cs - partner * sn) : (v * cs + partner * sn); }
            bf16* dst = (br == 1) ? KS : KW;
            dst[((size_t)(b * 2 + g) * S + s) * 64 + lane] = (bf16)f2bf(v);
        }
        for (int i = gtid; i < 2 * NB * 2 * 64 * 8 * 64; i += ngt) {
            const int d = i & 63, kc = (i >> 6) & 7, blk = (i >> 9) & 63, g = (i >> 15) & 1, b = (i >> 16) & 7, br = 1 + (i >> 19);
            const bf16* src = P + ((size_t)b * S + 64 * blk + 8 * kc) * PP + br * 256 + 128 + g * 64 + d;
            u32x4 w;
            w.x = (unsigned)src[0] | ((unsigned)src[PP] << 16); w.y = (unsigned)src[2 * PP] | ((unsigned)src[3 * PP] << 16);
            w.z = (unsigned)src[4 * PP] | ((unsigned)src[5 * PP] << 16); w.w = (unsigned)src[6 * PP] | ((unsigned)src[7 * PP] << 16);
            bf16* dst = ((br == 1) ? VST : VWT) + ((size_t)((b * 2 + g) * 64 + blk)) * 4096 + d * 64 + 8 * kc;
            *(u32x4*)dst = w;
        }
        for (int i = gtid; i < 2 * 4096 * 256; i += ngt) {
            const int d8 = i & 7, l = (i >> 3) & 31, r = (i >> 8) & 4095, j = i >> 20;
            u32x4 v = (u32x4){0u, 0u, 0u, 0u};
            if (r < 4080) { const int g = r & 1, bn = r >> 1, b = bn / NCMP, n = bn % NCMP;
                v = *(const u32x4*)(P + (size_t)(b * S + 16 * n + l) * PP + j * 128 + g * 64 + d8 * 8); }
            *(u32x4*)(CA + ((size_t)(j * 4096 + r) * 2048 + l * 64 + d8 * 8)) = v;
        }
    PHASE_END

    PHASE_BEGIN
        for (int j = 0; j < 2; ++j) {
            pg8::Gemm g{CA + (size_t)j * 4096 * 2048, WC1 + (size_t)j * 256 * 2048, 4096, 256, 2048}; pg8::StaticOrder So; So.init(4096, 256, G, (int)blockIdx.x);
            pg8::EpiGeluBiasBf16 Ep{HID + (size_t)j * 4096 * 256, 256, BIAS2 + j * 256};
            pg8::gemm_phase<pg8::EpiGeluBiasBf16, pg8::StaticOrder, true, PG8_SP2_ON>(ldsp, g, So, Ep);
        }
    PHASE_END

    PHASE_BEGIN
        for (int i = gtid; i < NB * 2 * 64; i += ngt) VC[((size_t)((i >> 6) * 4 + 3)) * 4096 + (i & 63) * 64 + 63] = (bf16)0;
        for (int item = gw; item < 2 * 4080; item += ngw) {
            const int j = item / 4080, it = item % 4080, g = it & 1, bn = it >> 1, b = bn / NCMP, n = bn % NCMP;
            const bf16* hp = HID + ((size_t)j * 4096 + it) * 256;
            const float* w2 = cmp_w2 + (size_t)j * 256 * 64 + lane;
            float acc = 0.f;
            for (int cc = 0; cc < 256; ++cc) acc = fmaf(ldbf(hp + cc), w2[cc * 64], acc);
            if (j == 0) {
                const float ss = wave_sum(acc * acc);
                float v = acc * rsqrtf(ss * (1.f / 64.f) + EPS) * k_gain_shared[0 * 64 + lane];
                const float partner = __shfl_xor(v, 8);
                const int sp = 16 * n + 31;
                if (lane < 16) { const int i = lane & 7; const float cs = ROPE[sp * 16 + i], sn = ROPE[sp * 16 + 8 + i];
                    v = (lane < 8) ? (v * cs - partner * sn) : (v * cs + partner * sn); }
                KC[((size_t)(b * 2 + g) * 256 + n) * 64 + lane] = (bf16)f2bf(v);
            } else {
                VC[((size_t)((b * 2 + g) * 4 + (n >> 6))) * 4096 + lane * 64 + (n & 63)] = (bf16)f2bf(acc);
            }
        }
    PHASE_END

    PHASE_BEGIN
        att::nsa_attention_mfma(P, KC, VC, KS, VST, KW, VWT, ROPE, b_q_gain, b_gate_b, AIN, lds_raw);
        att::mem_attention_mfma(P, 1572, MEMK + (size_t)NB * 4 * 256 * 64, MEMVT + (size_t)NB * 4 * 256 * 64, mem_q_gain + 64, AIN, lds_raw);
    PHASE_END

    PHASE_BEGIN
        { pg8::Gemm g{AIN, WOUT + (size_t)D * D, T, D, D}; pg8::StaticOrder So; So.init(T, D, G, (int)blockIdx.x);
          pg8::EpiResidual Ep{out, out, XB, sumsq3};
          pg8::gemm_phase<pg8::EpiResidual, pg8::StaticOrder, true, PG8_SP2_ON>(ldsp, g, So, Ep); }
    PHASE_END

    PHASE_BEGIN
        for (int tile = blockIdx.x; tile < (T / 256) * 8; tile += gridDim.x) {
            const int pm = tile >> 3, pn = tile & 7;
            pg8::Gemm g{XB, WFt + (size_t)2048 * 1024, T, 2048, D}; pg8::OneUnit So; So.u.pm = pm; So.u.pn = pn;
            pg8::EpiScoreScratch Ep{SCR, sumsq3};
            pg8::gemm_phase<pg8::EpiScoreScratch, pg8::OneUnit, false, PG8_SP2_ON>(ldsp, g, So, Ep);
            __syncthreads();
            topk_tile(SCR, pm * 256, pn, E, Gt);
        }
    PHASE_END

    PHASE_BEGIN
        peer_gather(out, XB, sumsq3, UT + (size_t)16384 * D, VT + (size_t)16384 * D, E, Gt, nullptr, smem + wv * 128);
    PHASE_END
#undef PHASE_BEGIN
#undef PHASE_END
}

template <int PH>
static void launch_phases(const Params& p, int grid, hipStream_t stream) {
    if constexpr (PH < N_PHASES) {
        static bool attr_set = false;
        if (!attr_set) { (void)hipFuncSetAttribute((const void*)fwd_kernel<PH, PH + 1>, hipFuncAttributeMaxDynamicSharedMemorySize, LDS_BYTES); attr_set = true; }
        hipLaunchKernelGGL((fwd_kernel<PH, PH + 1>), dim3(grid), dim3(NTHR), LDS_BYTES, stream, p);
        launch_phases<PH + 1>(p, grid, stream);
    }
}

extern "C" void kernel_launch(void* const* d_in, const int* in_sizes, int n_in, void* d_out, int out_size, void* d_ws, size_t ws_size, hipStream_t stream) {
    static int grid = 0;
    if (grid == 0) {
        if (n_in != 30 || out_size != T * D || ws_size < WS_END) { fprintf(stderr, "kernel_launch: unexpected shapes n_in %d out %d ws %zu\n", n_in, out_size, ws_size); grid = -1; return; }
        int dev = 0, cus = 0;
        (void)hipGetDevice(&dev);
        (void)hipDeviceGetAttribute(&cus, hipDeviceAttributeMultiprocessorCount, dev);
        grid = cus > 0 ? cus : 256;
    }
    if (grid < 0) return;
    Params p{};
    for (int i = 0; i < 30; ++i) p.in[i] = (const float*)d_in[i];
    p.out = (float*)d_out; p.ws = (unsigned char*)d_ws; p.ph_lo = 0; p.ph_hi = N_PHASES;
    launch_phases<0>(p, grid, stream);
}
```

```cpp
#include <hip/hip_runtime.h>
#include <hip/hip_cooperative_groups.h>
#include <cstdio>
#include <cstdint>
namespace cg = cooperative_groups;

constexpr int NB = 8, S = 4096, D = 1024, T = NB * S;
constexpr int MEMN = 256;
constexpr int LRUW = 768, NBLK = 12;
constexpr int NCMP = 255;
constexpr int PP = 2048;
constexpr int NTHR = 512;
constexpr float EPS = 1e-6f;
constexpr int NCHUNK = 64, CHL = 64;

typedef unsigned short bf16;
typedef unsigned u32x4 __attribute__((ext_vector_type(4)));
typedef unsigned u32x2 __attribute__((ext_vector_type(2)));
typedef __bf16 bf16x2_t __attribute__((ext_vector_type(2)));
typedef __bf16 bf16x8_t __attribute__((ext_vector_type(8)));
#define LAS __attribute__((address_space(3)))

constexpr size_t MiB = 1ull << 20;
constexpr size_t WS_CTL = 0;
constexpr size_t WS_RSTD = 1 * MiB;
constexpr size_t WS_ROPE = 2 * MiB;
constexpr size_t WS_BIAS2 = 2 * MiB + 512 * 1024;
constexpr size_t WS_WGF = 2 * MiB + 768 * 1024;
constexpr size_t WS_SGC = 2 * MiB + 968 * 1024;
constexpr size_t WS_WIN0 = 3 * MiB;
constexpr size_t WS_WOUT = 7 * MiB;
constexpr size_t WS_WF = 11 * MiB;
constexpr size_t WS_WKVB = 19 * MiB;
constexpr size_t WS_WMEM = 23 * MiB;
constexpr size_t WS_WC1 = 25 * MiB;
constexpr size_t WS_MEMB = 27 * MiB;
constexpr size_t WS_MEMKV = 31 * MiB;
constexpr size_t WS_SSQ1 = 35 * MiB;
constexpr size_t WS_SSQ3 = 37 * MiB;
constexpr size_t WS_SCAN = 39 * MiB;
constexpr size_t WS_HID = 42 * MiB;
constexpr size_t WS_KC = 46 * MiB;
constexpr size_t WS_VC = 47 * MiB;
constexpr size_t WS_CA = 48 * MiB;
constexpr size_t WS_E = 80 * MiB;
constexpr size_t WS_GT = 96 * MiB;
constexpr size_t WS_KS = 80 * MiB;
constexpr size_t WS_KW = 88 * MiB;
constexpr size_t WS_VST = 96 * MiB;
constexpr size_t WS_VWT = 104 * MiB;
constexpr size_t WS_XB = 112 * MiB;
constexpr size_t WS_HP = 176 * MiB;
constexpr size_t WS_AIN = 176 * MiB;
constexpr size_t WS_P = 240 * MiB;
constexpr size_t WS_UT = 368 * MiB;
constexpr size_t WS_VT = 400 * MiB;
constexpr size_t WS_SSQ2 = 432 * MiB;
constexpr size_t WS_MEMK = 496 * MiB;
constexpr size_t WS_MEMVT = 498 * MiB;
constexpr size_t WS_END = 500 * MiB;

struct Params {
    const float* in[30];
    float* out;
    unsigned char* ws;
    int ph_lo, ph_hi;
};

__device__ __forceinline__ int lane_now() { int l; asm volatile("v_mbcnt_lo_u32_b32 %0, -1, 0\n\tv_mbcnt_hi_u32_b32 %0, -1, %0" : "=v"(l)); return l; }
template <int M> __device__ __forceinline__ float sxor(float v) {
    if constexpr (M < 32) return __builtin_bit_cast(float, __builtin_amdgcn_ds_swizzle(__builtin_bit_cast(int, v), (M << 10) | 0x1f));
    else { const int l = lane_now();
           return __builtin_bit_cast(float, __builtin_amdgcn_ds_bpermute((l ^ 32) << 2, __builtin_bit_cast(int, v))); }
}
__device__ __forceinline__ float half_sum(float v) { v += sxor<1>(v); v += sxor<2>(v); v += sxor<4>(v); v += sxor<8>(v); v += sxor<16>(v); return v; }
__device__ __forceinline__ float half_max(float v) { v = fmaxf(v, sxor<1>(v)); v = fmaxf(v, sxor<2>(v)); v = fmaxf(v, sxor<4>(v)); v = fmaxf(v, sxor<8>(v)); v = fmaxf(v, sxor<16>(v)); return v; }
__device__ __forceinline__ float wave_sum(float v) { v = half_sum(v); v += sxor<32>(v); return v; }
__device__ __forceinline__ float wave_max(float v) { v = half_max(v); v = fmaxf(v, sxor<32>(v)); return v; }
__device__ __forceinline__ float gelu_tanh(float x) {
    const float c0 = -2.f * 0.7978845608028654f * 1.4426950408889634f, c1 = c0 * 0.044715f;
    const float e = __builtin_amdgcn_exp2f(x * (c0 + c1 * x * x));
    return x * __builtin_amdgcn_rcpf(1.f + e);
}
__device__ __forceinline__ float sigmoidf_(float x) { return __builtin_amdgcn_rcpf(1.f + __builtin_amdgcn_exp2f(x * -1.4426950408889634f)); }
typedef float f32x2_t __attribute__((ext_vector_type(2)));
__device__ __forceinline__ unsigned pk2(float lo, float hi) { const f32x2_t v = {lo, hi}; return __builtin_bit_cast(unsigned, __builtin_convertvector(v, bf16x2_t)); }
__device__ __forceinline__ unsigned f2bf(float f) { return pk2(f, f) & 0xffffu; }
__device__ __forceinline__ float bf2f(unsigned h) { return __builtin_bit_cast(float, h << 16); }
__device__ __forceinline__ float bflo(unsigned w) { return __builtin_bit_cast(float, w << 16); }
__device__ __forceinline__ float bfhi(unsigned w) { return __builtin_bit_cast(float, w & 0xffff0000u); }
__device__ __forceinline__ float ldbf(const bf16* p) { return bf2f((unsigned)*p); }
__device__ __forceinline__ const void* lds_ptr_uniform(const __attribute__((address_space(3))) unsigned char* a) {
    const u32x2 w = *(const __attribute__((address_space(3))) u32x2*)a;
    const unsigned lo = __builtin_amdgcn_readfirstlane(w.x), hi = __builtin_amdgcn_readfirstlane(w.y);
    return (const void*)(((unsigned long long)hi << 32) | lo);
}
__device__ __forceinline__ float rstd_from_parts(const float* ssq16) {
    const float4 a = ((const float4*)ssq16)[0], b = ((const float4*)ssq16)[1], c = ((const float4*)ssq16)[2], d = ((const float4*)ssq16)[3];
    const float s = ((a.x + a.y) + (a.z + a.w)) + ((b.x + b.y) + (b.z + b.w)) + ((c.x + c.y) + (c.z + c.w)) + ((d.x + d.y) + (d.z + d.w));
    return rsqrtf(s * (1.f / 1024.f) + EPS);
}
namespace pg8 {
#define PG8_LAS __attribute__((address_space(3)))
typedef unsigned short bf16_t;
typedef short bf16x8 __attribute__((ext_vector_type(8)));
typedef float f32x4 __attribute__((ext_vector_type(4)));
typedef unsigned u32x4 __attribute__((ext_vector_type(4)));
constexpr int BM = 256, BK = 64, HALF = 128, HTB = HALF * BK * 2  , STAGE_BYTES = 8 * HTB, NXCD = 8, WGM = 8;

__host__ __device__ __forceinline__ int lds_byte(int r, int c) { const int st = (r >> 4) * 2 + (c >> 5), rr = r & 15, cc = c & 31, ob = rr * 64 + cc * 2; return st * 1024 + (ob ^ (((ob >> 9) & 1) << 5)); }
__host__ __device__ __forceinline__ void stage_rc(int b, int& R, int& C) { const int st = b / 1024, sb = b % 1024, swz = sb ^ (((sb >> 9) & 1) << 5); R = (st >> 1) * 16 + swz / 64; C = (st & 1) * 32 + (swz % 64) / 2; }
__host__ __device__ __forceinline__ int perm32(int rho) { const int n = rho >> 4, i = rho & 15; return 8 * (i >> 2) + 4 * n + (i & 3); }

struct Unit { int pm, pn; };
struct Gemm { const bf16_t* A; const bf16_t* Bt; int M, N, K; };

struct StaticOrder {
    int nM, nN, nwg, G, c;
    __host__ __device__ void init(int M, int N, int G_, int c_) { nM = M / BM; nN = N / BM; nwg = nM * nN; G = G_; c = c_; }
    __host__ __device__ bool next(int i, Unit& u) const {
        const long L = (long)i * G + c; if (L >= nwg) return false;
        int wgid = (int)L; { const int q = nwg / NXCD, r = nwg % NXCD, xcd = wgid % NXCD, off = wgid / NXCD; wgid = (xcd < r ? xcd * (q + 1) : r * (q + 1) + (xcd - r) * q) + off; }
        const int nig = WGM * nN, gid = wgid / nig, fm = gid * WGM, gsz = (nM - fm) < WGM ? (nM - fm) : WGM;
        u.pm = fm + ((wgid % nig) % gsz); u.pn = (wgid % nig) / gsz; return true;
    }
    __device__ __forceinline__ void a_ready(const Unit&) const {}
    __device__ __forceinline__ void done(const Unit&) const {}
};

__device__ __forceinline__ unsigned cvt_pk_bf16(float lo, float hi) { return ::pk2(lo, hi); }
typedef float f32x2 __attribute__((ext_vector_type(2)));
template <class Epi, class Sched, bool ALIGN_EPI = false, bool SP2 = false>
__device__ __forceinline__ void gemm_phase(PG8_LAS unsigned char* lds, const Gemm g, const Sched& S, const Epi& E, const int tid) {
    const int wid = __builtin_amdgcn_readfirstlane(tid >> 6), lane = tid & 63, wr = wid >> 2, wc = wid & 3, fr = lane & 15, fq = lane >> 4;
    const int K = g.K, nt = K / BK;
    unsigned voffA[2], voffB[2];
#pragma unroll
    for (int i = 0; i < 2; ++i) { int R, C; stage_rc(tid * 16 + i * 8192, R, C); const int Rb = Epi::PERM ? ((R & ~31) + perm32(R & 31)) : R;
        voffA[i] = (unsigned)(R * K + C) * 2u; voffB[i] = (unsigned)(Rb * K + C) * 2u; }
    const size_t kstep = (size_t)(BK * 2);
    const size_t hstep = (size_t)HALF * K * 2;
    const size_t tstep = 2 * hstep;
    const unsigned ldsw = (unsigned)wid * 1024u;
    const int aoff = lds_byte(wr * 64 + fr, fq * 8), boff = lds_byte(wc * 32 + fr, fq * 8);
#define PG8_SA(b, h) (((b) * 2 + (h)) * HTB)
#define PG8_SB(b, h) ((4 + (b) * 2 + (h)) * HTB)
#define PG8_STAGE(bufoff, gbase, voff) do { _Pragma("unroll") for (int _i = 0; _i < 2; ++_i) \
        __builtin_amdgcn_global_load_lds((const unsigned*)((const char*)(gbase) + (voff)[_i]), (PG8_LAS unsigned*)(lds + (bufoff) + ldsw + _i * 8192), 16, 0, 0); } while (0)
#define PG8_LDA(dst, b, h) do { _Pragma("unroll") for (int m = 0; m < 4; ++m) _Pragma("unroll") for (int k = 0; k < 2; ++k) dst[m][k] = *(const PG8_LAS bf16x8*)(lds + PG8_SA(b, h) + aoff + m * 2048 + k * 1024); } while (0)
#define PG8_LDB(dst, b, h) do { _Pragma("unroll") for (int n = 0; n < 2; ++n) _Pragma("unroll") for (int k = 0; k < 2; ++k) dst[n][k] = *(const PG8_LAS bf16x8*)(lds + PG8_SB(b, h) + boff + n * 2048 + k * 1024); } while (0)
#define PG8_MMA(ai, bj, At, Bt) do { __builtin_amdgcn_s_setprio(1); _Pragma("unroll") for (int m = 0; m < 4; ++m) _Pragma("unroll") for (int n = 0; n < 2; ++n) _Pragma("unroll") for (int k = 0; k < 2; ++k) \
        acc[ai][bj][m][n] = __builtin_amdgcn_mfma_f32_16x16x32_bf16(Bt[n][k], At[m][k], acc[ai][bj][m][n], 0, 0, 0); __builtin_amdgcn_s_setprio(0); } while (0)
#define PG8_WAIT_V(n) asm volatile("s_waitcnt vmcnt(" #n ")" ::: "memory")
#define PG8_WAIT_L(n) asm volatile("s_waitcnt lgkmcnt(" #n ")" ::: "memory")
#define PG8_BAR __builtin_amdgcn_s_barrier()
#define PG8_SCHED __builtin_amdgcn_sched_barrier(0)
    Unit cur, nxt; int ui = 0;
    if (!S.next(0, cur)) return;
    f32x4 acc[2][2][4][2];
#pragma unroll
    for (int a = 0; a < 2; ++a)
#pragma unroll
        for (int b = 0; b < 2; ++b)
#pragma unroll
            for (int m = 0; m < 4; ++m)
#pragma unroll
                for (int n = 0; n < 2; ++n) acc[a][b][m][n] = (f32x4){0.f, 0.f, 0.f, 0.f};
    bf16x8 At[4][2], B0[2][2], B1[2][2];
    const char* cA = (const char*)g.A + (size_t)cur.pm * tstep; const char* cB = (const char*)g.Bt + (size_t)cur.pn * tstep;
    S.a_ready(cur);
    if constexpr (SP2) {
        PG8_STAGE(PG8_SB(0, 0), cB, voffB); PG8_STAGE(PG8_SB(0, 1), cB + hstep, voffB); PG8_STAGE(PG8_SA(0, 0), cA, voffA); PG8_STAGE(PG8_SA(0, 1), cA + hstep, voffA);
        if (wr == 1) PG8_BAR;
        PG8_WAIT_V(2); PG8_BAR;
        PG8_STAGE(PG8_SB(1, 0), cB + kstep, voffB); PG8_STAGE(PG8_SA(1, 0), cA + kstep, voffA); PG8_STAGE(PG8_SB(1, 1), cB + hstep + kstep, voffB);
        PG8_WAIT_V(6); PG8_BAR;
    } else {
        PG8_STAGE(PG8_SB(0, 0), cB, voffB); PG8_STAGE(PG8_SA(0, 0), cA, voffA); PG8_STAGE(PG8_SB(0, 1), cB + hstep, voffB); PG8_STAGE(PG8_SA(0, 1), cA + hstep, voffA);
        if (wr == 1) PG8_BAR;
        PG8_WAIT_V(4); PG8_BAR;
        PG8_STAGE(PG8_SB(1, 0), cB + kstep, voffB); PG8_STAGE(PG8_SA(1, 0), cA + kstep, voffA); PG8_STAGE(PG8_SB(1, 1), cB + hstep + kstep, voffB);
        PG8_WAIT_V(6); PG8_BAR;
    }
    for (;;) {
        const bool has_next = S.next(ui + 1, nxt);
        const char* nA = has_next ? (const char*)g.A + (size_t)nxt.pm * tstep : cA; const char* nB = has_next ? (const char*)g.Bt + (size_t)nxt.pn * tstep : cB;
        for (int t = 0; t < nt; t += 2) {
            const bool last = (t == nt - 2);
            const char* a1 = cA + (size_t)(t + 1) * kstep;
            const char* a2 = last ? nA : cA + (size_t)(t + 2) * kstep; const char* b2 = last ? nB : cB + (size_t)(t + 2) * kstep;
            const char* a3 = a2 + kstep; const char* b3 = b2 + kstep;
            if (last && has_next) S.a_ready(nxt);
            if constexpr (SP2) {
            PG8_LDB(B0, 0, 0); PG8_LDB(B1, 0, 1); PG8_SCHED; PG8_LDA(At, 0, 0); PG8_STAGE(PG8_SA(1, 1), a1 + hstep, voffA);
            PG8_WAIT_V(8); PG8_WAIT_L(0); PG8_BAR; PG8_MMA(0, 0, At, B0); PG8_MMA(0, 1, At, B1); PG8_BAR; PG8_SCHED;
            PG8_LDA(At, 0, 1); PG8_STAGE(PG8_SB(0, 0), b2, voffB); PG8_STAGE(PG8_SB(0, 1), b2 + hstep, voffB); PG8_STAGE(PG8_SA(0, 0), a2, voffA);
            PG8_WAIT_V(8); PG8_WAIT_L(0); PG8_BAR; PG8_MMA(1, 0, At, B0); PG8_MMA(1, 1, At, B1); PG8_BAR; PG8_SCHED;
            PG8_LDB(B0, 1, 0); PG8_LDB(B1, 1, 1); PG8_SCHED; PG8_LDA(At, 1, 0); PG8_STAGE(PG8_SA(0, 1), a2 + hstep, voffA);
            PG8_WAIT_V(8); PG8_WAIT_L(0); PG8_BAR; PG8_MMA(0, 0, At, B0); PG8_MMA(0, 1, At, B1); PG8_BAR; PG8_SCHED;
            PG8_LDA(At, 1, 1); PG8_STAGE(PG8_SB(1, 0), b3, voffB); PG8_STAGE(PG8_SB(1, 1), b3 + hstep, voffB); PG8_STAGE(PG8_SA(1, 0), a3, voffA);
            PG8_WAIT_V(8); PG8_WAIT_L(0); PG8_BAR; PG8_MMA(1, 0, At, B0); PG8_MMA(1, 1, At, B1); PG8_BAR; PG8_SCHED;
            } else {
            PG8_LDB(B0, 0, 0); PG8_SCHED; PG8_LDA(At, 0, 0); PG8_STAGE(PG8_SA(1, 1), a1 + hstep, voffA);
            PG8_WAIT_L(8); PG8_BAR; PG8_WAIT_L(0); PG8_MMA(0, 0, At, B0); PG8_BAR; PG8_SCHED;
            PG8_LDB(B1, 0, 1); PG8_STAGE(PG8_SB(0, 0), b2, voffB);
            PG8_BAR; PG8_WAIT_L(0); PG8_MMA(0, 1, At, B1); PG8_BAR;
            PG8_LDA(At, 0, 1); PG8_STAGE(PG8_SA(0, 0), a2, voffA);
            PG8_BAR; PG8_WAIT_L(0); PG8_MMA(1, 0, At, B0); PG8_BAR; PG8_SCHED;
            PG8_STAGE(PG8_SB(0, 1), b2 + hstep, voffB);
            PG8_WAIT_V(6); PG8_BAR; PG8_MMA(1, 1, At, B1); PG8_BAR;
            PG8_LDB(B0, 1, 0); PG8_SCHED; PG8_LDA(At, 1, 0); PG8_STAGE(PG8_SA(0, 1), a2 + hstep, voffA);
            PG8_WAIT_L(8); PG8_BAR; PG8_WAIT_L(0); PG8_MMA(0, 0, At, B0); PG8_BAR; PG8_SCHED;
            PG8_LDB(B1, 1, 1); PG8_STAGE(PG8_SB(1, 0), b3, voffB);
            PG8_BAR; PG8_WAIT_L(0); PG8_MMA(0, 1, At, B1); PG8_BAR;
            PG8_LDA(At, 1, 1); PG8_STAGE(PG8_SA(1, 0), a3, voffA);
            PG8_BAR; PG8_WAIT_L(0); PG8_MMA(1, 0, At, B0); PG8_BAR; PG8_SCHED;
            PG8_STAGE(PG8_SB(1, 1), b3 + hstep, voffB);
            PG8_WAIT_V(6); PG8_BAR; PG8_MMA(1, 1, At, B1); PG8_BAR;
            }
        }
        if constexpr (ALIGN_EPI) { if (wr == 0) PG8_BAR; }
        if constexpr (!Epi::AFTER_DRAIN) { E(acc, cur, wr, wc, fr, fq); S.done(cur); }
        if (!has_next) break;
#pragma unroll
        for (int a = 0; a < 2; ++a)
#pragma unroll
            for (int b = 0; b < 2; ++b)
#pragma unroll
                for (int m = 0; m < 4; ++m)
#pragma unroll
                    for (int n = 0; n < 2; ++n) acc[a][b][m][n] = (f32x4){0.f, 0.f, 0.f, 0.f};
        cur = nxt; cA = nA; cB = nB; ++ui;
        if constexpr (ALIGN_EPI) { if (wr == 1) PG8_BAR; }
    }
    PG8_WAIT_V(0);
    if constexpr (!ALIGN_EPI) { if (wr == 0) PG8_BAR; }
    PG8_BAR;
    if constexpr (Epi::AFTER_DRAIN) { E.fused(acc, cur, wr, wc, fr, fq, lds, wid, lane); S.done(cur); }
#undef PG8_SA
#undef PG8_SB
#undef PG8_STAGE
#undef PG8_LDA
#undef PG8_LDB
#undef PG8_MMA
#undef PG8_WAIT_V
#undef PG8_WAIT_L
#undef PG8_BAR
#undef PG8_SCHED
}
}

namespace pg8 {
struct OneUnit {
    Unit u;
    __device__ __forceinline__ bool next(int i, Unit& o) const { if (i > 0) return false; o = u; return true; }
    __device__ __forceinline__ void a_ready(const Unit&) const {}
    __device__ __forceinline__ void done(const Unit&) const {}
};
struct EpiRowScaleBf16 {
    static constexpr bool PERM = true, AFTER_DRAIN = false;
    bf16_t* O; int ldc; const float* rs; const float* ssq;
    __device__ __forceinline__ void operator()(const f32x4 (&acc)[2][2][4][2], const Unit& u, int wr, int wc, int fr, int fq) const {
        const int row0 = u.pm * BM + wr * 64 + fr, col0 = u.pn * BM + wc * 32 + 8 * fq;
#pragma unroll
        for (int ai = 0; ai < 2; ++ai)
#pragma unroll
            for (int m = 0; m < 4; ++m) {
                const int row = row0 + ai * HALF + m * 16;
                const float sc = ssq ? rstd_from_parts(ssq + (size_t)row * 16) : (rs ? rs[row] : 1.f);
                bf16_t* rowp = O + (size_t)row * ldc + col0;
#pragma unroll
                for (int bj = 0; bj < 2; ++bj) {
                    const f32x4 v0 = acc[ai][bj][m][0] * sc, v1 = acc[ai][bj][m][1] * sc;
                    u32x4 w; w.x = cvt_pk_bf16(v0[0], v0[1]); w.y = cvt_pk_bf16(v0[2], v0[3]); w.z = cvt_pk_bf16(v1[0], v1[1]); w.w = cvt_pk_bf16(v1[2], v1[3]);
                    *(u32x4*)(rowp + bj * HALF) = w;
                }
            }
    }
};
struct EpiGeluBiasBf16 {
    static constexpr bool PERM = true, AFTER_DRAIN = false;
    bf16_t* O; int ldc; const float* bias;
    __device__ __forceinline__ void operator()(const f32x4 (&acc)[2][2][4][2], const Unit& u, int wr, int wc, int fr, int fq) const {
        const int row0 = u.pm * BM + wr * 64 + fr, col0 = u.pn * BM + wc * 32 + 8 * fq;
#pragma unroll
        for (int bj = 0; bj < 2; ++bj) {
            const f32x4 b0 = *(const f32x4*)(bias + col0 + bj * HALF), b1 = *(const f32x4*)(bias + col0 + bj * HALF + 4);
#pragma unroll
            for (int ai = 0; ai < 2; ++ai)
#pragma unroll
                for (int m = 0; m < 4; ++m) {
                    bf16_t* rowp = O + (size_t)(row0 + ai * HALF + m * 16) * ldc + col0 + bj * HALF;
                    const f32x4 v0 = acc[ai][bj][m][0] + b0, v1 = acc[ai][bj][m][1] + b1;
                    u32x4 w; w.x = cvt_pk_bf16(gelu_tanh(v0[0]), gelu_tanh(v0[1])); w.y = cvt_pk_bf16(gelu_tanh(v0[2]), gelu_tanh(v0[3]));
                    w.z = cvt_pk_bf16(gelu_tanh(v1[0]), gelu_tanh(v1[1])); w.w = cvt_pk_bf16(gelu_tanh(v1[2]), gelu_tanh(v1[3]));
                    *(u32x4*)rowp = w;
                }
        }
    }
};
struct EpiPartF32 {
    static constexpr bool PERM = true, AFTER_DRAIN = false;
    float* O; int ldc;
    __device__ __forceinline__ void operator()(const f32x4 (&acc)[2][2][4][2], const Unit& u, int wr, int wc, int fr, int fq) const {
        const int row0 = u.pm * BM + wr * 64 + fr, col0 = u.pn * BM + wc * 32 + 8 * fq;
#pragma unroll
        for (int bj = 0; bj < 2; ++bj)
#pragma unroll
            for (int ai = 0; ai < 2; ++ai)
#pragma unroll
                for (int m = 0; m < 4; ++m) {
                    float* rowp = O + (size_t)(row0 + ai * HALF + m * 16) * ldc + col0 + bj * HALF;
                    *(f32x4*)rowp = acc[ai][bj][m][0]; *(f32x4*)(rowp + 4) = acc[ai][bj][m][1];
                }
    }
};
struct EpiResidual {
    static constexpr bool PERM = true, AFTER_DRAIN = false;
    bf16_t* xb; float* sumsq;
    __device__ __forceinline__ void operator()(const f32x4 (&acc)[2][2][4][2], const Unit& u, int wr, int wc, int fr, int fq) const {
        const int row0 = u.pm * BM + wr * 64 + fr, col0 = u.pn * BM + wc * 32 + 8 * fq;
#pragma unroll
        for (int ai = 0; ai < 2; ++ai)
#pragma unroll
            for (int m = 0; m < 4; ++m) {
                const int row = row0 + ai * HALF + m * 16;
                float ss = 0.f;
#pragma unroll
                for (int bj = 0; bj < 2; ++bj) {
                    const size_t off = (size_t)row * 1024 + col0 + bj * HALF;
                    const u32x4 r = *(const u32x4*)(xb + off);
                    const f32x4 r0 = {bflo(r.x), bfhi(r.x), bflo(r.y), bfhi(r.y)}, r1 = {bflo(r.z), bfhi(r.z), bflo(r.w), bfhi(r.w)};
                    const f32x4 v0 = acc[ai][bj][m][0] + r0, v1 = acc[ai][bj][m][1] + r1;
                    u32x4 w; w.x = cvt_pk_bf16(v0[0], v0[1]); w.y = cvt_pk_bf16(v0[2], v0[3]); w.z = cvt_pk_bf16(v1[0], v1[1]); w.w = cvt_pk_bf16(v1[2], v1[3]);
                    *(u32x4*)(xb + off) = w;
                    ss += v0[0] * v0[0] + v0[1] * v0[1] + v0[2] * v0[2] + v0[3] * v0[3] + v1[0] * v1[0] + v1[1] * v1[1] + v1[2] * v1[2] + v1[3] * v1[3];
                }
                ss += sxor<16>(ss); ss += sxor<32>(ss);
                if (fq == 0) sumsq[(size_t)row * 16 + u.pn * 4 + wc] = ss;
            }
    }
};

__device__ __forceinline__ float tk_pack(float v, unsigned idx, unsigned mask) {
    unsigned u = __builtin_bit_cast(unsigned, v);
    const unsigned tag = (u >> 31) ? idx : (mask - idx);
    u = (u & ~mask) | tag;
    return __builtin_bit_cast(float, u);
}
__device__ __forceinline__ unsigned tk_tag(float pv, unsigned mask) { const unsigned u = __builtin_bit_cast(unsigned, pv); return (u >> 31) ? (u & mask) : (mask - (u & mask)); }
__device__ __forceinline__ void tk_insert(float (&L)[16], float x) {
#pragma unroll
    for (int i = 0; i < 16; ++i) { const float hi = fmaxf(L[i], x); x = fminf(L[i], x); L[i] = hi; }
}
template <int N> __device__ __forceinline__ void tk_sort_desc(float (&v)[N]) {
#pragma unroll
    for (int k = 2; k <= N; k <<= 1)
#pragma unroll
        for (int j = k >> 1; j > 0; j >>= 1)
#pragma unroll
            for (int i = 0; i < N; ++i) { const int l = i ^ j;
                if (l > i) { const float hi = fmaxf(v[i], v[l]), lo = fminf(v[i], v[l]); const bool desc = ((i & k) == 0); v[i] = desc ? hi : lo; v[l] = desc ? lo : hi; } }
}
__device__ __forceinline__ void tk_clean16(float (&v)[16]) {
#pragma unroll
    for (int j = 8; j > 0; j >>= 1)
#pragma unroll
        for (int i = 0; i < 16; ++i) { const int l = i ^ j; if (l > i) { const float hi = fmaxf(v[i], v[l]), lo = fminf(v[i], v[l]); v[i] = hi; v[l] = lo; } }
}
__device__ __forceinline__ void tk_merge16(float (&a)[16], const float (&b)[16]) {
#pragma unroll
    for (int i = 0; i < 16; ++i) a[i] = fmaxf(a[i], b[15 - i]);
    tk_clean16(a);
}
#define TK_CE(i, j) { const float hi__ = fmaxf(v[i], v[j]), lo__ = fminf(v[i], v[j]); v[i] = hi__; v[j] = lo__; }
__device__ __forceinline__ void tk_sort16_desc(float (&v)[16]) {
    TK_CE(0,13) TK_CE(1,12) TK_CE(2,15) TK_CE(3,14) TK_CE(4,8) TK_CE(5,6) TK_CE(7,11) TK_CE(9,10)
    TK_CE(0,5) TK_CE(1,7) TK_CE(2,9) TK_CE(3,4) TK_CE(6,13) TK_CE(8,14) TK_CE(10,15) TK_CE(11,12)
    TK_CE(0,1) TK_CE(2,3) TK_CE(4,5) TK_CE(6,8) TK_CE(7,9) TK_CE(10,11) TK_CE(12,13) TK_CE(14,15)
    TK_CE(0,2) TK_CE(1,3) TK_CE(4,10) TK_CE(5,11) TK_CE(6,7) TK_CE(8,9) TK_CE(12,14) TK_CE(13,15)
    TK_CE(1,2) TK_CE(3,12) TK_CE(4,6) TK_CE(5,7) TK_CE(8,10) TK_CE(9,11) TK_CE(13,14)
    TK_CE(1,4) TK_CE(2,6) TK_CE(5,8) TK_CE(7,10) TK_CE(9,13) TK_CE(11,14)
    TK_CE(2,4) TK_CE(3,6) TK_CE(9,12) TK_CE(11,13)
    TK_CE(3,5) TK_CE(6,8) TK_CE(7,9) TK_CE(10,12)
    TK_CE(3,4) TK_CE(5,6) TK_CE(7,8) TK_CE(9,10) TK_CE(11,12)
    TK_CE(6,7) TK_CE(8,9)
}
__device__ __forceinline__ void tk_top16_of_64(float (&g0)[16], float (&g1)[16], float (&g2)[16], float (&g3)[16]) {
    tk_sort16_desc(g0); tk_sort16_desc(g1); tk_sort16_desc(g2); tk_sort16_desc(g3);
    tk_merge16(g0, g1); tk_merge16(g2, g3); tk_merge16(g0, g2);
}
struct EpiTopK {
    static constexpr bool PERM = true, AFTER_DRAIN = true;
    static constexpr int SROW = 260, LIST_OFF = 128 * SROW;
    const float* sumsq; int* E; float* Gt;
    __device__ __forceinline__ void fused(const f32x4 (&acc)[2][2][4][2], const Unit& u, int wr, int wc, int fr, int fq, PG8_LAS unsigned char* lds, int wid, int lane) const {
        PG8_LAS float* Sl = (PG8_LAS float*)lds;
        PG8_LAS float* Ls = Sl + LIST_OFF;
        const int tid = wid * 64 + lane;
#pragma unroll 1
        for (int ai = 0; ai < 2; ++ai) {
#pragma unroll
            for (int m = 0; m < 4; ++m) {
                const int rl = wr * 64 + m * 16 + fr;
                const float sc = rstd_from_parts(sumsq + (size_t)(u.pm * BM + ai * HALF + rl) * 16);
#pragma unroll
                for (int bj = 0; bj < 2; ++bj) {
                    PG8_LAS float* sp = Sl + rl * SROW + bj * HALF + wc * 32 + 8 * fq;
                    const f32x4 a0 = ai ? acc[1][bj][m][0] : acc[0][bj][m][0], a1 = ai ? acc[1][bj][m][1] : acc[0][bj][m][1];
                    *(PG8_LAS f32x4*)sp = a0 * sc; *(PG8_LAS f32x4*)(sp + 4) = a1 * sc;
                }
            }
            __syncthreads();
            const int row = tid & 127, p = (tid >> 7) & 1, half = tid >> 8;
            float L[16];
            {
                const PG8_LAS float* sp = Sl + row * SROW + p * 128 + half * 64;
                float G1[16], G2[16], G3[16];
#pragma unroll
                for (int k = 0; k < 4; ++k) {
                    const f32x4 v0 = *(const PG8_LAS f32x4*)(sp + 4 * k), v1 = *(const PG8_LAS f32x4*)(sp + 16 + 4 * k), v2 = *(const PG8_LAS f32x4*)(sp + 32 + 4 * k), v3 = *(const PG8_LAS f32x4*)(sp + 48 + 4 * k);
                    const unsigned base = half * 64 + 4 * k;
#pragma unroll
                    for (int e = 0; e < 4; ++e) { L[4 * k + e] = tk_pack(v0[e], base + e, 127u); G1[4 * k + e] = tk_pack(v1[e], base + 16 + e, 127u);
                        G2[4 * k + e] = tk_pack(v2[e], base + 32 + e, 127u); G3[4 * k + e] = tk_pack(v3[e], base + 48 + e, 127u); }
                }
                tk_top16_of_64(L, G1, G2, G3);
            }
            if (ai == 1) __syncthreads();
            PG8_LAS float* mine = (ai ? Sl : Ls) + (row * 2 + p) * 16;
            if (half == 1) {
#pragma unroll
                for (int i = 0; i < 4; ++i) *(PG8_LAS f32x4*)(mine + 4 * i) = (f32x4){L[4 * i], L[4 * i + 1], L[4 * i + 2], L[4 * i + 3]};
            }
            __syncthreads();
            if (half == 0) {
                f32x4 o[4];
#pragma unroll
                for (int i = 0; i < 4; ++i) o[i] = *(const PG8_LAS f32x4*)(mine + 4 * i);
                float ob[16];
#pragma unroll
                for (int i = 0; i < 4; ++i) { ob[4 * i] = o[i][0]; ob[4 * i + 1] = o[i][1]; ob[4 * i + 2] = o[i][2]; ob[4 * i + 3] = o[i][3]; }
                tk_merge16(L, ob);
#pragma unroll
                for (int i = 0; i < 4; ++i) *(PG8_LAS f32x4*)(mine + 4 * i) = (f32x4){L[4 * i], L[4 * i + 1], L[4 * i + 2], L[4 * i + 3]};
            }
            __syncthreads();
        }
        if (tid < 256) {
            {
                const int ai = tid >> 7, tr = tid & 127;
                const PG8_LAS float* lb = ai ? Sl : Ls;
                const PG8_LAS float* s1 = lb + (tr * 2 + 0) * 16, *s2 = lb + (tr * 2 + 1) * 16;
                float v1[16], v2[16];
#pragma unroll
                for (int i = 0; i < 4; ++i) { const f32x4 a = *(const PG8_LAS f32x4*)(s1 + 4 * i), b = *(const PG8_LAS f32x4*)(s2 + 4 * i);
                    v1[4 * i] = a[0]; v1[4 * i + 1] = a[1]; v1[4 * i + 2] = a[2]; v1[4 * i + 3] = a[3]; v2[4 * i] = b[0]; v2[4 * i + 1] = b[1]; v2[4 * i + 2] = b[2]; v2[4 * i + 3] = b[3]; }
#define TK_CAND(a, b) tk_pack(v1[a] + v2[b], (a) * 16 + (b), 255u)
                float C[16], D1[16], D2[16], D3[16];
#pragma unroll
                for (int i = 0; i < 16; ++i) C[i] = TK_CAND(0, i);
#pragma unroll
                for (int i = 0; i < 8; ++i) { D1[i] = TK_CAND(1, i); D1[8 + i] = TK_CAND(15 - i, 0); }
                D2[0] = TK_CAND(2, 0); D2[1] = TK_CAND(2, 1); D2[2] = TK_CAND(2, 2); D2[3] = TK_CAND(2, 3); D2[4] = TK_CAND(2, 4);
                D2[5] = TK_CAND(3, 0); D2[6] = TK_CAND(3, 1); D2[7] = TK_CAND(3, 2); D2[8] = TK_CAND(3, 3);
                D2[9] = TK_CAND(4, 0); D2[10] = TK_CAND(4, 1); D2[11] = TK_CAND(4, 2);
                D2[12] = TK_CAND(5, 0); D2[13] = TK_CAND(5, 1); D2[14] = -INFINITY; D2[15] = -INFINITY;
                { const float q = TK_CAND(6, 1), r = TK_CAND(7, 0);
                  D3[0] = TK_CAND(6, 0); D3[1] = fmaxf(q, r); D3[2] = fminf(q, r); D3[3] = TK_CAND(7, 1); }
#pragma unroll
                for (int i = 4; i < 16; ++i) D3[i] = -INFINITY;
#undef TK_CAND
                tk_clean16(D1); tk_sort16_desc(D2);
                tk_merge16(C, D1); tk_merge16(D2, D3); tk_merge16(C, D2);
                float sm = 0.f, ex[16];
#pragma unroll
                for (int i = 0; i < 16; ++i) { ex[i] = __expf(C[i] - C[0]); sm += ex[i]; }
                const float inv = 1.f / sm;
                const size_t t = (size_t)u.pm * BM + ai * HALF + tr;
                int* eo = E + t * 128 + u.pn * 16; float* go = Gt + t * 128 + u.pn * 16;
                int ev[16];
#pragma unroll
                for (int i = 0; i < 16; ++i) { const unsigned ci = tk_tag(C[i], 255u); ev[i] = (int)(tk_tag(s1[ci >> 4], 127u) * 128u + tk_tag(s2[ci & 15], 127u)); }
#pragma unroll
                for (int i = 0; i < 4; ++i) { *(int4*)(eo + 4 * i) = make_int4(ev[4 * i], ev[4 * i + 1], ev[4 * i + 2], ev[4 * i + 3]);
                    *(float4*)(go + 4 * i) = make_float4(ex[4 * i] * inv, ex[4 * i + 1] * inv, ex[4 * i + 2] * inv, ex[4 * i + 3] * inv); }
            }
        }
        __syncthreads();
    }
};
}

__device__ __forceinline__ void transpose_item(const float* __restrict__ W, int K, int N, const float* __restrict__ gain, bf16* __restrict__ WT, int row_off, float* scr, int item, int lane) {
    const int nblk = (N + 31) / 32, kb = item / nblk, nb = item % nblk, k0 = 64 * kb, n0 = 32 * nb;
    const int nn = n0 + (lane & 31);
    float tv[32];
#pragma unroll
    for (int i = 0; i < 32; ++i) { const int kk = 2 * i + (lane >> 5);
        float v = 0.f; if (nn < N) { v = W[(size_t)(k0 + kk) * N + nn]; if (gain) v *= gain[k0 + kk]; }
        tv[i] = v; }
#pragma unroll
    for (int i = 0; i < 32; ++i) scr[(2 * i + (lane >> 5)) * 33 + (lane & 31)] = tv[i];
    __builtin_amdgcn_s_waitcnt(0); __builtin_amdgcn_wave_barrier();
    const int c = lane & 7;
#pragma unroll
    for (int j = 0; j < 4; ++j) { const int n = (lane >> 3) + 8 * j; const float* s = scr + (8 * c) * 33 + n;
        if (n0 + n < N) { u32x4 o; o.x = pk2(s[0 * 33], s[1 * 33]); o.y = pk2(s[2 * 33], s[3 * 33]); o.z = pk2(s[4 * 33], s[5 * 33]); o.w = pk2(s[6 * 33], s[7 * 33]);
            *(u32x4*)(WT + (size_t)(row_off + n0 + n) * K + k0 + 8 * c) = o; } }
    __builtin_amdgcn_s_waitcnt(0); __builtin_amdgcn_wave_barrier();
}
__device__ __forceinline__ void rows4_to_bf16(const float* __restrict__ X, bf16* __restrict__ O, float* __restrict__ rstd, int r, int stride, int lane) {
    float4 v[4][4];
#pragma unroll
    for (int q = 0; q < 4; ++q) { const int rr = r + q * stride;
        if (rr < T) { const float4* xr = (const float4*)(X + (size_t)rr * D) + lane;
#pragma unroll
            for (int j = 0; j < 4; ++j) v[q][j] = xr[64 * j]; } }
#pragma unroll
    for (int q = 0; q < 4; ++q) { const int rr = r + q * stride;
        if (rr < T) {
            float s = 0.f;
#pragma unroll
            for (int j = 0; j < 4; ++j) s += v[q][j].x * v[q][j].x + v[q][j].y * v[q][j].y + v[q][j].z * v[q][j].z + v[q][j].w * v[q][j].w;
            s = wave_sum(s);
            if (lane == 0) rstd[rr] = rsqrtf(s * (1.f / D) + EPS);
            u32x2* o8 = (u32x2*)(O + (size_t)rr * D) + lane;
#pragma unroll
            for (int j = 0; j < 4; ++j) { u32x2 w; w.x = pk2(v[q][j].x, v[q][j].y); w.y = pk2(v[q][j].z, v[q][j].w); o8[64 * j] = w; } } }
}
__device__ __forceinline__ void row_to_bf16(const float* __restrict__ xrow, bf16* __restrict__ orow, float* __restrict__ rstd, int lane) {
    const float4* xr = (const float4*)xrow + lane;
    float4 v[4]; float s = 0.f;
#pragma unroll
    for (int j = 0; j < 4; ++j) { v[j] = xr[64 * j]; s += v[j].x * v[j].x + v[j].y * v[j].y + v[j].z * v[j].z + v[j].w * v[j].w; }
    s = wave_sum(s);
    if (lane == 0) *rstd = rsqrtf(s * (1.f / D) + EPS);
    u32x2* o8 = (u32x2*)orow + lane;
#pragma unroll
    for (int j = 0; j < 4; ++j) { u32x2 w; w.x = pk2(v[j].x, v[j].y); w.y = pk2(v[j].z, v[j].w); o8[64 * j] = w; }
}

__device__ __forceinline__ float bperm(int idx4, float v) { return __builtin_bit_cast(float, __builtin_amdgcn_ds_bpermute(idx4, __builtin_bit_cast(int, v))); }
template <bool APPLY>
__device__ __forceinline__ void scan_pass(const bf16* __restrict__ P, const float* __restrict__ conv_w, const float* __restrict__ conv_b, const bf16* __restrict__ WGF,
                                          const float* __restrict__ SGC  , float* __restrict__ AGG, bf16* __restrict__ AIN, unsigned char* ldsw  , int tid) {
    typedef short bf16x8 __attribute__((ext_vector_type(8)));
    typedef float f32x4 __attribute__((ext_vector_type(4)));
    const int lane = tid & 63, gw = blockIdx.x * (NTHR / 64) + (tid >> 6), ngw = gridDim.x * (NTHR / 64);
    const int c16 = lane & 15, g4 = lane >> 4;
    bf16* Xt = (bf16*)ldsw; bf16* Yt = (bf16*)(ldsw + 9648);
    const int up16 = ((lane - 16) & 63) << 2, up32 = ((lane - 32) & 63) << 2, last = (c16 + 48) << 2;
    for (int item = gw; item < NB * NCHUNK * NBLK; item += ngw) {
        const int n = item % NBLK, ci = (item / NBLK) % NCHUNK, b = item / (NBLK * NCHUNK);
        const int s0 = ci * CHL;
        {
            const bf16* xp = P + ((size_t)b * S + s0 - 3) * PP + n * 64;
#pragma unroll
            for (int j = 0; j < 9; ++j) { const int row = 8 * j + (lane >> 3), c8 = lane & 7;
                if (row < 67) { u32x4 v = (u32x4){0u, 0u, 0u, 0u}; if (s0 + row >= 3) v = *(const u32x4*)(xp + (size_t)row * PP + 8 * c8); *(u32x4*)(Xt + row * 72 + 8 * c8) = v; } }
            if (APPLY) {
                const bf16* yp = P + ((size_t)b * S + s0) * PP + 768 + n * 64;
#pragma unroll
                for (int j = 0; j < 8; ++j) { const int row = 8 * j + (lane >> 3), c8 = lane & 7; *(u32x4*)(Yt + row * 72 + 8 * c8) = *(const u32x4*)(yp + (size_t)row * PP + 8 * c8); }
            }
            const int c = n * 64 + lane;
            const float cw0 = conv_w[0 * LRUW + c], cw1 = conv_w[1 * LRUW + c], cw2 = conv_w[2 * LRUW + c], cw3 = conv_w[3 * LRUW + c], cb = conv_b[c];
            __builtin_amdgcn_s_waitcnt(0); __builtin_amdgcn_wave_barrier();
            float xin[CHL + 3];
#pragma unroll
            for (int i = 0; i < CHL + 3; ++i) xin[i] = ldbf(Xt + i * 72 + lane);
            __builtin_amdgcn_wave_barrier();
#pragma unroll
            for (int tt = 0; tt < CHL; tt += 2) {
                const float o0 = cb + cw0 * xin[tt] + cw1 * xin[tt + 1] + cw2 * xin[tt + 2] + cw3 * xin[tt + 3];
                const float o1 = cb + cw0 * xin[tt + 1] + cw1 * xin[tt + 2] + cw2 * xin[tt + 3] + cw3 * xin[tt + 4];
                const unsigned w = pk2(o0, o1);
                Xt[tt * 72 + lane] = (bf16)(w & 0xffffu); Xt[(tt + 1) * 72 + lane] = (bf16)(w >> 16);
            }
        }
        bf16x8 bfr[2][8];
#pragma unroll
        for (int ks = 0; ks < 2; ++ks)
#pragma unroll
            for (int ct = 0; ct < 8; ++ct) bfr[ks][ct] = *(const bf16x8*)(WGF + ((size_t)((n * 2 + ks) * 8 + ct) * 64 + lane) * 8);
        float brr[4], bii[4], sp8[4];
#pragma unroll
        for (int ch = 0; ch < 4; ++ch) { const int c = n * 64 + 16 * ch + c16; brr[ch] = SGC[c]; bii[ch] = SGC[LRUW + c]; sp8[ch] = SGC[2 * LRUW + c]; }
        float hA[4], hH[4];
#pragma unroll
        for (int ch = 0; ch < 4; ++ch) { hA[ch] = 1.f; hH[ch] = 0.f; }
        if (APPLY) {
            const int q0 = (ci * g4) >> 2, q1 = (ci * (g4 + 1)) >> 2;
#pragma unroll
            for (int ch = 0; ch < 4; ++ch) {
                const float* ap = AGG + (((size_t)b * NCHUNK) * LRUW + n * 64 + 16 * ch + c16) * 2;
                float A = 1.f, H = 0.f;
                for (int k = q0; k < q1; ++k) { const float2 ah = *(const float2*)(ap + (size_t)k * LRUW * 2); H = ah.x * H + ah.y; A *= ah.x; }
                float Ap = bperm(up16, A), Hp = bperm(up16, H);
                if (g4 >= 1) { H = A * Hp + H; A *= Ap; }
                Ap = bperm(up32, A); Hp = bperm(up32, H);
                if (g4 >= 2) { H = A * Hp + H; A *= Ap; }
                hH[ch] = bperm(last, H);
            }
        }
        __builtin_amdgcn_s_waitcnt(0); __builtin_amdgcn_wave_barrier();
#pragma unroll 1
        for (int tt4 = 0; tt4 < 4; ++tt4) {
            const bf16x8 a0 = *(const bf16x8*)(Xt + (16 * tt4 + c16) * 72 + 8 * g4), a1 = *(const bf16x8*)(Xt + (16 * tt4 + c16) * 72 + 32 + 8 * g4);
            f32x4 acc[8];
#pragma unroll
            for (int ct = 0; ct < 8; ++ct) { f32x4 z = {0.f, 0.f, 0.f, 0.f};
                z = __builtin_amdgcn_mfma_f32_16x16x32_bf16(a0, bfr[0][ct], z, 0, 0, 0);
                acc[ct] = __builtin_amdgcn_mfma_f32_16x16x32_bf16(a1, bfr[1][ct], z, 0, 0, 0); }
#pragma unroll
            for (int ch = 0; ch < 4; ++ch) {
                const int cidx = 16 * ch + c16;
                float av[4], uv[4], A = 1.f, H = 0.f;
#pragma unroll
                for (int jj = 0; jj < 4; ++jj) {
                    const int tt = 16 * tt4 + 4 * g4 + jj;
                    const float rg = __builtin_amdgcn_rcpf(1.f + __builtin_amdgcn_exp2f(acc[ch][jj] + brr[ch])), ig = __builtin_amdgcn_rcpf(1.f + __builtin_amdgcn_exp2f(acc[4 + ch][jj] + bii[ch]));
                    const float a = __builtin_amdgcn_exp2f(sp8[ch] * rg);
                    const float mult = __builtin_amdgcn_sqrtf(fmaxf(1.f - a * a, 0.f));
                    const float u = mult * (ig * ldbf(Xt + tt * 72 + cidx));
                    av[jj] = a; uv[jj] = u; H = a * H + u; A *= a;
                }
                float Ap = bperm(up16, A), Hp = bperm(up16, H);
                if (g4 >= 1) { H = A * Hp + H; A *= Ap; }
                Ap = bperm(up32, A); Hp = bperm(up32, H);
                if (g4 >= 2) { H = A * Hp + H; A *= Ap; }
                const float AT = bperm(last, A), HT = bperm(last, H);
                if (APPLY) {
                    float AE = bperm(up16, A), HE = bperm(up16, H);
                    if (g4 == 0) { AE = 1.f; HE = 0.f; }
                    float h = AE * hH[ch] + HE;
#pragma unroll
                    for (int jj = 0; jj < 4; ++jj) {
                        const int tt = 16 * tt4 + 4 * g4 + jj;
                        h = av[jj] * h + uv[jj];
                        Xt[tt * 72 + cidx] = (bf16)f2bf(h * gelu_tanh(ldbf(Yt + tt * 72 + cidx)));
                    }
                    hH[ch] = AT * hH[ch] + HT;
                } else { hH[ch] = AT * hH[ch] + HT; hA[ch] *= AT; }
            }
        }
        if (APPLY) {
            __builtin_amdgcn_s_waitcnt(0); __builtin_amdgcn_wave_barrier();
            bf16* op = AIN + ((size_t)b * S + s0) * D + n * 64;
#pragma unroll
            for (int j = 0; j < 8; ++j) { const int row = 8 * j + (lane >> 3), c8 = lane & 7; *(u32x4*)(op + (size_t)row * D + 8 * c8) = *(const u32x4*)(Xt + row * 72 + 8 * c8); }
        } else if (g4 == 0) {
#pragma unroll
            for (int ch = 0; ch < 4; ++ch) *(float2*)(AGG + (((size_t)b * NCHUNK + ci) * LRUW + n * 64 + 16 * ch + c16) * 2) = make_float2(hA[ch], hH[ch]);
        }
        __builtin_amdgcn_s_waitcnt(0); __builtin_amdgcn_wave_barrier();
    }
}

__device__ __forceinline__ void peer_gather(float* __restrict__ out, bf16* __restrict__ XB, const float* __restrict__ sumsq, const bf16* __restrict__ UT, const bf16* __restrict__ VT,
                                            const int* __restrict__ E, const float* __restrict__ Gt, float* __restrict__ rstd_next, float* actbuf  , bool dry, int tid) {
    const int lane = tid & 63, gw = blockIdx.x * (NTHR / 64) + (tid >> 6), ngw = gridDim.x * (NTHR / 64);
    const int g4 = lane >> 4, li = lane & 15;
    for (int t = gw; t < T; t += ngw) {
        const float rs = rstd_from_parts(sumsq + (size_t)t * 16);
        bf16x8_t hx[8];
#pragma unroll
        for (int j = 0; j < 8; ++j) hx[j] = __builtin_nontemporal_load((const bf16x8_t*)(XB + (size_t)t * D + li * 8 + 128 * j));
        const int* ep = E + (size_t)t * 128; const float* gp = Gt + (size_t)t * 128;
#pragma unroll 2
        for (int step = 0; step < 32; ++step) {
            const int e = ep[4 * step + g4];
            const bf16* up = UT + (size_t)e * D + li * 8;
            bf16x8_t u[8];
#pragma unroll
            for (int j = 0; j < 8; ++j) u[j] = *(const bf16x8_t*)(up + 128 * j);
            float d = 0.f;
#pragma unroll
            for (int j = 0; j < 8; ++j) {
                d = __builtin_amdgcn_fdot2_f32_bf16(__builtin_shufflevector(u[j], u[j], 0, 1), __builtin_shufflevector(hx[j], hx[j], 0, 1), d, false);
                d = __builtin_amdgcn_fdot2_f32_bf16(__builtin_shufflevector(u[j], u[j], 2, 3), __builtin_shufflevector(hx[j], hx[j], 2, 3), d, false);
                d = __builtin_amdgcn_fdot2_f32_bf16(__builtin_shufflevector(u[j], u[j], 4, 5), __builtin_shufflevector(hx[j], hx[j], 4, 5), d, false);
                d = __builtin_amdgcn_fdot2_f32_bf16(__builtin_shufflevector(u[j], u[j], 6, 7), __builtin_shufflevector(hx[j], hx[j], 6, 7), d, false);
            }
            d += sxor<1>(d); d += sxor<2>(d); d += sxor<4>(d); d += sxor<8>(d);
            const float a = gelu_tanh(d * rs) * gp[4 * step + g4];
            if (li == 0) actbuf[4 * step + g4] = a;
        }
        __builtin_amdgcn_s_waitcnt(0); __builtin_amdgcn_wave_barrier();
        float acc[16];
#pragma unroll
        for (int i = 0; i < 16; ++i) acc[i] = 0.f;
        const int e_lo = ep[lane], e_hi = ep[64 + lane];
#pragma unroll 4
        for (int idx = 0; idx < 128; ++idx) {
            const int e = __builtin_amdgcn_readlane(idx < 64 ? e_lo : e_hi, idx & 63);
            const bf16* vp = VT + (size_t)e * D + lane * 8;
            const u32x4 va = *(const u32x4*)vp, vb = *(const u32x4*)(vp + 512);
            const float a = actbuf[idx];
            acc[0] += a * bflo(va.x); acc[1] += a * bfhi(va.x); acc[2] += a * bflo(va.y); acc[3] += a * bfhi(va.y);
            acc[4] += a * bflo(va.z); acc[5] += a * bfhi(va.z); acc[6] += a * bflo(va.w); acc[7] += a * bfhi(va.w);
            acc[8] += a * bflo(vb.x); acc[9] += a * bfhi(vb.x); acc[10] += a * bflo(vb.y); acc[11] += a * bfhi(vb.y);
            acc[12] += a * bflo(vb.z); acc[13] += a * bfhi(vb.z); acc[14] += a * bflo(vb.w); acc[15] += a * bfhi(vb.w);
        }
        float ss = 0.f;
#pragma unroll
        for (int hf = 0; hf < 2; ++hf) {
            float* op = out + (size_t)t * D + hf * 512 + lane * 8;
            const pg8::f32x4 x0v = __builtin_nontemporal_load((const pg8::f32x4*)op), x1v = __builtin_nontemporal_load((const pg8::f32x4*)(op + 4));
            const float4 x0 = make_float4(x0v[0], x0v[1], x0v[2], x0v[3]), x1 = make_float4(x1v[0], x1v[1], x1v[2], x1v[3]);
            float4 r0 = make_float4(x0.x + acc[8 * hf + 0], x0.y + acc[8 * hf + 1], x0.z + acc[8 * hf + 2], x0.w + acc[8 * hf + 3]);
            float4 r1 = make_float4(x1.x + acc[8 * hf + 4], x1.y + acc[8 * hf + 5], x1.z + acc[8 * hf + 6], x1.w + acc[8 * hf + 7]);
            if (dry) { r0 = x0; r1 = x1; }
            __builtin_nontemporal_store((pg8::f32x4){r0.x, r0.y, r0.z, r0.w}, (pg8::f32x4*)op); __builtin_nontemporal_store((pg8::f32x4){r1.x, r1.y, r1.z, r1.w}, (pg8::f32x4*)(op + 4));
            u32x4 w; w.x = pk2(r0.x, r0.y); w.y = pk2(r0.z, r0.w); w.z = pk2(r1.x, r1.y); w.w = pk2(r1.z, r1.w);
            __builtin_nontemporal_store(w, (u32x4*)(XB + (size_t)t * D + hf * 512 + lane * 8));
            ss += r0.x * r0.x + r0.y * r0.y + r0.z * r0.z + r0.w * r0.w + r1.x * r1.x + r1.y * r1.y + r1.z * r1.z + r1.w * r1.w;
        }
        ss = wave_sum(ss);
        if (lane == 0 && rstd_next) rstd_next[t] = rsqrtf(ss * (1.f / D) + EPS);
        __builtin_amdgcn_s_waitcnt(0); __builtin_amdgcn_wave_barrier();
    }
}


typedef float f32x2_t __attribute__((ext_vector_type(2)));
__device__ __forceinline__ void fp8x16_to_f32(const u32x4 w, float (&f)[16]) {
    const unsigned ww[4] = {w.x, w.y, w.z, w.w};
#pragma unroll
    for (int q = 0; q < 4; ++q) { const f32x2_t lo = __builtin_amdgcn_cvt_pk_f32_fp8((int)ww[q], false), hi = __builtin_amdgcn_cvt_pk_f32_fp8((int)ww[q], true);
        f[4 * q] = lo[0]; f[4 * q + 1] = lo[1]; f[4 * q + 2] = hi[0]; f[4 * q + 3] = hi[1]; }
}
__device__ __forceinline__ void g1_ev(int (&ev)[16], const int* __restrict__ E, int t, int rg) {
    const int4* ep = (const int4*)(E + (size_t)t * 128 + 16 * rg);
#pragma unroll
    for (int q = 0; q < 4; ++q) { const int4 v = ep[q]; ev[4 * q] = v.x; ev[4 * q + 1] = v.y; ev[4 * q + 2] = v.z; ev[4 * q + 3] = v.w; }
}
template <int H> __device__ __forceinline__ void rows8(u32x4 (&w)[8], const int (&ev)[16], const unsigned char* __restrict__ T8, int col0) {
#pragma unroll
    for (int i = 0; i < 8; ++i) w[i] = *(const u32x4*)(T8 + (size_t)ev[8 * H + i] * 1024 + col0);
}
__device__ __forceinline__ float g1_math8(const u32x4 (&w)[8], const f32x2_t (&xf)[8], int cl) {
    float d[8];
#pragma unroll
    for (int i = 0; i < 8; ++i) {
        const unsigned ww[4] = {w[i].x, w[i].y, w[i].z, w[i].w};
        f32x2_t d2 = {0.f, 0.f};
#pragma unroll
        for (int q = 0; q < 4; ++q) { const f32x2_t lo = __builtin_amdgcn_cvt_pk_f32_fp8((int)ww[q], false), hi = __builtin_amdgcn_cvt_pk_f32_fp8((int)ww[q], true);
            d2 = lo * xf[2 * q] + d2; d2 = hi * xf[2 * q + 1] + d2; }
        d[i] = d2[0] + d2[1];
        if ((i & 1) == 1) __builtin_amdgcn_sched_barrier(0);
    }
    const bool b4 = cl & 4, b2 = cl & 2, b1 = cl & 1;
    float e[4];
#pragma unroll
    for (int k = 0; k < 4; ++k) { const float keep = b4 ? d[k + 4] : d[k], send = b4 ? d[k] : d[k + 4]; e[k] = keep + sxor<4>(send); }
    float f[2];
#pragma unroll
    for (int k = 0; k < 2; ++k) { const float keep = b2 ? e[k + 2] : e[k], send = b2 ? e[k] : e[k + 2]; f[k] = keep + sxor<2>(send); }
    const float keep = b1 ? f[1] : f[0], send = b1 ? f[0] : f[1];
    return keep + sxor<1>(send);
}
__device__ __forceinline__ void unpack_x(f32x2_t (&xf)[8], const u32x4 xa, const u32x4 xb2) {
    xf[0] = (f32x2_t){bflo(xa.x), bfhi(xa.x)}; xf[1] = (f32x2_t){bflo(xa.y), bfhi(xa.y)}; xf[2] = (f32x2_t){bflo(xa.z), bfhi(xa.z)}; xf[3] = (f32x2_t){bflo(xa.w), bfhi(xa.w)};
    xf[4] = (f32x2_t){bflo(xb2.x), bfhi(xb2.x)}; xf[5] = (f32x2_t){bflo(xb2.y), bfhi(xb2.y)}; xf[6] = (f32x2_t){bflo(xb2.z), bfhi(xb2.z)}; xf[7] = (f32x2_t){bflo(xb2.w), bfhi(xb2.w)};
}
constexpr int G_SLOTS = 8, G_NPRE = 5;
__device__ __forceinline__ void g_dma(const void* gsrc, unsigned char* slot) {
    __builtin_amdgcn_global_load_lds((const __attribute__((address_space(1))) unsigned*)gsrc, (__attribute__((address_space(3))) unsigned*)slot, 16, 0, 0);
}
__device__ __forceinline__ void lds_ev(int (&ev)[16], const unsigned char* slot, int rg) {
#pragma unroll
    for (int q = 0; q < 4; ++q) { const int4 v = *(const int4*)(slot + rg * 64 + 16 * q); ev[4 * q] = v.x; ev[4 * q + 1] = v.y; ev[4 * q + 2] = v.z; ev[4 * q + 3] = v.w; }
}
template <int N> __device__ __forceinline__ void rowsN(u32x4 (&w)[N], const int (&ev)[16], int off, const unsigned char* __restrict__ T8, int col0) {
#pragma unroll
    for (int i = 0; i < N; ++i) w[i] = *(const u32x4*)(T8 + (size_t)ev[off + i] * 1024 + col0);
}
#define G_WAIT_IDS() asm volatile("s_waitcnt vmcnt(30)" ::: "memory")
__device__ __forceinline__ void peer_u_partial(const bf16* __restrict__ XB, const unsigned char* __restrict__ UT8, const int* __restrict__ E, float* __restrict__ PART, unsigned char* ring, int tid,
                                               const int xs, const int r, const int nr) {
    const int lane = tid & 63, wv = tid >> 6, rg = lane >> 3, cl = lane & 7;
    const int col0 = 128 * xs + 16 * cl, step = nr * 8;
    float* pb = PART + (size_t)xs * T * 128 + 16 * rg + cl;
    const int t0 = r * 8 + wv;
    const int ntok = (t0 < T) ? (T - 1 - t0) / step + 1 : 0;
    if (ntok == 0) return;
    const size_t src_lane_off = (lane < 32) ? (size_t)lane * 16 : (size_t)((lane & 15) * 16);
    auto dma = [&](int k) { const int t = t0 + k * step;
        const unsigned char* src = (lane < 32) ? (const unsigned char*)(E + (size_t)t * 128) : (const unsigned char*)(XB + (size_t)t * D + 128 * xs);
        g_dma(src + src_lane_off, ring + (k & (G_SLOTS - 1)) * 1024); };
#pragma unroll 1
    for (int k = 0; k < G_NPRE && k < ntok; ++k) dma(k);
    asm volatile("s_waitcnt vmcnt(0)" ::: "memory");
    int ev[16]; u32x4 wA[16], wB[16];
    lds_ev(ev, ring, rg); rowsN<16>(wA, ev, 0, UT8, col0);
#pragma unroll 1
    for (int k = 0; k < ntok; k += 2) {
        if (k + G_NPRE < ntok) dma(k + G_NPRE);
        if (k + 1 < ntok) { G_WAIT_IDS(); lds_ev(ev, ring + ((k + 1) & (G_SLOTS - 1)) * 1024, rg); rowsN<16>(wB, ev, 0, UT8, col0); }
        {
            const unsigned char* slot = ring + (k & (G_SLOTS - 1)) * 1024;
            const u32x4 xa = *(const u32x4*)(slot + 512 + cl * 32), xb2 = *(const u32x4*)(slot + 512 + cl * 32 + 16);
            f32x2_t xf[8]; unpack_x(xf, xa, xb2);
            const float res0 = g1_math8(*(const u32x4(*)[8])&wA[0], xf, cl), res1 = g1_math8(*(const u32x4(*)[8])&wA[8], xf, cl);
            float* po = pb + (size_t)(t0 + k * step) * 128; po[0] = res0; po[8] = res1;
        }
        if (k + 1 >= ntok) break;
        if (k + 1 + G_NPRE < ntok) dma(k + 1 + G_NPRE);
        if (k + 2 < ntok) { G_WAIT_IDS(); lds_ev(ev, ring + ((k + 2) & (G_SLOTS - 1)) * 1024, rg); rowsN<16>(wA, ev, 0, UT8, col0); }
        {
            const unsigned char* slot = ring + ((k + 1) & (G_SLOTS - 1)) * 1024;
            const u32x4 xa = *(const u32x4*)(slot + 512 + cl * 32), xb2 = *(const u32x4*)(slot + 512 + cl * 32 + 16);
            f32x2_t xf[8]; unpack_x(xf, xa, xb2);
            const float res0 = g1_math8(*(const u32x4(*)[8])&wB[0], xf, cl), res1 = g1_math8(*(const u32x4(*)[8])&wB[8], xf, cl);
            float* po = pb + (size_t)(t0 + (k + 1) * step) * 128; po[0] = res0; po[8] = res1;
        }
    }
    asm volatile("s_waitcnt vmcnt(0)" ::: "memory");
}
__device__ __forceinline__ void peer_act(const float* __restrict__ PART, const float* __restrict__ ssq, float* __restrict__ Gt, int tid) {
    const int lane = tid & 63, gw = blockIdx.x * (NTHR / 64) + (tid >> 6), ngw = gridDim.x * (NTHR / 64);
    for (int t0 = gw; t0 < T; t0 += 2 * ngw) {
        float2 pv[2][8], gv[2];
#pragma unroll
        for (int h = 0; h < 2; ++h) { const int t = t0 + h * ngw;
            if (t < T) {
#pragma unroll
                for (int s = 0; s < 8; ++s) pv[h][s] = *(const float2*)(PART + ((size_t)s * T + t) * 128 + 2 * lane);
                gv[h] = *(const float2*)(Gt + (size_t)t * 128 + 2 * lane); } }
#pragma unroll
        for (int h = 0; h < 2; ++h) { const int t = t0 + h * ngw;
            if (t < T) {
                const float rs = rstd_from_parts(ssq + (size_t)t * 16) * (1.f / 64.f);
                float d0 = 0.f, d1 = 0.f;
#pragma unroll
                for (int s = 0; s < 8; ++s) { d0 += pv[h][s].x; d1 += pv[h][s].y; }
                *(float2*)(Gt + (size_t)t * 128 + 2 * lane) = make_float2(gelu_tanh(d0 * rs) * gv[h].x, gelu_tanh(d1 * rs) * gv[h].y); } }
    }
}
__device__ __forceinline__ void g3_act(float (&av)[16], const float* __restrict__ ACT, int t, int rg) {
    const float4* ap = (const float4*)(ACT + (size_t)t * 128 + 16 * rg);
#pragma unroll
    for (int q = 0; q < 4; ++q) { const float4 a = ap[q]; av[4 * q] = a.x; av[4 * q + 1] = a.y; av[4 * q + 2] = a.z; av[4 * q + 3] = a.w; }
}
template <int H> __device__ __forceinline__ void g3_math8(const u32x4 (&w)[8], const float (&av)[16], f32x2_t (&acc)[8]) {
#pragma unroll
    for (int i = 0; i < 8; ++i) {
        const unsigned ww[4] = {w[i].x, w[i].y, w[i].z, w[i].w};
        const f32x2_t a2 = {av[8 * H + i], av[8 * H + i]};
#pragma unroll
        for (int q = 0; q < 4; ++q) { const f32x2_t lo = __builtin_amdgcn_cvt_pk_f32_fp8((int)ww[q], false), hi = __builtin_amdgcn_cvt_pk_f32_fp8((int)ww[q], true);
            acc[2 * q] = lo * a2 + acc[2 * q]; acc[2 * q + 1] = hi * a2 + acc[2 * q + 1]; }
        __builtin_amdgcn_sched_barrier(0);
    }
}
__device__ __forceinline__ void g3_finish(const f32x2_t (&acc)[8], float* __restrict__ out, bf16* __restrict__ XB, float* __restrict__ ssq_next, bool dry, int t, int xs, int rg, int cl, int lane) {
    const bool b4 = rg & 4, b2 = rg & 2, b1 = rg & 1;
    f32x2_t e[4];
#pragma unroll
    for (int k = 0; k < 4; ++k) { const f32x2_t keep = b4 ? acc[k + 4] : acc[k], send = b4 ? acc[k] : acc[k + 4];
        e[k] = (f32x2_t){keep[0] + sxor<32>(send[0]), keep[1] + sxor<32>(send[1])}; }
    f32x2_t f[2];
#pragma unroll
    for (int k = 0; k < 2; ++k) { const f32x2_t keep = b2 ? e[k + 2] : e[k], send = b2 ? e[k] : e[k + 2];
        f[k] = (f32x2_t){keep[0] + sxor<16>(send[0]), keep[1] + sxor<16>(send[1])}; }
    const f32x2_t keep = b1 ? f[1] : f[0], send = b1 ? f[0] : f[1];
    const float a0 = keep[0] + sxor<8>(send[0]), a1 = keep[1] + sxor<8>(send[1]);
    const int col = 128 * xs + 16 * cl + 2 * rg;
    unsigned* xp = (unsigned*)(XB + (size_t)t * D + col);
    const unsigned xw = *xp;
    const float2 x0 = make_float2(bflo(xw), bfhi(xw));
    float2 r0 = make_float2(x0.x + 0.125f * a0, x0.y + 0.125f * a1);
    if (dry) r0 = x0;
    if (out) *(float2*)(out + (size_t)t * D + col) = r0;
    else *xp = pk2(r0.x, r0.y);
    if (ssq_next) {
        const float ss = wave_sum(r0.x * r0.x + r0.y * r0.y);
        if (lane < 2) ssq_next[(size_t)t * 16 + 8 * lane + xs] = lane ? 0.f : ss;
    }
}
__device__ __forceinline__ void lds_av(float (&av)[16], const unsigned char* slot, int rg) {
#pragma unroll
    for (int q = 0; q < 4; ++q) { const float4 a = *(const float4*)(slot + 512 + rg * 64 + 16 * q); av[4 * q] = a.x; av[4 * q + 1] = a.y; av[4 * q + 2] = a.z; av[4 * q + 3] = a.w; }
}
__device__ __forceinline__ void peer_v_slice(float* __restrict__ out, bf16* __restrict__ XB, const unsigned char* __restrict__ VT8, const int* __restrict__ E, const float* __restrict__ ACT,
                                             float* __restrict__ ssq_next, bool dry, unsigned char* ring, int tid, const int xs, const int r, const int nr) {
    const int lane = tid & 63, wv = tid >> 6, rg = lane >> 3, cl = lane & 7;
    const int col0 = 128 * xs + 16 * cl, step = nr * 8;
    const int t0 = r * 8 + wv;
    const int ntok = (t0 < T) ? (T - 1 - t0) / step + 1 : 0;
    if (ntok == 0) return;
    const size_t src_lane_off = (size_t)(lane & 31) * 16;
    auto dma = [&](int k) { const int t = t0 + k * step;
        const unsigned char* src = (lane < 32) ? (const unsigned char*)(E + (size_t)t * 128) : (const unsigned char*)(ACT + (size_t)t * 128);
        g_dma(src + src_lane_off, ring + (k & (G_SLOTS - 1)) * 1024); };
#pragma unroll 1
    for (int k = 0; k < G_NPRE && k < ntok; ++k) dma(k);
    asm volatile("s_waitcnt vmcnt(0)" ::: "memory");
    int ev[16]; u32x4 wA[16], wB[16];
    lds_ev(ev, ring, rg); rowsN<16>(wA, ev, 0, VT8, col0);
#pragma unroll 1
    for (int k = 0; k < ntok; k += 2) {
        if (k + G_NPRE < ntok) dma(k + G_NPRE);
        if (k + 1 < ntok) { G_WAIT_IDS(); lds_ev(ev, ring + ((k + 1) & (G_SLOTS - 1)) * 1024, rg); rowsN<16>(wB, ev, 0, VT8, col0); }
        {
            float av[16]; lds_av(av, ring + (k & (G_SLOTS - 1)) * 1024, rg);
            f32x2_t acc[8];
#pragma unroll
            for (int j = 0; j < 8; ++j) acc[j] = (f32x2_t){0.f, 0.f};
            g3_math8<0>(*(const u32x4(*)[8])&wA[0], av, acc); g3_math8<1>(*(const u32x4(*)[8])&wA[8], av, acc);
            g3_finish(acc, out, XB, ssq_next, dry, t0 + k * step, xs, rg, cl, lane);
        }
        if (k + 1 >= ntok) break;
        if (k + 1 + G_NPRE < ntok) dma(k + 1 + G_NPRE);
        if (k + 2 < ntok) { G_WAIT_IDS(); lds_ev(ev, ring + ((k + 2) & (G_SLOTS - 1)) * 1024, rg); rowsN<16>(wA, ev, 0, VT8, col0); }
        {
            float av[16]; lds_av(av, ring + ((k + 1) & (G_SLOTS - 1)) * 1024, rg);
            f32x2_t acc[8];
#pragma unroll
            for (int j = 0; j < 8; ++j) acc[j] = (f32x2_t){0.f, 0.f};
            g3_math8<0>(*(const u32x4(*)[8])&wB[0], av, acc); g3_math8<1>(*(const u32x4(*)[8])&wB[8], av, acc);
            g3_finish(acc, out, XB, ssq_next, dry, t0 + (k + 1) * step, xs, rg, cl, lane);
        }
    }
    asm volatile("s_waitcnt vmcnt(0)" ::: "memory");
}

namespace att {
typedef short bf16x8 __attribute__((ext_vector_type(8)));
typedef short bf16x4 __attribute__((ext_vector_type(4)));
typedef float f32x4 __attribute__((ext_vector_type(4)));
constexpr int TROW = 144;
constexpr int TILE_B = 64 * TROW;
constexpr int OFF_K = 0, OFF_V = 2 * TILE_B, OFF_IMP = 4 * TILE_B  , OFF_SEL = OFF_IMP + 16384, OFF_ANY = OFF_SEL + 512, OFF_STAGE = OFF_ANY + 512;
constexpr int STAGE_ROW = 68;
constexpr int LDS_NEED = OFF_STAGE + 384 * STAGE_ROW * 4;
constexpr float QSCALE = 0.125f * 1.4426950408889634f;
constexpr float SBOUND = QSCALE * 64.0f * 1.02f;

typedef float f32x2_ __attribute__((ext_vector_type(2)));
__device__ __forceinline__ unsigned cvt_pk(float lo, float hi) { const f32x2_ v = {lo, hi}; return __builtin_bit_cast(unsigned, __builtin_convertvector(v, bf16x2_t)); }

__device__ __forceinline__ void load_qfrag(bf16x8 (&qf)[2], const bf16* __restrict__ rowp, const float* __restrict__ gain, const float* __restrict__ rope_row, int g4) {
    const u32x4 w0 = *(const u32x4*)(rowp + 8 * g4), w1 = *(const u32x4*)(rowp + 32 + 8 * g4);
    float f0[8] = {bflo(w0.x), bfhi(w0.x), bflo(w0.y), bfhi(w0.y), bflo(w0.z), bfhi(w0.z), bflo(w0.w), bfhi(w0.w)};
    float f1[8] = {bflo(w1.x), bfhi(w1.x), bflo(w1.y), bfhi(w1.y), bflo(w1.z), bfhi(w1.z), bflo(w1.w), bfhi(w1.w)};
    float ss = 0.f;
#pragma unroll
    for (int j = 0; j < 8; ++j) ss += f0[j] * f0[j] + f1[j] * f1[j];
    ss += sxor<16>(ss); ss += sxor<32>(ss);
    const float rs = rsqrtf(ss * (1.f / 64.f) + EPS);
#pragma unroll
    for (int j = 0; j < 8; ++j) { f0[j] *= rs * gain[8 * g4 + j]; f1[j] *= rs * gain[32 + 8 * g4 + j]; }
    if (rope_row) {
#pragma unroll
        for (int j = 0; j < 8; ++j) {
            const float partner = sxor<16>(f0[j]);
            const float cs = rope_row[j], sn = rope_row[8 + j];
            if (g4 == 0) f0[j] = f0[j] * cs - partner * sn;
            else if (g4 == 1) f0[j] = f0[j] * cs + partner * sn;
        }
    }
    u32x4 o0, o1;
    o0.x = cvt_pk(f0[0] * QSCALE, f0[1] * QSCALE); o0.y = cvt_pk(f0[2] * QSCALE, f0[3] * QSCALE); o0.z = cvt_pk(f0[4] * QSCALE, f0[5] * QSCALE); o0.w = cvt_pk(f0[6] * QSCALE, f0[7] * QSCALE);
    o1.x = cvt_pk(f1[0] * QSCALE, f1[1] * QSCALE); o1.y = cvt_pk(f1[2] * QSCALE, f1[3] * QSCALE); o1.z = cvt_pk(f1[4] * QSCALE, f1[5] * QSCALE); o1.w = cvt_pk(f1[6] * QSCALE, f1[7] * QSCALE);
    qf[0] = __builtin_bit_cast(bf16x8, o0); qf[1] = __builtin_bit_cast(bf16x8, o1);
}

template <int NU>
__device__ __forceinline__ void qk_tile(const unsigned char* Kt, const bf16x8 (&qf)[NU][2], f32x4 (&Sv)[NU][4], int c16, int g4, const float (&init)[NU]) {
#pragma unroll
    for (int rt = 0; rt < 4; ++rt) {
        const bf16x8 k0 = *(const bf16x8*)(Kt + (16 * rt + c16) * TROW + 16 * g4);
        const bf16x8 k1 = *(const bf16x8*)(Kt + (16 * rt + c16) * TROW + 64 + 16 * g4);
#pragma unroll
        for (int u = 0; u < NU; ++u) {
            f32x4 a = {init[u], init[u], init[u], init[u]};
            a = __builtin_amdgcn_mfma_f32_16x16x32_bf16(k0, qf[u][0], a, 0, 0, 0);
            a = __builtin_amdgcn_mfma_f32_16x16x32_bf16(k1, qf[u][1], a, 0, 0, 0);
            Sv[u][rt] = a;
        }
    }
}
template <int NU, bool SUML>
__device__ __forceinline__ void pv_tile(const unsigned char* Vt, const f32x4 (&Sv)[NU][4], f32x4 (&O)[NU][4], int c16, int g4, f32x4 (&Ol)[NU]) {
    bf16x8 pf[NU][2];
#pragma unroll
    for (int u = 0; u < NU; ++u)
#pragma unroll
        for (int kk = 0; kk < 2; ++kk) {
            u32x4 w; w.x = cvt_pk(Sv[u][2 * kk][0], Sv[u][2 * kk][1]); w.y = cvt_pk(Sv[u][2 * kk][2], Sv[u][2 * kk][3]);
            w.z = cvt_pk(Sv[u][2 * kk + 1][0], Sv[u][2 * kk + 1][1]); w.w = cvt_pk(Sv[u][2 * kk + 1][2], Sv[u][2 * kk + 1][3]);
            pf[u][kk] = __builtin_bit_cast(bf16x8, w);
        }
    if (SUML) {
        const u32x4 o1 = {0x3f803f80u, 0x3f803f80u, 0x3f803f80u, 0x3f803f80u};
        const bf16x8 ones = __builtin_bit_cast(bf16x8, o1);
#pragma unroll
        for (int u = 0; u < NU; ++u) { Ol[u] = __builtin_amdgcn_mfma_f32_16x16x32_bf16(ones, pf[u][0], Ol[u], 0, 0, 0); Ol[u] = __builtin_amdgcn_mfma_f32_16x16x32_bf16(ones, pf[u][1], Ol[u], 0, 0, 0); }
    }
#pragma unroll
    for (int dt = 0; dt < 4; ++dt)
#pragma unroll
        for (int kk = 0; kk < 2; ++kk) {
            const unsigned char* vr = Vt + (16 * dt + c16) * TROW + (32 * kk + 4 * g4) * 2;
            const u32x2 lo = *(const u32x2*)vr, hi = *(const u32x2*)(vr + 32);
            u32x4 w; w.x = lo.x; w.y = lo.y; w.z = hi.x; w.w = hi.y;
            const bf16x8 vf = __builtin_bit_cast(bf16x8, w);
#pragma unroll
            for (int u = 0; u < NU; ++u) O[u][dt] = __builtin_amdgcn_mfma_f32_16x16x32_bf16(vf, pf[u][kk], O[u][dt], 0, 0, 0);
        }
}
constexpr float LAZY = 8.0f;
template <int NU, bool COLMASK, bool FIXED, bool NOSUM = false>
__device__ __forceinline__ void softmax_update(f32x4 (&Sv)[NU][4], float (&m)[NU], float (&l)[NU], f32x4 (&O)[NU][4], bool scaleO, const bool (&colok)[NU]) {
    if (FIXED) {
#pragma unroll
        for (int u = 0; u < NU; ++u) {
            float ps = 0.f;
#pragma unroll
            for (int rt = 0; rt < 4; ++rt)
#pragma unroll
                for (int jj = 0; jj < 4; ++jj) { const float p = __builtin_amdgcn_exp2f(Sv[u][rt][jj]); Sv[u][rt][jj] = p; if (!NOSUM) ps += p; }
            if (!NOSUM) l[u] += ps;
        }
        return;
    }
    float mx[NU]; bool need = false;
#pragma unroll
    for (int u = 0; u < NU; ++u) {
        float v = -INFINITY;
#pragma unroll
        for (int rt = 0; rt < 4; ++rt) v = fmaxf(fmaxf(v, fmaxf(Sv[u][rt][0], Sv[u][rt][1])), fmaxf(Sv[u][rt][2], Sv[u][rt][3]));
        v = fmaxf(v, sxor<16>(v)); v = fmaxf(v, sxor<32>(v));
        if (COLMASK && !colok[u]) v = -INFINITY;
        mx[u] = v;
        need = need || (v > m[u] + LAZY);
    }
    if (__builtin_amdgcn_ballot_w64(need) != 0ull) {
#pragma unroll
        for (int u = 0; u < NU; ++u) {
            if (mx[u] > m[u] + LAZY) {
                const float alpha = __builtin_amdgcn_exp2f(m[u] - mx[u]);
                m[u] = mx[u];
                l[u] *= alpha;
                if (scaleO) {
#pragma unroll
                    for (int dt = 0; dt < 4; ++dt) O[u][dt] = O[u][dt] * alpha;
                }
            }
        }
    }
#pragma unroll
    for (int u = 0; u < NU; ++u) {
        float mu = (m[u] == -INFINITY) ? 0.f : m[u];
        if (COLMASK && !colok[u]) mu = INFINITY;
        float ps = 0.f;
#pragma unroll
        for (int rt = 0; rt < 4; ++rt)
#pragma unroll
            for (int jj = 0; jj < 4; ++jj) { const float p = __builtin_amdgcn_exp2f(Sv[u][rt][jj] - mu); Sv[u][rt][jj] = p; ps += p; }
        l[u] += ps;
    }
}

#define SGB(mask, n) __builtin_amdgcn_sched_group_barrier(mask, n, 0)
template <int NU>
__device__ __forceinline__ void tile_fixed(const unsigned char* Kt, const unsigned char* Vt, const bf16x8 (&qf)[NU][2], f32x4 (&O)[NU][4], float (&l)[NU], int c16, int g4, const float (&init)[NU]) {
    f32x4 Sv[NU][4];
    float ps[NU];
    const unsigned char* kp = Kt + c16 * TROW + 16 * g4;
    const unsigned char* vp = Vt + c16 * TROW + 8 * g4;
#define KRD(rt, h) (*(const bf16x8*)(kp + (16 * (rt)) * TROW + 64 * (h)))
#define VRD(dt, kk) ({ const unsigned char* vr__ = vp + (16 * (dt)) * TROW + 64 * (kk); const u32x2 lo__ = *(const u32x2*)vr__, hi__ = *(const u32x2*)(vr__ + 32); \
                       u32x4 w__; w__.x = lo__.x; w__.y = lo__.y; w__.z = hi__.x; w__.w = hi__.y; __builtin_bit_cast(bf16x8, w__); })
#define QK_RT(rt, K0, K1) { _Pragma("unroll") for (int u = 0; u < NU; ++u) { f32x4 a__ = {init[u], init[u], init[u], init[u]}; \
                              a__ = __builtin_amdgcn_mfma_f32_16x16x32_bf16(K0, qf[u][0], a__, 0, 0, 0); Sv[u][rt] = __builtin_amdgcn_mfma_f32_16x16x32_bf16(K1, qf[u][1], a__, 0, 0, 0); } }
#define EXP_RT(rt) { _Pragma("unroll") for (int u = 0; u < NU; ++u) _Pragma("unroll") for (int jj = 0; jj < 4; ++jj) Sv[u][rt][jj] = __builtin_amdgcn_exp2f(Sv[u][rt][jj]); }
#define SUM_RT(rt) { _Pragma("unroll") for (int jj = 0; jj < 4; ++jj) _Pragma("unroll") for (int u = 0; u < NU; ++u) { ps[u] += Sv[u][rt][jj]; asm("" : "+v"(ps[u])); } }
#define CVT_KK(kk, PF) { _Pragma("unroll") for (int u = 0; u < NU; ++u) { u32x4 w__; w__.x = cvt_pk(Sv[u][2 * (kk)][0], Sv[u][2 * (kk)][1]); w__.y = cvt_pk(Sv[u][2 * (kk)][2], Sv[u][2 * (kk)][3]); \
                           w__.z = cvt_pk(Sv[u][2 * (kk) + 1][0], Sv[u][2 * (kk) + 1][1]); w__.w = cvt_pk(Sv[u][2 * (kk) + 1][2], Sv[u][2 * (kk) + 1][3]); PF[u] = __builtin_bit_cast(bf16x8, w__); } }
#define PV_DT(dt, VF, PF) { _Pragma("unroll") for (int u = 0; u < NU; ++u) O[u][dt] = __builtin_amdgcn_mfma_f32_16x16x32_bf16(VF, PF[u], O[u][dt], 0, 0, 0); }
#pragma unroll
    for (int u = 0; u < NU; ++u) ps[u] = 0.f;
    __builtin_amdgcn_sched_barrier(0);
    bf16x8 ka0 = KRD(0, 0), ka1 = KRD(0, 1), kb0 = KRD(1, 0), kb1 = KRD(1, 1);
    QK_RT(0, ka0, ka1)
    __builtin_amdgcn_sched_barrier(0);
    ka0 = KRD(2, 0); ka1 = KRD(2, 1);
    QK_RT(1, kb0, kb1)
    EXP_RT(0)
    SGB(0x100, 2);
#pragma unroll
    for (int i = 0; i < 2 * NU; ++i) { SGB(0x008, 1); SGB(0x400, 2); }
    __builtin_amdgcn_sched_barrier(0);
    kb0 = KRD(3, 0); kb1 = KRD(3, 1);
    QK_RT(2, ka0, ka1)
    EXP_RT(1)
    SUM_RT(0)
    SGB(0x100, 2);
#pragma unroll
    for (int i = 0; i < 2 * NU; ++i) { SGB(0x008, 1); SGB(0x400, 2); SGB(0x002, 2); }
    __builtin_amdgcn_sched_barrier(0);
    QK_RT(3, kb0, kb1)
    EXP_RT(2)
    SUM_RT(1)
#pragma unroll
    for (int i = 0; i < 2 * NU; ++i) { SGB(0x008, 1); SGB(0x400, 2); SGB(0x002, 2); }
    __builtin_amdgcn_sched_barrier(0);
    bf16x8 pf[NU];
    bf16x8 va = VRD(0, 0), vb = VRD(1, 0);
    CVT_KK(0, pf)
    PV_DT(0, va, pf)
    va = VRD(2, 0);
    PV_DT(1, vb, pf)
    vb = VRD(3, 0);
    EXP_RT(3)
    SUM_RT(2)
    PV_DT(2, va, pf)
    va = VRD(0, 1);
    PV_DT(3, vb, pf)
    vb = VRD(1, 1);
    SGB(0x100, 4); SGB(0x002, 4 * NU);
#pragma unroll
    for (int i = 0; i < 4; ++i) { SGB(0x008, 1); SGB(0x400, 1); SGB(0x002, 1); SGB(0x100, 1); SGB(0x008, 1); SGB(0x400, 1); SGB(0x002, 1); SGB(0x100, 1); SGB(0x008, 1); SGB(0x400, 1); SGB(0x002, 1); }
    __builtin_amdgcn_sched_barrier(0);
    bf16x8 pg[NU];
    CVT_KK(1, pg)
    PV_DT(0, va, pg)
    va = VRD(2, 1);
    PV_DT(1, vb, pg)
    vb = VRD(3, 1);
    PV_DT(2, va, pg)
    PV_DT(3, vb, pg)
    SUM_RT(3)
    SGB(0x002, 4 * NU);
#pragma unroll
    for (int i = 0; i < 4 * NU; ++i) { SGB(0x008, 1); SGB(0x002, 1); }
    __builtin_amdgcn_sched_barrier(0);
#pragma unroll
    for (int u = 0; u < NU; ++u) l[u] += ps[u];
#undef KRD
#undef VRD
#undef QK_RT
#undef EXP_RT
#undef CVT_KK
#undef PV_DT
}

__device__ __forceinline__ u32x4 tile_ld(const bf16* __restrict__ g, int tl) { return *(const u32x4*)(g + tl * 8); }
__device__ __forceinline__ void tile_st(unsigned char* lds_tile, u32x4 v, int tl) { *(u32x4*)(lds_tile + (tl >> 3) * TROW + (tl & 7) * 16) = v; }

template <bool FIXED>
__device__ __forceinline__ void mem_attention_mfma(const bf16* __restrict__ P, int qoff, const bf16* __restrict__ MK, const bf16* __restrict__ MVT, const float* __restrict__ q_gain,
                                                   bf16* __restrict__ AIN, unsigned char* lds, int tid_in, const float Mref) {
    int tid = tid_in; asm volatile("" : "+v"(tid));
    const int lane = tid & 63, wv = tid >> 6, c16 = lane & 15, g4 = lane >> 4;
    for (int item = blockIdx.x; item < NB * 4 * 16; item += gridDim.x) {
        int tl = tid; asm volatile("" : "+v"(tl));
        const int qt = item & 15, h = (item >> 4) & 3, b = item >> 6;
        const bf16* kb = MK + (size_t)(b * 4 + h) * 256 * 64;
        const bf16* vb = MVT + (size_t)(b * 4 + h) * 256 * 64;
        bf16x8 qf[2][2];
        size_t rowq[2];
#pragma unroll
        for (int u = 0; u < 2; ++u) { rowq[u] = (size_t)b * S + qt * 256 + wv * 32 + u * 16 + c16; load_qfrag(qf[u], P + rowq[u] * PP + qoff + h * 64, q_gain, nullptr, g4); }
        f32x4 O[2][4], Ol[2]; float m[2], l[2];
        Ol[0] = (f32x4){0.f, 0.f, 0.f, 0.f}; Ol[1] = (f32x4){0.f, 0.f, 0.f, 0.f};
#pragma unroll
        for (int u = 0; u < 2; ++u) { m[u] = FIXED ? Mref : -INFINITY; l[u] = 0.f;
#pragma unroll
            for (int dt = 0; dt < 4; ++dt) O[u][dt] = (f32x4){0.f, 0.f, 0.f, 0.f}; }
        u32x4 kr = tile_ld(kb, tl), vr = tile_ld(vb, tl);
        __syncthreads();
        tile_st(lds + OFF_K, kr, tl); tile_st(lds + OFF_V, vr, tl);
        __syncthreads();
        for (int kt = 0; kt < 4; ++kt) {
            const int cur = kt & 1;
            if (kt + 1 < 4) { kr = tile_ld(kb + (size_t)(kt + 1) * 4096, tl); vr = tile_ld(vb + (size_t)(kt + 1) * 4096, tl); }
            f32x4 Sv[2][4];
            { const float ini[2] = {FIXED ? -Mref : 0.f, FIXED ? -Mref : 0.f}; qk_tile<2>(lds + OFF_K + cur * TILE_B, qf, Sv, c16, g4, ini); }
            { const bool allok[2] = {true, true}; softmax_update<2, false, FIXED, false>(Sv, m, l, O, true, allok); }
            pv_tile<2, false>(lds + OFF_V + cur * TILE_B, Sv, O, c16, g4, Ol);
            if (kt + 1 < 4) { tile_st(lds + OFF_K + (cur ^ 1) * TILE_B, kr, tl); tile_st(lds + OFF_V + (cur ^ 1) * TILE_B, vr, tl); }
            __syncthreads();
        }
#pragma unroll
        for (int u = 0; u < 2; ++u) {
            float lt = l[u]; lt += sxor<16>(lt); lt += sxor<32>(lt);
            const float inv = 1.f / lt;
#pragma unroll
            for (int dt = 0; dt < 4; ++dt) {
                u32x2 w; w.x = cvt_pk(O[u][dt][0] * inv, O[u][dt][1] * inv); w.y = cvt_pk(O[u][dt][2] * inv, O[u][dt][3] * inv);
                *(u32x2*)(AIN + rowq[u] * D + 768 + h * 64 + 16 * dt + 4 * g4) = w;
            }
        }
    }
}

#define STAGE_BASE() ({ int t__ = tid_in; asm volatile("" : "+v"(t__)); stage + ((3 * (t__ >> 6)) * 16 + (t__ & 15)) * STAGE_ROW + 4 * ((t__ >> 4) & 3); })
template <bool FIXED, int VAR = 0>
__device__ __forceinline__ void nsa_attention_mfma(const bf16* __restrict__ P, const bf16* __restrict__ KC, const bf16* __restrict__ VCT, const bf16* __restrict__ KS, const bf16* __restrict__ VST,
                                                   const bf16* __restrict__ KW, const bf16* __restrict__ VWT, const float* __restrict__ rope, const float* __restrict__ qgain,
                                                   const float* __restrict__ gate_b, bf16* __restrict__ AIN, unsigned char* lds, int tid_in, const float Mc, const float Ms, const float Mw) {
    int* imp = (int*)(lds + OFF_IMP);
    unsigned* selw = (unsigned*)(lds + OFF_SEL);
    unsigned* anyw = (unsigned*)(lds + OFF_ANY);
    float* stage = (float*)(lds + OFF_STAGE);
    const int nitems = NB * 2 * 64;
    for (int it = blockIdx.x; it < nitems; it += gridDim.x) {
        int tid = tid_in; asm volatile("" : "+v"(tid));
        const int lane = tid & 63, wv = tid >> 6, c16 = lane & 15, g4 = lane >> 4;
        int tl = tid; asm volatile("" : "+v"(tl));
        int b, g, c;
        if (gridDim.x == 256) { const int k = blockIdx.x, r = it >> 8, bg = 2 * (k & 7) + ((k >> 3) & 1), s = k >> 4;
            b = bg >> 1; g = bg & 1; c = (r == 0) ? s : (r == 1) ? 31 - s : (r == 2) ? 32 + s : 63 - s; }
        else { c = it & 63; g = (it >> 6) & 1; b = it >> 7; }
        const int bg2 = b * 2 + g;
        const bf16* kcb = KC + (size_t)(b * 2 + g) * 256 * 64;
        u32x4 kr0 = ((VAR == 1) ? (u32x4){0u, 0u, 0u, 0u} : tile_ld(kcb, tl));
        bf16x8 qf[3][2]; int qq[3], hq[3];
#pragma unroll
        for (int u = 0; u < 3; ++u) {
            const int U = 3 * wv + u; hq[u] = g * 6 + (U >> 2); qq[u] = (U & 3) * 16 + c16;
            const size_t row = (size_t)b * S + c * 64 + qq[u];
            load_qfrag(qf[u], P + row * PP + 768 + hq[u] * 64, qgain, rope + (size_t)(c * 64 + qq[u]) * 16, g4);
        }
        __syncthreads();
        for (int i = tid; i < 64 * 64; i += NTHR) imp[i] = 0;
        if (tid < 2) anyw[tid] = 0u;
        f32x4 O[3][4], Ol[3]; float m[3], l[3];
        Ol[0] = (f32x4){0.f, 0.f, 0.f, 0.f}; Ol[1] = Ol[0]; Ol[2] = Ol[0];
        const int ktmax = (VAR == 3) ? -1 : (((4 * c + 2) >> 6) > 3 ? 3 : ((4 * c + 2) >> 6));
        const bf16* vcb = VCT + (size_t)bg2 * 256 * 64;
#pragma unroll
        for (int u = 0; u < 3; ++u) { m[u] = FIXED ? Mc : -INFINITY; l[u] = 0.f; }
        const float inic[3] = {FIXED ? -Mc : 0.f, FIXED ? -Mc : 0.f, FIXED ? -Mc : 0.f};
        {
            u32x4 kr = kr0;
            __syncthreads();
            if (VAR != 1) tile_st(lds + OFF_K, kr, tl);
            __syncthreads();
            for (int kt = 0; kt <= ktmax; ++kt) {
                const int cur = kt & 1;
                if (kt + 1 <= ktmax) kr = ((VAR == 1) ? (u32x4){0u, 0u, 0u, 0u} : tile_ld(kcb + (size_t)(kt + 1) * 4096, tl));
                f32x4 Sv[3][4];
                if (VAR < 2) qk_tile<3>(lds + OFF_K + cur * TILE_B, qf, Sv, c16, g4, inic); else { _Pragma("unroll") for (int u = 0; u < 3; ++u) _Pragma("unroll") for (int rt = 0; rt < 4; ++rt) Sv[u][rt] = (f32x4){0.f, 0.f, 0.f, 0.f}; }
#pragma unroll
                for (int u = 0; u < 3; ++u) { const int t = c * 64 + qq[u];
#pragma unroll
                    for (int rt = 0; rt < 4; ++rt)
#pragma unroll
                        for (int jj = 0; jj < 4; ++jj) { const int n = 64 * kt + 16 * rt + 4 * g4 + jj; if (!(n < NCMP && 16 * n + 31 <= t)) Sv[u][rt][jj] = -INFINITY; } }
                { const bool allok[3] = {true, true, true}; softmax_update<3, false, FIXED>(Sv, m, l, O, false, allok); }
                if (kt + 1 <= ktmax) if (VAR != 1) tile_st(lds + OFF_K + (cur ^ 1) * TILE_B, kr, tl);
                __syncthreads();
            }
        }
        float invl[3], mu[3];
#pragma unroll
        for (int u = 0; u < 3; ++u) { float lt = l[u]; lt += sxor<16>(lt); lt += sxor<32>(lt); invl[u] = (lt > 0.f) ? 1.f / lt : 0.f; mu[u] = FIXED ? 0.f : ((m[u] == -INFINITY) ? 0.f : m[u]);
#pragma unroll
            for (int dt = 0; dt < 4; ++dt) O[u][dt] = (f32x4){0.f, 0.f, 0.f, 0.f}; }
        {
            u32x4 kr = ((VAR == 1) ? (u32x4){0u, 0u, 0u, 0u} : tile_ld(kcb, tl)), vr = ((VAR == 1) ? (u32x4){0u, 0u, 0u, 0u} : tile_ld(vcb, tl));
            if (VAR != 1) tile_st(lds + OFF_K, kr, tl); if (VAR != 1) tile_st(lds + OFF_V, vr, tl);
            __syncthreads();
            for (int kt = 0; kt <= ktmax; ++kt) {
                const int cur = kt & 1;
                if (kt + 1 <= ktmax) { kr = ((VAR == 1) ? (u32x4){0u, 0u, 0u, 0u} : tile_ld(kcb + (size_t)(kt + 1) * 4096, tl)); vr = ((VAR == 1) ? (u32x4){0u, 0u, 0u, 0u} : tile_ld(vcb + (size_t)(kt + 1) * 4096, tl)); }
                f32x4 Sv[3][4];
                if (VAR < 2) qk_tile<3>(lds + OFF_K + cur * TILE_B, qf, Sv, c16, g4, inic); else { _Pragma("unroll") for (int u = 0; u < 3; ++u) _Pragma("unroll") for (int rt = 0; rt < 4; ++rt) Sv[u][rt] = (f32x4){0.f, 0.f, 0.f, 0.f}; }
#pragma unroll
                for (int u = 0; u < 3; ++u) { const int t = c * 64 + qq[u];
#pragma unroll
                    for (int rt = 0; rt < 4; ++rt) {
#pragma unroll
                        for (int jj = 0; jj < 4; ++jj) { const int n = 64 * kt + 16 * rt + 4 * g4 + jj; const bool ok = (n < NCMP && 16 * n + 31 <= t);
                            Sv[u][rt][jj] = ok ? __builtin_amdgcn_exp2f(Sv[u][rt][jj] - mu[u]) * invl[u] : 0.f; }
                        const int j = 16 * kt + 4 * rt + g4;
                        const float mainv = Sv[u][rt][0] + Sv[u][rt][1] + Sv[u][rt][2] + 0.5f * Sv[u][rt][3], spill = 0.5f * Sv[u][rt][3];
                        atomicAdd(&imp[qq[u] * 64 + j], (int)(mainv * 16777216.f + 0.5f));
                        if (j + 1 < 64) atomicAdd(&imp[qq[u] * 64 + j + 1], (int)(spill * 16777216.f + 0.5f));
                    } }
                pv_tile<3, false>(lds + OFF_V + cur * TILE_B, Sv, O, c16, g4, Ol);
                if (kt + 1 <= ktmax) { if (VAR != 1) tile_st(lds + OFF_K + (cur ^ 1) * TILE_B, kr, tl); if (VAR != 1) tile_st(lds + OFF_V + (cur ^ 1) * TILE_B, vr, tl); }
                __syncthreads();
            }
        }
#pragma unroll
        for (int u = 0; u < 3; ++u) { const float gcmp = sigmoidf_(ldbf(P + ((size_t)b * S + c * 64 + qq[u]) * PP + 1536 + hq[u] * 3 + 0) + gate_b[hq[u] * 3 + 0]);
#pragma unroll
            for (int dt = 0; dt < 4; ++dt) *(f32x4*)(STAGE_BASE() + (u * 16) * STAGE_ROW + 16 * dt) = O[u][dt] * gcmp; }
        const bf16* ksb = KS + (size_t)bg2 * S * 64;
        const bf16* vsb = VST + (size_t)bg2 * S * 64;
        u32x4 kA = ((VAR == 1) ? (u32x4){0u, 0u, 0u, 0u} : tile_ld(ksb, tl)), vA = ((VAR == 1) ? (u32x4){0u, 0u, 0u, 0u} : tile_ld(vsb, tl)), kB, vB;
        {
#pragma unroll 1
            for (int i = 0; i < 8; ++i) {
                const int q = 8 * wv + i, j = lane;
                int v = imp[q * 64 + j];
                const bool valid = j <= c, forced = (j == 0) || (j == c) || (j == c - 1);
                v = forced ? 0x7fffffc0 : (v & ~63);
                v = valid ? (v | (63 - j)) : -1;
                int rank = 0;
#pragma unroll
                for (int jj = 0; jj < 64; ++jj) { const int o = __builtin_amdgcn_readlane(v, jj); rank += (o > v) ? 1 : 0; }
                const unsigned long long msk = __ballot(rank < 16 && v >= 0);
                if (lane == 0) { selw[2 * q] = (unsigned)msk; selw[2 * q + 1] = (unsigned)(msk >> 32); atomicOr(&anyw[0], (unsigned)msk); atomicOr(&anyw[1], (unsigned)(msk >> 32)); }
            }
        }
        __syncthreads();
        unsigned long long anym = (unsigned long long)anyw[0] | ((unsigned long long)anyw[1] << 32);
        unsigned long long selm[3];
#pragma unroll
        for (int u = 0; u < 3; ++u) selm[u] = (unsigned long long)selw[2 * qq[u]] | ((unsigned long long)selw[2 * qq[u] + 1] << 32);
        {
#pragma unroll
            for (int u = 0; u < 3; ++u) { m[u] = FIXED ? Ms : -INFINITY; l[u] = 0.f; Ol[u] = (f32x4){0.f, 0.f, 0.f, 0.f};
#pragma unroll
                for (int dt = 0; dt < 4; ++dt) O[u][dt] = (f32x4){0.f, 0.f, 0.f, 0.f}; }
            auto nextsel = [&](int jj) -> int { const unsigned long long rest = (jj < 63) ? (anym >> (jj + 1)) : 0ull; return rest ? (jj + 1 + __builtin_ctzll(rest)) : -1; };
            auto compute = [&](int jj, int cur, bool diag) {
                bool colok[3]; float inis[3];
#pragma unroll
                for (int u = 0; u < 3; ++u) { colok[u] = (selm[u] >> jj) & 1ull; inis[u] = FIXED ? (colok[u] ? -Ms : -INFINITY) : 0.f; }
                if (FIXED && VAR == 0 && !diag) { tile_fixed<3>(lds + OFF_K + cur * TILE_B, lds + OFF_V + cur * TILE_B, qf, O, l, c16, g4, inis); return; }
                f32x4 Sv[3][4];
                if (VAR < 2) qk_tile<3>(lds + OFF_K + cur * TILE_B, qf, Sv, c16, g4, inis); else { _Pragma("unroll") for (int u = 0; u < 3; ++u) _Pragma("unroll") for (int rt = 0; rt < 4; ++rt) Sv[u][rt] = (f32x4){0.f, 0.f, 0.f, 0.f}; }
                if (diag) {
#pragma unroll
                    for (int u = 0; u < 3; ++u) { int qo = qq[u] - 4 * g4; asm volatile("" : "+v"(qo));
#pragma unroll
                        for (int rt = 0; rt < 4; ++rt)
#pragma unroll
                            for (int e = 0; e < 4; ++e) { if (16 * rt + e > qo) Sv[u][rt][e] = -INFINITY; } }
                }
                if (VAR < 2) { softmax_update<3, true, FIXED, false>(Sv, m, l, O, true, colok);
                pv_tile<3, false>(lds + OFF_V + cur * TILE_B, Sv, O, c16, g4, Ol); }
            };
            int j = __builtin_ctzll(anym);
            if (VAR != 1) tile_st(lds + OFF_K, kA, tl); if (VAR != 1) tile_st(lds + OFF_V, vA, tl);
            __syncthreads();
            int jn = nextsel(j), jnn, cur = 0;
            if (jn >= 0) { kA = ((VAR == 1) ? (u32x4){0u, 0u, 0u, 0u} : tile_ld(ksb + (size_t)jn * 4096, tl)); vA = ((VAR == 1) ? (u32x4){0u, 0u, 0u, 0u} : tile_ld(vsb + (size_t)jn * 4096, tl)); }
            if (!FIXED) {
                for (;;) {
                    jnn = (jn >= 0) ? nextsel(jn) : -1;
                    if (jnn >= 0) { kB = tile_ld(ksb + (size_t)jnn * 4096, tl); vB = tile_ld(vsb + (size_t)jnn * 4096, tl); }
                    compute(j, cur, j == c);
                    if (jn >= 0) { tile_st(lds + OFF_K + (cur ^ 1) * TILE_B, kA, tl); tile_st(lds + OFF_V + (cur ^ 1) * TILE_B, vA, tl); }
                    __syncthreads();
                    if (jn < 0) break;
                    j = jn; jn = jnn; cur ^= 1;
                    jnn = (jn >= 0) ? nextsel(jn) : -1;
                    if (jnn >= 0) { kA = tile_ld(ksb + (size_t)jnn * 4096, tl); vA = tile_ld(vsb + (size_t)jnn * 4096, tl); }
                    compute(j, cur, j == c);
                    if (jn >= 0) { tile_st(lds + OFF_K + (cur ^ 1) * TILE_B, kB, tl); tile_st(lds + OFF_V + (cur ^ 1) * TILE_B, vB, tl); }
                    __syncthreads();
                    if (jn < 0) break;
                    j = jn; jn = jnn; cur ^= 1;
                }
            } else {
            while (jn >= 0) {
                jnn = nextsel(jn);
                if (jnn >= 0) { kB = ((VAR == 1) ? (u32x4){0u, 0u, 0u, 0u} : tile_ld(ksb + (size_t)jnn * 4096, tl)); vB = ((VAR == 1) ? (u32x4){0u, 0u, 0u, 0u} : tile_ld(vsb + (size_t)jnn * 4096, tl)); }
                compute(j, cur, false);
                if (VAR != 1) tile_st(lds + OFF_K + (cur ^ 1) * TILE_B, kA, tl); if (VAR != 1) tile_st(lds + OFF_V + (cur ^ 1) * TILE_B, vA, tl);
                __syncthreads();
                j = jn; jn = jnn; cur ^= 1;
                if (jn < 0) break;
                jnn = nextsel(jn);
                if (jnn >= 0) { kA = ((VAR == 1) ? (u32x4){0u, 0u, 0u, 0u} : tile_ld(ksb + (size_t)jnn * 4096, tl)); vA = ((VAR == 1) ? (u32x4){0u, 0u, 0u, 0u} : tile_ld(vsb + (size_t)jnn * 4096, tl)); }
                compute(j, cur, false);
                if (VAR != 1) tile_st(lds + OFF_K + (cur ^ 1) * TILE_B, kB, tl); if (VAR != 1) tile_st(lds + OFF_V + (cur ^ 1) * TILE_B, vB, tl);
                __syncthreads();
                j = jn; jn = jnn; cur ^= 1;
            }
            compute(j, cur, true);
            __syncthreads();
            }
#pragma unroll
            for (int u = 0; u < 3; ++u) { float lt = l[u]; lt += sxor<16>(lt); lt += sxor<32>(lt); const float sc = (lt > 0.f) ? sigmoidf_(ldbf(P + ((size_t)b * S + c * 64 + qq[u]) * PP + 1536 + hq[u] * 3 + 1) + gate_b[hq[u] * 3 + 1]) / lt : 0.f;
#pragma unroll
                for (int dt = 0; dt < 4; ++dt) { float* sp = STAGE_BASE() + (u * 16) * STAGE_ROW + 16 * dt; *(f32x4*)sp = *(f32x4*)sp + O[u][dt] * sc; } }
        }
        {
            const bf16* kwb = KW + (size_t)bg2 * S * 64;
            const bf16* vwb = VWT + (size_t)bg2 * S * 64;
#pragma unroll
            for (int u = 0; u < 3; ++u) { m[u] = FIXED ? Mw : -INFINITY; l[u] = 0.f; Ol[u] = (f32x4){0.f, 0.f, 0.f, 0.f};
#pragma unroll
                for (int dt = 0; dt < 4; ++dt) O[u][dt] = (f32x4){0.f, 0.f, 0.f, 0.f}; }
            const float iniw[3] = {FIXED ? -Mw : 0.f, FIXED ? -Mw : 0.f, FIXED ? -Mw : 0.f};
            const int j0 = (c >= 8) ? c - 8 : 0;
            u32x4 kr = ((VAR == 1) ? (u32x4){0u, 0u, 0u, 0u} : tile_ld(kwb + (size_t)j0 * 4096, tl)), vr = ((VAR == 1) ? (u32x4){0u, 0u, 0u, 0u} : tile_ld(vwb + (size_t)j0 * 4096, tl));
            if (VAR != 1) tile_st(lds + OFF_K, kr, tl); if (VAR != 1) tile_st(lds + OFF_V, vr, tl);
            __syncthreads();
            int cur = 0;
            auto wstep = [&](int j, bool fast) {
                if (j + 1 <= c) { kr = ((VAR == 1) ? (u32x4){0u, 0u, 0u, 0u} : tile_ld(kwb + (size_t)(j + 1) * 4096, tl)); vr = ((VAR == 1) ? (u32x4){0u, 0u, 0u, 0u} : tile_ld(vwb + (size_t)(j + 1) * 4096, tl)); }
                if (FIXED && VAR == 0 && fast) tile_fixed<3>(lds + OFF_K + cur * TILE_B, lds + OFF_V + cur * TILE_B, qf, O, l, c16, g4, iniw);
                else {
                    f32x4 Sv[3][4];
                    if (VAR < 2) qk_tile<3>(lds + OFF_K + cur * TILE_B, qf, Sv, c16, g4, iniw); else { _Pragma("unroll") for (int u = 0; u < 3; ++u) _Pragma("unroll") for (int rt = 0; rt < 4; ++rt) Sv[u][rt] = (f32x4){0.f, 0.f, 0.f, 0.f}; }
                    if (j == c || j == c - 8) {
#pragma unroll
                        for (int u = 0; u < 3; ++u) { int qo = qq[u] - 4 * g4; asm volatile("" : "+v"(qo));
#pragma unroll
                            for (int rt = 0; rt < 4; ++rt)
#pragma unroll
                                for (int jj = 0; jj < 4; ++jj) { const int kk = 16 * rt + jj; const bool ok = (j == c) ? (kk <= qo) : (kk > qo); if (!ok) Sv[u][rt][jj] = -INFINITY; } }
                    }
                    if (VAR < 2) { { const bool allok[3] = {true, true, true}; softmax_update<3, false, FIXED, false>(Sv, m, l, O, true, allok); }
                    pv_tile<3, false>(lds + OFF_V + cur * TILE_B, Sv, O, c16, g4, Ol); }
                }
                if (j + 1 <= c) { if (VAR != 1) tile_st(lds + OFF_K + (cur ^ 1) * TILE_B, kr, tl); if (VAR != 1) tile_st(lds + OFF_V + (cur ^ 1) * TILE_B, vr, tl); }
                __syncthreads();
                cur ^= 1;
            };
            if (!FIXED) { for (int j = j0; j <= c; ++j) wstep(j, false); }
            else {
                wstep(j0, false);
                for (int j = j0 + 1; j < c; ++j) wstep(j, true);
                if (c > j0) wstep(c, false);
            }
#pragma unroll
            for (int u = 0; u < 3; ++u) { float lt = l[u]; lt += sxor<16>(lt); lt += sxor<32>(lt); const float sc = (lt > 0.f) ? sigmoidf_(ldbf(P + ((size_t)b * S + c * 64 + qq[u]) * PP + 1536 + hq[u] * 3 + 2) + gate_b[hq[u] * 3 + 2]) / lt : 0.f;
#pragma unroll
                for (int dt = 0; dt < 4; ++dt) { float* sp = STAGE_BASE() + (u * 16) * STAGE_ROW + 16 * dt; *(f32x4*)sp = *(f32x4*)sp + O[u][dt] * sc; } }
        }
        __syncthreads();
        for (int i = tid; i < 384 * 8; i += NTHR) {
            const int d8 = i & 7, col = i >> 3, r = col >> 6, q = col & 63;
            const float* sp = stage + col * STAGE_ROW + d8 * 8;
            const f32x4 a = *(const f32x4*)sp, bb = *(const f32x4*)(sp + 4);
            u32x4 w; w.x = cvt_pk(a[0], a[1]); w.y = cvt_pk(a[2], a[3]); w.z = cvt_pk(bb[0], bb[1]); w.w = cvt_pk(bb[2], bb[3]);
            *(u32x4*)(AIN + ((size_t)b * S + c * 64 + q) * D + (g * 6 + r) * 64 + d8 * 8) = w;
        }
    }
}
}

#define XB_LAS __attribute__((address_space(3)))
#define XB_TMO      128
#define XB_XCNT(j)  (256  + 64 * (j))
#define XB_XSUB(j)  (1280 + 64 * (j))
#define XB_XGEN(j)  (2304 + 64 * (j))
#define XB_TOP      3328
#define XB_TOPGEN   3392
#define XCD_BAR_WORDS 3456
#define XB_SPIN_CAP (1u << 18)

__device__ __forceinline__ unsigned xb_ld(unsigned* p)              { return __hip_atomic_load(p, __ATOMIC_RELAXED, __HIP_MEMORY_SCOPE_AGENT); }
__device__ __forceinline__ unsigned xb_add(unsigned* p, unsigned v) { return __hip_atomic_fetch_add(p, v, __ATOMIC_RELAXED, __HIP_MEMORY_SCOPE_AGENT); }
__device__ __forceinline__ unsigned xb_xcc_id() { return (unsigned)__builtin_amdgcn_s_getreg((3 << 11) | 20) & 0xFu; }
#define XB_SPIN(cond, bar) do { unsigned _sp = 0; while (cond) { __builtin_amdgcn_s_sleep(1); \
    if ((++_sp & 255u) == 0u) { if (xb_ld(&(bar)[XB_TMO])) break; if (_sp > XB_SPIN_CAP) { atomicAdd(&(bar)[XB_TMO], 1u); break; } } } } while (0)

struct XcdBarrier {
    unsigned* bar; unsigned x;
    volatile XB_LAS unsigned* st;
};

__device__ __forceinline__ XcdBarrier xcd_barrier_post(unsigned* bar, volatile XB_LAS unsigned* st) {
    XcdBarrier b; b.bar = bar; b.x = xb_xcc_id(); b.st = st;
    if (threadIdx.x == 0) { const unsigned rank = xb_add(&bar[XB_XCNT(b.x)], 1u); st[2] = b.x; st[3] = rank; }
    return b;
}
__device__ __forceinline__ void xcd_barrier_complete(unsigned* bar, unsigned x, unsigned& nloc, unsigned& nx) {
    const unsigned G = gridDim.x * gridDim.y * gridDim.z;
    unsigned sum, cnt, mine, sp = 0u;
    for (;;) {
        sum = 0u; cnt = 0u; mine = 0u;
#pragma unroll
        for (unsigned j = 0; j < 16; ++j) { const unsigned c = xb_ld(&bar[XB_XCNT(j)]); sum += c; cnt += (c > 0u) ? 1u : 0u; mine = (j == x) ? c : mine; }
        if (sum == G) break;
        __builtin_amdgcn_s_sleep(1);
        if ((++sp & 255u) == 0u) { if (xb_ld(&bar[XB_TMO])) break; if (sp > XB_SPIN_CAP) { atomicAdd(&bar[XB_TMO], 1u); break; } }
    }
    nloc = mine > 0u ? mine : 1u; nx = cnt > 0u ? cnt : 1u;
}

__device__ __forceinline__ void xcd_barrier(const XcdBarrier& b, const bool leader_thread) {
    asm volatile("s_waitcnt vmcnt(0)" ::: "memory");
    __syncthreads();
    if (leader_thread) {
        unsigned* bar = b.bar;
        __builtin_amdgcn_s_waitcnt(0);
        unsigned nloc = b.st[0], nx = b.st[1];
        if (nloc == 0u) { xcd_barrier_complete(bar, b.x, nloc, nx); b.st[0] = nloc; b.st[1] = nx; }
        const unsigned old = xb_add(&bar[XB_XSUB(b.x)], 1u);
        const unsigned gen = old / nloc;
        if (old + 1u == (gen + 1u) * nloc) {
            __builtin_amdgcn_fence(__ATOMIC_RELEASE, "agent");
            asm volatile("s_waitcnt vmcnt(0)" ::: "memory");
            const unsigned og = xb_add(&bar[XB_TOP], 1u);
            const unsigned tg = og / nx;
            if (og + 1u == (tg + 1u) * nx) xb_add(&bar[XB_TOPGEN], 1u);
            else XB_SPIN(xb_ld(&bar[XB_TOPGEN]) == tg, bar);
            __builtin_amdgcn_fence(__ATOMIC_ACQUIRE, "agent");
            xb_add(&bar[XB_XGEN(b.x)], 1u);
            asm volatile("s_waitcnt vmcnt(0)" ::: "memory");
        } else {
            XB_SPIN(xb_ld(&bar[XB_XGEN(b.x)]) == gen, bar);
            __builtin_amdgcn_fence(__ATOMIC_ACQUIRE, "agent");
            asm volatile("s_waitcnt vmcnt(0)" ::: "memory");
        }
    }
    __syncthreads();
}

__device__ __forceinline__ void xcd_barrier_here(unsigned char* ws_ctl, volatile XB_LAS unsigned* st, const bool leader_thread) {
    XcdBarrier b; b.bar = (unsigned*)ws_ctl; b.x = xb_xcc_id(); b.st = st;
    xcd_barrier(b, leader_thread);
}

constexpr int N_PHASES = 18;
constexpr int LDS_BYTES = 163840;
static_assert((pg8::EpiTopK::LIST_OFF + 256 * 16) * 4 <= LDS_BYTES - 64 - 256, "top-k LDS map");
static_assert(att::LDS_NEED <= LDS_BYTES - 64 - 256, "attention LDS map (the last 64 B hold the grid barrier's set-up words)");
#define PG8_SP2_ON true

template <int LO, int HI>
__global__ void __launch_bounds__(NTHR) fwd_kernel(Params p) {
    cg::grid_group grid = cg::this_grid();
    extern __shared__ __attribute__((aligned(16))) unsigned char lds_raw[];
    float* smem = (float*)lds_raw;
    PG8_LAS unsigned char* ldsp = (PG8_LAS unsigned char*)lds_raw;
    constexpr int lo = LO, hi = HI;
    int ph = 0;
    const int wave_s__ = __builtin_amdgcn_readfirstlane(threadIdx.x >> 6);
    if (threadIdx.x < 30) ((const float* XB_LAS*)((XB_LAS unsigned char*)lds_raw + (LDS_BYTES - 64 - 256)))[threadIdx.x] = p.in[threadIdx.x];
    __syncthreads();
#define INP(i) ((const float*)lds_ptr_uniform((XB_LAS unsigned char*)lds_raw + (LDS_BYTES - 64 - 256) + 8 * (i)))
    if (hi - lo > 1) {
        if (threadIdx.x < 16) ((volatile XB_LAS unsigned*)((XB_LAS unsigned char*)lds_raw + (LDS_BYTES - 64)))[threadIdx.x] = 0u;
        __syncthreads();
        (void)xcd_barrier_post((unsigned*)(p.ws + WS_CTL), (volatile XB_LAS unsigned*)((XB_LAS unsigned char*)lds_raw + (LDS_BYTES - 64)));
    }
#define GRID_BAR() xcd_barrier_here(p.ws + WS_CTL, (volatile XB_LAS unsigned*)((XB_LAS unsigned char*)lds_raw + (LDS_BYTES - 64)), wave_s__ == 0 && lane_now() == 0)
#define PHASE_PROLOGUE \
    const int wv = wave_s__; \
    const int tid = wave_s__ * 64 + lane_now(); \
    const int lane = tid & 63; \
    const int gw = blockIdx.x * (NTHR / 64) + wv, ngw = gridDim.x * (NTHR / 64); \
    const int gtid = blockIdx.x * NTHR + tid, ngt = gridDim.x * NTHR; \
    const int G = gridDim.x; \
    const float* x = INP(0); const float* mem = INP(1); const int* positions = (const int*)INP(2); \
    const float* norm_mix = INP(3); const float* norm_ffn = INP(4); const float* norm_mem = INP(5); \
    const float* w_out = INP(6); const float* w_mem_kv = INP(7); const float* mem_q_gain = INP(8); const float* mem_k_gain = INP(9); \
    const float* a_w_in = INP(10); const float* a_conv_w = INP(11); const float* a_conv_b = INP(12); const float* a_gate_w = INP(13); \
    const float* a_gate_b = INP(14); const float* a_lambda = INP(15); const float* b_w_in = INP(16); const float* b_gate_b = INP(17); \
    const float* b_q_gain = INP(18); const float* kv_norm = INP(19); const float* w_kv_shared = INP(20); const float* k_gain_shared = INP(21); \
    const float* cmp_pos = INP(22); const float* cmp_w1 = INP(23); const float* cmp_b1 = INP(24); const float* cmp_w2 = INP(25); \
    const float* peer_wq = INP(26); const float* peer_subkeys = INP(27); const float* peer_u = INP(28); const float* peer_v = INP(29); \
    float* out = p.out; \
    unsigned char* ws = p.ws; asm volatile("" : "+s"(ws)); \
    float* RSTD = (float*)(ws + WS_RSTD); \
    float* rstd0 = RSTD, *rstd2 = RSTD + 2 * T, *rstdm = RSTD + 4 * T; \
    float* sumsq1 = (float*)(ws + WS_SSQ1), *sumsq3 = (float*)(ws + WS_SSQ3); \
    float* ROPE = (float*)(ws + WS_ROPE); float* BIAS2 = (float*)(ws + WS_BIAS2); bf16* WGF = (bf16*)(ws + WS_WGF); \
    bf16* WIN0 = (bf16*)(ws + WS_WIN0); bf16* WOUT = (bf16*)(ws + WS_WOUT); bf16* WFt = (bf16*)(ws + WS_WF); bf16* WKVB = (bf16*)(ws + WS_WKVB); \
    bf16* WMEM = (bf16*)(ws + WS_WMEM); bf16* WC1 = (bf16*)(ws + WS_WC1); bf16* MEMB = (bf16*)(ws + WS_MEMB); bf16* MEMKV = (bf16*)(ws + WS_MEMKV); \
    float* AGG = (float*)(ws + WS_SCAN); bf16* HID = (bf16*)(ws + WS_HID); bf16* KC = (bf16*)(ws + WS_KC); bf16* VC = (bf16*)(ws + WS_VC); \
    bf16* CA = (bf16*)(ws + WS_CA); int* E = (int*)(ws + WS_E); float* Gt = (float*)(ws + WS_GT); bf16* KS = (bf16*)(ws + WS_KS); bf16* KW = (bf16*)(ws + WS_KW); \
    bf16* XB = (bf16*)(ws + WS_XB); bf16* AIN = (bf16*)(ws + WS_AIN); bf16* P = (bf16*)(ws + WS_P); \
    unsigned char* UT8 = ws + WS_UT; unsigned char* VT8 = ws + WS_VT; float* PART = (float*)(ws + WS_P); float* sumsq2 = (float*)(ws + WS_SSQ2); \
    bf16* MEMK = (bf16*)(ws + WS_MEMK); bf16* MEMVT = (bf16*)(ws + WS_MEMVT); bf16* VST = (bf16*)(ws + WS_VST); bf16* VWT = (bf16*)(ws + WS_VWT); \
    (void)lane; (void)gw; (void)ngw; (void)gtid; (void)ngt; (void)G;

#define SLICE_COORDS() \
    int sl_xs, sl_r, sl_nr; { \
        const unsigned* ctlw = (const unsigned*)(ws + WS_CTL); \
        bool clean = (gridDim.x & 7) == 0; \
        _Pragma("unroll") for (int jx = 0; jx < 8; ++jx) clean = clean && (__hip_atomic_load(ctlw + XB_XCNT(jx), __ATOMIC_RELAXED, __HIP_MEMORY_SCOPE_AGENT) == gridDim.x / 8); \
        volatile XB_LAS unsigned* stw = (volatile XB_LAS unsigned*)((XB_LAS unsigned char*)lds_raw + (LDS_BYTES - 64)); \
        const int hx = (int)stw[2], hr = (int)stw[3]; \
        if (clean) { sl_xs = __builtin_amdgcn_readfirstlane(hx); sl_r = __builtin_amdgcn_readfirstlane(hr); sl_nr = gridDim.x / 8; } \
        else { sl_xs = blockIdx.x & 7; sl_r = blockIdx.x >> 3; sl_nr = (gridDim.x - sl_xs + 7) >> 3; } }
#ifndef PROBE_SUB
#define PROBE_SUB (-1)
#endif
#define SUBREP(id) for (int r2__ = 0; r2__ < ((PROBE_SUB == (id)) ? 2 : 1); ++r2__)
#ifndef PROBE_DUP
#define PROBE_DUP (-1)
#endif
#define PHASE_BEGIN if (ph >= lo && ph < hi) { for (int rep__ = (ph == PROBE_DUP ? 0 : 1); rep__ < 2; ++rep__) { PHASE_PROLOGUE
#define PHASE_END if (rep__ == 0) GRID_BAR(); } } ++ph; if (ph > lo && ph < hi) { if (ph == 1) grid.sync(); else GRID_BAR(); }

    PHASE_BEGIN
        SUBREP(1) for (int r = gw; r < T; r += ngw) row_to_bf16(x + (size_t)r * D, XB + (size_t)r * D, rstd0 + r, lane);
        for (int r = gw; r < NB * MEMN; r += ngw) row_to_bf16(mem + (size_t)r * D, MEMB + (size_t)r * D, rstdm + r, lane);
        for (int i = gtid; i < S * 8; i += ngt) {
            const int s = i >> 3, k = i & 7;
            const float freq = powf(500000.0f, -(float)k / 8.0f);
            const float ang = (float)positions[s] * freq;
            ROPE[s * 16 + k] = cosf(ang); ROPE[s * 16 + 8 + k] = sinf(ang);
        }
        SUBREP(2) {
            float* scr = smem + wv * (64 * 33);
            constexpr int I_IN0 = 16 * 56, I_OUT = 16 * 32, I_KV = 16 * 24, I_BIN = 16 * 34, I_MEM = 16 * 16, I_C1 = 32 * 8;
            constexpr int NIT = I_IN0 + 2 * I_OUT + I_KV + I_BIN + 2 * I_MEM + 2 * I_C1;
            for (int it = gw; it < NIT; it += ngw) {
                int r = it;
                if (r < I_IN0) { transpose_item(a_w_in, D, 1792, norm_mix, WIN0, 0, scr, r, lane); continue; } r -= I_IN0;
                if (r < I_OUT) { transpose_item(w_out, D, D, nullptr, WOUT, 0, scr, r, lane); continue; } r -= I_OUT;
                if (r < I_OUT) { transpose_item(w_out + (size_t)D * D, D, D, nullptr, WOUT + (size_t)D * D, 0, scr, r, lane); continue; } r -= I_OUT;
                if (r < I_KV) { transpose_item(w_kv_shared, D, 768, kv_norm, WKVB, 0, scr, r, lane); continue; } r -= I_KV;
                if (r < I_BIN) { transpose_item(b_w_in, D, 1060, norm_mix + D, WKVB, 768, scr, r, lane); continue; } r -= I_BIN;
                if (r < I_MEM) { transpose_item(w_mem_kv, D, 512, norm_mem, WMEM, 0, scr, r, lane); continue; } r -= I_MEM;
                if (r < I_MEM) { transpose_item(w_mem_kv + (size_t)D * 512, D, 512, norm_mem + D, WMEM, 512, scr, r, lane); continue; } r -= I_MEM;
                { const int j = r / I_C1, rq = r % I_C1, ks = rq >> 6;
                  transpose_item(cmp_w1 + ((size_t)j * 2048 + ks * 512) * 256, 512, 256, nullptr, WC1 + ((size_t)(j * 4 + ks) * 256) * 512, 0, scr, rq & 63, lane); }
            }
            for (int i = gtid; i < 220 * 1024 / 8; i += ngt) ((u32x4*)(WKVB + (size_t)1828 * 1024))[i] = (u32x4){0u, 0u, 0u, 0u};
        }
        SUBREP(3) for (int item = blockIdx.x; item < 2 * 16 * 2 * 4; item += gridDim.x) {
            const int nq = item & 3, kh = (item >> 2) & 1, hp = (item >> 3) & 15, l = item >> 7;
            const float* sk = peer_subkeys + (((size_t)l * 16 + hp) * 128 + nq * 32) * 128;
            __syncthreads();
            for (int i = tid; i < 32 * 128; i += NTHR) smem[i] = sk[i];
            __syncthreads();
            const int k = kh * 512 + tid;
            float* wst = smem + 4096 + wv * (64 * 36);
            const float* wqb = peer_wq + ((size_t)l * D + kh * 512 + wv * 64) * 2048 + hp * 128;
            float4 wr4[32];
#pragma unroll
            for (int c = 0; c < 4; ++c) {
                __builtin_amdgcn_wave_barrier();
#pragma unroll
                for (int j = 0; j < 8; ++j) { const float4 tq = *(const float4*)(wqb + (size_t)(8 * j + (lane >> 3)) * 2048 + 32 * c + 4 * (lane & 7));
                    *(float4*)(wst + (8 * j + (lane >> 3)) * 36 + 4 * (lane & 7)) = tq; }
                __builtin_amdgcn_wave_barrier();
#pragma unroll
                for (int i = 0; i < 8; ++i) wr4[8 * c + i] = *(const float4*)(wst + lane * 36 + 4 * i);
                __builtin_amdgcn_sched_barrier(0);
            }
            const float gk = norm_ffn[l * D + k];
#pragma unroll 1
            for (int n = 0; n < 32; ++n) {
                const float4* sr = (const float4*)(smem + n * 128);
                float acc = 0.f;
#pragma unroll
                for (int i = 0; i < 32; ++i) { const float4 s4 = sr[i]; acc += wr4[i].x * s4.x + wr4[i].y * s4.y + wr4[i].z * s4.z + wr4[i].w * s4.w;
                    if ((i & 7) == 7) __builtin_amdgcn_sched_barrier(0); }
                WFt[((size_t)l * 2048 + hp * 128 + nq * 32 + n) * 1024 + k] = (bf16)f2bf(acc * gk);
            }
        }
        for (int i = gtid; i < NBLK * 2 * 8 * 64; i += ngt) {
            const int ln = i & 63, ct = (i >> 6) & 7, ks = (i >> 9) & 1, n = i >> 10;
            const int col = 16 * ct + (ln & 15), gsel = col >> 6, e = col & 63;
            const float* wp = a_gate_w + ((size_t)(gsel * NBLK + n) * 64 + 32 * ks + 8 * (ln >> 4)) * 64 + e;
            const float nl2 = -1.4426950408889634f;
            u32x4 w; w.x = pk2(wp[0] * nl2, wp[64] * nl2); w.y = pk2(wp[128] * nl2, wp[192] * nl2); w.z = pk2(wp[256] * nl2, wp[320] * nl2); w.w = pk2(wp[384] * nl2, wp[448] * nl2);
            *(u32x4*)(WGF + (size_t)i * 8) = w;
        }
        for (int i = gtid; i < LRUW; i += ngt) {
            float* SGC = (float*)(ws + WS_SGC);
            const float lam = a_lambda[i];
            SGC[i] = -1.4426950408889634f * a_gate_b[i]; SGC[LRUW + i] = -1.4426950408889634f * a_gate_b[LRUW + i];
            SGC[2 * LRUW + i] = -8.0f * 1.4426950408889634f * ((-lam > 20.f) ? -lam : log1pf(expf(-lam)));
        }
        for (int i = gtid; i < 2 * 32 * 256; i += ngt) {
            const int c = i & 255, kc = (i >> 8) & 31, j = i >> 13;
            float acc = 0.f;
#pragma unroll 8
            for (int k = kc * 64; k < kc * 64 + 64; ++k) acc = fmaf(cmp_pos[j * 2048 + k], cmp_w1[((size_t)j * 2048 + k) * 256 + c], acc);
            BIAS2[1024 + i] = acc;
        }
        SUBREP(4) for (int l = 0; l < 2; ++l) {
            const int kk = (int)(((size_t)gtid * 16) & 1023);
            float4 gq[4];
#pragma unroll
            for (int q = 0; q < 4; ++q) gq[q] = *(const float4*)(norm_ffn + l * D + kk + 4 * q);
            const size_t lbase = (size_t)l * 16384 * 1024;
            for (size_t i = gtid; i < (size_t)16384 * 64; i += 2 * (size_t)ngt) {
                float4 a[2][4], v[2][4];
#pragma unroll
                for (int h = 0; h < 2; ++h) { const size_t e16 = lbase + (i + (size_t)h * ngt) * 16;
                    if (i + (size_t)h * ngt < (size_t)16384 * 64) {
#pragma unroll
                        for (int q = 0; q < 4; ++q) { a[h][q] = *(const float4*)(peer_u + e16 + 4 * q); v[h][q] = *(const float4*)(peer_v + e16 + 4 * q); } } }
#pragma unroll
                for (int h = 0; h < 2; ++h) { const size_t e16 = lbase + (i + (size_t)h * ngt) * 16;
                    if (i + (size_t)h * ngt < (size_t)16384 * 64) {
                        unsigned wu[4], wv4[4];
#pragma unroll
                        for (int q = 0; q < 4; ++q) { const float4 g = gq[q];
                            int w = 0; w = __builtin_amdgcn_cvt_pk_fp8_f32(a[h][q].x * g.x * 64.f, a[h][q].y * g.y * 64.f, w, false); w = __builtin_amdgcn_cvt_pk_fp8_f32(a[h][q].z * g.z * 64.f, a[h][q].w * g.w * 64.f, w, true); wu[q] = (unsigned)w;
                            int y = 0; y = __builtin_amdgcn_cvt_pk_fp8_f32(v[h][q].x * 8.f, v[h][q].y * 8.f, y, false); y = __builtin_amdgcn_cvt_pk_fp8_f32(v[h][q].z * 8.f, v[h][q].w * 8.f, y, true); wv4[q] = (unsigned)y; }
                        *(u32x4*)(UT8 + e16) = (u32x4){wu[0], wu[1], wu[2], wu[3]};
                        *(u32x4*)(VT8 + e16) = (u32x4){wv4[0], wv4[1], wv4[2], wv4[3]}; } }
            }
        }
    PHASE_END

    PHASE_BEGIN
        { pg8::Gemm g{XB, WIN0, T, 1792, D}; pg8::StaticOrder So; So.init(T, 1792, G, (int)blockIdx.x);
          pg8::EpiRowScaleBf16 Ep{P, PP, rstd0, nullptr};
          pg8::gemm_phase<pg8::EpiRowScaleBf16, pg8::StaticOrder, true, PG8_SP2_ON>(ldsp, g, So, Ep, tid); }
        { pg8::Gemm g{MEMB, WMEM, NB * MEMN, 1024, D}; pg8::StaticOrder So; So.init(NB * MEMN, 1024, G, (int)((blockIdx.x + G / 2) % G));
          pg8::EpiRowScaleBf16 Ep{MEMKV, 1024, rstdm, nullptr};
          pg8::gemm_phase<pg8::EpiRowScaleBf16, pg8::StaticOrder, true, PG8_SP2_ON>(ldsp, g, So, Ep, tid); }
    PHASE_END

    PHASE_BEGIN
        scan_pass<false>(P, a_conv_w, a_conv_b, WGF, (const float*)(ws + WS_SGC), AGG, AIN, lds_raw + wv * 18864, tid);
        for (int item = gw; item < 2 * 4 * 256; item += ngw) {
            const int h = item & 3, grp = (item >> 2) & 255, l = item >> 10, row = grp * 8 + (lane >> 3), c8 = lane & 7, b = row >> 8, mm = row & 255;
            const u32x4 w = *(const u32x4*)(MEMKV + (size_t)row * 1024 + l * 512 + h * 64 + 8 * c8);
            const float4 ga = *(const float4*)(mem_k_gain + l * 64 + 8 * c8), gb = *(const float4*)(mem_k_gain + l * 64 + 8 * c8 + 4);
            float v[8] = {bflo(w.x), bfhi(w.x), bflo(w.y), bfhi(w.y), bflo(w.z), bfhi(w.z), bflo(w.w), bfhi(w.w)};
            float ss = 0.f;
#pragma unroll
            for (int i = 0; i < 8; ++i) ss += v[i] * v[i];
            ss += sxor<1>(ss); ss += sxor<2>(ss); ss += sxor<4>(ss);
            const float rs = rsqrtf(ss * (1.f / 64.f) + EPS);
            u32x4 o; o.x = pk2(v[0] * rs * ga.x, v[1] * rs * ga.y); o.y = pk2(v[2] * rs * ga.z, v[3] * rs * ga.w); o.z = pk2(v[4] * rs * gb.x, v[5] * rs * gb.y); o.w = pk2(v[6] * rs * gb.z, v[7] * rs * gb.w);
            *(u32x4*)(MEMK + ((size_t)((l * NB + b) * 4 + h) * 256 + mm) * 64 + 8 * c8) = o;
        }
        {
            bf16* tl = (bf16*)(lds_raw + wv * 18864);
            for (int item = gw; item < 2 * NB * 4 * 4; item += ngw) {
                const int kt = item & 3, h = (item >> 2) & 3, b = (item >> 4) & 7, l = item >> 7;
                const bf16* src = MEMKV + ((size_t)b * 256 + 64 * kt) * 1024 + l * 512 + 256 + h * 64;
#pragma unroll
                for (int i = 0; i < 8; ++i) {
                    const int key = 8 * i + (lane >> 3), c8 = lane & 7;
                    const u32x4 v = *(const u32x4*)(src + (size_t)key * 1024 + 8 * c8);
                    bf16* tp = tl + (8 * c8) * 72 + key;
                    tp[0 * 72] = (bf16)(v.x & 0xffffu); tp[1 * 72] = (bf16)(v.x >> 16); tp[2 * 72] = (bf16)(v.y & 0xffffu); tp[3 * 72] = (bf16)(v.y >> 16);
                    tp[4 * 72] = (bf16)(v.z & 0xffffu); tp[5 * 72] = (bf16)(v.z >> 16); tp[6 * 72] = (bf16)(v.w & 0xffffu); tp[7 * 72] = (bf16)(v.w >> 16);
                }
                __builtin_amdgcn_s_waitcnt(0); __builtin_amdgcn_wave_barrier();
                bf16* dst = MEMVT + ((size_t)(((l * NB + b) * 4 + h) * 4 + kt)) * 4096;
#pragma unroll
                for (int jq = 0; jq < 8; ++jq) {
                    const int d = 8 * jq + (lane >> 3), c8 = lane & 7;
                    *(u32x4*)(dst + d * 64 + 8 * c8) = *(const u32x4*)(tl + d * 72 + 8 * c8);
                }
                __builtin_amdgcn_s_waitcnt(0); __builtin_amdgcn_wave_barrier();
            }
        }
    PHASE_END

    PHASE_BEGIN
        scan_pass<true>(P, a_conv_w, a_conv_b, WGF, (const float*)(ws + WS_SGC), AGG, AIN, lds_raw + wv * 18864, tid);
        __syncthreads();
        {
            const float Mm = __builtin_bit_cast(float, __builtin_amdgcn_readfirstlane(__builtin_bit_cast(int, att::SBOUND * wave_max(fabsf(mem_q_gain[lane])) * wave_max(fabsf(mem_k_gain[lane])))));
            if (Mm <= 40.f) att::mem_attention_mfma<true>(P, 1536, MEMK, MEMVT, mem_q_gain, AIN, lds_raw, tid, Mm);
            else att::mem_attention_mfma<false>(P, 1536, MEMK, MEMVT, mem_q_gain, AIN, lds_raw, tid, 0.f);
        }
    PHASE_END

    PHASE_BEGIN
        { pg8::Gemm g{AIN, WOUT, T, D, D}; pg8::StaticOrder So; So.init(T, D, G, (int)blockIdx.x);
          pg8::EpiResidual Ep{XB, sumsq1};
          pg8::gemm_phase<pg8::EpiResidual, pg8::StaticOrder, true, PG8_SP2_ON>(ldsp, g, So, Ep, tid); }
    PHASE_END

    PHASE_BEGIN
        for (int tile = blockIdx.x; tile < (T / 256) * 8; tile += gridDim.x) {
            int pm, pn;
            if ((gridDim.x & 255) == 0) { const int rr = tile / (int)gridDim.x, bb = tile % (int)gridDim.x, xq = bb & 7, sl = bb >> 3, per = (int)gridDim.x >> 6;
                pm = (rr * 8 + xq) * per + (sl >> 3); pn = sl & 7; }
            else { pm = tile >> 3; pn = tile & 7; }
            const int tidt = wave_s__ * 64 + lane_now();
            pg8::Gemm g{XB, WFt, T, 2048, D}; pg8::OneUnit So; So.u.pm = pm; So.u.pn = pn;
            pg8::EpiTopK Ep{sumsq1, E, Gt};
            pg8::gemm_phase<pg8::EpiTopK, pg8::OneUnit, false, PG8_SP2_ON>(ldsp, g, So, Ep, tidt);
        }
    PHASE_END

    PHASE_BEGIN
        SLICE_COORDS(); peer_u_partial(XB, UT8, E, PART, lds_raw + wv * (G_SLOTS * 1024), tid, sl_xs, sl_r, sl_nr);
    PHASE_END
    PHASE_BEGIN
        peer_act(PART, sumsq1, Gt, tid);
    PHASE_END
    PHASE_BEGIN
        SLICE_COORDS(); peer_v_slice(nullptr, XB, VT8, E, Gt, sumsq2, rep__ == 0, lds_raw + wv * (G_SLOTS * 1024), tid, sl_xs, sl_r, sl_nr);
    PHASE_END

    PHASE_BEGIN
        for (int i = gtid; i < 512; i += ngt) {
            const int j = i >> 8, c = i & 255;
            float acc = cmp_b1[i];
            for (int kc = 0; kc < 32; ++kc) acc += BIAS2[1024 + (j * 32 + kc) * 256 + c];
            BIAS2[i] = acc;
        }
        { pg8::Gemm g{XB, WKVB, T, 2048, D}; pg8::StaticOrder So; So.init(T, 2048, G, (int)blockIdx.x);
          pg8::EpiRowScaleBf16 Ep{P, PP, nullptr, sumsq2};
          pg8::gemm_phase<pg8::EpiRowScaleBf16, pg8::StaticOrder, true, PG8_SP2_ON>(ldsp, g, So, Ep, tid); }
    PHASE_END

    PHASE_BEGIN
        if (blockIdx.x < 128) {
            const int j = blockIdx.x >> 6, ks = (blockIdx.x >> 4) & 3, pm = blockIdx.x & 15;
            bf16* CAq = CA + (size_t)(j * 4 + ks) * 4096 * 512;
            for (int i0 = tid; i0 < 256 * 64; i0 += 8 * NTHR) {
                u32x4 v[8];
#pragma unroll
                for (int q = 0; q < 8; ++q) { const int i = i0 + q * NTHR;
                    const int d8 = i & 7, l8 = (i >> 3) & 7, r = 256 * pm + (i >> 6);
                    v[q] = (u32x4){0u, 0u, 0u, 0u};
                    if (r < 4080) { const int g = r & 1, bn = r >> 1, b = bn / NCMP, n = bn % NCMP;
                        v[q] = *(const u32x4*)(P + (size_t)(b * S + 16 * n + 8 * ks + l8) * PP + j * 128 + g * 64 + d8 * 8); } }
#pragma unroll
                for (int q = 0; q < 8; ++q) { const int i = i0 + q * NTHR;
                    const int d8 = i & 7, l8 = (i >> 3) & 7, r = 256 * pm + (i >> 6);
                    *(u32x4*)(CAq + (size_t)r * 512 + l8 * 64 + d8 * 8) = v[q]; }
            }
            __syncthreads();
            pg8::Gemm g{CAq, WC1 + (size_t)(j * 4 + ks) * 256 * 512, 4096, 256, 512}; pg8::OneUnit So; So.u.pm = pm; So.u.pn = 0;
            pg8::EpiPartF32 Ep{(float*)(ws + WS_HP) + (size_t)(j * 4 + ks) * 4096 * 256, 256};
            pg8::gemm_phase<pg8::EpiPartF32, pg8::OneUnit, false, PG8_SP2_ON>(ldsp, g, So, Ep, tid);
        } else {
            const int b0 = 128;
            const int gw2 = (blockIdx.x - b0) * (NTHR / 64) + wv, ngw2 = (G - b0) * (NTHR / 64);
            for (int item0 = gw2; item0 < (T / 8) * 4; item0 += 2 * ngw2) {
                u32x4 wq[2];
#pragma unroll
                for (int hh = 0; hh < 2; ++hh) { const int item = item0 + hh * ngw2;
                    if (item < (T / 8) * 4) { const int g = item & 1, br = 1 + ((item >> 1) & 1), row = (item >> 2) * 8 + (lane >> 3), c8 = lane & 7;
                        wq[hh] = *(const u32x4*)(P + (size_t)row * PP + br * 256 + g * 64 + 8 * c8); } }
#pragma unroll
                for (int hh = 0; hh < 2; ++hh) { const int item = item0 + hh * ngw2;
                  if (item < (T / 8) * 4) {
                const int g = item & 1, br = 1 + ((item >> 1) & 1), row = (item >> 2) * 8 + (lane >> 3), c8 = lane & 7;
                const int b = row / S, s = row % S;
                const u32x4 w = wq[hh];
                const float4 ga = *(const float4*)(k_gain_shared + br * 64 + 8 * c8), gb = *(const float4*)(k_gain_shared + br * 64 + 8 * c8 + 4);
                const float4 csa = *(const float4*)(ROPE + s * 16), csb = *(const float4*)(ROPE + s * 16 + 4), sna = *(const float4*)(ROPE + s * 16 + 8), snb = *(const float4*)(ROPE + s * 16 + 12);
                float v[8] = {bflo(w.x), bfhi(w.x), bflo(w.y), bfhi(w.y), bflo(w.z), bfhi(w.z), bflo(w.w), bfhi(w.w)};
                float ss = 0.f;
#pragma unroll
                for (int i = 0; i < 8; ++i) ss += v[i] * v[i];
                ss += sxor<1>(ss); ss += sxor<2>(ss); ss += sxor<4>(ss);
                const float rs = rsqrtf(ss * (1.f / 64.f) + EPS);
                const float gg[8] = {ga.x, ga.y, ga.z, ga.w, gb.x, gb.y, gb.z, gb.w};
                const float cs[8] = {csa.x, csa.y, csa.z, csa.w, csb.x, csb.y, csb.z, csb.w}, sn[8] = {sna.x, sna.y, sna.z, sna.w, snb.x, snb.y, snb.z, snb.w};
#pragma unroll
                for (int i = 0; i < 8; ++i) {
                    v[i] = v[i] * rs * gg[i];
                    const float partner = sxor<1>(v[i]);
                    if (c8 == 0) v[i] = v[i] * cs[i] - partner * sn[i];
                    else if (c8 == 1) v[i] = v[i] * cs[i] + partner * sn[i];
                }
                bf16* dst = (br == 1) ? KS : KW;
                u32x4 o; o.x = pk2(v[0], v[1]); o.y = pk2(v[2], v[3]); o.z = pk2(v[4], v[5]); o.w = pk2(v[6], v[7]);
                *(u32x4*)(dst + ((size_t)(b * 2 + g) * S + s) * 64 + 8 * c8) = o;
                  } }
            }
            {
                bf16* tl = (bf16*)(lds_raw + wv * 9216);
                for (int item = gw2; item < 2 * NB * 2 * 64; item += ngw2) {
                    const int blk = item & 63, g = (item >> 6) & 1, b = (item >> 7) & 7, br = 1 + (item >> 10);
                    const bf16* src = P + ((size_t)b * S + 64 * blk) * PP + br * 256 + 128 + g * 64;
#pragma unroll
                    for (int i = 0; i < 8; ++i) {
                        const int key = 8 * i + (lane >> 3), c8 = lane & 7;
                        const u32x4 v = *(const u32x4*)(src + (size_t)key * PP + 8 * c8);
                        bf16* tp = tl + (8 * c8) * 72 + key;
                        tp[0 * 72] = (bf16)(v.x & 0xffffu); tp[1 * 72] = (bf16)(v.x >> 16); tp[2 * 72] = (bf16)(v.y & 0xffffu); tp[3 * 72] = (bf16)(v.y >> 16);
                        tp[4 * 72] = (bf16)(v.z & 0xffffu); tp[5 * 72] = (bf16)(v.z >> 16); tp[6 * 72] = (bf16)(v.w & 0xffffu); tp[7 * 72] = (bf16)(v.w >> 16);
                    }
                    __builtin_amdgcn_s_waitcnt(0); __builtin_amdgcn_wave_barrier();
                    bf16* dst = ((br == 1) ? VST : VWT) + ((size_t)((b * 2 + g) * 64 + blk)) * 4096;
#pragma unroll
                    for (int jq = 0; jq < 8; ++jq) {
                        const int d = 8 * jq + (lane >> 3), c8 = lane & 7;
                        *(u32x4*)(dst + d * 64 + 8 * c8) = *(const u32x4*)(tl + d * 72 + 8 * c8);
                    }
                    __builtin_amdgcn_s_waitcnt(0); __builtin_amdgcn_wave_barrier();
                }
            }
        }
    PHASE_END

    PHASE_BEGIN
        for (int i = gtid; i < NB * 2 * 64; i += ngt) VC[((size_t)((i >> 6) * 4 + 3)) * 4096 + (i & 63) * 64 + 63] = (bf16)0;
        for (int i0 = tid; i0 < 2 * 256 * 16; i0 += 8 * NTHR) {
            float4 v[8];
#pragma unroll
            for (int q = 0; q < 8; ++q) { const int i = i0 + q * NTHR, n4 = i & 15, cc = (i >> 4) & 255, j = i >> 12;
                v[q] = *(const float4*)(cmp_w2 + ((size_t)j * 256 + cc) * 64 + 4 * n4); }
#pragma unroll
            for (int q = 0; q < 8; ++q) { const int i = i0 + q * NTHR, n4 = i & 15, cc = (i >> 4) & 255, j = i >> 12;
                float* d = smem + ((j * 64 + (cc >> 2)) * 64 + 4 * n4) * 4 + (cc & 3);
                d[0] = v[q].x; d[4] = v[q].y; d[8] = v[q].z; d[12] = v[q].w; }
        }
        __syncthreads();
        for (int item = gw; item < 2 * 4080; item += ngw) {
            const int j = item / 4080, it = item % 4080, g = it & 1, bn = it >> 1, b = bn / NCMP, n = bn % NCMP;
            float* hb = smem + 32768 + wv * 256;
            { const float* hpp = (const float*)(ws + WS_HP) + ((size_t)(j * 4) * 4096 + it) * 256 + 4 * lane;
              const float4 p0 = *(const float4*)hpp, p1 = *(const float4*)(hpp + (size_t)4096 * 256), p2 = *(const float4*)(hpp + (size_t)2 * 4096 * 256), p3 = *(const float4*)(hpp + (size_t)3 * 4096 * 256);
              const float4 bb = *(const float4*)(BIAS2 + j * 256 + 4 * lane);
              __builtin_amdgcn_wave_barrier();
              *(float4*)(hb + 4 * lane) = make_float4(gelu_tanh(((p0.x + p1.x) + (p2.x + p3.x)) + bb.x), gelu_tanh(((p0.y + p1.y) + (p2.y + p3.y)) + bb.y),
                                                      gelu_tanh(((p0.z + p1.z) + (p2.z + p3.z)) + bb.z), gelu_tanh(((p0.w + p1.w) + (p2.w + p3.w)) + bb.w));
              __builtin_amdgcn_wave_barrier(); }
            const float* wj = smem + (size_t)j * 16384 + lane * 4;
            float a0 = 0.f, a1 = 0.f, a2 = 0.f, a3 = 0.f;
#pragma unroll 8
            for (int c4 = 0; c4 < 64; ++c4) { const float4 h4 = *(const float4*)(hb + 4 * c4), w4 = *(const float4*)(wj + c4 * 256);
                a0 = fmaf(h4.x, w4.x, a0); a1 = fmaf(h4.y, w4.y, a1); a2 = fmaf(h4.z, w4.z, a2); a3 = fmaf(h4.w, w4.w, a3); }
            const float acc = (a0 + a1) + (a2 + a3);
            if (j == 0) {
                const float ss = wave_sum(acc * acc);
                float v = acc * rsqrtf(ss * (1.f / 64.f) + EPS) * k_gain_shared[0 * 64 + lane];
                const float partner = sxor<8>(v);
                const int sp = 16 * n + 31;
                if (lane < 16) { const int i = lane & 7; const float cs = ROPE[sp * 16 + i], sn = ROPE[sp * 16 + 8 + i];
                    v = (lane < 8) ? (v * cs - partner * sn) : (v * cs + partner * sn); }
                KC[((size_t)(b * 2 + g) * 256 + n) * 64 + lane] = (bf16)f2bf(v);
            } else {
                VC[((size_t)((b * 2 + g) * 4 + (n >> 6))) * 4096 + lane * 64 + (n & 63)] = (bf16)f2bf(acc);
            }
        }
    PHASE_END

    PHASE_BEGIN
        {
#define UNIF(x) __builtin_bit_cast(float, __builtin_amdgcn_readfirstlane(__builtin_bit_cast(int, (x))))
            const float Gq = wave_max(fabsf(b_q_gain[lane]));
            const float Mc = UNIF(att::SBOUND * Gq * wave_max(fabsf(k_gain_shared[lane]))), Ms = UNIF(att::SBOUND * Gq * wave_max(fabsf(k_gain_shared[64 + lane]))), Mw = UNIF(att::SBOUND * Gq * wave_max(fabsf(k_gain_shared[128 + lane])));
#ifdef PROBE_VAR
            if (rep__ == 0) att::nsa_attention_mfma<true, PROBE_VAR>(P, KC, VC, KS, VST, KW, VWT, ROPE, b_q_gain, b_gate_b, AIN, lds_raw, tid, Mc, Ms, Mw); else
#endif
            if (fmaxf(Mc, fmaxf(Ms, Mw)) <= 40.f) att::nsa_attention_mfma<true>(P, KC, VC, KS, VST, KW, VWT, ROPE, b_q_gain, b_gate_b, AIN, lds_raw, tid, Mc, Ms, Mw);
            else att::nsa_attention_mfma<false>(P, KC, VC, KS, VST, KW, VWT, ROPE, b_q_gain, b_gate_b, AIN, lds_raw, tid, 0.f, 0.f, 0.f);
            const float Mm = UNIF(att::SBOUND * wave_max(fabsf(mem_q_gain[64 + lane])) * wave_max(fabsf(mem_k_gain[64 + lane])));
            SUBREP(5) {
                if (Mm <= 40.f) att::mem_attention_mfma<true>(P, 1572, MEMK + (size_t)NB * 4 * 256 * 64, MEMVT + (size_t)NB * 4 * 256 * 64, mem_q_gain + 64, AIN, lds_raw, tid, Mm);
                else att::mem_attention_mfma<false>(P, 1572, MEMK + (size_t)NB * 4 * 256 * 64, MEMVT + (size_t)NB * 4 * 256 * 64, mem_q_gain + 64, AIN, lds_raw, tid, 0.f);
            }
        }
    PHASE_END

    PHASE_BEGIN
        { pg8::Gemm g{AIN, WOUT + (size_t)D * D, T, D, D}; pg8::StaticOrder So; So.init(T, D, G, (int)blockIdx.x);
          pg8::EpiResidual Ep{XB, sumsq3};
          pg8::gemm_phase<pg8::EpiResidual, pg8::StaticOrder, true, PG8_SP2_ON>(ldsp, g, So, Ep, tid); }
    PHASE_END

    PHASE_BEGIN
        for (int tile = blockIdx.x; tile < (T / 256) * 8; tile += gridDim.x) {
            int pm, pn;
            if ((gridDim.x & 255) == 0) { const int rr = tile / (int)gridDim.x, bb = tile % (int)gridDim.x, xq = bb & 7, sl = bb >> 3, per = (int)gridDim.x >> 6;
                pm = (rr * 8 + xq) * per + (sl >> 3); pn = sl & 7; }
            else { pm = tile >> 3; pn = tile & 7; }
            const int tidt = wave_s__ * 64 + lane_now();
            pg8::Gemm g{XB, WFt + (size_t)2048 * 1024, T, 2048, D}; pg8::OneUnit So; So.u.pm = pm; So.u.pn = pn;
            pg8::EpiTopK Ep{sumsq3, E, Gt};
            pg8::gemm_phase<pg8::EpiTopK, pg8::OneUnit, false, PG8_SP2_ON>(ldsp, g, So, Ep, tidt);
        }
    PHASE_END

    PHASE_BEGIN
        SLICE_COORDS(); peer_u_partial(XB, UT8 + (size_t)16384 * 1024, E, PART, lds_raw + wv * (G_SLOTS * 1024), tid, sl_xs, sl_r, sl_nr);
    PHASE_END
    PHASE_BEGIN
        peer_act(PART, sumsq3, Gt, tid);
    PHASE_END
    PHASE_BEGIN
        SLICE_COORDS(); peer_v_slice(out, XB, VT8 + (size_t)16384 * 1024, E, Gt, nullptr, rep__ == 0, lds_raw + wv * (G_SLOTS * 1024), tid, sl_xs, sl_r, sl_nr);
    PHASE_END
#undef PHASE_BEGIN
#undef PHASE_END
}

#ifndef N_LAUNCH_MODE
#define N_LAUNCH_MODE 1
#endif
template <int PH>
static void launch_phases(const Params& p, int grid, hipStream_t stream) {
    if constexpr (PH < N_PHASES) {
        static bool attr_set = false;
        if (!attr_set) { (void)hipFuncSetAttribute((const void*)fwd_kernel<PH, PH + 1>, hipFuncAttributeMaxDynamicSharedMemorySize, LDS_BYTES); attr_set = true; }
        hipLaunchKernelGGL((fwd_kernel<PH, PH + 1>), dim3(grid), dim3(NTHR), LDS_BYTES, stream, p);
        launch_phases<PH + 1>(p, grid, stream);
    }
}

extern "C" void kernel_launch(void* const* d_in, const int* in_sizes, int n_in, void* d_out, int out_size, void* d_ws, size_t ws_size, hipStream_t stream) {
    static int grid = 0;
    if (grid == 0) {
        if (n_in != 30 || out_size != T * D || ws_size < WS_END) { fprintf(stderr, "kernel_launch: unexpected shapes n_in %d out %d ws %zu\n", n_in, out_size, ws_size); grid = -1; return; }
        int dev = 0, cus = 0, per_cu = 0;
        (void)hipGetDevice(&dev);
        (void)hipDeviceGetAttribute(&cus, hipDeviceAttributeMultiprocessorCount, dev);
#if N_LAUNCH_MODE == 1
        if (hipFuncSetAttribute((const void*)fwd_kernel<0, N_PHASES>, hipFuncAttributeMaxDynamicSharedMemorySize, LDS_BYTES) != hipSuccess) { fprintf(stderr, "kernel_launch: hipFuncSetAttribute failed\n"); grid = -1; return; }
        if (hipOccupancyMaxActiveBlocksPerMultiprocessor(&per_cu, (const void*)fwd_kernel<0, N_PHASES>, NTHR, LDS_BYTES) != hipSuccess || per_cu < 1) { fprintf(stderr, "kernel_launch: occupancy query says %d\n", per_cu); grid = -1; return; }
        if (cus < 160) { fprintf(stderr, "kernel_launch: this kernel needs at least 160 CUs (got %d)\n", cus); grid = -1; return; }
        grid = cus;
#else
        grid = cus > 0 ? cus : 256;
#endif
    }
    if (grid < 0) return;
    Params p{};
    for (int i = 0; i < 30; ++i) p.in[i] = (const float*)d_in[i];
    p.out = (float*)d_out; p.ws = (unsigned char*)d_ws; p.ph_lo = 0; p.ph_hi = N_PHASES;
#if N_LAUNCH_MODE == 1
    if (hipMemsetAsync((char*)d_ws + WS_CTL, 0, 65536, stream) != hipSuccess) { fprintf(stderr, "kernel_launch: hipMemsetAsync failed\n"); return; }
    void* args[] = {&p};
    hipError_t e = hipLaunchCooperativeKernel((const void*)fwd_kernel<0, N_PHASES>, dim3(grid), dim3(NTHR), args, LDS_BYTES, stream);
    if (e != hipSuccess) fprintf(stderr, "cooperative launch failed: %s (grid %d)\n", hipGetErrorString(e), grid);
#else
    launch_phases<0>(p, grid, stream);
#endif
}
```

```cpp
#include <hip/hip_runtime.h>
#include <hip/hip_cooperative_groups.h>
#include <cstdio>
#include <cstdint>
namespace cg = cooperative_groups;

constexpr int NB = 8, S = 4096, D = 1024, T = NB * S;
constexpr int MEMN = 256;
constexpr int LRUW = 768, NBLK = 12;
constexpr int NCMP = 255;
constexpr int PP = 2048;
constexpr int NTHR = 512;
constexpr float EPS = 1e-6f;
constexpr int NCHUNK = 64, CHL = 64;

typedef unsigned short bf16;
typedef unsigned u32x4 __attribute__((ext_vector_type(4)));
typedef unsigned u32x2 __attribute__((ext_vector_type(2)));
typedef __bf16 bf16x2_t __attribute__((ext_vector_type(2)));
typedef __bf16 bf16x8_t __attribute__((ext_vector_type(8)));
#define LAS __attribute__((address_space(3)))

constexpr size_t MiB = 1ull << 20;
constexpr size_t WS_CTL = 0;
constexpr size_t WS_RSTD = 1 * MiB;
constexpr size_t WS_ROPE = 2 * MiB;
constexpr size_t WS_BIAS2 = 2 * MiB + 512 * 1024;
constexpr size_t WS_WGF = 2 * MiB + 768 * 1024;
constexpr size_t WS_SGC = 2 * MiB + 968 * 1024;
constexpr size_t WS_WIN0 = 3 * MiB;
constexpr size_t WS_WOUT = 7 * MiB;
constexpr size_t WS_WF = 11 * MiB;
constexpr size_t WS_WKVB = 19 * MiB;
constexpr size_t WS_WMEM = 23 * MiB;
constexpr size_t WS_WC1 = 25 * MiB;
constexpr size_t WS_MEMB = 27 * MiB;
constexpr size_t WS_MEMKV = 31 * MiB;
constexpr size_t WS_SSQ1 = 35 * MiB;
constexpr size_t WS_SSQ3 = 37 * MiB;
constexpr size_t WS_SCAN = 39 * MiB;
constexpr size_t WS_HID = 42 * MiB;
constexpr size_t WS_KC = 46 * MiB;
constexpr size_t WS_VC = 47 * MiB;
constexpr size_t WS_CA = 48 * MiB;
constexpr size_t WS_E = 80 * MiB;
constexpr size_t WS_GT = 96 * MiB;
constexpr size_t WS_KS = 80 * MiB;
constexpr size_t WS_KW = 88 * MiB;
constexpr size_t WS_VST = 96 * MiB;
constexpr size_t WS_VWT = 104 * MiB;
constexpr size_t WS_XB = 112 * MiB;
constexpr size_t WS_HP = 176 * MiB;
constexpr size_t WS_AIN = 176 * MiB;
constexpr size_t WS_P = 240 * MiB;
constexpr size_t WS_UT = 368 * MiB;
constexpr size_t WS_VT = 400 * MiB;
constexpr size_t WS_SSQ2 = 432 * MiB;
constexpr size_t WS_MEMK = 496 * MiB;
constexpr size_t WS_MEMVT = 498 * MiB;
constexpr size_t WS_END = 500 * MiB;

struct Params {
    const float* in[30];
    float* out;
    unsigned char* ws;
    int ph_lo, ph_hi;
};

__device__ __forceinline__ int lane_now() { int l; asm volatile("v_mbcnt_lo_u32_b32 %0, -1, 0\n\tv_mbcnt_hi_u32_b32 %0, -1, %0" : "=v"(l)); return l; }
template <int M> __device__ __forceinline__ float sxor(float v) {
    if constexpr (M < 32) return __builtin_bit_cast(float, __builtin_amdgcn_ds_swizzle(__builtin_bit_cast(int, v), (M << 10) | 0x1f));
    else { const int l = lane_now();
           return __builtin_bit_cast(float, __builtin_amdgcn_ds_bpermute((l ^ 32) << 2, __builtin_bit_cast(int, v))); }
}
__device__ __forceinline__ float half_sum(float v) { v += sxor<1>(v); v += sxor<2>(v); v += sxor<4>(v); v += sxor<8>(v); v += sxor<16>(v); return v; }
__device__ __forceinline__ float half_max(float v) { v = fmaxf(v, sxor<1>(v)); v = fmaxf(v, sxor<2>(v)); v = fmaxf(v, sxor<4>(v)); v = fmaxf(v, sxor<8>(v)); v = fmaxf(v, sxor<16>(v)); return v; }
__device__ __forceinline__ float wave_sum(float v) { v = half_sum(v); v += sxor<32>(v); return v; }
__device__ __forceinline__ float wave_max(float v) { v = half_max(v); v = fmaxf(v, sxor<32>(v)); return v; }
__device__ __forceinline__ float gelu_tanh(float x) {
    const float c0 = -2.f * 0.7978845608028654f * 1.4426950408889634f, c1 = c0 * 0.044715f;
    const float e = __builtin_amdgcn_exp2f(x * (c0 + c1 * x * x));
    return x * __builtin_amdgcn_rcpf(1.f + e);
}
__device__ __forceinline__ float sigmoidf_(float x) { return __builtin_amdgcn_rcpf(1.f + __builtin_amdgcn_exp2f(x * -1.4426950408889634f)); }
typedef float f32x2_t __attribute__((ext_vector_type(2)));
__device__ __forceinline__ unsigned pk2(float lo, float hi) { const f32x2_t v = {lo, hi}; return __builtin_bit_cast(unsigned, __builtin_convertvector(v, bf16x2_t)); }
__device__ __forceinline__ unsigned f2bf(float f) { return pk2(f, f) & 0xffffu; }
__device__ __forceinline__ float bf2f(unsigned h) { return __builtin_bit_cast(float, h << 16); }
__device__ __forceinline__ float bflo(unsigned w) { return __builtin_bit_cast(float, w << 16); }
__device__ __forceinline__ float bfhi(unsigned w) { return __builtin_bit_cast(float, w & 0xffff0000u); }
__device__ __forceinline__ float ldbf(const bf16* p) { return bf2f((unsigned)*p); }
__device__ __forceinline__ const void* lds_ptr_uniform(const __attribute__((address_space(3))) unsigned char* a) {
    const u32x2 w = *(const __attribute__((address_space(3))) u32x2*)a;
    const unsigned lo = __builtin_amdgcn_readfirstlane(w.x), hi = __builtin_amdgcn_readfirstlane(w.y);
    return (const void*)(((unsigned long long)hi << 32) | lo);
}
__device__ __forceinline__ float rstd_from_parts(const float* ssq16) {
    const float4 a = ((const float4*)ssq16)[0], b = ((const float4*)ssq16)[1], c = ((const float4*)ssq16)[2], d = ((const float4*)ssq16)[3];
    const float s = ((a.x + a.y) + (a.z + a.w)) + ((b.x + b.y) + (b.z + b.w)) + ((c.x + c.y) + (c.z + c.w)) + ((d.x + d.y) + (d.z + d.w));
    return rsqrtf(s * (1.f / 1024.f) + EPS);
}
namespace pg8 {
#define PG8_LAS __attribute__((address_space(3)))
typedef unsigned short bf16_t;
typedef short bf16x8 __attribute__((ext_vector_type(8)));
typedef float f32x4 __attribute__((ext_vector_type(4)));
typedef unsigned u32x4 __attribute__((ext_vector_type(4)));
constexpr int BM = 256, BK = 64, HALF = 128, HTB = HALF * BK * 2  , STAGE_BYTES = 8 * HTB, NXCD = 8, WGM = 8;

__host__ __device__ __forceinline__ int lds_byte(int r, int c) { const int st = (r >> 4) * 2 + (c >> 5), rr = r & 15, cc = c & 31, ob = rr * 64 + cc * 2; return st * 1024 + (ob ^ (((ob >> 9) & 1) << 5)); }
__host__ __device__ __forceinline__ void stage_rc(int b, int& R, int& C) { const int st = b / 1024, sb = b % 1024, swz = sb ^ (((sb >> 9) & 1) << 5); R = (st >> 1) * 16 + swz / 64; C = (st & 1) * 32 + (swz % 64) / 2; }
__host__ __device__ __forceinline__ int perm32(int rho) { const int n = rho >> 4, i = rho & 15; return 8 * (i >> 2) + 4 * n + (i & 3); }

struct Unit { int pm, pn; };
struct Gemm { const bf16_t* A; const bf16_t* Bt; int M, N, K; };

struct StaticOrder {
    int nM, nN, nwg, G, c;
    __host__ __device__ void init(int M, int N, int G_, int c_) { nM = M / BM; nN = N / BM; nwg = nM * nN; G = G_; c = c_; }
    __host__ __device__ bool next(int i, Unit& u) const {
        const long L = (long)i * G + c; if (L >= nwg) return false;
        int wgid = (int)L; { const int q = nwg / NXCD, r = nwg % NXCD, xcd = wgid % NXCD, off = wgid / NXCD; wgid = (xcd < r ? xcd * (q + 1) : r * (q + 1) + (xcd - r) * q) + off; }
        const int nig = WGM * nN, gid = wgid / nig, fm = gid * WGM, gsz = (nM - fm) < WGM ? (nM - fm) : WGM;
        u.pm = fm + ((wgid % nig) % gsz); u.pn = (wgid % nig) / gsz; return true;
    }
    __device__ __forceinline__ void a_ready(const Unit&) const {}
    __device__ __forceinline__ void done(const Unit&) const {}
};

__device__ __forceinline__ unsigned cvt_pk_bf16(float lo, float hi) { return ::pk2(lo, hi); }
typedef float f32x2 __attribute__((ext_vector_type(2)));
template <class Epi, class Sched, bool ALIGN_EPI = false, bool SP2 = false>
__device__ __forceinline__ void gemm_phase(PG8_LAS unsigned char* lds, const Gemm g, const Sched& S, const Epi& E, const int tid) {
    const int wid = __builtin_amdgcn_readfirstlane(tid >> 6), lane = tid & 63, wr = wid >> 2, wc = wid & 3, fr = lane & 15, fq = lane >> 4;
    const int K = g.K, nt = K / BK;
    unsigned voffA[2], voffB[2];
#pragma unroll
    for (int i = 0; i < 2; ++i) { int R, C; stage_rc(tid * 16 + i * 8192, R, C); const int Rb = Epi::PERM ? ((R & ~31) + perm32(R & 31)) : R;
        voffA[i] = (unsigned)(R * K + C) * 2u; voffB[i] = (unsigned)(Rb * K + C) * 2u; }
    const size_t kstep = (size_t)(BK * 2);
    const size_t hstep = (size_t)HALF * K * 2;
    const size_t tstep = 2 * hstep;
    const unsigned ldsw = (unsigned)wid * 1024u;
    const int aoff = lds_byte(wr * 64 + fr, fq * 8), boff = lds_byte(wc * 32 + fr, fq * 8);
#define PG8_SA(b, h) (((b) * 2 + (h)) * HTB)
#define PG8_SB(b, h) ((4 + (b) * 2 + (h)) * HTB)
#define PG8_STAGE(bufoff, gbase, voff) do { _Pragma("unroll") for (int _i = 0; _i < 2; ++_i) \
        __builtin_amdgcn_global_load_lds((const unsigned*)((const char*)(gbase) + (voff)[_i]), (PG8_LAS unsigned*)(lds + (bufoff) + ldsw + _i * 8192), 16, 0, 0); } while (0)
#define PG8_LDA(dst, b, h) do { _Pragma("unroll") for (int m = 0; m < 4; ++m) _Pragma("unroll") for (int k = 0; k < 2; ++k) dst[m][k] = *(const PG8_LAS bf16x8*)(lds + PG8_SA(b, h) + aoff + m * 2048 + k * 1024); } while (0)
#define PG8_LDB(dst, b, h) do { _Pragma("unroll") for (int n = 0; n < 2; ++n) _Pragma("unroll") for (int k = 0; k < 2; ++k) dst[n][k] = *(const PG8_LAS bf16x8*)(lds + PG8_SB(b, h) + boff + n * 2048 + k * 1024); } while (0)
#define PG8_MMA(ai, bj, At, Bt) do { __builtin_amdgcn_s_setprio(1); _Pragma("unroll") for (int m = 0; m < 4; ++m) _Pragma("unroll") for (int n = 0; n < 2; ++n) _Pragma("unroll") for (int k = 0; k < 2; ++k) \
        acc[ai][bj][m][n] = __builtin_amdgcn_mfma_f32_16x16x32_bf16(Bt[n][k], At[m][k], acc[ai][bj][m][n], 0, 0, 0); __builtin_amdgcn_s_setprio(0); } while (0)
#define PG8_WAIT_V(n) asm volatile("s_waitcnt vmcnt(" #n ")" ::: "memory")
#define PG8_WAIT_L(n) asm volatile("s_waitcnt lgkmcnt(" #n ")" ::: "memory")
#define PG8_BAR __builtin_amdgcn_s_barrier()
#define PG8_SCHED __builtin_amdgcn_sched_barrier(0)
    Unit cur, nxt; int ui = 0;
    if (!S.next(0, cur)) return;
    f32x4 acc[2][2][4][2];
#pragma unroll
    for (int a = 0; a < 2; ++a)
#pragma unroll
        for (int b = 0; b < 2; ++b)
#pragma unroll
            for (int m = 0; m < 4; ++m)
#pragma unroll
                for (int n = 0; n < 2; ++n) acc[a][b][m][n] = (f32x4){0.f, 0.f, 0.f, 0.f};
    bf16x8 At[4][2], B0[2][2], B1[2][2];
    const char* cA = (const char*)g.A + (size_t)cur.pm * tstep; const char* cB = (const char*)g.Bt + (size_t)cur.pn * tstep;
    S.a_ready(cur);
    if constexpr (SP2) {
        PG8_STAGE(PG8_SB(0, 0), cB, voffB); PG8_STAGE(PG8_SB(0, 1), cB + hstep, voffB); PG8_STAGE(PG8_SA(0, 0), cA, voffA); PG8_STAGE(PG8_SA(0, 1), cA + hstep, voffA);
        if (wr == 1) PG8_BAR;
        PG8_WAIT_V(2); PG8_BAR;
        PG8_STAGE(PG8_SB(1, 0), cB + kstep, voffB); PG8_STAGE(PG8_SA(1, 0), cA + kstep, voffA); PG8_STAGE(PG8_SB(1, 1), cB + hstep + kstep, voffB);
        PG8_WAIT_V(6); PG8_BAR;
    } else {
        PG8_STAGE(PG8_SB(0, 0), cB, voffB); PG8_STAGE(PG8_SA(0, 0), cA, voffA); PG8_STAGE(PG8_SB(0, 1), cB + hstep, voffB); PG8_STAGE(PG8_SA(0, 1), cA + hstep, voffA);
        if (wr == 1) PG8_BAR;
        PG8_WAIT_V(4); PG8_BAR;
        PG8_STAGE(PG8_SB(1, 0), cB + kstep, voffB); PG8_STAGE(PG8_SA(1, 0), cA + kstep, voffA); PG8_STAGE(PG8_SB(1, 1), cB + hstep + kstep, voffB);
        PG8_WAIT_V(6); PG8_BAR;
    }
    for (;;) {
        const bool has_next = S.next(ui + 1, nxt);
        const char* nA = has_next ? (const char*)g.A + (size_t)nxt.pm * tstep : cA; const char* nB = has_next ? (const char*)g.Bt + (size_t)nxt.pn * tstep : cB;
        for (int t = 0; t < nt; t += 2) {
            const bool last = (t == nt - 2);
            const char* a1 = cA + (size_t)(t + 1) * kstep;
            const char* a2 = last ? nA : cA + (size_t)(t + 2) * kstep; const char* b2 = last ? nB : cB + (size_t)(t + 2) * kstep;
            const char* a3 = a2 + kstep; const char* b3 = b2 + kstep;
            if (last && has_next) S.a_ready(nxt);
            if constexpr (SP2) {
            PG8_LDB(B0, 0, 0); PG8_LDB(B1, 0, 1); PG8_SCHED; PG8_LDA(At, 0, 0); PG8_STAGE(PG8_SA(1, 1), a1 + hstep, voffA);
            PG8_WAIT_V(8); PG8_WAIT_L(0); PG8_BAR; PG8_MMA(0, 0, At, B0); PG8_MMA(0, 1, At, B1); PG8_BAR; PG8_SCHED;
            PG8_LDA(At, 0, 1); PG8_STAGE(PG8_SB(0, 0), b2, voffB); PG8_STAGE(PG8_SB(0, 1), b2 + hstep, voffB); PG8_STAGE(PG8_SA(0, 0), a2, voffA);
            PG8_WAIT_V(8); PG8_WAIT_L(0); PG8_BAR; PG8_MMA(1, 0, At, B0); PG8_MMA(1, 1, At, B1); PG8_BAR; PG8_SCHED;
            PG8_LDB(B0, 1, 0); PG8_LDB(B1, 1, 1); PG8_SCHED; PG8_LDA(At, 1, 0); PG8_STAGE(PG8_SA(0, 1), a2 + hstep, voffA);
            PG8_WAIT_V(8); PG8_WAIT_L(0); PG8_BAR; PG8_MMA(0, 0, At, B0); PG8_MMA(0, 1, At, B1); PG8_BAR; PG8_SCHED;
            PG8_LDA(At, 1, 1); PG8_STAGE(PG8_SB(1, 0), b3, voffB); PG8_STAGE(PG8_SB(1, 1), b3 + hstep, voffB); PG8_STAGE(PG8_SA(1, 0), a3, voffA);
            PG8_WAIT_V(8); PG8_WAIT_L(0); PG8_BAR; PG8_MMA(1, 0, At, B0); PG8_MMA(1, 1, At, B1); PG8_BAR; PG8_SCHED;
            } else {
            PG8_LDB(B0, 0, 0); PG8_SCHED; PG8_LDA(At, 0, 0); PG8_STAGE(PG8_SA(1, 1), a1 + hstep, voffA);
            PG8_WAIT_L(8); PG8_BAR; PG8_WAIT_L(0); PG8_MMA(0, 0, At, B0); PG8_BAR; PG8_SCHED;
            PG8_LDB(B1, 0, 1); PG8_STAGE(PG8_SB(0, 0), b2, voffB);
            PG8_BAR; PG8_WAIT_L(0); PG8_MMA(0, 1, At, B1); PG8_BAR;
            PG8_LDA(At, 0, 1); PG8_STAGE(PG8_SA(0, 0), a2, voffA);
            PG8_BAR; PG8_WAIT_L(0); PG8_MMA(1, 0, At, B0); PG8_BAR; PG8_SCHED;
            PG8_STAGE(PG8_SB(0, 1), b2 + hstep, voffB);
            PG8_WAIT_V(6); PG8_BAR; PG8_MMA(1, 1, At, B1); PG8_BAR;
            PG8_LDB(B0, 1, 0); PG8_SCHED; PG8_LDA(At, 1, 0); PG8_STAGE(PG8_SA(0, 1), a2 + hstep, voffA);
            PG8_WAIT_L(8); PG8_BAR; PG8_WAIT_L(0); PG8_MMA(0, 0, At, B0); PG8_BAR; PG8_SCHED;
            PG8_LDB(B1, 1, 1); PG8_STAGE(PG8_SB(1, 0), b3, voffB);
            PG8_BAR; PG8_WAIT_L(0); PG8_MMA(0, 1, At, B1); PG8_BAR;
            PG8_LDA(At, 1, 1); PG8_STAGE(PG8_SA(1, 0), a3, voffA);
            PG8_BAR; PG8_WAIT_L(0); PG8_MMA(1, 0, At, B0); PG8_BAR; PG8_SCHED;
            PG8_STAGE(PG8_SB(1, 1), b3 + hstep, voffB);
            PG8_WAIT_V(6); PG8_BAR; PG8_MMA(1, 1, At, B1); PG8_BAR;
            }
        }
        if constexpr (ALIGN_EPI) { if (wr == 0) PG8_BAR; }
        if constexpr (!Epi::AFTER_DRAIN) { E(acc, cur, wr, wc, fr, fq); S.done(cur); }
        if (!has_next) break;
#pragma unroll
        for (int a = 0; a < 2; ++a)
#pragma unroll
            for (int b = 0; b < 2; ++b)
#pragma unroll
                for (int m = 0; m < 4; ++m)
#pragma unroll
                    for (int n = 0; n < 2; ++n) acc[a][b][m][n] = (f32x4){0.f, 0.f, 0.f, 0.f};
        cur = nxt; cA = nA; cB = nB; ++ui;
        if constexpr (ALIGN_EPI) { if (wr == 1) PG8_BAR; }
    }
    PG8_WAIT_V(0);
    if constexpr (!ALIGN_EPI) { if (wr == 0) PG8_BAR; }
    PG8_BAR;
    if constexpr (Epi::AFTER_DRAIN) { E.fused(acc, cur, wr, wc, fr, fq, lds, wid, lane); S.done(cur); }
#undef PG8_SA
#undef PG8_SB
#undef PG8_STAGE
#undef PG8_LDA
#undef PG8_LDB
#undef PG8_MMA
#undef PG8_WAIT_V
#undef PG8_WAIT_L
#undef PG8_BAR
#undef PG8_SCHED
}
}

namespace pg8 {
struct OneUnit {
    Unit u;
    __device__ __forceinline__ bool next(int i, Unit& o) const { if (i > 0) return false; o = u; return true; }
    __device__ __forceinline__ void a_ready(const Unit&) const {}
    __device__ __forceinline__ void done(const Unit&) const {}
};
struct EpiRowScaleBf16 {
    static constexpr bool PERM = true, AFTER_DRAIN = false;
    bf16_t* O; int ldc; const float* rs; const float* ssq;
    __device__ __forceinline__ void operator()(const f32x4 (&acc)[2][2][4][2], const Unit& u, int wr, int wc, int fr, int fq) const {
        const int row0 = u.pm * BM + wr * 64 + fr, col0 = u.pn * BM + wc * 32 + 8 * fq;
#pragma unroll
        for (int ai = 0; ai < 2; ++ai)
#pragma unroll
            for (int m = 0; m < 4; ++m) {
                const int row = row0 + ai * HALF + m * 16;
                const float sc = ssq ? rstd_from_parts(ssq + (size_t)row * 16) : (rs ? rs[row] : 1.f);
                bf16_t* rowp = O + (size_t)row * ldc + col0;
#pragma unroll
                for (int bj = 0; bj < 2; ++bj) {
                    const f32x4 v0 = acc[ai][bj][m][0] * sc, v1 = acc[ai][bj][m][1] * sc;
                    u32x4 w; w.x = cvt_pk_bf16(v0[0], v0[1]); w.y = cvt_pk_bf16(v0[2], v0[3]); w.z = cvt_pk_bf16(v1[0], v1[1]); w.w = cvt_pk_bf16(v1[2], v1[3]);
                    *(u32x4*)(rowp + bj * HALF) = w;
                }
            }
    }
};
struct EpiGeluBiasBf16 {
    static constexpr bool PERM = true, AFTER_DRAIN = false;
    bf16_t* O; int ldc; const float* bias;
    __device__ __forceinline__ void operator()(const f32x4 (&acc)[2][2][4][2], const Unit& u, int wr, int wc, int fr, int fq) const {
        const int row0 = u.pm * BM + wr * 64 + fr, col0 = u.pn * BM + wc * 32 + 8 * fq;
#pragma unroll
        for (int bj = 0; bj < 2; ++bj) {
            const f32x4 b0 = *(const f32x4*)(bias + col0 + bj * HALF), b1 = *(const f32x4*)(bias + col0 + bj * HALF + 4);
#pragma unroll
            for (int ai = 0; ai < 2; ++ai)
#pragma unroll
                for (int m = 0; m < 4; ++m) {
                    bf16_t* rowp = O + (size_t)(row0 + ai * HALF + m * 16) * ldc + col0 + bj * HALF;
                    const f32x4 v0 = acc[ai][bj][m][0] + b0, v1 = acc[ai][bj][m][1] + b1;
                    u32x4 w; w.x = cvt_pk_bf16(gelu_tanh(v0[0]), gelu_tanh(v0[1])); w.y = cvt_pk_bf16(gelu_tanh(v0[2]), gelu_tanh(v0[3]));
                    w.z = cvt_pk_bf16(gelu_tanh(v1[0]), gelu_tanh(v1[1])); w.w = cvt_pk_bf16(gelu_tanh(v1[2]), gelu_tanh(v1[3]));
                    *(u32x4*)rowp = w;
                }
        }
    }
};
struct EpiPartF32 {
    static constexpr bool PERM = true, AFTER_DRAIN = false;
    float* O; int ldc;
    __device__ __forceinline__ void operator()(const f32x4 (&acc)[2][2][4][2], const Unit& u, int wr, int wc, int fr, int fq) const {
        const int row0 = u.pm * BM + wr * 64 + fr, col0 = u.pn * BM + wc * 32 + 8 * fq;
#pragma unroll
        for (int bj = 0; bj < 2; ++bj)
#pragma unroll
            for (int ai = 0; ai < 2; ++ai)
#pragma unroll
                for (int m = 0; m < 4; ++m) {
                    float* rowp = O + (size_t)(row0 + ai * HALF + m * 16) * ldc + col0 + bj * HALF;
                    *(f32x4*)rowp = acc[ai][bj][m][0]; *(f32x4*)(rowp + 4) = acc[ai][bj][m][1];
                }
    }
};
struct EpiResidual {
    static constexpr bool PERM = true, AFTER_DRAIN = false;
    bf16_t* xb; float* sumsq;
    __device__ __forceinline__ void operator()(const f32x4 (&acc)[2][2][4][2], const Unit& u, int wr, int wc, int fr, int fq) const {
        const int row0 = u.pm * BM + wr * 64 + fr, col0 = u.pn * BM + wc * 32 + 8 * fq;
#pragma unroll
        for (int ai = 0; ai < 2; ++ai)
#pragma unroll
            for (int m = 0; m < 4; ++m) {
                const int row = row0 + ai * HALF + m * 16;
                float ss = 0.f;
#pragma unroll
                for (int bj = 0; bj < 2; ++bj) {
                    const size_t off = (size_t)row * 1024 + col0 + bj * HALF;
                    const u32x4 r = *(const u32x4*)(xb + off);
                    const f32x4 r0 = {bflo(r.x), bfhi(r.x), bflo(r.y), bfhi(r.y)}, r1 = {bflo(r.z), bfhi(r.z), bflo(r.w), bfhi(r.w)};
                    const f32x4 v0 = acc[ai][bj][m][0] + r0, v1 = acc[ai][bj][m][1] + r1;
                    u32x4 w; w.x = cvt_pk_bf16(v0[0], v0[1]); w.y = cvt_pk_bf16(v0[2], v0[3]); w.z = cvt_pk_bf16(v1[0], v1[1]); w.w = cvt_pk_bf16(v1[2], v1[3]);
                    *(u32x4*)(xb + off) = w;
                    ss += v0[0] * v0[0] + v0[1] * v0[1] + v0[2] * v0[2] + v0[3] * v0[3] + v1[0] * v1[0] + v1[1] * v1[1] + v1[2] * v1[2] + v1[3] * v1[3];
                }
                ss += sxor<16>(ss); ss += sxor<32>(ss);
                if (fq == 0) sumsq[(size_t)row * 16 + u.pn * 4 + wc] = ss;
            }
    }
};

__device__ __forceinline__ float tk_pack(float v, unsigned idx, unsigned mask) {
    unsigned u = __builtin_bit_cast(unsigned, v);
    const unsigned tag = (u >> 31) ? idx : (mask - idx);
    u = (u & ~mask) | tag;
    return __builtin_bit_cast(float, u);
}
__device__ __forceinline__ unsigned tk_tag(float pv, unsigned mask) { const unsigned u = __builtin_bit_cast(unsigned, pv); return (u >> 31) ? (u & mask) : (mask - (u & mask)); }
__device__ __forceinline__ void tk_insert(float (&L)[16], float x) {
#pragma unroll
    for (int i = 0; i < 16; ++i) { const float hi = fmaxf(L[i], x); x = fminf(L[i], x); L[i] = hi; }
}
template <int N> __device__ __forceinline__ void tk_sort_desc(float (&v)[N]) {
#pragma unroll
    for (int k = 2; k <= N; k <<= 1)
#pragma unroll
        for (int j = k >> 1; j > 0; j >>= 1)
#pragma unroll
            for (int i = 0; i < N; ++i) { const int l = i ^ j;
                if (l > i) { const float hi = fmaxf(v[i], v[l]), lo = fminf(v[i], v[l]); const bool desc = ((i & k) == 0); v[i] = desc ? hi : lo; v[l] = desc ? lo : hi; } }
}
__device__ __forceinline__ void tk_clean16(float (&v)[16]) {
#pragma unroll
    for (int j = 8; j > 0; j >>= 1)
#pragma unroll
        for (int i = 0; i < 16; ++i) { const int l = i ^ j; if (l > i) { const float hi = fmaxf(v[i], v[l]), lo = fminf(v[i], v[l]); v[i] = hi; v[l] = lo; } }
}
__device__ __forceinline__ void tk_merge16(float (&a)[16], const float (&b)[16]) {
#pragma unroll
    for (int i = 0; i < 16; ++i) a[i] = fmaxf(a[i], b[15 - i]);
    tk_clean16(a);
}
#define TK_CE(i, j) { const float hi__ = fmaxf(v[i], v[j]), lo__ = fminf(v[i], v[j]); v[i] = hi__; v[j] = lo__; }
__device__ __forceinline__ void tk_sort16_desc(float (&v)[16]) {
    TK_CE(0,13) TK_CE(1,12) TK_CE(2,15) TK_CE(3,14) TK_CE(4,8) TK_CE(5,6) TK_CE(7,11) TK_CE(9,10)
    TK_CE(0,5) TK_CE(1,7) TK_CE(2,9) TK_CE(3,4) TK_CE(6,13) TK_CE(8,14) TK_CE(10,15) TK_CE(11,12)
    TK_CE(0,1) TK_CE(2,3) TK_CE(4,5) TK_CE(6,8) TK_CE(7,9) TK_CE(10,11) TK_CE(12,13) TK_CE(14,15)
    TK_CE(0,2) TK_CE(1,3) TK_CE(4,10) TK_CE(5,11) TK_CE(6,7) TK_CE(8,9) TK_CE(12,14) TK_CE(13,15)
    TK_CE(1,2) TK_CE(3,12) TK_CE(4,6) TK_CE(5,7) TK_CE(8,10) TK_CE(9,11) TK_CE(13,14)
    TK_CE(1,4) TK_CE(2,6) TK_CE(5,8) TK_CE(7,10) TK_CE(9,13) TK_CE(11,14)
    TK_CE(2,4) TK_CE(3,6) TK_CE(9,12) TK_CE(11,13)
    TK_CE(3,5) TK_CE(6,8) TK_CE(7,9) TK_CE(10,12)
    TK_CE(3,4) TK_CE(5,6) TK_CE(7,8) TK_CE(9,10) TK_CE(11,12)
    TK_CE(6,7) TK_CE(8,9)
}
__device__ __forceinline__ void tk_top16_of_64(float (&g0)[16], float (&g1)[16], float (&g2)[16], float (&g3)[16]) {
    tk_sort16_desc(g0); tk_sort16_desc(g1); tk_sort16_desc(g2); tk_sort16_desc(g3);
    tk_merge16(g0, g1); tk_merge16(g2, g3); tk_merge16(g0, g2);
}
struct EpiTopK {
    static constexpr bool PERM = true, AFTER_DRAIN = true;
    static constexpr int SROW = 260, LIST_OFF = 128 * SROW;
    const float* sumsq; int* E; float* Gt;
    __device__ __forceinline__ void fused(const f32x4 (&acc)[2][2][4][2], const Unit& u, int wr, int wc, int fr, int fq, PG8_LAS unsigned char* lds, int wid, int lane) const {
        PG8_LAS float* Sl = (PG8_LAS float*)lds;
        PG8_LAS float* Ls = Sl + LIST_OFF;
        const int tid = wid * 64 + lane;
#pragma unroll 1
        for (int ai = 0; ai < 2; ++ai) {
#pragma unroll
            for (int m = 0; m < 4; ++m) {
                const int rl = wr * 64 + m * 16 + fr;
                const float sc = rstd_from_parts(sumsq + (size_t)(u.pm * BM + ai * HALF + rl) * 16);
#pragma unroll
                for (int bj = 0; bj < 2; ++bj) {
                    PG8_LAS float* sp = Sl + rl * SROW + bj * HALF + wc * 32 + 8 * fq;
                    const f32x4 a0 = ai ? acc[1][bj][m][0] : acc[0][bj][m][0], a1 = ai ? acc[1][bj][m][1] : acc[0][bj][m][1];
                    *(PG8_LAS f32x4*)sp = a0 * sc; *(PG8_LAS f32x4*)(sp + 4) = a1 * sc;
                }
            }
            __syncthreads();
            const int row = tid & 127, p = (tid >> 7) & 1, half = tid >> 8;
            float L[16];
            {
                const PG8_LAS float* sp = Sl + row * SROW + p * 128 + half * 64;
                float G1[16], G2[16], G3[16];
#pragma unroll
                for (int k = 0; k < 4; ++k) {
                    const f32x4 v0 = *(const PG8_LAS f32x4*)(sp + 4 * k), v1 = *(const PG8_LAS f32x4*)(sp + 16 + 4 * k), v2 = *(const PG8_LAS f32x4*)(sp + 32 + 4 * k), v3 = *(const PG8_LAS f32x4*)(sp + 48 + 4 * k);
                    const unsigned base = half * 64 + 4 * k;
#pragma unroll
                    for (int e = 0; e < 4; ++e) { L[4 * k + e] = tk_pack(v0[e], base + e, 127u); G1[4 * k + e] = tk_pack(v1[e], base + 16 + e, 127u);
                        G2[4 * k + e] = tk_pack(v2[e], base + 32 + e, 127u); G3[4 * k + e] = tk_pack(v3[e], base + 48 + e, 127u); }
                }
                tk_top16_of_64(L, G1, G2, G3);
            }
            if (ai == 1) __syncthreads();
            PG8_LAS float* mine = (ai ? Sl : Ls) + (row * 2 + p) * 16;
            if (half == 1) {
#pragma unroll
                for (int i = 0; i < 4; ++i) *(PG8_LAS f32x4*)(mine + 4 * i) = (f32x4){L[4 * i], L[4 * i + 1], L[4 * i + 2], L[4 * i + 3]};
            }
            __syncthreads();
            if (half == 0) {
                f32x4 o[4];
#pragma unroll
                for (int i = 0; i < 4; ++i) o[i] = *(const PG8_LAS f32x4*)(mine + 4 * i);
                float ob[16];
#pragma unroll
                for (int i = 0; i < 4; ++i) { ob[4 * i] = o[i][0]; ob[4 * i + 1] = o[i][1]; ob[4 * i + 2] = o[i][2]; ob[4 * i + 3] = o[i][3]; }
                tk_merge16(L, ob);
#pragma unroll
                for (int i = 0; i < 4; ++i) *(PG8_LAS f32x4*)(mine + 4 * i) = (f32x4){L[4 * i], L[4 * i + 1], L[4 * i + 2], L[4 * i + 3]};
            }
            __syncthreads();
        }
        if (tid < 256) {
            {
                const int ai = tid >> 7, tr = tid & 127;
                const PG8_LAS float* lb = ai ? Sl : Ls;
                const PG8_LAS float* s1 = lb + (tr * 2 + 0) * 16, *s2 = lb + (tr * 2 + 1) * 16;
                float v1[16], v2[16];
#pragma unroll
                for (int i = 0; i < 4; ++i) { const f32x4 a = *(const PG8_LAS f32x4*)(s1 + 4 * i), b = *(const PG8_LAS f32x4*)(s2 + 4 * i);
                    v1[4 * i] = a[0]; v1[4 * i + 1] = a[1]; v1[4 * i + 2] = a[2]; v1[4 * i + 3] = a[3]; v2[4 * i] = b[0]; v2[4 * i + 1] = b[1]; v2[4 * i + 2] = b[2]; v2[4 * i + 3] = b[3]; }
#define TK_CAND(a, b) tk_pack(v1[a] + v2[b], (a) * 16 + (b), 255u)
                float C[16], D1[16], D2[16], D3[16];
#pragma unroll
                for (int i = 0; i < 16; ++i) C[i] = TK_CAND(0, i);
#pragma unroll
                for (int i = 0; i < 8; ++i) { D1[i] = TK_CAND(1, i); D1[8 + i] = TK_CAND(15 - i, 0); }
                D2[0] = TK_CAND(2, 0); D2[1] = TK_CAND(2, 1); D2[2] = TK_CAND(2, 2); D2[3] = TK_CAND(2, 3); D2[4] = TK_CAND(2, 4);
                D2[5] = TK_CAND(3, 0); D2[6] = TK_CAND(3, 1); D2[7] = TK_CAND(3, 2); D2[8] = TK_CAND(3, 3);
                D2[9] = TK_CAND(4, 0); D2[10] = TK_CAND(4, 1); D2[11] = TK_CAND(4, 2);
                D2[12] = TK_CAND(5, 0); D2[13] = TK_CAND(5, 1); D2[14] = -INFINITY; D2[15] = -INFINITY;
                { const float q = TK_CAND(6, 1), r = TK_CAND(7, 0);
                  D3[0] = TK_CAND(6, 0); D3[1] = fmaxf(q, r); D3[2] = fminf(q, r); D3[3] = TK_CAND(7, 1); }
#pragma unroll
                for (int i = 4; i < 16; ++i) D3[i] = -INFINITY;
#undef TK_CAND
                tk_clean16(D1); tk_sort16_desc(D2);
                tk_merge16(C, D1); tk_merge16(D2, D3); tk_merge16(C, D2);
                float sm = 0.f, ex[16];
#pragma unroll
                for (int i = 0; i < 16; ++i) { ex[i] = __expf(C[i] - C[0]); sm += ex[i]; }
                const float inv = 1.f / sm;
                const size_t t = (size_t)u.pm * BM + ai * HALF + tr;
                int* eo = E + t * 128 + u.pn * 16; float* go = Gt + t * 128 + u.pn * 16;
                int ev[16];
#pragma unroll
                for (int i = 0; i < 16; ++i) { const unsigned ci = tk_tag(C[i], 255u); ev[i] = (int)(tk_tag(s1[ci >> 4], 127u) * 128u + tk_tag(s2[ci & 15], 127u)); }
#pragma unroll
                for (int i = 0; i < 4; ++i) { *(int4*)(eo + 4 * i) = make_int4(ev[4 * i], ev[4 * i + 1], ev[4 * i + 2], ev[4 * i + 3]);
                    *(float4*)(go + 4 * i) = make_float4(ex[4 * i] * inv, ex[4 * i + 1] * inv, ex[4 * i + 2] * inv, ex[4 * i + 3] * inv); }
            }
        }
        __syncthreads();
    }
};
}

__device__ __forceinline__ void transpose_item(const float* __restrict__ W, int K, int N, const float* __restrict__ gain, bf16* __restrict__ WT, int row_off, float* scr, int item, int lane) {
    const int nblk = (N + 31) / 32, kb = item / nblk, nb = item % nblk, k0 = 64 * kb, n0 = 32 * nb;
    const int nn = n0 + (lane & 31);
    float tv[32];
#pragma unroll
    for (int i = 0; i < 32; ++i) { const int kk = 2 * i + (lane >> 5);
        float v = 0.f; if (nn < N) { v = W[(size_t)(k0 + kk) * N + nn]; if (gain) v *= gain[k0 + kk]; }
        tv[i] = v; }
#pragma unroll
    for (int i = 0; i < 32; ++i) scr[(2 * i + (lane >> 5)) * 33 + (lane & 31)] = tv[i];
    __builtin_amdgcn_s_waitcnt(0); __builtin_amdgcn_wave_barrier();
    const int c = lane & 7;
#pragma unroll
    for (int j = 0; j < 4; ++j) { const int n = (lane >> 3) + 8 * j; const float* s = scr + (8 * c) * 33 + n;
        if (n0 + n < N) { u32x4 o; o.x = pk2(s[0 * 33], s[1 * 33]); o.y = pk2(s[2 * 33], s[3 * 33]); o.z = pk2(s[4 * 33], s[5 * 33]); o.w = pk2(s[6 * 33], s[7 * 33]);
            *(u32x4*)(WT + (size_t)(row_off + n0 + n) * K + k0 + 8 * c) = o; } }
    __builtin_amdgcn_s_waitcnt(0); __builtin_amdgcn_wave_barrier();
}
__device__ __forceinline__ void rows4_to_bf16(const float* __restrict__ X, bf16* __restrict__ O, float* __restrict__ rstd, int r, int stride, int lane) {
    float4 v[4][4];
#pragma unroll
    for (int q = 0; q < 4; ++q) { const int rr = r + q * stride;
        if (rr < T) { const float4* xr = (const float4*)(X + (size_t)rr * D) + lane;
#pragma unroll
            for (int j = 0; j < 4; ++j) v[q][j] = xr[64 * j]; } }
#pragma unroll
    for (int q = 0; q < 4; ++q) { const int rr = r + q * stride;
        if (rr < T) {
            float s = 0.f;
#pragma unroll
            for (int j = 0; j < 4; ++j) s += v[q][j].x * v[q][j].x + v[q][j].y * v[q][j].y + v[q][j].z * v[q][j].z + v[q][j].w * v[q][j].w;
            s = wave_sum(s);
            if (lane == 0) rstd[rr] = rsqrtf(s * (1.f / D) + EPS);
            u32x2* o8 = (u32x2*)(O + (size_t)rr * D) + lane;
#pragma unroll
            for (int j = 0; j < 4; ++j) { u32x2 w; w.x = pk2(v[q][j].x, v[q][j].y); w.y = pk2(v[q][j].z, v[q][j].w); o8[64 * j] = w; } } }
}
__device__ __forceinline__ void row_to_bf16(const float* __restrict__ xrow, bf16* __restrict__ orow, float* __restrict__ rstd, int lane) {
    const float4* xr = (const float4*)xrow + lane;
    float4 v[4]; float s = 0.f;
#pragma unroll
    for (int j = 0; j < 4; ++j) { v[j] = xr[64 * j]; s += v[j].x * v[j].x + v[j].y * v[j].y + v[j].z * v[j].z + v[j].w * v[j].w; }
    s = wave_sum(s);
    if (lane == 0) *rstd = rsqrtf(s * (1.f / D) + EPS);
    u32x2* o8 = (u32x2*)orow + lane;
#pragma unroll
    for (int j = 0; j < 4; ++j) { u32x2 w; w.x = pk2(v[j].x, v[j].y); w.y = pk2(v[j].z, v[j].w); o8[64 * j] = w; }
}

__device__ __forceinline__ float bperm(int idx4, float v) { return __builtin_bit_cast(float, __builtin_amdgcn_ds_bpermute(idx4, __builtin_bit_cast(int, v))); }
template <bool APPLY>
__device__ __forceinline__ void scan_pass(const bf16* __restrict__ P, const float* __restrict__ conv_w, const float* __restrict__ conv_b, const bf16* __restrict__ WGF,
                                          const float* __restrict__ SGC  , float* __restrict__ AGG, bf16* __restrict__ AIN, unsigned char* ldsw  , int tid) {
    typedef short bf16x8 __attribute__((ext_vector_type(8)));
    typedef float f32x4 __attribute__((ext_vector_type(4)));
    const int lane = tid & 63, gw = blockIdx.x * (NTHR / 64) + (tid >> 6), ngw = gridDim.x * (NTHR / 64);
    const int c16 = lane & 15, g4 = lane >> 4;
    bf16* Xt = (bf16*)ldsw; bf16* Yt = (bf16*)(ldsw + 9648);
    const int up16 = ((lane - 16) & 63) << 2, up32 = ((lane - 32) & 63) << 2, last = (c16 + 48) << 2;
    for (int item = gw; item < NB * NCHUNK * NBLK; item += ngw) {
        const int n = item % NBLK, ci = (item / NBLK) % NCHUNK, b = item / (NBLK * NCHUNK);
        const int s0 = ci * CHL;
        {
            const bf16* xp = P + ((size_t)b * S + s0 - 3) * PP + n * 64;
#pragma unroll
            for (int j = 0; j < 9; ++j) { const int row = 8 * j + (lane >> 3), c8 = lane & 7;
                if (row < 67) { u32x4 v = (u32x4){0u, 0u, 0u, 0u}; if (s0 + row >= 3) v = *(const u32x4*)(xp + (size_t)row * PP + 8 * c8); *(u32x4*)(Xt + row * 72 + 8 * c8) = v; } }
            if (APPLY) {
                const bf16* yp = P + ((size_t)b * S + s0) * PP + 768 + n * 64;
#pragma unroll
                for (int j = 0; j < 8; ++j) { const int row = 8 * j + (lane >> 3), c8 = lane & 7; *(u32x4*)(Yt + row * 72 + 8 * c8) = *(const u32x4*)(yp + (size_t)row * PP + 8 * c8); }
            }
            const int c = n * 64 + lane;
            const float cw0 = conv_w[0 * LRUW + c], cw1 = conv_w[1 * LRUW + c], cw2 = conv_w[2 * LRUW + c], cw3 = conv_w[3 * LRUW + c], cb = conv_b[c];
            __builtin_amdgcn_s_waitcnt(0); __builtin_amdgcn_wave_barrier();
            float xin[CHL + 3];
#pragma unroll
            for (int i = 0; i < CHL + 3; ++i) xin[i] = ldbf(Xt + i * 72 + lane);
            __builtin_amdgcn_wave_barrier();
#pragma unroll
            for (int tt = 0; tt < CHL; tt += 2) {
                const float o0 = cb + cw0 * xin[tt] + cw1 * xin[tt + 1] + cw2 * xin[tt + 2] + cw3 * xin[tt + 3];
                const float o1 = cb + cw0 * xin[tt + 1] + cw1 * xin[tt + 2] + cw2 * xin[tt + 3] + cw3 * xin[tt + 4];
                const unsigned w = pk2(o0, o1);
                Xt[tt * 72 + lane] = (bf16)(w & 0xffffu); Xt[(tt + 1) * 72 + lane] = (bf16)(w >> 16);
            }
        }
        bf16x8 bfr[2][8];
#pragma unroll
        for (int ks = 0; ks < 2; ++ks)
#pragma unroll
            for (int ct = 0; ct < 8; ++ct) bfr[ks][ct] = *(const bf16x8*)(WGF + ((size_t)((n * 2 + ks) * 8 + ct) * 64 + lane) * 8);
        float brr[4], bii[4], sp8[4];
#pragma unroll
        for (int ch = 0; ch < 4; ++ch) { const int c = n * 64 + 16 * ch + c16; brr[ch] = SGC[c]; bii[ch] = SGC[LRUW + c]; sp8[ch] = SGC[2 * LRUW + c]; }
        float hA[4], hH[4];
#pragma unroll
        for (int ch = 0; ch < 4; ++ch) { hA[ch] = 1.f; hH[ch] = 0.f; }
        if (APPLY) {
            const int q0 = (ci * g4) >> 2, q1 = (ci * (g4 + 1)) >> 2;
#pragma unroll
            for (int ch = 0; ch < 4; ++ch) {
                const float* ap = AGG + (((size_t)b * NCHUNK) * LRUW + n * 64 + 16 * ch + c16) * 2;
                float A = 1.f, H = 0.f;
                for (int k = q0; k < q1; ++k) { const float2 ah = *(const float2*)(ap + (size_t)k * LRUW * 2); H = ah.x * H + ah.y; A *= ah.x; }
                float Ap = bperm(up16, A), Hp = bperm(up16, H);
                if (g4 >= 1) { H = A * Hp + H; A *= Ap; }
                Ap = bperm(up32, A); Hp = bperm(up32, H);
                if (g4 >= 2) { H = A * Hp + H; A *= Ap; }
                hH[ch] = bperm(last, H);
            }
        }
        __builtin_amdgcn_s_waitcnt(0); __builtin_amdgcn_wave_barrier();
#pragma unroll 1
        for (int tt4 = 0; tt4 < 4; ++tt4) {
            const bf16x8 a0 = *(const bf16x8*)(Xt + (16 * tt4 + c16) * 72 + 8 * g4), a1 = *(const bf16x8*)(Xt + (16 * tt4 + c16) * 72 + 32 + 8 * g4);
            f32x4 acc[8];
#pragma unroll
            for (int ct = 0; ct < 8; ++ct) { f32x4 z = {0.f, 0.f, 0.f, 0.f};
                z = __builtin_amdgcn_mfma_f32_16x16x32_bf16(a0, bfr[0][ct], z, 0, 0, 0);
                acc[ct] = __builtin_amdgcn_mfma_f32_16x16x32_bf16(a1, bfr[1][ct], z, 0, 0, 0); }
#pragma unroll
            for (int ch = 0; ch < 4; ++ch) {
                const int cidx = 16 * ch + c16;
                float av[4], uv[4], A = 1.f, H = 0.f;
#pragma unroll
                for (int jj = 0; jj < 4; ++jj) {
                    const int tt = 16 * tt4 + 4 * g4 + jj;
                    const float rg = __builtin_amdgcn_rcpf(1.f + __builtin_amdgcn_exp2f(acc[ch][jj] + brr[ch])), ig = __builtin_amdgcn_rcpf(1.f + __builtin_amdgcn_exp2f(acc[4 + ch][jj] + bii[ch]));
                    const float a = __builtin_amdgcn_exp2f(sp8[ch] * rg);
                    const float mult = __builtin_amdgcn_sqrtf(fmaxf(1.f - a * a, 0.f));
                    const float u = mult * (ig * ldbf(Xt + tt * 72 + cidx));
                    av[jj] = a; uv[jj] = u; H = a * H + u; A *= a;
                }
                float Ap = bperm(up16, A), Hp = bperm(up16, H);
                if (g4 >= 1) { H = A * Hp + H; A *= Ap; }
                Ap = bperm(up32, A); Hp = bperm(up32, H);
                if (g4 >= 2) { H = A * Hp + H; A *= Ap; }
                const float AT = bperm(last, A), HT = bperm(last, H);
                if (APPLY) {
                    float AE = bperm(up16, A), HE = bperm(up16, H);
                    if (g4 == 0) { AE = 1.f; HE = 0.f; }
                    float h = AE * hH[ch] + HE;
#pragma unroll
                    for (int jj = 0; jj < 4; ++jj) {
                        const int tt = 16 * tt4 + 4 * g4 + jj;
                        h = av[jj] * h + uv[jj];
                        Xt[tt * 72 + cidx] = (bf16)f2bf(h * gelu_tanh(ldbf(Yt + tt * 72 + cidx)));
                    }
                    hH[ch] = AT * hH[ch] + HT;
                } else { hH[ch] = AT * hH[ch] + HT; hA[ch] *= AT; }
            }
        }
        if (APPLY) {
            __builtin_amdgcn_s_waitcnt(0); __builtin_amdgcn_wave_barrier();
            bf16* op = AIN + ((size_t)b * S + s0) * D + n * 64;
#pragma unroll
            for (int j = 0; j < 8; ++j) { const int row = 8 * j + (lane >> 3), c8 = lane & 7; *(u32x4*)(op + (size_t)row * D + 8 * c8) = *(const u32x4*)(Xt + row * 72 + 8 * c8); }
        } else if (g4 == 0) {
#pragma unroll
            for (int ch = 0; ch < 4; ++ch) *(float2*)(AGG + (((size_t)b * NCHUNK + ci) * LRUW + n * 64 + 16 * ch + c16) * 2) = make_float2(hA[ch], hH[ch]);
        }
        __builtin_amdgcn_s_waitcnt(0); __builtin_amdgcn_wave_barrier();
    }
}

__device__ __forceinline__ void peer_gather(float* __restrict__ out, bf16* __restrict__ XB, const float* __restrict__ sumsq, const bf16* __restrict__ UT, const bf16* __restrict__ VT,
                                            const int* __restrict__ E, const float* __restrict__ Gt, float* __restrict__ rstd_next, float* actbuf  , bool dry, int tid) {
    const int lane = tid & 63, gw = blockIdx.x * (NTHR / 64) + (tid >> 6), ngw = gridDim.x * (NTHR / 64);
    const int g4 = lane >> 4, li = lane & 15;
    for (int t = gw; t < T; t += ngw) {
        const float rs = rstd_from_parts(sumsq + (size_t)t * 16);
        bf16x8_t hx[8];
#pragma unroll
        for (int j = 0; j < 8; ++j) hx[j] = __builtin_nontemporal_load((const bf16x8_t*)(XB + (size_t)t * D + li * 8 + 128 * j));
        const int* ep = E + (size_t)t * 128; const float* gp = Gt + (size_t)t * 128;
#pragma unroll 2
        for (int step = 0; step < 32; ++step) {
            const int e = ep[4 * step + g4];
            const bf16* up = UT + (size_t)e * D + li * 8;
            bf16x8_t u[8];
#pragma unroll
            for (int j = 0; j < 8; ++j) u[j] = *(const bf16x8_t*)(up + 128 * j);
            float d = 0.f;
#pragma unroll
            for (int j = 0; j < 8; ++j) {
                d = __builtin_amdgcn_fdot2_f32_bf16(__builtin_shufflevector(u[j], u[j], 0, 1), __builtin_shufflevector(hx[j], hx[j], 0, 1), d, false);
                d = __builtin_amdgcn_fdot2_f32_bf16(__builtin_shufflevector(u[j], u[j], 2, 3), __builtin_shufflevector(hx[j], hx[j], 2, 3), d, false);
                d = __builtin_amdgcn_fdot2_f32_bf16(__builtin_shufflevector(u[j], u[j], 4, 5), __builtin_shufflevector(hx[j], hx[j], 4, 5), d, false);
                d = __builtin_amdgcn_fdot2_f32_bf16(__builtin_shufflevector(u[j], u[j], 6, 7), __builtin_shufflevector(hx[j], hx[j], 6, 7), d, false);
            }
            d += sxor<1>(d); d += sxor<2>(d); d += sxor<4>(d); d += sxor<8>(d);
            const float a = gelu_tanh(d * rs) * gp[4 * step + g4];
            if (li == 0) actbuf[4 * step + g4] = a;
        }
        __builtin_amdgcn_s_waitcnt(0); __builtin_amdgcn_wave_barrier();
        float acc[16];
#pragma unroll
        for (int i = 0; i < 16; ++i) acc[i] = 0.f;
        const int e_lo = ep[lane], e_hi = ep[64 + lane];
#pragma unroll 4
        for (int idx = 0; idx < 128; ++idx) {
            const int e = __builtin_amdgcn_readlane(idx < 64 ? e_lo : e_hi, idx & 63);
            const bf16* vp = VT + (size_t)e * D + lane * 8;
            const u32x4 va = *(const u32x4*)vp, vb = *(const u32x4*)(vp + 512);
            const float a = actbuf[idx];
            acc[0] += a * bflo(va.x); acc[1] += a * bfhi(va.x); acc[2] += a * bflo(va.y); acc[3] += a * bfhi(va.y);
            acc[4] += a * bflo(va.z); acc[5] += a * bfhi(va.z); acc[6] += a * bflo(va.w); acc[7] += a * bfhi(va.w);
            acc[8] += a * bflo(vb.x); acc[9] += a * bfhi(vb.x); acc[10] += a * bflo(vb.y); acc[11] += a * bfhi(vb.y);
            acc[12] += a * bflo(vb.z); acc[13] += a * bfhi(vb.z); acc[14] += a * bflo(vb.w); acc[15] += a * bfhi(vb.w);
        }
        float ss = 0.f;
#pragma unroll
        for (int hf = 0; hf < 2; ++hf) {
            float* op = out + (size_t)t * D + hf * 512 + lane * 8;
            const pg8::f32x4 x0v = __builtin_nontemporal_load((const pg8::f32x4*)op), x1v = __builtin_nontemporal_load((const pg8::f32x4*)(op + 4));
            const float4 x0 = make_float4(x0v[0], x0v[1], x0v[2], x0v[3]), x1 = make_float4(x1v[0], x1v[1], x1v[2], x1v[3]);
            float4 r0 = make_float4(x0.x + acc[8 * hf + 0], x0.y + acc[8 * hf + 1], x0.z + acc[8 * hf + 2], x0.w + acc[8 * hf + 3]);
            float4 r1 = make_float4(x1.x + acc[8 * hf + 4], x1.y + acc[8 * hf + 5], x1.z + acc[8 * hf + 6], x1.w + acc[8 * hf + 7]);
            if (dry) { r0 = x0; r1 = x1; }
            __builtin_nontemporal_store((pg8::f32x4){r0.x, r0.y, r0.z, r0.w}, (pg8::f32x4*)op); __builtin_nontemporal_store((pg8::f32x4){r1.x, r1.y, r1.z, r1.w}, (pg8::f32x4*)(op + 4));
            u32x4 w; w.x = pk2(r0.x, r0.y); w.y = pk2(r0.z, r0.w); w.z = pk2(r1.x, r1.y); w.w = pk2(r1.z, r1.w);
            __builtin_nontemporal_store(w, (u32x4*)(XB + (size_t)t * D + hf * 512 + lane * 8));
            ss += r0.x * r0.x + r0.y * r0.y + r0.z * r0.z + r0.w * r0.w + r1.x * r1.x + r1.y * r1.y + r1.z * r1.z + r1.w * r1.w;
        }
        ss = wave_sum(ss);
        if (lane == 0 && rstd_next) rstd_next[t] = rsqrtf(ss * (1.f / D) + EPS);
        __builtin_amdgcn_s_waitcnt(0); __builtin_amdgcn_wave_barrier();
    }
}


typedef float f32x2_t __attribute__((ext_vector_type(2)));
__device__ __forceinline__ void fp8x16_to_f32(const u32x4 w, float (&f)[16]) {
    const unsigned ww[4] = {w.x, w.y, w.z, w.w};
#pragma unroll
    for (int q = 0; q < 4; ++q) { const f32x2_t lo = __builtin_amdgcn_cvt_pk_f32_fp8((int)ww[q], false), hi = __builtin_amdgcn_cvt_pk_f32_fp8((int)ww[q], true);
        f[4 * q] = lo[0]; f[4 * q + 1] = lo[1]; f[4 * q + 2] = hi[0]; f[4 * q + 3] = hi[1]; }
}
__device__ __forceinline__ void g1_ev(int (&ev)[16], const int* __restrict__ E, int t, int rg) {
    const int4* ep = (const int4*)(E + (size_t)t * 128 + 16 * rg);
#pragma unroll
    for (int q = 0; q < 4; ++q) { const int4 v = ep[q]; ev[4 * q] = v.x; ev[4 * q + 1] = v.y; ev[4 * q + 2] = v.z; ev[4 * q + 3] = v.w; }
}
template <int H> __device__ __forceinline__ void rows8(u32x4 (&w)[8], const int (&ev)[16], const unsigned char* __restrict__ T8, int col0) {
#pragma unroll
    for (int i = 0; i < 8; ++i) w[i] = *(const u32x4*)(T8 + (size_t)ev[8 * H + i] * 1024 + col0);
}
__device__ __forceinline__ float g1_math8(const u32x4 (&w)[8], const f32x2_t (&xf)[8], int cl) {
    float d[8];
#pragma unroll
    for (int i = 0; i < 8; ++i) {
        const unsigned ww[4] = {w[i].x, w[i].y, w[i].z, w[i].w};
        f32x2_t d2 = {0.f, 0.f};
#pragma unroll
        for (int q = 0; q < 4; ++q) { const f32x2_t lo = __builtin_amdgcn_cvt_pk_f32_fp8((int)ww[q], false), hi = __builtin_amdgcn_cvt_pk_f32_fp8((int)ww[q], true);
            d2 = lo * xf[2 * q] + d2; d2 = hi * xf[2 * q + 1] + d2; }
        d[i] = d2[0] + d2[1];
        if ((i & 1) == 1) __builtin_amdgcn_sched_barrier(0);
    }
    const bool b4 = cl & 4, b2 = cl & 2, b1 = cl & 1;
    float e[4];
#pragma unroll
    for (int k = 0; k < 4; ++k) { const float keep = b4 ? d[k + 4] : d[k], send = b4 ? d[k] : d[k + 4]; e[k] = keep + sxor<4>(send); }
    float f[2];
#pragma unroll
    for (int k = 0; k < 2; ++k) { const float keep = b2 ? e[k + 2] : e[k], send = b2 ? e[k] : e[k + 2]; f[k] = keep + sxor<2>(send); }
    const float keep = b1 ? f[1] : f[0], send = b1 ? f[0] : f[1];
    return keep + sxor<1>(send);
}
__device__ __forceinline__ void unpack_x(f32x2_t (&xf)[8], const u32x4 xa, const u32x4 xb2) {
    xf[0] = (f32x2_t){bflo(xa.x), bfhi(xa.x)}; xf[1] = (f32x2_t){bflo(xa.y), bfhi(xa.y)}; xf[2] = (f32x2_t){bflo(xa.z), bfhi(xa.z)}; xf[3] = (f32x2_t){bflo(xa.w), bfhi(xa.w)};
    xf[4] = (f32x2_t){bflo(xb2.x), bfhi(xb2.x)}; xf[5] = (f32x2_t){bflo(xb2.y), bfhi(xb2.y)}; xf[6] = (f32x2_t){bflo(xb2.z), bfhi(xb2.z)}; xf[7] = (f32x2_t){bflo(xb2.w), bfhi(xb2.w)};
}
constexpr int G_SLOTS = 8, G_NPRE = 5;
__device__ __forceinline__ void g_dma(const void* gsrc, unsigned char* slot) {
    __builtin_amdgcn_global_load_lds((const __attribute__((address_space(1))) unsigned*)gsrc, (__attribute__((address_space(3))) unsigned*)slot, 16, 0, 0);
}
__device__ __forceinline__ void lds_ev(int (&ev)[16], const unsigned char* slot, int rg) {
#pragma unroll
    for (int q = 0; q < 4; ++q) { const int4 v = *(const int4*)(slot + rg * 64 + 16 * q); ev[4 * q] = v.x; ev[4 * q + 1] = v.y; ev[4 * q + 2] = v.z; ev[4 * q + 3] = v.w; }
}
template <int N> __device__ __forceinline__ void rowsN(u32x4 (&w)[N], const int (&ev)[16], int off, const unsigned char* __restrict__ T8, int col0) {
#pragma unroll
    for (int i = 0; i < N; ++i) w[i] = *(const u32x4*)(T8 + (size_t)ev[off + i] * 128 + col0);
}
#define G_WAIT_IDS() asm volatile("s_waitcnt vmcnt(30)" ::: "memory")
__device__ __forceinline__ void peer_u_partial(const bf16* __restrict__ XB, const unsigned char* __restrict__ UT8, const int* __restrict__ E, float* __restrict__ PART, unsigned char* ring, int tid,
                                               const int xs, const int r, const int nr) {
    const int lane = tid & 63, wv = tid >> 6, rg = lane >> 3, cl = lane & 7;
    const int col0 = xs * (16384 * 128) + 16 * cl, step = nr * 8;
    float* pb = PART + (size_t)xs * T * 128 + 16 * rg + cl;
    const int t0 = r * 8 + wv;
    const int ntok = (t0 < T) ? (T - 1 - t0) / step + 1 : 0;
    if (ntok == 0) return;
    const size_t src_lane_off = (lane < 32) ? (size_t)lane * 16 : (size_t)((lane & 15) * 16);
    auto dma = [&](int k) { const int t = t0 + k * step;
        const unsigned char* src = (lane < 32) ? (const unsigned char*)(E + (size_t)t * 128) : (const unsigned char*)(XB + (size_t)t * D + 128 * xs);
        g_dma(src + src_lane_off, ring + (k & (G_SLOTS - 1)) * 1024); };
#pragma unroll 1
    for (int k = 0; k < G_NPRE && k < ntok; ++k) dma(k);
    asm volatile("s_waitcnt vmcnt(0)" ::: "memory");
    int ev[16]; u32x4 wA[16], wB[16];
    lds_ev(ev, ring, rg); rowsN<16>(wA, ev, 0, UT8, col0);
#pragma unroll 1
    for (int k = 0; k < ntok; k += 2) {
        if (k + G_NPRE < ntok) dma(k + G_NPRE);
        if (k + 1 < ntok) { G_WAIT_IDS(); lds_ev(ev, ring + ((k + 1) & (G_SLOTS - 1)) * 1024, rg); rowsN<16>(wB, ev, 0, UT8, col0); }
        {
            const unsigned char* slot = ring + (k & (G_SLOTS - 1)) * 1024;
            const u32x4 xa = *(const u32x4*)(slot + 512 + cl * 32), xb2 = *(const u32x4*)(slot + 512 + cl * 32 + 16);
            f32x2_t xf[8]; unpack_x(xf, xa, xb2);
            const float res0 = g1_math8(*(const u32x4(*)[8])&wA[0], xf, cl), res1 = g1_math8(*(const u32x4(*)[8])&wA[8], xf, cl);
            float* po = pb + (size_t)(t0 + k * step) * 128; po[0] = res0; po[8] = res1;
        }
        if (k + 1 >= ntok) break;
        if (k + 1 + G_NPRE < ntok) dma(k + 1 + G_NPRE);
        if (k + 2 < ntok) { G_WAIT_IDS(); lds_ev(ev, ring + ((k + 2) & (G_SLOTS - 1)) * 1024, rg); rowsN<16>(wA, ev, 0, UT8, col0); }
        {
            const unsigned char* slot = ring + ((k + 1) & (G_SLOTS - 1)) * 1024;
            const u32x4 xa = *(const u32x4*)(slot + 512 + cl * 32), xb2 = *(const u32x4*)(slot + 512 + cl * 32 + 16);
            f32x2_t xf[8]; unpack_x(xf, xa, xb2);
            const float res0 = g1_math8(*(const u32x4(*)[8])&wB[0], xf, cl), res1 = g1_math8(*(const u32x4(*)[8])&wB[8], xf, cl);
            float* po = pb + (size_t)(t0 + (k + 1) * step) * 128; po[0] = res0; po[8] = res1;
        }
    }
    asm volatile("s_waitcnt vmcnt(0)" ::: "memory");
}
__device__ __forceinline__ void peer_act(const float* __restrict__ PART, const float* __restrict__ ssq, float* __restrict__ Gt, int tid) {
    const int lane = tid & 63, gw = blockIdx.x * (NTHR / 64) + (tid >> 6), ngw = gridDim.x * (NTHR / 64);
    for (int t = gw; t < T; t += ngw) {
        const float rs = rstd_from_parts(ssq + (size_t)t * 16) * (1.f / 64.f);
        float d0 = 0.f, d1 = 0.f;
#pragma unroll
        for (int s = 0; s < 8; ++s) { const float2 v = *(const float2*)(PART + ((size_t)s * T + t) * 128 + 2 * lane); d0 += v.x; d1 += v.y; }
        float2* gp = (float2*)(Gt + (size_t)t * 128 + 2 * lane);
        const float2 g = *gp;
        *gp = make_float2(gelu_tanh(d0 * rs) * g.x, gelu_tanh(d1 * rs) * g.y);
    }
}
__device__ __forceinline__ void g3_act(float (&av)[16], const float* __restrict__ ACT, int t, int rg) {
    const float4* ap = (const float4*)(ACT + (size_t)t * 128 + 16 * rg);
#pragma unroll
    for (int q = 0; q < 4; ++q) { const float4 a = ap[q]; av[4 * q] = a.x; av[4 * q + 1] = a.y; av[4 * q + 2] = a.z; av[4 * q + 3] = a.w; }
}
template <int H> __device__ __forceinline__ void g3_math8(const u32x4 (&w)[8], const float (&av)[16], f32x2_t (&acc)[8]) {
#pragma unroll
    for (int i = 0; i < 8; ++i) {
        const unsigned ww[4] = {w[i].x, w[i].y, w[i].z, w[i].w};
        const f32x2_t a2 = {av[8 * H + i], av[8 * H + i]};
#pragma unroll
        for (int q = 0; q < 4; ++q) { const f32x2_t lo = __builtin_amdgcn_cvt_pk_f32_fp8((int)ww[q], false), hi = __builtin_amdgcn_cvt_pk_f32_fp8((int)ww[q], true);
            acc[2 * q] = lo * a2 + acc[2 * q]; acc[2 * q + 1] = hi * a2 + acc[2 * q + 1]; }
        __builtin_amdgcn_sched_barrier(0);
    }
}
__device__ __forceinline__ void g3_finish(const f32x2_t (&acc)[8], float* __restrict__ out, bf16* __restrict__ XB, float* __restrict__ ssq_next, bool dry, int t, int xs, int rg, int cl, int lane) {
    const bool b4 = rg & 4, b2 = rg & 2, b1 = rg & 1;
    f32x2_t e[4];
#pragma unroll
    for (int k = 0; k < 4; ++k) { const f32x2_t keep = b4 ? acc[k + 4] : acc[k], send = b4 ? acc[k] : acc[k + 4];
        e[k] = (f32x2_t){keep[0] + sxor<32>(send[0]), keep[1] + sxor<32>(send[1])}; }
    f32x2_t f[2];
#pragma unroll
    for (int k = 0; k < 2; ++k) { const f32x2_t keep = b2 ? e[k + 2] : e[k], send = b2 ? e[k] : e[k + 2];
        f[k] = (f32x2_t){keep[0] + sxor<16>(send[0]), keep[1] + sxor<16>(send[1])}; }
    const f32x2_t keep = b1 ? f[1] : f[0], send = b1 ? f[0] : f[1];
    const float a0 = keep[0] + sxor<8>(send[0]), a1 = keep[1] + sxor<8>(send[1]);
    const int col = 128 * xs + 16 * cl + 2 * rg;
    unsigned* xp = (unsigned*)(XB + (size_t)t * D + col);
    const unsigned xw = *xp;
    const float2 x0 = make_float2(bflo(xw), bfhi(xw));
    float2 r0 = make_float2(x0.x + 0.125f * a0, x0.y + 0.125f * a1);
    if (dry) r0 = x0;
    if (out) *(float2*)(out + (size_t)t * D + col) = r0;
    else *xp = pk2(r0.x, r0.y);
    if (ssq_next) {
        const float ss = wave_sum(r0.x * r0.x + r0.y * r0.y);
        if (lane < 2) ssq_next[(size_t)t * 16 + 8 * lane + xs] = lane ? 0.f : ss;
    }
}
__device__ __forceinline__ void lds_av(float (&av)[16], const unsigned char* slot, int rg) {
#pragma unroll
    for (int q = 0; q < 4; ++q) { const float4 a = *(const float4*)(slot + 512 + rg * 64 + 16 * q); av[4 * q] = a.x; av[4 * q + 1] = a.y; av[4 * q + 2] = a.z; av[4 * q + 3] = a.w; }
}
__device__ __forceinline__ void peer_v_slice(float* __restrict__ out, bf16* __restrict__ XB, const unsigned char* __restrict__ VT8, const int* __restrict__ E, const float* __restrict__ ACT,
                                             float* __restrict__ ssq_next, bool dry, unsigned char* ring, int tid, const int xs, const int r, const int nr) {
    const int lane = tid & 63, wv = tid >> 6, rg = lane >> 3, cl = lane & 7;
    const int col0 = xs * (16384 * 128) + 16 * cl, step = nr * 8;
    const int t0 = r * 8 + wv;
    const int ntok = (t0 < T) ? (T - 1 - t0) / step + 1 : 0;
    if (ntok == 0) return;
    const size_t src_lane_off = (size_t)(lane & 31) * 16;
    auto dma = [&](int k) { const int t = t0 + k * step;
        const unsigned char* src = (lane < 32) ? (const unsigned char*)(E + (size_t)t * 128) : (const unsigned char*)(ACT + (size_t)t * 128);
        g_dma(src + src_lane_off, ring + (k & (G_SLOTS - 1)) * 1024); };
#pragma unroll 1
    for (int k = 0; k < G_NPRE && k < ntok; ++k) dma(k);
    asm volatile("s_waitcnt vmcnt(0)" ::: "memory");
    int ev[16]; u32x4 wA[16], wB[16];
    lds_ev(ev, ring, rg); rowsN<16>(wA, ev, 0, VT8, col0);
#pragma unroll 1
    for (int k = 0; k < ntok; k += 2) {
        if (k + G_NPRE < ntok) dma(k + G_NPRE);
        if (k + 1 < ntok) { G_WAIT_IDS(); lds_ev(ev, ring + ((k + 1) & (G_SLOTS - 1)) * 1024, rg); rowsN<16>(wB, ev, 0, VT8, col0); }
        {
            float av[16]; lds_av(av, ring + (k & (G_SLOTS - 1)) * 1024, rg);
            f32x2_t acc[8];
#pragma unroll
            for (int j = 0; j < 8; ++j) acc[j] = (f32x2_t){0.f, 0.f};
            g3_math8<0>(*(const u32x4(*)[8])&wA[0], av, acc); g3_math8<1>(*(const u32x4(*)[8])&wA[8], av, acc);
            g3_finish(acc, out, XB, ssq_next, dry, t0 + k * step, xs, rg, cl, lane);
        }
        if (k + 1 >= ntok) break;
        if (k + 1 + G_NPRE < ntok) dma(k + 1 + G_NPRE);
        if (k + 2 < ntok) { G_WAIT_IDS(); lds_ev(ev, ring + ((k + 2) & (G_SLOTS - 1)) * 1024, rg); rowsN<16>(wA, ev, 0, VT8, col0); }
        {
            float av[16]; lds_av(av, ring + ((k + 1) & (G_SLOTS - 1)) * 1024, rg);
            f32x2_t acc[8];
#pragma unroll
            for (int j = 0; j < 8; ++j) acc[j] = (f32x2_t){0.f, 0.f};
            g3_math8<0>(*(const u32x4(*)[8])&wB[0], av, acc); g3_math8<1>(*(const u32x4(*)[8])&wB[8], av, acc);
            g3_finish(acc, out, XB, ssq_next, dry, t0 + (k + 1) * step, xs, rg, cl, lane);
        }
    }
    asm volatile("s_waitcnt vmcnt(0)" ::: "memory");
}

namespace att {
typedef short bf16x8 __attribute__((ext_vector_type(8)));
typedef short bf16x4 __attribute__((ext_vector_type(4)));
typedef float f32x4 __attribute__((ext_vector_type(4)));
constexpr int TROW = 144;
constexpr int TILE_B = 64 * TROW;
constexpr int OFF_K = 0, OFF_V = 2 * TILE_B, OFF_IMP = 4 * TILE_B  , OFF_SEL = OFF_IMP + 16384, OFF_ANY = OFF_SEL + 512, OFF_STAGE = OFF_ANY + 512;
constexpr int STAGE_ROW = 68;
constexpr int LDS_NEED = OFF_STAGE + 384 * STAGE_ROW * 4;
constexpr float QSCALE = 0.125f * 1.4426950408889634f;
constexpr float SBOUND = QSCALE * 64.0f * 1.02f;

typedef float f32x2_ __attribute__((ext_vector_type(2)));
__device__ __forceinline__ unsigned cvt_pk(float lo, float hi) { const f32x2_ v = {lo, hi}; return __builtin_bit_cast(unsigned, __builtin_convertvector(v, bf16x2_t)); }

__device__ __forceinline__ void load_qfrag(bf16x8 (&qf)[2], const bf16* __restrict__ rowp, const float* __restrict__ gain, const float* __restrict__ rope_row, int g4) {
    const u32x4 w0 = *(const u32x4*)(rowp + 8 * g4), w1 = *(const u32x4*)(rowp + 32 + 8 * g4);
    float f0[8] = {bflo(w0.x), bfhi(w0.x), bflo(w0.y), bfhi(w0.y), bflo(w0.z), bfhi(w0.z), bflo(w0.w), bfhi(w0.w)};
    float f1[8] = {bflo(w1.x), bfhi(w1.x), bflo(w1.y), bfhi(w1.y), bflo(w1.z), bfhi(w1.z), bflo(w1.w), bfhi(w1.w)};
    float ss = 0.f;
#pragma unroll
    for (int j = 0; j < 8; ++j) ss += f0[j] * f0[j] + f1[j] * f1[j];
    ss += sxor<16>(ss); ss += sxor<32>(ss);
    const float rs = rsqrtf(ss * (1.f / 64.f) + EPS);
#pragma unroll
    for (int j = 0; j < 8; ++j) { f0[j] *= rs * gain[8 * g4 + j]; f1[j] *= rs * gain[32 + 8 * g4 + j]; }
    if (rope_row) {
#pragma unroll
        for (int j = 0; j < 8; ++j) {
            const float partner = sxor<16>(f0[j]);
            const float cs = rope_row[j], sn = rope_row[8 + j];
            if (g4 == 0) f0[j] = f0[j] * cs - partner * sn;
            else if (g4 == 1) f0[j] = f0[j] * cs + partner * sn;
        }
    }
    u32x4 o0, o1;
    o0.x = cvt_pk(f0[0] * QSCALE, f0[1] * QSCALE); o0.y = cvt_pk(f0[2] * QSCALE, f0[3] * QSCALE); o0.z = cvt_pk(f0[4] * QSCALE, f0[5] * QSCALE); o0.w = cvt_pk(f0[6] * QSCALE, f0[7] * QSCALE);
    o1.x = cvt_pk(f1[0] * QSCALE, f1[1] * QSCALE); o1.y = cvt_pk(f1[2] * QSCALE, f1[3] * QSCALE); o1.z = cvt_pk(f1[4] * QSCALE, f1[5] * QSCALE); o1.w = cvt_pk(f1[6] * QSCALE, f1[7] * QSCALE);
    qf[0] = __builtin_bit_cast(bf16x8, o0); qf[1] = __builtin_bit_cast(bf16x8, o1);
}

template <int NU>
__device__ __forceinline__ void qk_tile(const unsigned char* Kt, const bf16x8 (&qf)[NU][2], f32x4 (&Sv)[NU][4], int c16, int g4, const float (&init)[NU]) {
#pragma unroll
    for (int rt = 0; rt < 4; ++rt) {
        const bf16x8 k0 = *(const bf16x8*)(Kt + (16 * rt + c16) * TROW + 16 * g4);
        const bf16x8 k1 = *(const bf16x8*)(Kt + (16 * rt + c16) * TROW + 64 + 16 * g4);
#pragma unroll
        for (int u = 0; u < NU; ++u) {
            f32x4 a = {init[u], init[u], init[u], init[u]};
            a = __builtin_amdgcn_mfma_f32_16x16x32_bf16(k0, qf[u][0], a, 0, 0, 0);
            a = __builtin_amdgcn_mfma_f32_16x16x32_bf16(k1, qf[u][1], a, 0, 0, 0);
            Sv[u][rt] = a;
        }
    }
}
template <int NU, bool SUML>
__device__ __forceinline__ void pv_tile(const unsigned char* Vt, const f32x4 (&Sv)[NU][4], f32x4 (&O)[NU][4], int c16, int g4, f32x4 (&Ol)[NU]) {
    bf16x8 pf[NU][2];
#pragma unroll
    for (int u = 0; u < NU; ++u)
#pragma unroll
        for (int kk = 0; kk < 2; ++kk) {
            u32x4 w; w.x = cvt_pk(Sv[u][2 * kk][0], Sv[u][2 * kk][1]); w.y = cvt_pk(Sv[u][2 * kk][2], Sv[u][2 * kk][3]);
            w.z = cvt_pk(Sv[u][2 * kk + 1][0], Sv[u][2 * kk + 1][1]); w.w = cvt_pk(Sv[u][2 * kk + 1][2], Sv[u][2 * kk + 1][3]);
            pf[u][kk] = __builtin_bit_cast(bf16x8, w);
        }
    if (SUML) {
        const u32x4 o1 = {0x3f803f80u, 0x3f803f80u, 0x3f803f80u, 0x3f803f80u};
        const bf16x8 ones = __builtin_bit_cast(bf16x8, o1);
#pragma unroll
        for (int u = 0; u < NU; ++u) { Ol[u] = __builtin_amdgcn_mfma_f32_16x16x32_bf16(ones, pf[u][0], Ol[u], 0, 0, 0); Ol[u] = __builtin_amdgcn_mfma_f32_16x16x32_bf16(ones, pf[u][1], Ol[u], 0, 0, 0); }
    }
#pragma unroll
    for (int dt = 0; dt < 4; ++dt)
#pragma unroll
        for (int kk = 0; kk < 2; ++kk) {
            const unsigned char* vr = Vt + (16 * dt + c16) * TROW + (32 * kk + 4 * g4) * 2;
            const u32x2 lo = *(const u32x2*)vr, hi = *(const u32x2*)(vr + 32);
            u32x4 w; w.x = lo.x; w.y = lo.y; w.z = hi.x; w.w = hi.y;
            const bf16x8 vf = __builtin_bit_cast(bf16x8, w);
#pragma unroll
            for (int u = 0; u < NU; ++u) O[u][dt] = __builtin_amdgcn_mfma_f32_16x16x32_bf16(vf, pf[u][kk], O[u][dt], 0, 0, 0);
        }
}
constexpr float LAZY = 8.0f;
template <int NU, bool COLMASK, bool FIXED, bool NOSUM = false>
__device__ __forceinline__ void softmax_update(f32x4 (&Sv)[NU][4], float (&m)[NU], float (&l)[NU], f32x4 (&O)[NU][4], bool scaleO, const bool (&colok)[NU]) {
    if (FIXED) {
#pragma unroll
        for (int u = 0; u < NU; ++u) {
            float ps = 0.f;
#pragma unroll
            for (int rt = 0; rt < 4; ++rt)
#pragma unroll
                for (int jj = 0; jj < 4; ++jj) { const float p = __builtin_amdgcn_exp2f(Sv[u][rt][jj]); Sv[u][rt][jj] = p; if (!NOSUM) ps += p; }
            if (!NOSUM) l[u] += ps;
        }
        return;
    }
    float mx[NU]; bool need = false;
#pragma unroll
    for (int u = 0; u < NU; ++u) {
        float v = -INFINITY;
#pragma unroll
        for (int rt = 0; rt < 4; ++rt) v = fmaxf(fmaxf(v, fmaxf(Sv[u][rt][0], Sv[u][rt][1])), fmaxf(Sv[u][rt][2], Sv[u][rt][3]));
        v = fmaxf(v, sxor<16>(v)); v = fmaxf(v, sxor<32>(v));
        if (COLMASK && !colok[u]) v = -INFINITY;
        mx[u] = v;
        need = need || (v > m[u] + LAZY);
    }
    if (__builtin_amdgcn_ballot_w64(need) != 0ull) {
#pragma unroll
        for (int u = 0; u < NU; ++u) {
            if (mx[u] > m[u] + LAZY) {
                const float alpha = __builtin_amdgcn_exp2f(m[u] - mx[u]);
                m[u] = mx[u];
                l[u] *= alpha;
                if (scaleO) {
#pragma unroll
                    for (int dt = 0; dt < 4; ++dt) O[u][dt] = O[u][dt] * alpha;
                }
            }
        }
    }
#pragma unroll
    for (int u = 0; u < NU; ++u) {
        float mu = (m[u] == -INFINITY) ? 0.f : m[u];
        if (COLMASK && !colok[u]) mu = INFINITY;
        float ps = 0.f;
#pragma unroll
        for (int rt = 0; rt < 4; ++rt)
#pragma unroll
            for (int jj = 0; jj < 4; ++jj) { const float p = __builtin_amdgcn_exp2f(Sv[u][rt][jj] - mu); Sv[u][rt][jj] = p; ps += p; }
        l[u] += ps;
    }
}

#define SGB(mask, n) __builtin_amdgcn_sched_group_barrier(mask, n, 0)
template <int NU>
__device__ __forceinline__ void tile_fixed(const unsigned char* Kt, const unsigned char* Vt, const bf16x8 (&qf)[NU][2], f32x4 (&O)[NU][4], float (&l)[NU], int c16, int g4, const float (&init)[NU]) {
    f32x4 Sv[NU][4];
    float ps[NU];
    const unsigned char* kp = Kt + c16 * TROW + 16 * g4;
    const unsigned char* vp = Vt + c16 * TROW + 8 * g4;
#define KRD(rt, h) (*(const bf16x8*)(kp + (16 * (rt)) * TROW + 64 * (h)))
#define VRD(dt, kk) ({ const unsigned char* vr__ = vp + (16 * (dt)) * TROW + 64 * (kk); const u32x2 lo__ = *(const u32x2*)vr__, hi__ = *(const u32x2*)(vr__ + 32); \
                       u32x4 w__; w__.x = lo__.x; w__.y = lo__.y; w__.z = hi__.x; w__.w = hi__.y; __builtin_bit_cast(bf16x8, w__); })
#define QK_RT(rt, K0, K1) { _Pragma("unroll") for (int u = 0; u < NU; ++u) { f32x4 a__ = {init[u], init[u], init[u], init[u]}; \
                              a__ = __builtin_amdgcn_mfma_f32_16x16x32_bf16(K0, qf[u][0], a__, 0, 0, 0); Sv[u][rt] = __builtin_amdgcn_mfma_f32_16x16x32_bf16(K1, qf[u][1], a__, 0, 0, 0); } }
#define EXP_RT(rt) { _Pragma("unroll") for (int u = 0; u < NU; ++u) _Pragma("unroll") for (int jj = 0; jj < 4; ++jj) Sv[u][rt][jj] = __builtin_amdgcn_exp2f(Sv[u][rt][jj]); }
#define SUM_RT(rt) { _Pragma("unroll") for (int jj = 0; jj < 4; ++jj) _Pragma("unroll") for (int u = 0; u < NU; ++u) { ps[u] += Sv[u][rt][jj]; asm("" : "+v"(ps[u])); } }
#define CVT_KK(kk, PF) { _Pragma("unroll") for (int u = 0; u < NU; ++u) { u32x4 w__; w__.x = cvt_pk(Sv[u][2 * (kk)][0], Sv[u][2 * (kk)][1]); w__.y = cvt_pk(Sv[u][2 * (kk)][2], Sv[u][2 * (kk)][3]); \
                           w__.z = cvt_pk(Sv[u][2 * (kk) + 1][0], Sv[u][2 * (kk) + 1][1]); w__.w = cvt_pk(Sv[u][2 * (kk) + 1][2], Sv[u][2 * (kk) + 1][3]); PF[u] = __builtin_bit_cast(bf16x8, w__); } }
#define PV_DT(dt, VF, PF) { _Pragma("unroll") for (int u = 0; u < NU; ++u) O[u][dt] = __builtin_amdgcn_mfma_f32_16x16x32_bf16(VF, PF[u], O[u][dt], 0, 0, 0); }
#pragma unroll
    for (int u = 0; u < NU; ++u) ps[u] = 0.f;
    __builtin_amdgcn_sched_barrier(0);
    bf16x8 ka0 = KRD(0, 0), ka1 = KRD(0, 1), kb0 = KRD(1, 0), kb1 = KRD(1, 1);
    QK_RT(0, ka0, ka1)
    __builtin_amdgcn_sched_barrier(0);
    ka0 = KRD(2, 0); ka1 = KRD(2, 1);
    QK_RT(1, kb0, kb1)
    EXP_RT(0)
    SGB(0x100, 2);
#pragma unroll
    for (int i = 0; i < 2 * NU; ++i) { SGB(0x008, 1); SGB(0x400, 2); }
    __builtin_amdgcn_sched_barrier(0);
    kb0 = KRD(3, 0); kb1 = KRD(3, 1);
    QK_RT(2, ka0, ka1)
    EXP_RT(1)
    SUM_RT(0)
    SGB(0x100, 2);
#pragma unroll
    for (int i = 0; i < 2 * NU; ++i) { SGB(0x008, 1); SGB(0x400, 2); SGB(0x002, 2); }
    __builtin_amdgcn_sched_barrier(0);
    QK_RT(3, kb0, kb1)
    EXP_RT(2)
    SUM_RT(1)
#pragma unroll
    for (int i = 0; i < 2 * NU; ++i) { SGB(0x008, 1); SGB(0x400, 2); SGB(0x002, 2); }
    __builtin_amdgcn_sched_barrier(0);
    bf16x8 pf[NU];
    bf16x8 va = VRD(0, 0), vb = VRD(1, 0);
    CVT_KK(0, pf)
    PV_DT(0, va, pf)
    va = VRD(2, 0);
    PV_DT(1, vb, pf)
    vb = VRD(3, 0);
    EXP_RT(3)
    SUM_RT(2)
    PV_DT(2, va, pf)
    va = VRD(0, 1);
    PV_DT(3, vb, pf)
    vb = VRD(1, 1);
    SGB(0x100, 4); SGB(0x002, 4 * NU);
#pragma unroll
    for (int i = 0; i < 4; ++i) { SGB(0x008, 1); SGB(0x400, 1); SGB(0x002, 1); SGB(0x100, 1); SGB(0x008, 1); SGB(0x400, 1); SGB(0x002, 1); SGB(0x100, 1); SGB(0x008, 1); SGB(0x400, 1); SGB(0x002, 1); }
    __builtin_amdgcn_sched_barrier(0);
    bf16x8 pg[NU];
    CVT_KK(1, pg)
    PV_DT(0, va, pg)
    va = VRD(2, 1);
    PV_DT(1, vb, pg)
    vb = VRD(3, 1);
    PV_DT(2, va, pg)
    PV_DT(3, vb, pg)
    SUM_RT(3)
    SGB(0x002, 4 * NU);
#pragma unroll
    for (int i = 0; i < 4 * NU; ++i) { SGB(0x008, 1); SGB(0x002, 1); }
    __builtin_amdgcn_sched_barrier(0);
#pragma unroll
    for (int u = 0; u < NU; ++u) l[u] += ps[u];
#undef KRD
#undef VRD
#undef QK_RT
#undef EXP_RT
#undef CVT_KK
#undef PV_DT
}

__device__ __forceinline__ u32x4 tile_ld(const bf16* __restrict__ g, int tl) { return *(const u32x4*)(g + tl * 8); }
__device__ __forceinline__ void tile_st(unsigned char* lds_tile, u32x4 v, int tl) { *(u32x4*)(lds_tile + (tl >> 3) * TROW + (tl & 7) * 16) = v; }

template <bool FIXED>
__device__ __forceinline__ void mem_attention_mfma(const bf16* __restrict__ P, int qoff, const bf16* __restrict__ MK, const bf16* __restrict__ MVT, const float* __restrict__ q_gain,
                                                   bf16* __restrict__ AIN, unsigned char* lds, int tid_in, const float Mref) {
    int tid = tid_in; asm volatile("" : "+v"(tid));
    const int lane = tid & 63, wv = tid >> 6, c16 = lane & 15, g4 = lane >> 4;
    for (int item = blockIdx.x; item < NB * 4 * 16; item += gridDim.x) {
        int tl = tid; asm volatile("" : "+v"(tl));
        const int qt = item & 15, h = (item >> 4) & 3, b = item >> 6;
        const bf16* kb = MK + (size_t)(b * 4 + h) * 256 * 64;
        const bf16* vb = MVT + (size_t)(b * 4 + h) * 256 * 64;
        bf16x8 qf[2][2];
        size_t rowq[2];
#pragma unroll
        for (int u = 0; u < 2; ++u) { rowq[u] = (size_t)b * S + qt * 256 + wv * 32 + u * 16 + c16; load_qfrag(qf[u], P + rowq[u] * PP + qoff + h * 64, q_gain, nullptr, g4); }
        f32x4 O[2][4], Ol[2]; float m[2], l[2];
        Ol[0] = (f32x4){0.f, 0.f, 0.f, 0.f}; Ol[1] = (f32x4){0.f, 0.f, 0.f, 0.f};
#pragma unroll
        for (int u = 0; u < 2; ++u) { m[u] = FIXED ? Mref : -INFINITY; l[u] = 0.f;
#pragma unroll
            for (int dt = 0; dt < 4; ++dt) O[u][dt] = (f32x4){0.f, 0.f, 0.f, 0.f}; }
        u32x4 kr = tile_ld(kb, tl), vr = tile_ld(vb, tl);
        __syncthreads();
        tile_st(lds + OFF_K, kr, tl); tile_st(lds + OFF_V, vr, tl);
        __syncthreads();
        for (int kt = 0; kt < 4; ++kt) {
            const int cur = kt & 1;
            if (kt + 1 < 4) { kr = tile_ld(kb + (size_t)(kt + 1) * 4096, tl); vr = tile_ld(vb + (size_t)(kt + 1) * 4096, tl); }
            f32x4 Sv[2][4];
            { const float ini[2] = {FIXED ? -Mref : 0.f, FIXED ? -Mref : 0.f}; qk_tile<2>(lds + OFF_K + cur * TILE_B, qf, Sv, c16, g4, ini); }
            { const bool allok[2] = {true, true}; softmax_update<2, false, FIXED, false>(Sv, m, l, O, true, allok); }
            pv_tile<2, false>(lds + OFF_V + cur * TILE_B, Sv, O, c16, g4, Ol);
            if (kt + 1 < 4) { tile_st(lds + OFF_K + (cur ^ 1) * TILE_B, kr, tl); tile_st(lds + OFF_V + (cur ^ 1) * TILE_B, vr, tl); }
            __syncthreads();
        }
#pragma unroll
        for (int u = 0; u < 2; ++u) {
            float lt = l[u]; lt += sxor<16>(lt); lt += sxor<32>(lt);
            const float inv = 1.f / lt;
#pragma unroll
            for (int dt = 0; dt < 4; ++dt) {
                u32x2 w; w.x = cvt_pk(O[u][dt][0] * inv, O[u][dt][1] * inv); w.y = cvt_pk(O[u][dt][2] * inv, O[u][dt][3] * inv);
                *(u32x2*)(AIN + rowq[u] * D + 768 + h * 64 + 16 * dt + 4 * g4) = w;
            }
        }
    }
}

#define STAGE_BASE() ({ int t__ = tid_in; asm volatile("" : "+v"(t__)); stage + ((3 * (t__ >> 6)) * 16 + (t__ & 15)) * STAGE_ROW + 4 * ((t__ >> 4) & 3); })
template <bool FIXED, int VAR = 0>
__device__ __forceinline__ void nsa_attention_mfma(const bf16* __restrict__ P, const bf16* __restrict__ KC, const bf16* __restrict__ VCT, const bf16* __restrict__ KS, const bf16* __restrict__ VST,
                                                   const bf16* __restrict__ KW, const bf16* __restrict__ VWT, const float* __restrict__ rope, const float* __restrict__ qgain,
                                                   const float* __restrict__ gate_b, bf16* __restrict__ AIN, unsigned char* lds, int tid_in, const float Mc, const float Ms, const float Mw) {
    int* imp = (int*)(lds + OFF_IMP);
    unsigned* selw = (unsigned*)(lds + OFF_SEL);
    unsigned* anyw = (unsigned*)(lds + OFF_ANY);
    float* stage = (float*)(lds + OFF_STAGE);
    const int nitems = NB * 2 * 64;
    for (int it = blockIdx.x; it < nitems; it += gridDim.x) {
        int tid = tid_in; asm volatile("" : "+v"(tid));
        const int lane = tid & 63, wv = tid >> 6, c16 = lane & 15, g4 = lane >> 4;
        int tl = tid; asm volatile("" : "+v"(tl));
        int b, g, c;
        if (gridDim.x == 256) { const int k = blockIdx.x, r = it >> 8, bg = 2 * (k & 7) + ((k >> 3) & 1), s = k >> 4;
            b = bg >> 1; g = bg & 1; c = (r == 0) ? s : (r == 1) ? 31 - s : (r == 2) ? 32 + s : 63 - s; }
        else { c = it & 63; g = (it >> 6) & 1; b = it >> 7; }
        const int bg2 = b * 2 + g;
        const bf16* kcb = KC + (size_t)(b * 2 + g) * 256 * 64;
        u32x4 kr0 = ((VAR == 1) ? (u32x4){0u, 0u, 0u, 0u} : tile_ld(kcb, tl));
        bf16x8 qf[3][2]; int qq[3], hq[3];
#pragma unroll
        for (int u = 0; u < 3; ++u) {
            const int U = 3 * wv + u; hq[u] = g * 6 + (U >> 2); qq[u] = (U & 3) * 16 + c16;
            const size_t row = (size_t)b * S + c * 64 + qq[u];
            load_qfrag(qf[u], P + row * PP + 768 + hq[u] * 64, qgain, rope + (size_t)(c * 64 + qq[u]) * 16, g4);
        }
        __syncthreads();
        for (int i = tid; i < 64 * 64; i += NTHR) imp[i] = 0;
        if (tid < 2) anyw[tid] = 0u;
        f32x4 O[3][4], Ol[3]; float m[3], l[3];
        Ol[0] = (f32x4){0.f, 0.f, 0.f, 0.f}; Ol[1] = Ol[0]; Ol[2] = Ol[0];
        const int ktmax = (VAR == 3) ? -1 : (((4 * c + 2) >> 6) > 3 ? 3 : ((4 * c + 2) >> 6));
        const bf16* vcb = VCT + (size_t)bg2 * 256 * 64;
#pragma unroll
        for (int u = 0; u < 3; ++u) { m[u] = FIXED ? Mc : -INFINITY; l[u] = 0.f; }
        const float inic[3] = {FIXED ? -Mc : 0.f, FIXED ? -Mc : 0.f, FIXED ? -Mc : 0.f};
        {
            u32x4 kr = kr0;
            __syncthreads();
            if (VAR != 1) tile_st(lds + OFF_K, kr, tl);
            __syncthreads();
            for (int kt = 0; kt <= ktmax; ++kt) {
                const int cur = kt & 1;
                if (kt + 1 <= ktmax) kr = ((VAR == 1) ? (u32x4){0u, 0u, 0u, 0u} : tile_ld(kcb + (size_t)(kt + 1) * 4096, tl));
                f32x4 Sv[3][4];
                if (VAR < 2) qk_tile<3>(lds + OFF_K + cur * TILE_B, qf, Sv, c16, g4, inic); else { _Pragma("unroll") for (int u = 0; u < 3; ++u) _Pragma("unroll") for (int rt = 0; rt < 4; ++rt) Sv[u][rt] = (f32x4){0.f, 0.f, 0.f, 0.f}; }
#pragma unroll
                for (int u = 0; u < 3; ++u) { const int t = c * 64 + qq[u];
#pragma unroll
                    for (int rt = 0; rt < 4; ++rt)
#pragma unroll
                        for (int jj = 0; jj < 4; ++jj) { const int n = 64 * kt + 16 * rt + 4 * g4 + jj; if (!(n < NCMP && 16 * n + 31 <= t)) Sv[u][rt][jj] = -INFINITY; } }
                { const bool allok[3] = {true, true, true}; softmax_update<3, false, FIXED>(Sv, m, l, O, false, allok); }
                if (kt + 1 <= ktmax) if (VAR != 1) tile_st(lds + OFF_K + (cur ^ 1) * TILE_B, kr, tl);
                __syncthreads();
            }
        }
        float invl[3], mu[3];
#pragma unroll
        for (int u = 0; u < 3; ++u) { float lt = l[u]; lt += sxor<16>(lt); lt += sxor<32>(lt); invl[u] = (lt > 0.f) ? 1.f / lt : 0.f; mu[u] = FIXED ? 0.f : ((m[u] == -INFINITY) ? 0.f : m[u]);
#pragma unroll
            for (int dt = 0; dt < 4; ++dt) O[u][dt] = (f32x4){0.f, 0.f, 0.f, 0.f}; }
        {
            u32x4 kr = ((VAR == 1) ? (u32x4){0u, 0u, 0u, 0u} : tile_ld(kcb, tl)), vr = ((VAR == 1) ? (u32x4){0u, 0u, 0u, 0u} : tile_ld(vcb, tl));
            if (VAR != 1) tile_st(lds + OFF_K, kr, tl); if (VAR != 1) tile_st(lds + OFF_V, vr, tl);
            __syncthreads();
            for (int kt = 0; kt <= ktmax; ++kt) {
                const int cur = kt & 1;
                if (kt + 1 <= ktmax) { kr = ((VAR == 1) ? (u32x4){0u, 0u, 0u, 0u} : tile_ld(kcb + (size_t)(kt + 1) * 4096, tl)); vr = ((VAR == 1) ? (u32x4){0u, 0u, 0u, 0u} : tile_ld(vcb + (size_t)(kt + 1) * 4096, tl)); }
                f32x4 Sv[3][4];
                if (VAR < 2) qk_tile<3>(lds + OFF_K + cur * TILE_B, qf, Sv, c16, g4, inic); else { _Pragma("unroll") for (int u = 0; u < 3; ++u) _Pragma("unroll") for (int rt = 0; rt < 4; ++rt) Sv[u][rt] = (f32x4){0.f, 0.f, 0.f, 0.f}; }
#pragma unroll
                for (int u = 0; u < 3; ++u) { const int t = c * 64 + qq[u];
#pragma unroll
                    for (int rt = 0; rt < 4; ++rt) {
#pragma unroll
                        for (int jj = 0; jj < 4; ++jj) { const int n = 64 * kt + 16 * rt + 4 * g4 + jj; const bool ok = (n < NCMP && 16 * n + 31 <= t);
                            Sv[u][rt][jj] = ok ? __builtin_amdgcn_exp2f(Sv[u][rt][jj] - mu[u]) * invl[u] : 0.f; }
                        const int j = 16 * kt + 4 * rt + g4;
                        const float mainv = Sv[u][rt][0] + Sv[u][rt][1] + Sv[u][rt][2] + 0.5f * Sv[u][rt][3], spill = 0.5f * Sv[u][rt][3];
                        atomicAdd(&imp[qq[u] * 64 + j], (int)(mainv * 16777216.f + 0.5f));
                        if (j + 1 < 64) atomicAdd(&imp[qq[u] * 64 + j + 1], (int)(spill * 16777216.f + 0.5f));
                    } }
                pv_tile<3, false>(lds + OFF_V + cur * TILE_B, Sv, O, c16, g4, Ol);
                if (kt + 1 <= ktmax) { if (VAR != 1) tile_st(lds + OFF_K + (cur ^ 1) * TILE_B, kr, tl); if (VAR != 1) tile_st(lds + OFF_V + (cur ^ 1) * TILE_B, vr, tl); }
                __syncthreads();
            }
        }
#pragma unroll
        for (int u = 0; u < 3; ++u) { const float gcmp = sigmoidf_(ldbf(P + ((size_t)b * S + c * 64 + qq[u]) * PP + 1536 + hq[u] * 3 + 0) + gate_b[hq[u] * 3 + 0]);
#pragma unroll
            for (int dt = 0; dt < 4; ++dt) *(f32x4*)(STAGE_BASE() + (u * 16) * STAGE_ROW + 16 * dt) = O[u][dt] * gcmp; }
        const bf16* ksb = KS + (size_t)bg2 * S * 64;
        const bf16* vsb = VST + (size_t)bg2 * S * 64;
        u32x4 kA = ((VAR == 1) ? (u32x4){0u, 0u, 0u, 0u} : tile_ld(ksb, tl)), vA = ((VAR == 1) ? (u32x4){0u, 0u, 0u, 0u} : tile_ld(vsb, tl)), kB, vB;
        {
#pragma unroll 1
            for (int i = 0; i < 8; ++i) {
                const int q = 8 * wv + i, j = lane;
                int v = imp[q * 64 + j];
                const bool valid = j <= c, forced = (j == 0) || (j == c) || (j == c - 1);
                v = forced ? 0x7fffffc0 : (v & ~63);
                v = valid ? (v | (63 - j)) : -1;
                int rank = 0;
#pragma unroll
                for (int jj = 0; jj < 64; ++jj) { const int o = __builtin_amdgcn_readlane(v, jj); rank += (o > v) ? 1 : 0; }
                const unsigned long long msk = __ballot(rank < 16 && v >= 0);
                if (lane == 0) { selw[2 * q] = (unsigned)msk; selw[2 * q + 1] = (unsigned)(msk >> 32); atomicOr(&anyw[0], (unsigned)msk); atomicOr(&anyw[1], (unsigned)(msk >> 32)); }
            }
        }
        __syncthreads();
        unsigned long long anym = (unsigned long long)anyw[0] | ((unsigned long long)anyw[1] << 32);
        unsigned long long selm[3];
#pragma unroll
        for (int u = 0; u < 3; ++u) selm[u] = (unsigned long long)selw[2 * qq[u]] | ((unsigned long long)selw[2 * qq[u] + 1] << 32);
        {
#pragma unroll
            for (int u = 0; u < 3; ++u) { m[u] = FIXED ? Ms : -INFINITY; l[u] = 0.f; Ol[u] = (f32x4){0.f, 0.f, 0.f, 0.f};
#pragma unroll
                for (int dt = 0; dt < 4; ++dt) O[u][dt] = (f32x4){0.f, 0.f, 0.f, 0.f}; }
            auto nextsel = [&](int jj) -> int { const unsigned long long rest = (jj < 63) ? (anym >> (jj + 1)) : 0ull; return rest ? (jj + 1 + __builtin_ctzll(rest)) : -1; };
            auto compute = [&](int jj, int cur, bool diag) {
                bool colok[3]; float inis[3];
#pragma unroll
                for (int u = 0; u < 3; ++u) { colok[u] = (selm[u] >> jj) & 1ull; inis[u] = FIXED ? (colok[u] ? -Ms : -INFINITY) : 0.f; }
                if (FIXED && VAR == 0 && !diag) { tile_fixed<3>(lds + OFF_K + cur * TILE_B, lds + OFF_V + cur * TILE_B, qf, O, l, c16, g4, inis); return; }
                f32x4 Sv[3][4];
                if (VAR < 2) qk_tile<3>(lds + OFF_K + cur * TILE_B, qf, Sv, c16, g4, inis); else { _Pragma("unroll") for (int u = 0; u < 3; ++u) _Pragma("unroll") for (int rt = 0; rt < 4; ++rt) Sv[u][rt] = (f32x4){0.f, 0.f, 0.f, 0.f}; }
                if (diag) {
#pragma unroll
                    for (int u = 0; u < 3; ++u) { int qo = qq[u] - 4 * g4; asm volatile("" : "+v"(qo));
#pragma unroll
                        for (int rt = 0; rt < 4; ++rt)
#pragma unroll
                            for (int e = 0; e < 4; ++e) { if (16 * rt + e > qo) Sv[u][rt][e] = -INFINITY; } }
                }
                if (VAR < 2) { softmax_update<3, true, FIXED, false>(Sv, m, l, O, true, colok);
                pv_tile<3, false>(lds + OFF_V + cur * TILE_B, Sv, O, c16, g4, Ol); }
            };
            int j = __builtin_ctzll(anym);
            if (VAR != 1) tile_st(lds + OFF_K, kA, tl); if (VAR != 1) tile_st(lds + OFF_V, vA, tl);
            __syncthreads();
            int jn = nextsel(j), jnn, cur = 0;
            if (jn >= 0) { kA = ((VAR == 1) ? (u32x4){0u, 0u, 0u, 0u} : tile_ld(ksb + (size_t)jn * 4096, tl)); vA = ((VAR == 1) ? (u32x4){0u, 0u, 0u, 0u} : tile_ld(vsb + (size_t)jn * 4096, tl)); }
            if (!FIXED) {
                for (;;) {
                    jnn = (jn >= 0) ? nextsel(jn) : -1;
                    if (jnn >= 0) { kB = tile_ld(ksb + (size_t)jnn * 4096, tl); vB = tile_ld(vsb + (size_t)jnn * 4096, tl); }
                    compute(j, cur, j == c);
                    if (jn >= 0) { tile_st(lds + OFF_K + (cur ^ 1) * TILE_B, kA, tl); tile_st(lds + OFF_V + (cur ^ 1) * TILE_B, vA, tl); }
                    __syncthreads();
                    if (jn < 0) break;
                    j = jn; jn = jnn; cur ^= 1;
                    jnn = (jn >= 0) ? nextsel(jn) : -1;
                    if (jnn >= 0) { kA = tile_ld(ksb + (size_t)jnn * 4096, tl); vA = tile_ld(vsb + (size_t)jnn * 4096, tl); }
                    compute(j, cur, j == c);
                    if (jn >= 0) { tile_st(lds + OFF_K + (cur ^ 1) * TILE_B, kB, tl); tile_st(lds + OFF_V + (cur ^ 1) * TILE_B, vB, tl); }
                    __syncthreads();
                    if (jn < 0) break;
                    j = jn; jn = jnn; cur ^= 1;
                }
            } else {
            while (jn >= 0) {
                jnn = nextsel(jn);
                if (jnn >= 0) { kB = ((VAR == 1) ? (u32x4){0u, 0u, 0u, 0u} : tile_ld(ksb + (size_t)jnn * 4096, tl)); vB = ((VAR == 1) ? (u32x4){0u, 0u, 0u, 0u} : tile_ld(vsb + (size_t)jnn * 4096, tl)); }
                compute(j, cur, false);
                if (VAR != 1) tile_st(lds + OFF_K + (cur ^ 1) * TILE_B, kA, tl); if (VAR != 1) tile_st(lds + OFF_V + (cur ^ 1) * TILE_B, vA, tl);
                __syncthreads();
                j = jn; jn = jnn; cur ^= 1;
                if (jn < 0) break;
                jnn = nextsel(jn);
                if (jnn >= 0) { kA = ((VAR == 1) ? (u32x4){0u, 0u, 0u, 0u} : tile_ld(ksb + (size_t)jnn * 4096, tl)); vA = ((VAR == 1) ? (u32x4){0u, 0u, 0u, 0u} : tile_ld(vsb + (size_t)jnn * 4096, tl)); }
                compute(j, cur, false);
                if (VAR != 1) tile_st(lds + OFF_K + (cur ^ 1) * TILE_B, kB, tl); if (VAR != 1) tile_st(lds + OFF_V + (cur ^ 1) * TILE_B, vB, tl);
                __syncthreads();
                j = jn; jn = jnn; cur ^= 1;
            }
            compute(j, cur, true);
            __syncthreads();
            }
#pragma unroll
            for (int u = 0; u < 3; ++u) { float lt = l[u]; lt += sxor<16>(lt); lt += sxor<32>(lt); const float sc = (lt > 0.f) ? sigmoidf_(ldbf(P + ((size_t)b * S + c * 64 + qq[u]) * PP + 1536 + hq[u] * 3 + 1) + gate_b[hq[u] * 3 + 1]) / lt : 0.f;
#pragma unroll
                for (int dt = 0; dt < 4; ++dt) { float* sp = STAGE_BASE() + (u * 16) * STAGE_ROW + 16 * dt; *(f32x4*)sp = *(f32x4*)sp + O[u][dt] * sc; } }
        }
        {
            const bf16* kwb = KW + (size_t)bg2 * S * 64;
            const bf16* vwb = VWT + (size_t)bg2 * S * 64;
#pragma unroll
            for (int u = 0; u < 3; ++u) { m[u] = FIXED ? Mw : -INFINITY; l[u] = 0.f; Ol[u] = (f32x4){0.f, 0.f, 0.f, 0.f};
#pragma unroll
                for (int dt = 0; dt < 4; ++dt) O[u][dt] = (f32x4){0.f, 0.f, 0.f, 0.f}; }
            const float iniw[3] = {FIXED ? -Mw : 0.f, FIXED ? -Mw : 0.f, FIXED ? -Mw : 0.f};
            const int j0 = (c >= 8) ? c - 8 : 0;
            u32x4 kr = ((VAR == 1) ? (u32x4){0u, 0u, 0u, 0u} : tile_ld(kwb + (size_t)j0 * 4096, tl)), vr = ((VAR == 1) ? (u32x4){0u, 0u, 0u, 0u} : tile_ld(vwb + (size_t)j0 * 4096, tl));
            if (VAR != 1) tile_st(lds + OFF_K, kr, tl); if (VAR != 1) tile_st(lds + OFF_V, vr, tl);
            __syncthreads();
            int cur = 0;
            auto wstep = [&](int j, bool fast) {
                if (j + 1 <= c) { kr = ((VAR == 1) ? (u32x4){0u, 0u, 0u, 0u} : tile_ld(kwb + (size_t)(j + 1) * 4096, tl)); vr = ((VAR == 1) ? (u32x4){0u, 0u, 0u, 0u} : tile_ld(vwb + (size_t)(j + 1) * 4096, tl)); }
                if (FIXED && VAR == 0 && fast) tile_fixed<3>(lds + OFF_K + cur * TILE_B, lds + OFF_V + cur * TILE_B, qf, O, l, c16, g4, iniw);
                else {
                    f32x4 Sv[3][4];
                    if (VAR < 2) qk_tile<3>(lds + OFF_K + cur * TILE_B, qf, Sv, c16, g4, iniw); else { _Pragma("unroll") for (int u = 0; u < 3; ++u) _Pragma("unroll") for (int rt = 0; rt < 4; ++rt) Sv[u][rt] = (f32x4){0.f, 0.f, 0.f, 0.f}; }
                    if (j == c || j == c - 8) {
#pragma unroll
                        for (int u = 0; u < 3; ++u) { int qo = qq[u] - 4 * g4; asm volatile("" : "+v"(qo));
#pragma unroll
                            for (int rt = 0; rt < 4; ++rt)
#pragma unroll
                                for (int jj = 0; jj < 4; ++jj) { const int kk = 16 * rt + jj; const bool ok = (j == c) ? (kk <= qo) : (kk > qo); if (!ok) Sv[u][rt][jj] = -INFINITY; } }
                    }
                    if (VAR < 2) { { const bool allok[3] = {true, true, true}; softmax_update<3, false, FIXED, false>(Sv, m, l, O, true, allok); }
                    pv_tile<3, false>(lds + OFF_V + cur * TILE_B, Sv, O, c16, g4, Ol); }
                }
                if (j + 1 <= c) { if (VAR != 1) tile_st(lds + OFF_K + (cur ^ 1) * TILE_B, kr, tl); if (VAR != 1) tile_st(lds + OFF_V + (cur ^ 1) * TILE_B, vr, tl); }
                __syncthreads();
                cur ^= 1;
            };
            if (!FIXED) { for (int j = j0; j <= c; ++j) wstep(j, false); }
            else {
                wstep(j0, false);
                for (int j = j0 + 1; j < c; ++j) wstep(j, true);
                if (c > j0) wstep(c, false);
            }
#pragma unroll
            for (int u = 0; u < 3; ++u) { float lt = l[u]; lt += sxor<16>(lt); lt += sxor<32>(lt); const float sc = (lt > 0.f) ? sigmoidf_(ldbf(P + ((size_t)b * S + c * 64 + qq[u]) * PP + 1536 + hq[u] * 3 + 2) + gate_b[hq[u] * 3 + 2]) / lt : 0.f;
#pragma unroll
                for (int dt = 0; dt < 4; ++dt) { float* sp = STAGE_BASE() + (u * 16) * STAGE_ROW + 16 * dt; *(f32x4*)sp = *(f32x4*)sp + O[u][dt] * sc; } }
        }
        __syncthreads();
        for (int i = tid; i < 384 * 8; i += NTHR) {
            const int d8 = i & 7, col = i >> 3, r = col >> 6, q = col & 63;
            const float* sp = stage + col * STAGE_ROW + d8 * 8;
            const f32x4 a = *(const f32x4*)sp, bb = *(const f32x4*)(sp + 4);
            u32x4 w; w.x = cvt_pk(a[0], a[1]); w.y = cvt_pk(a[2], a[3]); w.z = cvt_pk(bb[0], bb[1]); w.w = cvt_pk(bb[2], bb[3]);
            *(u32x4*)(AIN + ((size_t)b * S + c * 64 + q) * D + (g * 6 + r) * 64 + d8 * 8) = w;
        }
    }
}
}

#define XB_LAS __attribute__((address_space(3)))
#define XB_TMO      128
#define XB_XCNT(j)  (256  + 64 * (j))
#define XB_XSUB(j)  (1280 + 64 * (j))
#define XB_XGEN(j)  (2304 + 64 * (j))
#define XB_TOP      3328
#define XB_TOPGEN   3392
#define XCD_BAR_WORDS 3456
#define XB_SPIN_CAP (1u << 18)

__device__ __forceinline__ unsigned xb_ld(unsigned* p)              { return __hip_atomic_load(p, __ATOMIC_RELAXED, __HIP_MEMORY_SCOPE_AGENT); }
__device__ __forceinline__ unsigned xb_add(unsigned* p, unsigned v) { return __hip_atomic_fetch_add(p, v, __ATOMIC_RELAXED, __HIP_MEMORY_SCOPE_AGENT); }
__device__ __forceinline__ unsigned xb_xcc_id() { return (unsigned)__builtin_amdgcn_s_getreg((3 << 11) | 20) & 0xFu; }
#define XB_SPIN(cond, bar) do { unsigned _sp = 0; while (cond) { __builtin_amdgcn_s_sleep(1); \
    if ((++_sp & 255u) == 0u) { if (xb_ld(&(bar)[XB_TMO])) break; if (_sp > XB_SPIN_CAP) { atomicAdd(&(bar)[XB_TMO], 1u); break; } } } } while (0)

struct XcdBarrier {
    unsigned* bar; unsigned x;
    volatile XB_LAS unsigned* st;
};

__device__ __forceinline__ XcdBarrier xcd_barrier_post(unsigned* bar, volatile XB_LAS unsigned* st) {
    XcdBarrier b; b.bar = bar; b.x = xb_xcc_id(); b.st = st;
    if (threadIdx.x == 0) { const unsigned rank = xb_add(&bar[XB_XCNT(b.x)], 1u); st[2] = b.x; st[3] = rank; }
    return b;
}
__device__ __forceinline__ void xcd_barrier_complete(unsigned* bar, unsigned x, unsigned& nloc, unsigned& nx) {
    const unsigned G = gridDim.x * gridDim.y * gridDim.z;
    unsigned sum, cnt, mine, sp = 0u;
    for (;;) {
        sum = 0u; cnt = 0u; mine = 0u;
#pragma unroll
        for (unsigned j = 0; j < 16; ++j) { const unsigned c = xb_ld(&bar[XB_XCNT(j)]); sum += c; cnt += (c > 0u) ? 1u : 0u; mine = (j == x) ? c : mine; }
        if (sum == G) break;
        __builtin_amdgcn_s_sleep(1);
        if ((++sp & 255u) == 0u) { if (xb_ld(&bar[XB_TMO])) break; if (sp > XB_SPIN_CAP) { atomicAdd(&bar[XB_TMO], 1u); break; } }
    }
    nloc = mine > 0u ? mine : 1u; nx = cnt > 0u ? cnt : 1u;
}

__device__ __forceinline__ void xcd_barrier(const XcdBarrier& b, const bool leader_thread) {
    asm volatile("s_waitcnt vmcnt(0)" ::: "memory");
    __syncthreads();
    if (leader_thread) {
        unsigned* bar = b.bar;
        __builtin_amdgcn_s_waitcnt(0);
        unsigned nloc = b.st[0], nx = b.st[1];
        if (nloc == 0u) { xcd_barrier_complete(bar, b.x, nloc, nx); b.st[0] = nloc; b.st[1] = nx; }
        const unsigned old = xb_add(&bar[XB_XSUB(b.x)], 1u);
        const unsigned gen = old / nloc;
        if (old + 1u == (gen + 1u) * nloc) {
            __builtin_amdgcn_fence(__ATOMIC_RELEASE, "agent");
            asm volatile("s_waitcnt vmcnt(0)" ::: "memory");
            const unsigned og = xb_add(&bar[XB_TOP], 1u);
            const unsigned tg = og / nx;
            if (og + 1u == (tg + 1u) * nx) xb_add(&bar[XB_TOPGEN], 1u);
            else XB_SPIN(xb_ld(&bar[XB_TOPGEN]) == tg, bar);
            __builtin_amdgcn_fence(__ATOMIC_ACQUIRE, "agent");
            xb_add(&bar[XB_XGEN(b.x)], 1u);
            asm volatile("s_waitcnt vmcnt(0)" ::: "memory");
        } else {
            XB_SPIN(xb_ld(&bar[XB_XGEN(b.x)]) == gen, bar);
            __builtin_amdgcn_fence(__ATOMIC_ACQUIRE, "agent");
            asm volatile("s_waitcnt vmcnt(0)" ::: "memory");
        }
    }
    __syncthreads();
}

__device__ __forceinline__ void xcd_barrier_here(unsigned char* ws_ctl, volatile XB_LAS unsigned* st, const bool leader_thread) {
    XcdBarrier b; b.bar = (unsigned*)ws_ctl; b.x = xb_xcc_id(); b.st = st;
    xcd_barrier(b, leader_thread);
}

constexpr int N_PHASES = 18;
constexpr int LDS_BYTES = 163840;
static_assert((pg8::EpiTopK::LIST_OFF + 256 * 16) * 4 <= LDS_BYTES - 64 - 256, "top-k LDS map");
static_assert(att::LDS_NEED <= LDS_BYTES - 64 - 256, "attention LDS map (the last 64 B hold the grid barrier's set-up words)");
#define PG8_SP2_ON true

template <int LO, int HI>
__global__ void __launch_bounds__(NTHR) fwd_kernel(Params p) {
    cg::grid_group grid = cg::this_grid();
    extern __shared__ __attribute__((aligned(16))) unsigned char lds_raw[];
    float* smem = (float*)lds_raw;
    PG8_LAS unsigned char* ldsp = (PG8_LAS unsigned char*)lds_raw;
    constexpr int lo = LO, hi = HI;
    int ph = 0;
    const int wave_s__ = __builtin_amdgcn_readfirstlane(threadIdx.x >> 6);
    if (threadIdx.x < 30) ((const float* XB_LAS*)((XB_LAS unsigned char*)lds_raw + (LDS_BYTES - 64 - 256)))[threadIdx.x] = p.in[threadIdx.x];
    __syncthreads();
#define INP(i) ((const float*)lds_ptr_uniform((XB_LAS unsigned char*)lds_raw + (LDS_BYTES - 64 - 256) + 8 * (i)))
    if (hi - lo > 1) {
        if (threadIdx.x < 16) ((volatile XB_LAS unsigned*)((XB_LAS unsigned char*)lds_raw + (LDS_BYTES - 64)))[threadIdx.x] = 0u;
        __syncthreads();
        (void)xcd_barrier_post((unsigned*)(p.ws + WS_CTL), (volatile XB_LAS unsigned*)((XB_LAS unsigned char*)lds_raw + (LDS_BYTES - 64)));
    }
#define GRID_BAR() xcd_barrier_here(p.ws + WS_CTL, (volatile XB_LAS unsigned*)((XB_LAS unsigned char*)lds_raw + (LDS_BYTES - 64)), wave_s__ == 0 && lane_now() == 0)
#define PHASE_PROLOGUE \
    const int wv = wave_s__; \
    const int tid = wave_s__ * 64 + lane_now(); \
    const int lane = tid & 63; \
    const int gw = blockIdx.x * (NTHR / 64) + wv, ngw = gridDim.x * (NTHR / 64); \
    const int gtid = blockIdx.x * NTHR + tid, ngt = gridDim.x * NTHR; \
    const int G = gridDim.x; \
    const float* x = INP(0); const float* mem = INP(1); const int* positions = (const int*)INP(2); \
    const float* norm_mix = INP(3); const float* norm_ffn = INP(4); const float* norm_mem = INP(5); \
    const float* w_out = INP(6); const float* w_mem_kv = INP(7); const float* mem_q_gain = INP(8); const float* mem_k_gain = INP(9); \
    const float* a_w_in = INP(10); const float* a_conv_w = INP(11); const float* a_conv_b = INP(12); const float* a_gate_w = INP(13); \
    const float* a_gate_b = INP(14); const float* a_lambda = INP(15); const float* b_w_in = INP(16); const float* b_gate_b = INP(17); \
    const float* b_q_gain = INP(18); const float* kv_norm = INP(19); const float* w_kv_shared = INP(20); const float* k_gain_shared = INP(21); \
    const float* cmp_pos = INP(22); const float* cmp_w1 = INP(23); const float* cmp_b1 = INP(24); const float* cmp_w2 = INP(25); \
    const float* peer_wq = INP(26); const float* peer_subkeys = INP(27); const float* peer_u = INP(28); const float* peer_v = INP(29); \
    float* out = p.out; \
    unsigned char* ws = p.ws; asm volatile("" : "+s"(ws)); \
    float* RSTD = (float*)(ws + WS_RSTD); \
    float* rstd0 = RSTD, *rstd2 = RSTD + 2 * T, *rstdm = RSTD + 4 * T; \
    float* sumsq1 = (float*)(ws + WS_SSQ1), *sumsq3 = (float*)(ws + WS_SSQ3); \
    float* ROPE = (float*)(ws + WS_ROPE); float* BIAS2 = (float*)(ws + WS_BIAS2); bf16* WGF = (bf16*)(ws + WS_WGF); \
    bf16* WIN0 = (bf16*)(ws + WS_WIN0); bf16* WOUT = (bf16*)(ws + WS_WOUT); bf16* WFt = (bf16*)(ws + WS_WF); bf16* WKVB = (bf16*)(ws + WS_WKVB); \
    bf16* WMEM = (bf16*)(ws + WS_WMEM); bf16* WC1 = (bf16*)(ws + WS_WC1); bf16* MEMB = (bf16*)(ws + WS_MEMB); bf16* MEMKV = (bf16*)(ws + WS_MEMKV); \
    float* AGG = (float*)(ws + WS_SCAN); bf16* HID = (bf16*)(ws + WS_HID); bf16* KC = (bf16*)(ws + WS_KC); bf16* VC = (bf16*)(ws + WS_VC); \
    bf16* CA = (bf16*)(ws + WS_CA); int* E = (int*)(ws + WS_E); float* Gt = (float*)(ws + WS_GT); bf16* KS = (bf16*)(ws + WS_KS); bf16* KW = (bf16*)(ws + WS_KW); \
    bf16* XB = (bf16*)(ws + WS_XB); bf16* AIN = (bf16*)(ws + WS_AIN); bf16* P = (bf16*)(ws + WS_P); \
    unsigned char* UT8 = ws + WS_UT; unsigned char* VT8 = ws + WS_VT; float* PART = (float*)(ws + WS_P); float* sumsq2 = (float*)(ws + WS_SSQ2); \
    bf16* MEMK = (bf16*)(ws + WS_MEMK); bf16* MEMVT = (bf16*)(ws + WS_MEMVT); bf16* VST = (bf16*)(ws + WS_VST); bf16* VWT = (bf16*)(ws + WS_VWT); \
    (void)lane; (void)gw; (void)ngw; (void)gtid; (void)ngt; (void)G;

#define SLICE_COORDS() \
    int sl_xs, sl_r, sl_nr; { \
        const unsigned* ctlw = (const unsigned*)(ws + WS_CTL); \
        bool clean = (gridDim.x & 7) == 0; \
        _Pragma("unroll") for (int jx = 0; jx < 8; ++jx) clean = clean && (__hip_atomic_load(ctlw + XB_XCNT(jx), __ATOMIC_RELAXED, __HIP_MEMORY_SCOPE_AGENT) == gridDim.x / 8); \
        volatile XB_LAS unsigned* stw = (volatile XB_LAS unsigned*)((XB_LAS unsigned char*)lds_raw + (LDS_BYTES - 64)); \
        const int hx = (int)stw[2], hr = (int)stw[3]; \
        if (clean) { sl_xs = __builtin_amdgcn_readfirstlane(hx); sl_r = __builtin_amdgcn_readfirstlane(hr); sl_nr = gridDim.x / 8; } \
        else { sl_xs = blockIdx.x & 7; sl_r = blockIdx.x >> 3; sl_nr = (gridDim.x - sl_xs + 7) >> 3; } }
#ifndef PROBE_SUB
#define PROBE_SUB (-1)
#endif
#define SUBREP(id) for (int r2__ = 0; r2__ < ((PROBE_SUB == (id)) ? 2 : 1); ++r2__)
#ifndef PROBE_DUP
#define PROBE_DUP (-1)
#endif
#define PHASE_BEGIN if (ph >= lo && ph < hi) { for (int rep__ = (ph == PROBE_DUP ? 0 : 1); rep__ < 2; ++rep__) { PHASE_PROLOGUE
#define PHASE_END if (rep__ == 0) GRID_BAR(); } } ++ph; if (ph > lo && ph < hi) { if (ph == 1) grid.sync(); else GRID_BAR(); }

    PHASE_BEGIN
        SUBREP(1) for (int r = gw; r < T; r += ngw) row_to_bf16(x + (size_t)r * D, XB + (size_t)r * D, rstd0 + r, lane);
        for (int r = gw; r < NB * MEMN; r += ngw) row_to_bf16(mem + (size_t)r * D, MEMB + (size_t)r * D, rstdm + r, lane);
        for (int i = gtid; i < S * 8; i += ngt) {
            const int s = i >> 3, k = i & 7;
            const float freq = powf(500000.0f, -(float)k / 8.0f);
            const float ang = (float)positions[s] * freq;
            ROPE[s * 16 + k] = cosf(ang); ROPE[s * 16 + 8 + k] = sinf(ang);
        }
        SUBREP(2) {
            float* scr = smem + wv * (64 * 33);
            constexpr int I_IN0 = 16 * 56, I_OUT = 16 * 32, I_KV = 16 * 24, I_BIN = 16 * 34, I_MEM = 16 * 16, I_C1 = 32 * 8;
            constexpr int NIT = I_IN0 + 2 * I_OUT + I_KV + I_BIN + 2 * I_MEM + 2 * I_C1;
            for (int it = gw; it < NIT; it += ngw) {
                int r = it;
                if (r < I_IN0) { transpose_item(a_w_in, D, 1792, norm_mix, WIN0, 0, scr, r, lane); continue; } r -= I_IN0;
                if (r < I_OUT) { transpose_item(w_out, D, D, nullptr, WOUT, 0, scr, r, lane); continue; } r -= I_OUT;
                if (r < I_OUT) { transpose_item(w_out + (size_t)D * D, D, D, nullptr, WOUT + (size_t)D * D, 0, scr, r, lane); continue; } r -= I_OUT;
                if (r < I_KV) { transpose_item(w_kv_shared, D, 768, kv_norm, WKVB, 0, scr, r, lane); continue; } r -= I_KV;
                if (r < I_BIN) { transpose_item(b_w_in, D, 1060, norm_mix + D, WKVB, 768, scr, r, lane); continue; } r -= I_BIN;
                if (r < I_MEM) { transpose_item(w_mem_kv, D, 512, norm_mem, WMEM, 0, scr, r, lane); continue; } r -= I_MEM;
                if (r < I_MEM) { transpose_item(w_mem_kv + (size_t)D * 512, D, 512, norm_mem + D, WMEM, 512, scr, r, lane); continue; } r -= I_MEM;
                { const int j = r / I_C1, rq = r % I_C1, ks = rq >> 6;
                  transpose_item(cmp_w1 + ((size_t)j * 2048 + ks * 512) * 256, 512, 256, nullptr, WC1 + ((size_t)(j * 4 + ks) * 256) * 512, 0, scr, rq & 63, lane); }
            }
            for (int i = gtid; i < 220 * 1024 / 8; i += ngt) ((u32x4*)(WKVB + (size_t)1828 * 1024))[i] = (u32x4){0u, 0u, 0u, 0u};
        }
        SUBREP(3) for (int item = blockIdx.x; item < 2 * 16 * 2 * 4; item += gridDim.x) {
            const int nq = item & 3, kh = (item >> 2) & 1, hp = (item >> 3) & 15, l = item >> 7;
            const float* sk = peer_subkeys + (((size_t)l * 16 + hp) * 128 + nq * 32) * 128;
            __syncthreads();
            for (int i = tid; i < 32 * 128; i += NTHR) smem[i] = sk[i];
            __syncthreads();
            const int k = kh * 512 + tid;
            float* wst = smem + 4096 + wv * (64 * 36);
            const float* wqb = peer_wq + ((size_t)l * D + kh * 512 + wv * 64) * 2048 + hp * 128;
            float4 wr4[32];
#pragma unroll
            for (int c = 0; c < 4; ++c) {
                __builtin_amdgcn_wave_barrier();
#pragma unroll
                for (int j = 0; j < 8; ++j) { const float4 tq = *(const float4*)(wqb + (size_t)(8 * j + (lane >> 3)) * 2048 + 32 * c + 4 * (lane & 7));
                    *(float4*)(wst + (8 * j + (lane >> 3)) * 36 + 4 * (lane & 7)) = tq; }
                __builtin_amdgcn_wave_barrier();
#pragma unroll
                for (int i = 0; i < 8; ++i) wr4[8 * c + i] = *(const float4*)(wst + lane * 36 + 4 * i);
                __builtin_amdgcn_sched_barrier(0);
            }
            const float gk = norm_ffn[l * D + k];
#pragma unroll 1
            for (int n = 0; n < 32; ++n) {
                const float4* sr = (const float4*)(smem + n * 128);
                float acc = 0.f;
#pragma unroll
                for (int i = 0; i < 32; ++i) { const float4 s4 = sr[i]; acc += wr4[i].x * s4.x + wr4[i].y * s4.y + wr4[i].z * s4.z + wr4[i].w * s4.w;
                    if ((i & 7) == 7) __builtin_amdgcn_sched_barrier(0); }
                WFt[((size_t)l * 2048 + hp * 128 + nq * 32 + n) * 1024 + k] = (bf16)f2bf(acc * gk);
            }
        }
        for (int i = gtid; i < NBLK * 2 * 8 * 64; i += ngt) {
            const int ln = i & 63, ct = (i >> 6) & 7, ks = (i >> 9) & 1, n = i >> 10;
            const int col = 16 * ct + (ln & 15), gsel = col >> 6, e = col & 63;
            const float* wp = a_gate_w + ((size_t)(gsel * NBLK + n) * 64 + 32 * ks + 8 * (ln >> 4)) * 64 + e;
            const float nl2 = -1.4426950408889634f;
            u32x4 w; w.x = pk2(wp[0] * nl2, wp[64] * nl2); w.y = pk2(wp[128] * nl2, wp[192] * nl2); w.z = pk2(wp[256] * nl2, wp[320] * nl2); w.w = pk2(wp[384] * nl2, wp[448] * nl2);
            *(u32x4*)(WGF + (size_t)i * 8) = w;
        }
        for (int i = gtid; i < LRUW; i += ngt) {
            float* SGC = (float*)(ws + WS_SGC);
            const float lam = a_lambda[i];
            SGC[i] = -1.4426950408889634f * a_gate_b[i]; SGC[LRUW + i] = -1.4426950408889634f * a_gate_b[LRUW + i];
            SGC[2 * LRUW + i] = -8.0f * 1.4426950408889634f * ((-lam > 20.f) ? -lam : log1pf(expf(-lam)));
        }
        for (int i = gtid; i < 2 * 32 * 256; i += ngt) {
            const int c = i & 255, kc = (i >> 8) & 31, j = i >> 13;
            float acc = 0.f;
#pragma unroll 8
            for (int k = kc * 64; k < kc * 64 + 64; ++k) acc = fmaf(cmp_pos[j * 2048 + k], cmp_w1[((size_t)j * 2048 + k) * 256 + c], acc);
            BIAS2[1024 + i] = acc;
        }
        SUBREP(4) for (int l = 0; l < 2; ++l) {
            const int kk = (int)(((size_t)gtid * 16) & 1023);
            float4 gq[4];
#pragma unroll
            for (int q = 0; q < 4; ++q) gq[q] = *(const float4*)(norm_ffn + l * D + kk + 4 * q);
            const size_t lbase = (size_t)l * 16384 * 1024;
            for (size_t i = gtid; i < (size_t)16384 * 64; i += 2 * (size_t)ngt) {
                float4 a[2][4], v[2][4];
#pragma unroll
                for (int h = 0; h < 2; ++h) { const size_t e16 = lbase + (i + (size_t)h * ngt) * 16;
                    if (i + (size_t)h * ngt < (size_t)16384 * 64) {
#pragma unroll
                        for (int q = 0; q < 4; ++q) { a[h][q] = *(const float4*)(peer_u + e16 + 4 * q); v[h][q] = *(const float4*)(peer_v + e16 + 4 * q); } } }
#pragma unroll
                for (int h = 0; h < 2; ++h) { const size_t e16 = lbase + (i + (size_t)h * ngt) * 16;
                    if (i + (size_t)h * ngt < (size_t)16384 * 64) {
                        unsigned wu[4], wv4[4];
#pragma unroll
                        for (int q = 0; q < 4; ++q) { const float4 g = gq[q];
                            int w = 0; w = __builtin_amdgcn_cvt_pk_fp8_f32(a[h][q].x * g.x * 64.f, a[h][q].y * g.y * 64.f, w, false); w = __builtin_amdgcn_cvt_pk_fp8_f32(a[h][q].z * g.z * 64.f, a[h][q].w * g.w * 64.f, w, true); wu[q] = (unsigned)w;
                            int y = 0; y = __builtin_amdgcn_cvt_pk_fp8_f32(v[h][q].x * 8.f, v[h][q].y * 8.f, y, false); y = __builtin_amdgcn_cvt_pk_fp8_f32(v[h][q].z * 8.f, v[h][q].w * 8.f, y, true); wv4[q] = (unsigned)y; }
                        const size_t rel = e16 - lbase, dsto = lbase + ((rel & 1023) >> 7) * (size_t)(16384 * 128) + (rel >> 10) * 128 + (rel & 127);
                        *(u32x4*)(UT8 + dsto) = (u32x4){wu[0], wu[1], wu[2], wu[3]};
                        *(u32x4*)(VT8 + dsto) = (u32x4){wv4[0], wv4[1], wv4[2], wv4[3]}; } }
            }
        }
    PHASE_END

    PHASE_BEGIN
        { pg8::Gemm g{XB, WIN0, T, 1792, D}; pg8::StaticOrder So; So.init(T, 1792, G, (int)blockIdx.x);
          pg8::EpiRowScaleBf16 Ep{P, PP, rstd0, nullptr};
          pg8::gemm_phase<pg8::EpiRowScaleBf16, pg8::StaticOrder, true, PG8_SP2_ON>(ldsp, g, So, Ep, tid); }
        { pg8::Gemm g{MEMB, WMEM, NB * MEMN, 1024, D}; pg8::StaticOrder So; So.init(NB * MEMN, 1024, G, (int)((blockIdx.x + G / 2) % G));
          pg8::EpiRowScaleBf16 Ep{MEMKV, 1024, rstdm, nullptr};
          pg8::gemm_phase<pg8::EpiRowScaleBf16, pg8::StaticOrder, true, PG8_SP2_ON>(ldsp, g, So, Ep, tid); }
    PHASE_END

    PHASE_BEGIN
        scan_pass<false>(P, a_conv_w, a_conv_b, WGF, (const float*)(ws + WS_SGC), AGG, AIN, lds_raw + wv * 18864, tid);
        for (int item = gw; item < 2 * 4 * 256; item += ngw) {
            const int h = item & 3, grp = (item >> 2) & 255, l = item >> 10, row = grp * 8 + (lane >> 3), c8 = lane & 7, b = row >> 8, mm = row & 255;
            const u32x4 w = *(const u32x4*)(MEMKV + (size_t)row * 1024 + l * 512 + h * 64 + 8 * c8);
            const float4 ga = *(const float4*)(mem_k_gain + l * 64 + 8 * c8), gb = *(const float4*)(mem_k_gain + l * 64 + 8 * c8 + 4);
            float v[8] = {bflo(w.x), bfhi(w.x), bflo(w.y), bfhi(w.y), bflo(w.z), bfhi(w.z), bflo(w.w), bfhi(w.w)};
            float ss = 0.f;
#pragma unroll
            for (int i = 0; i < 8; ++i) ss += v[i] * v[i];
            ss += sxor<1>(ss); ss += sxor<2>(ss); ss += sxor<4>(ss);
            const float rs = rsqrtf(ss * (1.f / 64.f) + EPS);
            u32x4 o; o.x = pk2(v[0] * rs * ga.x, v[1] * rs * ga.y); o.y = pk2(v[2] * rs * ga.z, v[3] * rs * ga.w); o.z = pk2(v[4] * rs * gb.x, v[5] * rs * gb.y); o.w = pk2(v[6] * rs * gb.z, v[7] * rs * gb.w);
            *(u32x4*)(MEMK + ((size_t)((l * NB + b) * 4 + h) * 256 + mm) * 64 + 8 * c8) = o;
        }
        {
            bf16* tl = (bf16*)(lds_raw + wv * 18864);
            for (int item = gw; item < 2 * NB * 4 * 4; item += ngw) {
                const int kt = item & 3, h = (item >> 2) & 3, b = (item >> 4) & 7, l = item >> 7;
                const bf16* src = MEMKV + ((size_t)b * 256 + 64 * kt) * 1024 + l * 512 + 256 + h * 64;
#pragma unroll
                for (int i = 0; i < 8; ++i) {
                    const int key = 8 * i + (lane >> 3), c8 = lane & 7;
                    const u32x4 v = *(const u32x4*)(src + (size_t)key * 1024 + 8 * c8);
                    bf16* tp = tl + (8 * c8) * 72 + key;
                    tp[0 * 72] = (bf16)(v.x & 0xffffu); tp[1 * 72] = (bf16)(v.x >> 16); tp[2 * 72] = (bf16)(v.y & 0xffffu); tp[3 * 72] = (bf16)(v.y >> 16);
                    tp[4 * 72] = (bf16)(v.z & 0xffffu); tp[5 * 72] = (bf16)(v.z >> 16); tp[6 * 72] = (bf16)(v.w & 0xffffu); tp[7 * 72] = (bf16)(v.w >> 16);
                }
                __builtin_amdgcn_s_waitcnt(0); __builtin_amdgcn_wave_barrier();
                bf16* dst = MEMVT + ((size_t)(((l * NB + b) * 4 + h) * 4 + kt)) * 4096;
#pragma unroll
                for (int jq = 0; jq < 8; ++jq) {
                    const int d = 8 * jq + (lane >> 3), c8 = lane & 7;
                    *(u32x4*)(dst + d * 64 + 8 * c8) = *(const u32x4*)(tl + d * 72 + 8 * c8);
                }
                __builtin_amdgcn_s_waitcnt(0); __builtin_amdgcn_wave_barrier();
            }
        }
    PHASE_END

    PHASE_BEGIN
        scan_pass<true>(P, a_conv_w, a_conv_b, WGF, (const float*)(ws + WS_SGC), AGG, AIN, lds_raw + wv * 18864, tid);
        __syncthreads();
        {
            const float Mm = __builtin_bit_cast(float, __builtin_amdgcn_readfirstlane(__builtin_bit_cast(int, att::SBOUND * wave_max(fabsf(mem_q_gain[lane])) * wave_max(fabsf(mem_k_gain[lane])))));
            if (Mm <= 40.f) att::mem_attention_mfma<true>(P, 1536, MEMK, MEMVT, mem_q_gain, AIN, lds_raw, tid, Mm);
            else att::mem_attention_mfma<false>(P, 1536, MEMK, MEMVT, mem_q_gain, AIN, lds_raw, tid, 0.f);
        }
    PHASE_END

    PHASE_BEGIN
        { pg8::Gemm g{AIN, WOUT, T, D, D}; pg8::StaticOrder So; So.init(T, D, G, (int)blockIdx.x);
          pg8::EpiResidual Ep{XB, sumsq1};
          pg8::gemm_phase<pg8::EpiResidual, pg8::StaticOrder, true, PG8_SP2_ON>(ldsp, g, So, Ep, tid); }
    PHASE_END

    PHASE_BEGIN
        for (int tile = blockIdx.x; tile < (T / 256) * 8; tile += gridDim.x) {
            int pm, pn;
            if ((gridDim.x & 255) == 0) { const int rr = tile / (int)gridDim.x, bb = tile % (int)gridDim.x, xq = bb & 7, sl = bb >> 3, per = (int)gridDim.x >> 6;
                pm = (rr * 8 + xq) * per + (sl >> 3); pn = sl & 7; }
            else { pm = tile >> 3; pn = tile & 7; }
            const int tidt = wave_s__ * 64 + lane_now();
            pg8::Gemm g{XB, WFt, T, 2048, D}; pg8::OneUnit So; So.u.pm = pm; So.u.pn = pn;
            pg8::EpiTopK Ep{sumsq1, E, Gt};
            pg8::gemm_phase<pg8::EpiTopK, pg8::OneUnit, false, PG8_SP2_ON>(ldsp, g, So, Ep, tidt);
        }
    PHASE_END

    PHASE_BEGIN
        SLICE_COORDS(); peer_u_partial(XB, UT8, E, PART, lds_raw + wv * (G_SLOTS * 1024), tid, sl_xs, sl_r, sl_nr);
    PHASE_END
    PHASE_BEGIN
        peer_act(PART, sumsq1, Gt, tid);
    PHASE_END
    PHASE_BEGIN
        SLICE_COORDS(); peer_v_slice(nullptr, XB, VT8, E, Gt, sumsq2, rep__ == 0, lds_raw + wv * (G_SLOTS * 1024), tid, sl_xs, sl_r, sl_nr);
    PHASE_END

    PHASE_BEGIN
        for (int i = gtid; i < 512; i += ngt) {
            const int j = i >> 8, c = i & 255;
            float acc = cmp_b1[i];
            for (int kc = 0; kc < 32; ++kc) acc += BIAS2[1024 + (j * 32 + kc) * 256 + c];
            BIAS2[i] = acc;
        }
        { pg8::Gemm g{XB, WKVB, T, 2048, D}; pg8::StaticOrder So; So.init(T, 2048, G, (int)blockIdx.x);
          pg8::EpiRowScaleBf16 Ep{P, PP, nullptr, sumsq2};
          pg8::gemm_phase<pg8::EpiRowScaleBf16, pg8::StaticOrder, true, PG8_SP2_ON>(ldsp, g, So, Ep, tid); }
    PHASE_END

    PHASE_BEGIN
        if (blockIdx.x < 128) {
            const int j = blockIdx.x >> 6, ks = (blockIdx.x >> 4) & 3, pm = blockIdx.x & 15;
            bf16* CAq = CA + (size_t)(j * 4 + ks) * 4096 * 512;
            for (int i0 = tid; i0 < 256 * 64; i0 += 8 * NTHR) {
                u32x4 v[8];
#pragma unroll
                for (int q = 0; q < 8; ++q) { const int i = i0 + q * NTHR;
                    const int d8 = i & 7, l8 = (i >> 3) & 7, r = 256 * pm + (i >> 6);
                    v[q] = (u32x4){0u, 0u, 0u, 0u};
                    if (r < 4080) { const int g = r & 1, bn = r >> 1, b = bn / NCMP, n = bn % NCMP;
                        v[q] = *(const u32x4*)(P + (size_t)(b * S + 16 * n + 8 * ks + l8) * PP + j * 128 + g * 64 + d8 * 8); } }
#pragma unroll
                for (int q = 0; q < 8; ++q) { const int i = i0 + q * NTHR;
                    const int d8 = i & 7, l8 = (i >> 3) & 7, r = 256 * pm + (i >> 6);
                    *(u32x4*)(CAq + (size_t)r * 512 + l8 * 64 + d8 * 8) = v[q]; }
            }
            __syncthreads();
            pg8::Gemm g{CAq, WC1 + (size_t)(j * 4 + ks) * 256 * 512, 4096, 256, 512}; pg8::OneUnit So; So.u.pm = pm; So.u.pn = 0;
            pg8::EpiPartF32 Ep{(float*)(ws + WS_HP) + (size_t)(j * 4 + ks) * 4096 * 256, 256};
            pg8::gemm_phase<pg8::EpiPartF32, pg8::OneUnit, false, PG8_SP2_ON>(ldsp, g, So, Ep, tid);
        } else {
            const int b0 = 128;
            const int gw2 = (blockIdx.x - b0) * (NTHR / 64) + wv, ngw2 = (G - b0) * (NTHR / 64);
            for (int item0 = gw2; item0 < (T / 8) * 4; item0 += 2 * ngw2) {
                u32x4 wq[2];
#pragma unroll
                for (int hh = 0; hh < 2; ++hh) { const int item = item0 + hh * ngw2;
                    if (item < (T / 8) * 4) { const int g = item & 1, br = 1 + ((item >> 1) & 1), row = (item >> 2) * 8 + (lane >> 3), c8 = lane & 7;
                        wq[hh] = *(const u32x4*)(P + (size_t)row * PP + br * 256 + g * 64 + 8 * c8); } }
#pragma unroll
                for (int hh = 0; hh < 2; ++hh) { const int item = item0 + hh * ngw2;
                  if (item < (T / 8) * 4) {
                const int g = item & 1, br = 1 + ((item >> 1) & 1), row = (item >> 2) * 8 + (lane >> 3), c8 = lane & 7;
                const int b = row / S, s = row % S;
                const u32x4 w = wq[hh];
                const float4 ga = *(const float4*)(k_gain_shared + br * 64 + 8 * c8), gb = *(const float4*)(k_gain_shared + br * 64 + 8 * c8 + 4);
                const float4 csa = *(const float4*)(ROPE + s * 16), csb = *(const float4*)(ROPE + s * 16 + 4), sna = *(const float4*)(ROPE + s * 16 + 8), snb = *(const float4*)(ROPE + s * 16 + 12);
                float v[8] = {bflo(w.x), bfhi(w.x), bflo(w.y), bfhi(w.y), bflo(w.z), bfhi(w.z), bflo(w.w), bfhi(w.w)};
                float ss = 0.f;
#pragma unroll
                for (int i = 0; i < 8; ++i) ss += v[i] * v[i];
                ss += sxor<1>(ss); ss += sxor<2>(ss); ss += sxor<4>(ss);
                const float rs = rsqrtf(ss * (1.f / 64.f) + EPS);
                const float gg[8] = {ga.x, ga.y, ga.z, ga.w, gb.x, gb.y, gb.z, gb.w};
                const float cs[8] = {csa.x, csa.y, csa.z, csa.w, csb.x, csb.y, csb.z, csb.w}, sn[8] = {sna.x, sna.y, sna.z, sna.w, snb.x, snb.y, snb.z, snb.w};
#pragma unroll
                for (int i = 0; i < 8; ++i) {
                    v[i] = v[i] * rs * gg[i];
                    const float partner = sxor<1>(v[i]);
                    if (c8 == 0) v[i] = v[i] * cs[i] - partner * sn[i];
                    else if (c8 == 1) v[i] = v[i] * cs[i] + partner * sn[i];
                }
                bf16* dst = (br == 1) ? KS : KW;
                u32x4 o; o.x = pk2(v[0], v[1]); o.y = pk2(v[2], v[3]); o.z = pk2(v[4], v[5]); o.w = pk2(v[6], v[7]);
                *(u32x4*)(dst + ((size_t)(b * 2 + g) * S + s) * 64 + 8 * c8) = o;
                  } }
            }
            {
                bf16* tl = (bf16*)(lds_raw + wv * 9216);
                for (int item = gw2; item < 2 * NB * 2 * 64; item += ngw2) {
                    const int blk = item & 63, g = (item >> 6) & 1, b = (item >> 7) & 7, br = 1 + (item >> 10);
                    const bf16* src = P + ((size_t)b * S + 64 * blk) * PP + br * 256 + 128 + g * 64;
#pragma unroll
                    for (int i = 0; i < 8; ++i) {
                        const int key = 8 * i + (lane >> 3), c8 = lane & 7;
                        const u32x4 v = *(const u32x4*)(src + (size_t)key * PP + 8 * c8);
                        bf16* tp = tl + (8 * c8) * 72 + key;
                        tp[0 * 72] = (bf16)(v.x & 0xffffu); tp[1 * 72] = (bf16)(v.x >> 16); tp[2 * 72] = (bf16)(v.y & 0xffffu); tp[3 * 72] = (bf16)(v.y >> 16);
                        tp[4 * 72] = (bf16)(v.z & 0xffffu); tp[5 * 72] = (bf16)(v.z >> 16); tp[6 * 72] = (bf16)(v.w & 0xffffu); tp[7 * 72] = (bf16)(v.w >> 16);
                    }
                    __builtin_amdgcn_s_waitcnt(0); __builtin_amdgcn_wave_barrier();
                    bf16* dst = ((br == 1) ? VST : VWT) + ((size_t)((b * 2 + g) * 64 + blk)) * 4096;
#pragma unroll
                    for (int jq = 0; jq < 8; ++jq) {
                        const int d = 8 * jq + (lane >> 3), c8 = lane & 7;
                        *(u32x4*)(dst + d * 64 + 8 * c8) = *(const u32x4*)(tl + d * 72 + 8 * c8);
                    }
                    __builtin_amdgcn_s_waitcnt(0); __builtin_amdgcn_wave_barrier();
                }
            }
        }
    PHASE_END

    PHASE_BEGIN
        for (int i = gtid; i < NB * 2 * 64; i += ngt) VC[((size_t)((i >> 6) * 4 + 3)) * 4096 + (i & 63) * 64 + 63] = (bf16)0;
        for (int i0 = tid; i0 < 2 * 256 * 16; i0 += 8 * NTHR) {
            float4 v[8];
#pragma unroll
            for (int q = 0; q < 8; ++q) { const int i = i0 + q * NTHR, n4 = i & 15, cc = (i >> 4) & 255, j = i >> 12;
                v[q] = *(const float4*)(cmp_w2 + ((size_t)j * 256 + cc) * 64 + 4 * n4); }
#pragma unroll
            for (int q = 0; q < 8; ++q) { const int i = i0 + q * NTHR, n4 = i & 15, cc = (i >> 4) & 255, j = i >> 12;
                float* d = smem + ((j * 64 + (cc >> 2)) * 64 + 4 * n4) * 4 + (cc & 3);
                d[0] = v[q].x; d[4] = v[q].y; d[8] = v[q].z; d[12] = v[q].w; }
        }
        __syncthreads();
        for (int item = gw; item < 2 * 4080; item += ngw) {
            const int j = item / 4080, it = item % 4080, g = it & 1, bn = it >> 1, b = bn / NCMP, n = bn % NCMP;
            float* hb = smem + 32768 + wv * 256;
            { const float* hpp = (const float*)(ws + WS_HP) + ((size_t)(j * 4) * 4096 + it) * 256 + 4 * lane;
              const float4 p0 = *(const float4*)hpp, p1 = *(const float4*)(hpp + (size_t)4096 * 256), p2 = *(const float4*)(hpp + (size_t)2 * 4096 * 256), p3 = *(const float4*)(hpp + (size_t)3 * 4096 * 256);
              const float4 bb = *(const float4*)(BIAS2 + j * 256 + 4 * lane);
              __builtin_amdgcn_wave_barrier();
              *(float4*)(hb + 4 * lane) = make_float4(gelu_tanh(((p0.x + p1.x) + (p2.x + p3.x)) + bb.x), gelu_tanh(((p0.y + p1.y) + (p2.y + p3.y)) + bb.y),
                                                      gelu_tanh(((p0.z + p1.z) + (p2.z + p3.z)) + bb.z), gelu_tanh(((p0.w + p1.w) + (p2.w + p3.w)) + bb.w));
              __builtin_amdgcn_wave_barrier(); }
            const float* wj = smem + (size_t)j * 16384 + lane * 4;
            float a0 = 0.f, a1 = 0.f, a2 = 0.f, a3 = 0.f;
#pragma unroll 8
            for (int c4 = 0; c4 < 64; ++c4) { const float4 h4 = *(const float4*)(hb + 4 * c4), w4 = *(const float4*)(wj + c4 * 256);
                a0 = fmaf(h4.x, w4.x, a0); a1 = fmaf(h4.y, w4.y, a1); a2 = fmaf(h4.z, w4.z, a2); a3 = fmaf(h4.w, w4.w, a3); }
            const float acc = (a0 + a1) + (a2 + a3);
            if (j == 0) {
                const float ss = wave_sum(acc * acc);
                float v = acc * rsqrtf(ss * (1.f / 64.f) + EPS) * k_gain_shared[0 * 64 + lane];
                const float partner = sxor<8>(v);
                const int sp = 16 * n + 31;
                if (lane < 16) { const int i = lane & 7; const float cs = ROPE[sp * 16 + i], sn = ROPE[sp * 16 + 8 + i];
                    v = (lane < 8) ? (v * cs - partner * sn) : (v * cs + partner * sn); }
                KC[((size_t)(b * 2 + g) * 256 + n) * 64 + lane] = (bf16)f2bf(v);
            } else {
                VC[((size_t)((b * 2 + g) * 4 + (n >> 6))) * 4096 + lane * 64 + (n & 63)] = (bf16)f2bf(acc);
            }
        }
    PHASE_END

    PHASE_BEGIN
        {
#define UNIF(x) __builtin_bit_cast(float, __builtin_amdgcn_readfirstlane(__builtin_bit_cast(int, (x))))
            const float Gq = wave_max(fabsf(b_q_gain[lane]));
            const float Mc = UNIF(att::SBOUND * Gq * wave_max(fabsf(k_gain_shared[lane]))), Ms = UNIF(att::SBOUND * Gq * wave_max(fabsf(k_gain_shared[64 + lane]))), Mw = UNIF(att::SBOUND * Gq * wave_max(fabsf(k_gain_shared[128 + lane])));
#ifdef PROBE_VAR
            if (rep__ == 0) att::nsa_attention_mfma<true, PROBE_VAR>(P, KC, VC, KS, VST, KW, VWT, ROPE, b_q_gain, b_gate_b, AIN, lds_raw, tid, Mc, Ms, Mw); else
#endif
            if (fmaxf(Mc, fmaxf(Ms, Mw)) <= 40.f) att::nsa_attention_mfma<true>(P, KC, VC, KS, VST, KW, VWT, ROPE, b_q_gain, b_gate_b, AIN, lds_raw, tid, Mc, Ms, Mw);
            else att::nsa_attention_mfma<false>(P, KC, VC, KS, VST, KW, VWT, ROPE, b_q_gain, b_gate_b, AIN, lds_raw, tid, 0.f, 0.f, 0.f);
            const float Mm = UNIF(att::SBOUND * wave_max(fabsf(mem_q_gain[64 + lane])) * wave_max(fabsf(mem_k_gain[64 + lane])));
            SUBREP(5) {
                if (Mm <= 40.f) att::mem_attention_mfma<true>(P, 1572, MEMK + (size_t)NB * 4 * 256 * 64, MEMVT + (size_t)NB * 4 * 256 * 64, mem_q_gain + 64, AIN, lds_raw, tid, Mm);
                else att::mem_attention_mfma<false>(P, 1572, MEMK + (size_t)NB * 4 * 256 * 64, MEMVT + (size_t)NB * 4 * 256 * 64, mem_q_gain + 64, AIN, lds_raw, tid, 0.f);
            }
        }
    PHASE_END

    PHASE_BEGIN
        { pg8::Gemm g{AIN, WOUT + (size_t)D * D, T, D, D}; pg8::StaticOrder So; So.init(T, D, G, (int)blockIdx.x);
          pg8::EpiResidual Ep{XB, sumsq3};
          pg8::gemm_phase<pg8::EpiResidual, pg8::StaticOrder, true, PG8_SP2_ON>(ldsp, g, So, Ep, tid); }
    PHASE_END

    PHASE_BEGIN
        for (int tile = blockIdx.x; tile < (T / 256) * 8; tile += gridDim.x) {
            int pm, pn;
            if ((gridDim.x & 255) == 0) { const int rr = tile / (int)gridDim.x, bb = tile % (int)gridDim.x, xq = bb & 7, sl = bb >> 3, per = (int)gridDim.x >> 6;
                pm = (rr * 8 + xq) * per + (sl >> 3); pn = sl & 7; }
            else { pm = tile >> 3; pn = tile & 7; }
            const int tidt = wave_s__ * 64 + lane_now();
            pg8::Gemm g{XB, WFt + (size_t)2048 * 1024, T, 2048, D}; pg8::OneUnit So; So.u.pm = pm; So.u.pn = pn;
            pg8::EpiTopK Ep{sumsq3, E, Gt};
            pg8::gemm_phase<pg8::EpiTopK, pg8::OneUnit, false, PG8_SP2_ON>(ldsp, g, So, Ep, tidt);
        }
    PHASE_END

    PHASE_BEGIN
        SLICE_COORDS(); peer_u_partial(XB, UT8 + (size_t)16384 * 1024, E, PART, lds_raw + wv * (G_SLOTS * 1024), tid, sl_xs, sl_r, sl_nr);
    PHASE_END
    PHASE_BEGIN
        peer_act(PART, sumsq3, Gt, tid);
    PHASE_END
    PHASE_BEGIN
        SLICE_COORDS(); peer_v_slice(out, XB, VT8 + (size_t)16384 * 1024, E, Gt, nullptr, rep__ == 0, lds_raw + wv * (G_SLOTS * 1024), tid, sl_xs, sl_r, sl_nr);
    PHASE_END
#undef PHASE_BEGIN
#undef PHASE_END
}

#ifndef N_LAUNCH_MODE
#define N_LAUNCH_MODE 1
#endif
template <int PH>
static void launch_phases(const Params& p, int grid, hipStream_t stream) {
    if constexpr (PH < N_PHASES) {
        static bool attr_set = false;
        if (!attr_set) { (void)hipFuncSetAttribute((const void*)fwd_kernel<PH, PH + 1>, hipFuncAttributeMaxDynamicSharedMemorySize, LDS_BYTES); attr_set = true; }
        hipLaunchKernelGGL((fwd_kernel<PH, PH + 1>), dim3(grid), dim3(NTHR), LDS_BYTES, stream, p);
        launch_phases<PH + 1>(p, grid, stream);
    }
}

extern "C" void kernel_launch(void* const* d_in, const int* in_sizes, int n_in, void* d_out, int out_size, void* d_ws, size_t ws_size, hipStream_t stream) {
    static int grid = 0;
    if (grid == 0) {
        if (n_in != 30 || out_size != T * D || ws_size < WS_END) { fprintf(stderr, "kernel_launch: unexpected shapes n_in %d out %d ws %zu\n", n_in, out_size, ws_size); grid = -1; return; }
        int dev = 0, cus = 0, per_cu = 0;
        (void)hipGetDevice(&dev);
        (void)hipDeviceGetAttribute(&cus, hipDeviceAttributeMultiprocessorCount, dev);
#if N_LAUNCH_MODE == 1
        if (hipFuncSetAttribute((const void*)fwd_kernel<0, N_PHASES>, hipFuncAttributeMaxDynamicSharedMemorySize, LDS_BYTES) != hipSuccess) { fprintf(stderr, "kernel_launch: hipFuncSetAttribute failed\n"); grid = -1; return; }
        if (hipOccupancyMaxActiveBlocksPerMultiprocessor(&per_cu, (const void*)fwd_kernel<0, N_PHASES>, NTHR, LDS_BYTES) != hipSuccess || per_cu < 1) { fprintf(stderr, "kernel_launch: occupancy query says %d\n", per_cu); grid = -1; return; }
        if (cus < 160) { fprintf(stderr, "kernel_launch: this kernel needs at least 160 CUs (got %d)\n", cus); grid = -1; return; }
        grid = cus;
#else
        grid = cus > 0 ? cus : 256;
#endif
    }
    if (grid < 0) return;
    Params p{};
    for (int i = 0; i < 30; ++i) p.in[i] = (const float*)d_in[i];
    p.out = (float*)d_out; p.ws = (unsigned char*)d_ws; p.ph_lo = 0; p.ph_hi = N_PHASES;
#if N_LAUNCH_MODE == 1
    if (hipMemsetAsync((char*)d_ws + WS_CTL, 0, 65536, stream) != hipSuccess) { fprintf(stderr, "kernel_launch: hipMemsetAsync failed\n"); return; }
    void* args[] = {&p};
    hipError_t e = hipLaunchCooperativeKernel((const void*)fwd_kernel<0, N_PHASES>, dim3(grid), dim3(NTHR), args, LDS_BYTES, stream);
    if (e != hipSuccess) fprintf(stderr, "cooperative launch failed: %s (grid %d)\n", hipGetErrorString(e), grid);
#else
    launch_phases<0>(p, grid, stream);
#endif
}
```

```cpp
#include <hip/hip_runtime.h>
#include <hip/hip_cooperative_groups.h>
#include <cstdio>
#include <cstdint>
namespace cg = cooperative_groups;

constexpr int NB = 8, S = 4096, D = 1024, T = NB * S;
constexpr int MEMN = 256;
constexpr int LRUW = 768, NBLK = 12;
constexpr int NCMP = 255;
constexpr int PP = 2048;
constexpr int NTHR = 512;
constexpr float EPS = 1e-6f;
constexpr int NCHUNK = 64, CHL = 64;

typedef unsigned short bf16;
typedef unsigned u32x4 __attribute__((ext_vector_type(4)));
typedef unsigned u32x2 __attribute__((ext_vector_type(2)));
typedef __bf16 bf16x2_t __attribute__((ext_vector_type(2)));
typedef __bf16 bf16x8_t __attribute__((ext_vector_type(8)));
#define LAS __attribute__((address_space(3)))

constexpr size_t MiB = 1ull << 20;
constexpr size_t WS_CTL = 0;
constexpr size_t WS_RSTD = 1 * MiB;
constexpr size_t WS_ROPE = 2 * MiB;
constexpr size_t WS_BIAS2 = 2 * MiB + 512 * 1024;
constexpr size_t WS_WGF = 2 * MiB + 768 * 1024;
constexpr size_t WS_SGC = 2 * MiB + 968 * 1024;
constexpr size_t WS_WIN0 = 3 * MiB;
constexpr size_t WS_WOUT = 7 * MiB;
constexpr size_t WS_WF = 11 * MiB;
constexpr size_t WS_WKVB = 19 * MiB;
constexpr size_t WS_WMEM = 23 * MiB;
constexpr size_t WS_WC1 = 25 * MiB;
constexpr size_t WS_MEMB = 27 * MiB;
constexpr size_t WS_MEMKV = 31 * MiB;
constexpr size_t WS_SSQ1 = 35 * MiB;
constexpr size_t WS_SSQ3 = 37 * MiB;
constexpr size_t WS_SCAN = 39 * MiB;
constexpr size_t WS_HID = 42 * MiB;
constexpr size_t WS_KC = 46 * MiB;
constexpr size_t WS_VC = 47 * MiB;
constexpr size_t WS_CA = 48 * MiB;
constexpr size_t WS_E = 80 * MiB;
constexpr size_t WS_GT = 96 * MiB;
constexpr size_t WS_KS = 80 * MiB;
constexpr size_t WS_KW = 88 * MiB;
constexpr size_t WS_VST = 96 * MiB;
constexpr size_t WS_VWT = 104 * MiB;
constexpr size_t WS_XB = 112 * MiB;
constexpr size_t WS_HP = 176 * MiB;
constexpr size_t WS_AIN = 176 * MiB;
constexpr size_t WS_P = 240 * MiB;
constexpr size_t WS_UT = 368 * MiB;
constexpr size_t WS_VT = 400 * MiB;
constexpr size_t WS_SSQ2 = 432 * MiB;
constexpr size_t WS_MEMK = 496 * MiB;
constexpr size_t WS_MEMVT = 498 * MiB;
constexpr size_t WS_END = 500 * MiB;

struct Params {
    const float* in[30];
    float* out;
    unsigned char* ws;
    int ph_lo, ph_hi;
};

#define AS1 __attribute__((address_space(1)))
template <typename TT> __device__ __forceinline__ const AS1 TT* gptr(const TT* p) { return (const AS1 TT*)p; }
template <typename TT> __device__ __forceinline__ AS1 TT* gptr(TT* p) { return (AS1 TT*)p; }
__device__ __forceinline__ int lane_now() { int l; asm volatile("v_mbcnt_lo_u32_b32 %0, -1, 0\n\tv_mbcnt_hi_u32_b32 %0, -1, %0" : "=v"(l)); return l; }
template <int M> __device__ __forceinline__ float sxor(float v) {
    if constexpr (M < 32) return __builtin_bit_cast(float, __builtin_amdgcn_ds_swizzle(__builtin_bit_cast(int, v), (M << 10) | 0x1f));
    else { const int l = lane_now();
           return __builtin_bit_cast(float, __builtin_amdgcn_ds_bpermute((l ^ 32) << 2, __builtin_bit_cast(int, v))); }
}
__device__ __forceinline__ float half_sum(float v) { v += sxor<1>(v); v += sxor<2>(v); v += sxor<4>(v); v += sxor<8>(v); v += sxor<16>(v); return v; }
__device__ __forceinline__ float half_max(float v) { v = fmaxf(v, sxor<1>(v)); v = fmaxf(v, sxor<2>(v)); v = fmaxf(v, sxor<4>(v)); v = fmaxf(v, sxor<8>(v)); v = fmaxf(v, sxor<16>(v)); return v; }
__device__ __forceinline__ float wave_sum(float v) { v = half_sum(v); v += sxor<32>(v); return v; }
__device__ __forceinline__ float wave_max(float v) { v = half_max(v); v = fmaxf(v, sxor<32>(v)); return v; }
__device__ __forceinline__ float gelu_tanh(float x) {
    const float c0 = -2.f * 0.7978845608028654f * 1.4426950408889634f, c1 = c0 * 0.044715f;
    const float e = __builtin_amdgcn_exp2f(x * (c0 + c1 * x * x));
    return x * __builtin_amdgcn_rcpf(1.f + e);
}
__device__ __forceinline__ float sigmoidf_(float x) { return __builtin_amdgcn_rcpf(1.f + __builtin_amdgcn_exp2f(x * -1.4426950408889634f)); }
typedef float f32x2_t __attribute__((ext_vector_type(2)));
__device__ __forceinline__ unsigned pk2(float lo, float hi) { const f32x2_t v = {lo, hi}; return __builtin_bit_cast(unsigned, __builtin_convertvector(v, bf16x2_t)); }
__device__ __forceinline__ unsigned f2bf(float f) { return pk2(f, f) & 0xffffu; }
__device__ __forceinline__ float bf2f(unsigned h) { return __builtin_bit_cast(float, h << 16); }
__device__ __forceinline__ float bflo(unsigned w) { return __builtin_bit_cast(float, w << 16); }
__device__ __forceinline__ float bfhi(unsigned w) { return __builtin_bit_cast(float, w & 0xffff0000u); }
__device__ __forceinline__ float ldbf(const bf16* p) { return bf2f((unsigned)*p); }
__device__ __forceinline__ const void* lds_ptr_uniform(const __attribute__((address_space(3))) unsigned char* a) {
    const u32x2 w = *(const __attribute__((address_space(3))) u32x2*)a;
    const unsigned lo = __builtin_amdgcn_readfirstlane(w.x), hi = __builtin_amdgcn_readfirstlane(w.y);
    return (const void*)(((unsigned long long)hi << 32) | lo);
}
__device__ __forceinline__ float rstd_from_parts(const float* ssq16) {
    const float4 a = ((const float4*)ssq16)[0], b = ((const float4*)ssq16)[1], c = ((const float4*)ssq16)[2], d = ((const float4*)ssq16)[3];
    const float s = ((a.x + a.y) + (a.z + a.w)) + ((b.x + b.y) + (b.z + b.w)) + ((c.x + c.y) + (c.z + c.w)) + ((d.x + d.y) + (d.z + d.w));
    return rsqrtf(s * (1.f / 1024.f) + EPS);
}
namespace pg8 {
#define PG8_LAS __attribute__((address_space(3)))
typedef unsigned short bf16_t;
typedef short bf16x8 __attribute__((ext_vector_type(8)));
typedef float f32x4 __attribute__((ext_vector_type(4)));
typedef unsigned u32x4 __attribute__((ext_vector_type(4)));
constexpr int BM = 256, BK = 64, HALF = 128, HTB = HALF * BK * 2  , STAGE_BYTES = 8 * HTB, NXCD = 8, WGM = 8;

__host__ __device__ __forceinline__ int lds_byte(int r, int c) { const int st = (r >> 4) * 2 + (c >> 5), rr = r & 15, cc = c & 31, ob = rr * 64 + cc * 2; return st * 1024 + (ob ^ (((ob >> 9) & 1) << 5)); }
__host__ __device__ __forceinline__ void stage_rc(int b, int& R, int& C) { const int st = b / 1024, sb = b % 1024, swz = sb ^ (((sb >> 9) & 1) << 5); R = (st >> 1) * 16 + swz / 64; C = (st & 1) * 32 + (swz % 64) / 2; }
__host__ __device__ __forceinline__ int perm32(int rho) { const int n = rho >> 4, i = rho & 15; return 8 * (i >> 2) + 4 * n + (i & 3); }

struct Unit { int pm, pn; };
struct Gemm { const bf16_t* A; const bf16_t* Bt; int M, N, K; };

struct StaticOrder {
    int nM, nN, nwg, G, c;
    __host__ __device__ void init(int M, int N, int G_, int c_) { nM = M / BM; nN = N / BM; nwg = nM * nN; G = G_; c = c_; }
    __host__ __device__ bool next(int i, Unit& u) const {
        const long L = (long)i * G + c; if (L >= nwg) return false;
        int wgid = (int)L; { const int q = nwg / NXCD, r = nwg % NXCD, xcd = wgid % NXCD, off = wgid / NXCD; wgid = (xcd < r ? xcd * (q + 1) : r * (q + 1) + (xcd - r) * q) + off; }
        const int nig = WGM * nN, gid = wgid / nig, fm = gid * WGM, gsz = (nM - fm) < WGM ? (nM - fm) : WGM;
        u.pm = fm + ((wgid % nig) % gsz); u.pn = (wgid % nig) / gsz; return true;
    }
    __device__ __forceinline__ void a_ready(const Unit&) const {}
    __device__ __forceinline__ void done(const Unit&) const {}
};

__device__ __forceinline__ unsigned cvt_pk_bf16(float lo, float hi) { return ::pk2(lo, hi); }
typedef float f32x2 __attribute__((ext_vector_type(2)));
template <class Epi, class Sched, bool ALIGN_EPI = false, bool SP2 = false>
__device__ __forceinline__ void gemm_phase(PG8_LAS unsigned char* lds, const Gemm g, const Sched& S, const Epi& E, const int tid) {
    const int wid = __builtin_amdgcn_readfirstlane(tid >> 6), lane = tid & 63, wr = wid >> 2, wc = wid & 3, fr = lane & 15, fq = lane >> 4;
    const int K = g.K, nt = K / BK;
    unsigned voffA[2], voffB[2];
#pragma unroll
    for (int i = 0; i < 2; ++i) { int R, C; stage_rc(tid * 16 + i * 8192, R, C); const int Rb = Epi::PERM ? ((R & ~31) + perm32(R & 31)) : R;
        voffA[i] = (unsigned)(R * K + C) * 2u; voffB[i] = (unsigned)(Rb * K + C) * 2u; }
    const size_t kstep = (size_t)(BK * 2);
    const size_t hstep = (size_t)HALF * K * 2;
    const size_t tstep = 2 * hstep;
    const unsigned ldsw = (unsigned)wid * 1024u;
    const int aoff = lds_byte(wr * 64 + fr, fq * 8), boff = lds_byte(wc * 32 + fr, fq * 8);
#define PG8_SA(b, h) (((b) * 2 + (h)) * HTB)
#define PG8_SB(b, h) ((4 + (b) * 2 + (h)) * HTB)
#define PG8_STAGE(bufoff, gbase, voff) do { _Pragma("unroll") for (int _i = 0; _i < 2; ++_i) \
        __builtin_amdgcn_global_load_lds((const unsigned*)((const char*)(gbase) + (voff)[_i]), (PG8_LAS unsigned*)(lds + (bufoff) + ldsw + _i * 8192), 16, 0, 0); } while (0)
#define PG8_LDA(dst, b, h) do { _Pragma("unroll") for (int m = 0; m < 4; ++m) _Pragma("unroll") for (int k = 0; k < 2; ++k) dst[m][k] = *(const PG8_LAS bf16x8*)(lds + PG8_SA(b, h) + aoff + m * 2048 + k * 1024); } while (0)
#define PG8_LDB(dst, b, h) do { _Pragma("unroll") for (int n = 0; n < 2; ++n) _Pragma("unroll") for (int k = 0; k < 2; ++k) dst[n][k] = *(const PG8_LAS bf16x8*)(lds + PG8_SB(b, h) + boff + n * 2048 + k * 1024); } while (0)
#define PG8_MMA(ai, bj, At, Bt) do { __builtin_amdgcn_s_setprio(1); _Pragma("unroll") for (int m = 0; m < 4; ++m) _Pragma("unroll") for (int n = 0; n < 2; ++n) _Pragma("unroll") for (int k = 0; k < 2; ++k) \
        acc[ai][bj][m][n] = __builtin_amdgcn_mfma_f32_16x16x32_bf16(Bt[n][k], At[m][k], acc[ai][bj][m][n], 0, 0, 0); __builtin_amdgcn_s_setprio(0); } while (0)
#define PG8_WAIT_V(n) asm volatile("s_waitcnt vmcnt(" #n ")" ::: "memory")
#define PG8_WAIT_L(n) asm volatile("s_waitcnt lgkmcnt(" #n ")" ::: "memory")
#define PG8_BAR __builtin_amdgcn_s_barrier()
#define PG8_SCHED __builtin_amdgcn_sched_barrier(0)
    Unit cur, nxt; int ui = 0;
    if (!S.next(0, cur)) return;
    f32x4 acc[2][2][4][2];
#pragma unroll
    for (int a = 0; a < 2; ++a)
#pragma unroll
        for (int b = 0; b < 2; ++b)
#pragma unroll
            for (int m = 0; m < 4; ++m)
#pragma unroll
                for (int n = 0; n < 2; ++n) acc[a][b][m][n] = (f32x4){0.f, 0.f, 0.f, 0.f};
    bf16x8 At[4][2], B0[2][2], B1[2][2];
    const char* cA = (const char*)g.A + (size_t)cur.pm * tstep; const char* cB = (const char*)g.Bt + (size_t)cur.pn * tstep;
    S.a_ready(cur);
    if constexpr (SP2) {
        PG8_STAGE(PG8_SB(0, 0), cB, voffB); PG8_STAGE(PG8_SB(0, 1), cB + hstep, voffB); PG8_STAGE(PG8_SA(0, 0), cA, voffA); PG8_STAGE(PG8_SA(0, 1), cA + hstep, voffA);
        if (wr == 1) PG8_BAR;
        PG8_WAIT_V(2); PG8_BAR;
        PG8_STAGE(PG8_SB(1, 0), cB + kstep, voffB); PG8_STAGE(PG8_SA(1, 0), cA + kstep, voffA); PG8_STAGE(PG8_SB(1, 1), cB + hstep + kstep, voffB);
        PG8_WAIT_V(6); PG8_BAR;
    } else {
        PG8_STAGE(PG8_SB(0, 0), cB, voffB); PG8_STAGE(PG8_SA(0, 0), cA, voffA); PG8_STAGE(PG8_SB(0, 1), cB + hstep, voffB); PG8_STAGE(PG8_SA(0, 1), cA + hstep, voffA);
        if (wr == 1) PG8_BAR;
        PG8_WAIT_V(4); PG8_BAR;
        PG8_STAGE(PG8_SB(1, 0), cB + kstep, voffB); PG8_STAGE(PG8_SA(1, 0), cA + kstep, voffA); PG8_STAGE(PG8_SB(1, 1), cB + hstep + kstep, voffB);
        PG8_WAIT_V(6); PG8_BAR;
    }
    for (;;) {
        const bool has_next = S.next(ui + 1, nxt);
        const char* nA = has_next ? (const char*)g.A + (size_t)nxt.pm * tstep : cA; const char* nB = has_next ? (const char*)g.Bt + (size_t)nxt.pn * tstep : cB;
        for (int t = 0; t < nt; t += 2) {
            const bool last = (t == nt - 2);
            const char* a1 = cA + (size_t)(t + 1) * kstep;
            const char* a2 = last ? nA : cA + (size_t)(t + 2) * kstep; const char* b2 = last ? nB : cB + (size_t)(t + 2) * kstep;
            const char* a3 = a2 + kstep; const char* b3 = b2 + kstep;
            if (last && has_next) S.a_ready(nxt);
            if constexpr (SP2) {
            PG8_LDB(B0, 0, 0); PG8_LDB(B1, 0, 1); PG8_SCHED; PG8_LDA(At, 0, 0); PG8_STAGE(PG8_SA(1, 1), a1 + hstep, voffA);
            PG8_WAIT_V(8); PG8_WAIT_L(0); PG8_BAR; PG8_MMA(0, 0, At, B0); PG8_MMA(0, 1, At, B1); PG8_BAR; PG8_SCHED;
            PG8_LDA(At, 0, 1); PG8_STAGE(PG8_SB(0, 0), b2, voffB); PG8_STAGE(PG8_SB(0, 1), b2 + hstep, voffB); PG8_STAGE(PG8_SA(0, 0), a2, voffA);
            PG8_WAIT_V(8); PG8_WAIT_L(0); PG8_BAR; PG8_MMA(1, 0, At, B0); PG8_MMA(1, 1, At, B1); PG8_BAR; PG8_SCHED;
            PG8_LDB(B0, 1, 0); PG8_LDB(B1, 1, 1); PG8_SCHED; PG8_LDA(At, 1, 0); PG8_STAGE(PG8_SA(0, 1), a2 + hstep, voffA);
            PG8_WAIT_V(8); PG8_WAIT_L(0); PG8_BAR; PG8_MMA(0, 0, At, B0); PG8_MMA(0, 1, At, B1); PG8_BAR; PG8_SCHED;
            PG8_LDA(At, 1, 1); PG8_STAGE(PG8_SB(1, 0), b3, voffB); PG8_STAGE(PG8_SB(1, 1), b3 + hstep, voffB); PG8_STAGE(PG8_SA(1, 0), a3, voffA);
            PG8_WAIT_V(8); PG8_WAIT_L(0); PG8_BAR; PG8_MMA(1, 0, At, B0); PG8_MMA(1, 1, At, B1); PG8_BAR; PG8_SCHED;
            } else {
            PG8_LDB(B0, 0, 0); PG8_SCHED; PG8_LDA(At, 0, 0); PG8_STAGE(PG8_SA(1, 1), a1 + hstep, voffA);
            PG8_WAIT_L(8); PG8_BAR; PG8_WAIT_L(0); PG8_MMA(0, 0, At, B0); PG8_BAR; PG8_SCHED;
            PG8_LDB(B1, 0, 1); PG8_STAGE(PG8_SB(0, 0), b2, voffB);
            PG8_BAR; PG8_WAIT_L(0); PG8_MMA(0, 1, At, B1); PG8_BAR;
            PG8_LDA(At, 0, 1); PG8_STAGE(PG8_SA(0, 0), a2, voffA);
            PG8_BAR; PG8_WAIT_L(0); PG8_MMA(1, 0, At, B0); PG8_BAR; PG8_SCHED;
            PG8_STAGE(PG8_SB(0, 1), b2 + hstep, voffB);
            PG8_WAIT_V(6); PG8_BAR; PG8_MMA(1, 1, At, B1); PG8_BAR;
            PG8_LDB(B0, 1, 0); PG8_SCHED; PG8_LDA(At, 1, 0); PG8_STAGE(PG8_SA(0, 1), a2 + hstep, voffA);
            PG8_WAIT_L(8); PG8_BAR; PG8_WAIT_L(0); PG8_MMA(0, 0, At, B0); PG8_BAR; PG8_SCHED;
            PG8_LDB(B1, 1, 1); PG8_STAGE(PG8_SB(1, 0), b3, voffB);
            PG8_BAR; PG8_WAIT_L(0); PG8_MMA(0, 1, At, B1); PG8_BAR;
            PG8_LDA(At, 1, 1); PG8_STAGE(PG8_SA(1, 0), a3, voffA);
            PG8_BAR; PG8_WAIT_L(0); PG8_MMA(1, 0, At, B0); PG8_BAR; PG8_SCHED;
            PG8_STAGE(PG8_SB(1, 1), b3 + hstep, voffB);
            PG8_WAIT_V(6); PG8_BAR; PG8_MMA(1, 1, At, B1); PG8_BAR;
            }
        }
        if constexpr (ALIGN_EPI) { if (wr == 0) PG8_BAR; }
        if constexpr (!Epi::AFTER_DRAIN) { E(acc, cur, wr, wc, fr, fq); S.done(cur); }
        if (!has_next) break;
#pragma unroll
        for (int a = 0; a < 2; ++a)
#pragma unroll
            for (int b = 0; b < 2; ++b)
#pragma unroll
                for (int m = 0; m < 4; ++m)
#pragma unroll
                    for (int n = 0; n < 2; ++n) acc[a][b][m][n] = (f32x4){0.f, 0.f, 0.f, 0.f};
        cur = nxt; cA = nA; cB = nB; ++ui;
        if constexpr (ALIGN_EPI) { if (wr == 1) PG8_BAR; }
    }
    PG8_WAIT_V(0);
    if constexpr (!ALIGN_EPI) { if (wr == 0) PG8_BAR; }
    PG8_BAR;
    if constexpr (Epi::AFTER_DRAIN) { E.fused(acc, cur, wr, wc, fr, fq, lds, wid, lane); S.done(cur); }
#undef PG8_SA
#undef PG8_SB
#undef PG8_STAGE
#undef PG8_LDA
#undef PG8_LDB
#undef PG8_MMA
#undef PG8_WAIT_V
#undef PG8_WAIT_L
#undef PG8_BAR
#undef PG8_SCHED
}
}

namespace pg8 {
struct OneUnit {
    Unit u;
    __device__ __forceinline__ bool next(int i, Unit& o) const { if (i > 0) return false; o = u; return true; }
    __device__ __forceinline__ void a_ready(const Unit&) const {}
    __device__ __forceinline__ void done(const Unit&) const {}
};
struct EpiRowScaleBf16 {
    static constexpr bool PERM = true, AFTER_DRAIN = false;
    bf16_t* O; int ldc; const float* rs; const float* ssq;
    __device__ __forceinline__ void operator()(const f32x4 (&acc)[2][2][4][2], const Unit& u, int wr, int wc, int fr, int fq) const {
        const int row0 = u.pm * BM + wr * 64 + fr, col0 = u.pn * BM + wc * 32 + 8 * fq;
#pragma unroll
        for (int ai = 0; ai < 2; ++ai)
#pragma unroll
            for (int m = 0; m < 4; ++m) {
                const int row = row0 + ai * HALF + m * 16;
                const float sc = ssq ? rstd_from_parts(ssq + (size_t)row * 16) : (rs ? rs[row] : 1.f);
                bf16_t* rowp = O + (size_t)row * ldc + col0;
#pragma unroll
                for (int bj = 0; bj < 2; ++bj) {
                    const f32x4 v0 = acc[ai][bj][m][0] * sc, v1 = acc[ai][bj][m][1] * sc;
                    u32x4 w; w.x = cvt_pk_bf16(v0[0], v0[1]); w.y = cvt_pk_bf16(v0[2], v0[3]); w.z = cvt_pk_bf16(v1[0], v1[1]); w.w = cvt_pk_bf16(v1[2], v1[3]);
                    *(u32x4*)(rowp + bj * HALF) = w;
                }
            }
    }
};
struct EpiGeluBiasBf16 {
    static constexpr bool PERM = true, AFTER_DRAIN = false;
    bf16_t* O; int ldc; const float* bias;
    __device__ __forceinline__ void operator()(const f32x4 (&acc)[2][2][4][2], const Unit& u, int wr, int wc, int fr, int fq) const {
        const int row0 = u.pm * BM + wr * 64 + fr, col0 = u.pn * BM + wc * 32 + 8 * fq;
#pragma unroll
        for (int bj = 0; bj < 2; ++bj) {
            const f32x4 b0 = *(const f32x4*)(bias + col0 + bj * HALF), b1 = *(const f32x4*)(bias + col0 + bj * HALF + 4);
#pragma unroll
            for (int ai = 0; ai < 2; ++ai)
#pragma unroll
                for (int m = 0; m < 4; ++m) {
                    bf16_t* rowp = O + (size_t)(row0 + ai * HALF + m * 16) * ldc + col0 + bj * HALF;
                    const f32x4 v0 = acc[ai][bj][m][0] + b0, v1 = acc[ai][bj][m][1] + b1;
                    u32x4 w; w.x = cvt_pk_bf16(gelu_tanh(v0[0]), gelu_tanh(v0[1])); w.y = cvt_pk_bf16(gelu_tanh(v0[2]), gelu_tanh(v0[3]));
                    w.z = cvt_pk_bf16(gelu_tanh(v1[0]), gelu_tanh(v1[1])); w.w = cvt_pk_bf16(gelu_tanh(v1[2]), gelu_tanh(v1[3]));
                    *(u32x4*)rowp = w;
                }
        }
    }
};
struct EpiPartF32 {
    static constexpr bool PERM = true, AFTER_DRAIN = false;
    float* O; int ldc;
    __device__ __forceinline__ void operator()(const f32x4 (&acc)[2][2][4][2], const Unit& u, int wr, int wc, int fr, int fq) const {
        const int row0 = u.pm * BM + wr * 64 + fr, col0 = u.pn * BM + wc * 32 + 8 * fq;
#pragma unroll
        for (int bj = 0; bj < 2; ++bj)
#pragma unroll
            for (int ai = 0; ai < 2; ++ai)
#pragma unroll
                for (int m = 0; m < 4; ++m) {
                    float* rowp = O + (size_t)(row0 + ai * HALF + m * 16) * ldc + col0 + bj * HALF;
                    *(f32x4*)rowp = acc[ai][bj][m][0]; *(f32x4*)(rowp + 4) = acc[ai][bj][m][1];
                }
    }
};
struct EpiResidual {
    static constexpr bool PERM = true, AFTER_DRAIN = false;
    bf16_t* xb; float* sumsq;
    __device__ __forceinline__ void operator()(const f32x4 (&acc)[2][2][4][2], const Unit& u, int wr, int wc, int fr, int fq) const {
        const int row0 = u.pm * BM + wr * 64 + fr, col0 = u.pn * BM + wc * 32 + 8 * fq;
#pragma unroll
        for (int ai = 0; ai < 2; ++ai)
#pragma unroll
            for (int m = 0; m < 4; ++m) {
                const int row = row0 + ai * HALF + m * 16;
                float ss = 0.f;
#pragma unroll
                for (int bj = 0; bj < 2; ++bj) {
                    const size_t off = (size_t)row * 1024 + col0 + bj * HALF;
                    const u32x4 r = *(const u32x4*)(xb + off);
                    const f32x4 r0 = {bflo(r.x), bfhi(r.x), bflo(r.y), bfhi(r.y)}, r1 = {bflo(r.z), bfhi(r.z), bflo(r.w), bfhi(r.w)};
                    const f32x4 v0 = acc[ai][bj][m][0] + r0, v1 = acc[ai][bj][m][1] + r1;
                    u32x4 w; w.x = cvt_pk_bf16(v0[0], v0[1]); w.y = cvt_pk_bf16(v0[2], v0[3]); w.z = cvt_pk_bf16(v1[0], v1[1]); w.w = cvt_pk_bf16(v1[2], v1[3]);
                    *(u32x4*)(xb + off) = w;
                    ss += v0[0] * v0[0] + v0[1] * v0[1] + v0[2] * v0[2] + v0[3] * v0[3] + v1[0] * v1[0] + v1[1] * v1[1] + v1[2] * v1[2] + v1[3] * v1[3];
                }
                ss += sxor<16>(ss); ss += sxor<32>(ss);
                if (fq == 0) sumsq[(size_t)row * 16 + u.pn * 4 + wc] = ss;
            }
    }
};

__device__ __forceinline__ float tk_pack(float v, unsigned idx, unsigned mask) {
    unsigned u = __builtin_bit_cast(unsigned, v);
    const unsigned tag = (u >> 31) ? idx : (mask - idx);
    u = (u & ~mask) | tag;
    return __builtin_bit_cast(float, u);
}
__device__ __forceinline__ unsigned tk_tag(float pv, unsigned mask) { const unsigned u = __builtin_bit_cast(unsigned, pv); return (u >> 31) ? (u & mask) : (mask - (u & mask)); }
__device__ __forceinline__ void tk_insert(float (&L)[16], float x) {
#pragma unroll
    for (int i = 0; i < 16; ++i) { const float hi = fmaxf(L[i], x); x = fminf(L[i], x); L[i] = hi; }
}
template <int N> __device__ __forceinline__ void tk_sort_desc(float (&v)[N]) {
#pragma unroll
    for (int k = 2; k <= N; k <<= 1)
#pragma unroll
        for (int j = k >> 1; j > 0; j >>= 1)
#pragma unroll
            for (int i = 0; i < N; ++i) { const int l = i ^ j;
                if (l > i) { const float hi = fmaxf(v[i], v[l]), lo = fminf(v[i], v[l]); const bool desc = ((i & k) == 0); v[i] = desc ? hi : lo; v[l] = desc ? lo : hi; } }
}
__device__ __forceinline__ void tk_clean16(float (&v)[16]) {
#pragma unroll
    for (int j = 8; j > 0; j >>= 1)
#pragma unroll
        for (int i = 0; i < 16; ++i) { const int l = i ^ j; if (l > i) { const float hi = fmaxf(v[i], v[l]), lo = fminf(v[i], v[l]); v[i] = hi; v[l] = lo; } }
}
__device__ __forceinline__ void tk_merge16(float (&a)[16], const float (&b)[16]) {
#pragma unroll
    for (int i = 0; i < 16; ++i) a[i] = fmaxf(a[i], b[15 - i]);
    tk_clean16(a);
}
#define TK_CE(i, j) { const float hi__ = fmaxf(v[i], v[j]), lo__ = fminf(v[i], v[j]); v[i] = hi__; v[j] = lo__; }
__device__ __forceinline__ void tk_sort16_desc(float (&v)[16]) {
    TK_CE(0,13) TK_CE(1,12) TK_CE(2,15) TK_CE(3,14) TK_CE(4,8) TK_CE(5,6) TK_CE(7,11) TK_CE(9,10)
    TK_CE(0,5) TK_CE(1,7) TK_CE(2,9) TK_CE(3,4) TK_CE(6,13) TK_CE(8,14) TK_CE(10,15) TK_CE(11,12)
    TK_CE(0,1) TK_CE(2,3) TK_CE(4,5) TK_CE(6,8) TK_CE(7,9) TK_CE(10,11) TK_CE(12,13) TK_CE(14,15)
    TK_CE(0,2) TK_CE(1,3) TK_CE(4,10) TK_CE(5,11) TK_CE(6,7) TK_CE(8,9) TK_CE(12,14) TK_CE(13,15)
    TK_CE(1,2) TK_CE(3,12) TK_CE(4,6) TK_CE(5,7) TK_CE(8,10) TK_CE(9,11) TK_CE(13,14)
    TK_CE(1,4) TK_CE(2,6) TK_CE(5,8) TK_CE(7,10) TK_CE(9,13) TK_CE(11,14)
    TK_CE(2,4) TK_CE(3,6) TK_CE(9,12) TK_CE(11,13)
    TK_CE(3,5) TK_CE(6,8) TK_CE(7,9) TK_CE(10,12)
    TK_CE(3,4) TK_CE(5,6) TK_CE(7,8) TK_CE(9,10) TK_CE(11,12)
    TK_CE(6,7) TK_CE(8,9)
}
__device__ __forceinline__ void tk_top16_of_64(float (&g0)[16], float (&g1)[16], float (&g2)[16], float (&g3)[16]) {
    tk_sort16_desc(g0); tk_sort16_desc(g1); tk_sort16_desc(g2); tk_sort16_desc(g3);
    tk_merge16(g0, g1); tk_merge16(g2, g3); tk_merge16(g0, g2);
}
struct EpiTopK {
    static constexpr bool PERM = true, AFTER_DRAIN = true;
    static constexpr int SROW = 260, LIST_OFF = 128 * SROW;
    const float* sumsq; int* E; float* Gt;
    __device__ __forceinline__ void fused(const f32x4 (&acc)[2][2][4][2], const Unit& u, int wr, int wc, int fr, int fq, PG8_LAS unsigned char* lds, int wid, int lane) const {
        PG8_LAS float* Sl = (PG8_LAS float*)lds;
        PG8_LAS float* Ls = Sl + LIST_OFF;
        const int tid = wid * 64 + lane;
#pragma unroll 1
        for (int ai = 0; ai < 2; ++ai) {
#pragma unroll
            for (int m = 0; m < 4; ++m) {
                const int rl = wr * 64 + m * 16 + fr;
                const float sc = rstd_from_parts(sumsq + (size_t)(u.pm * BM + ai * HALF + rl) * 16);
#pragma unroll
                for (int bj = 0; bj < 2; ++bj) {
                    PG8_LAS float* sp = Sl + rl * SROW + bj * HALF + wc * 32 + 8 * fq;
                    const f32x4 a0 = ai ? acc[1][bj][m][0] : acc[0][bj][m][0], a1 = ai ? acc[1][bj][m][1] : acc[0][bj][m][1];
                    *(PG8_LAS f32x4*)sp = a0 * sc; *(PG8_LAS f32x4*)(sp + 4) = a1 * sc;
                }
            }
            __syncthreads();
            const int row = tid & 127, p = (tid >> 7) & 1, half = tid >> 8;
            float L[16];
            {
                const PG8_LAS float* sp = Sl + row * SROW + p * 128 + half * 64;
                float G1[16], G2[16], G3[16];
#pragma unroll
                for (int k = 0; k < 4; ++k) {
                    const f32x4 v0 = *(const PG8_LAS f32x4*)(sp + 4 * k), v1 = *(const PG8_LAS f32x4*)(sp + 16 + 4 * k), v2 = *(const PG8_LAS f32x4*)(sp + 32 + 4 * k), v3 = *(const PG8_LAS f32x4*)(sp + 48 + 4 * k);
                    const unsigned base = half * 64 + 4 * k;
#pragma unroll
                    for (int e = 0; e < 4; ++e) { L[4 * k + e] = tk_pack(v0[e], base + e, 127u); G1[4 * k + e] = tk_pack(v1[e], base + 16 + e, 127u);
                        G2[4 * k + e] = tk_pack(v2[e], base + 32 + e, 127u); G3[4 * k + e] = tk_pack(v3[e], base + 48 + e, 127u); }
                }
                tk_top16_of_64(L, G1, G2, G3);
            }
            if (ai == 1) __syncthreads();
            PG8_LAS float* mine = (ai ? Sl : Ls) + (row * 2 + p) * 16;
            if (half == 1) {
#pragma unroll
                for (int i = 0; i < 4; ++i) *(PG8_LAS f32x4*)(mine + 4 * i) = (f32x4){L[4 * i], L[4 * i + 1], L[4 * i + 2], L[4 * i + 3]};
            }
            __syncthreads();
            if (half == 0) {
                f32x4 o[4];
#pragma unroll
                for (int i = 0; i < 4; ++i) o[i] = *(const PG8_LAS f32x4*)(mine + 4 * i);
                float ob[16];
#pragma unroll
                for (int i = 0; i < 4; ++i) { ob[4 * i] = o[i][0]; ob[4 * i + 1] = o[i][1]; ob[4 * i + 2] = o[i][2]; ob[4 * i + 3] = o[i][3]; }
                tk_merge16(L, ob);
#pragma unroll
                for (int i = 0; i < 4; ++i) *(PG8_LAS f32x4*)(mine + 4 * i) = (f32x4){L[4 * i], L[4 * i + 1], L[4 * i + 2], L[4 * i + 3]};
            }
            __syncthreads();
        }
        if (tid < 256) {
            {
                const int ai = tid >> 7, tr = tid & 127;
                const PG8_LAS float* lb = ai ? Sl : Ls;
                const PG8_LAS float* s1 = lb + (tr * 2 + 0) * 16, *s2 = lb + (tr * 2 + 1) * 16;
                float v1[16], v2[16];
#pragma unroll
                for (int i = 0; i < 4; ++i) { const f32x4 a = *(const PG8_LAS f32x4*)(s1 + 4 * i), b = *(const PG8_LAS f32x4*)(s2 + 4 * i);
                    v1[4 * i] = a[0]; v1[4 * i + 1] = a[1]; v1[4 * i + 2] = a[2]; v1[4 * i + 3] = a[3]; v2[4 * i] = b[0]; v2[4 * i + 1] = b[1]; v2[4 * i + 2] = b[2]; v2[4 * i + 3] = b[3]; }
#define TK_CAND(a, b) tk_pack(v1[a] + v2[b], (a) * 16 + (b), 255u)
                float C[16], D1[16], D2[16], D3[16];
#pragma unroll
                for (int i = 0; i < 16; ++i) C[i] = TK_CAND(0, i);
#pragma unroll
                for (int i = 0; i < 8; ++i) { D1[i] = TK_CAND(1, i); D1[8 + i] = TK_CAND(15 - i, 0); }
                D2[0] = TK_CAND(2, 0); D2[1] = TK_CAND(2, 1); D2[2] = TK_CAND(2, 2); D2[3] = TK_CAND(2, 3); D2[4] = TK_CAND(2, 4);
                D2[5] = TK_CAND(3, 0); D2[6] = TK_CAND(3, 1); D2[7] = TK_CAND(3, 2); D2[8] = TK_CAND(3, 3);
                D2[9] = TK_CAND(4, 0); D2[10] = TK_CAND(4, 1); D2[11] = TK_CAND(4, 2);
                D2[12] = TK_CAND(5, 0); D2[13] = TK_CAND(5, 1); D2[14] = -INFINITY; D2[15] = -INFINITY;
                { const float q = TK_CAND(6, 1), r = TK_CAND(7, 0);
                  D3[0] = TK_CAND(6, 0); D3[1] = fmaxf(q, r); D3[2] = fminf(q, r); D3[3] = TK_CAND(7, 1); }
#pragma unroll
                for (int i = 4; i < 16; ++i) D3[i] = -INFINITY;
#undef TK_CAND
                tk_clean16(D1); tk_sort16_desc(D2);
                tk_merge16(C, D1); tk_merge16(D2, D3); tk_merge16(C, D2);
                float sm = 0.f, ex[16];
#pragma unroll
                for (int i = 0; i < 16; ++i) { ex[i] = __expf(C[i] - C[0]); sm += ex[i]; }
                const float inv = 1.f / sm;
                const size_t t = (size_t)u.pm * BM + ai * HALF + tr;
                int* eo = E + t * 128 + u.pn * 16; float* go = Gt + t * 128 + u.pn * 16;
                int ev[16];
#pragma unroll
                for (int i = 0; i < 16; ++i) { const unsigned ci = tk_tag(C[i], 255u); ev[i] = (int)(tk_tag(s1[ci >> 4], 127u) * 128u + tk_tag(s2[ci & 15], 127u)); }
#pragma unroll
                for (int i = 0; i < 4; ++i) { *(int4*)(eo + 4 * i) = make_int4(ev[4 * i], ev[4 * i + 1], ev[4 * i + 2], ev[4 * i + 3]);
                    *(float4*)(go + 4 * i) = make_float4(ex[4 * i] * inv, ex[4 * i + 1] * inv, ex[4 * i + 2] * inv, ex[4 * i + 3] * inv); }
            }
        }
        __syncthreads();
    }
};
}

__device__ __forceinline__ void transpose_item(const float* __restrict__ W, int K, int N, const float* __restrict__ gain, bf16* __restrict__ WT, int row_off, float* scr, int item, int lane) {
    const int nblk = (N + 31) / 32, kb = item / nblk, nb = item % nblk, k0 = 64 * kb, n0 = 32 * nb;
    const int nn = n0 + (lane & 31);
    float tv[32];
#pragma unroll
    for (int i = 0; i < 32; ++i) { const int kk = 2 * i + (lane >> 5);
        float v = 0.f; if (nn < N) { v = W[(size_t)(k0 + kk) * N + nn]; if (gain) v *= gain[k0 + kk]; }
        tv[i] = v; }
#pragma unroll
    for (int i = 0; i < 32; ++i) scr[(2 * i + (lane >> 5)) * 33 + (lane & 31)] = tv[i];
    __builtin_amdgcn_s_waitcnt(0); __builtin_amdgcn_wave_barrier();
    const int c = lane & 7;
#pragma unroll
    for (int j = 0; j < 4; ++j) { const int n = (lane >> 3) + 8 * j; const float* s = scr + (8 * c) * 33 + n;
        if (n0 + n < N) { u32x4 o; o.x = pk2(s[0 * 33], s[1 * 33]); o.y = pk2(s[2 * 33], s[3 * 33]); o.z = pk2(s[4 * 33], s[5 * 33]); o.w = pk2(s[6 * 33], s[7 * 33]);
            *(u32x4*)(WT + (size_t)(row_off + n0 + n) * K + k0 + 8 * c) = o; } }
    __builtin_amdgcn_s_waitcnt(0); __builtin_amdgcn_wave_barrier();
}
__device__ __forceinline__ void rows4_to_bf16(const float* __restrict__ X, bf16* __restrict__ O, float* __restrict__ rstd, int r, int stride, int lane) {
    float4 v[4][4];
#pragma unroll
    for (int q = 0; q < 4; ++q) { const int rr = r + q * stride;
        if (rr < T) { const float4* xr = (const float4*)(X + (size_t)rr * D) + lane;
#pragma unroll
            for (int j = 0; j < 4; ++j) v[q][j] = xr[64 * j]; } }
#pragma unroll
    for (int q = 0; q < 4; ++q) { const int rr = r + q * stride;
        if (rr < T) {
            float s = 0.f;
#pragma unroll
            for (int j = 0; j < 4; ++j) s += v[q][j].x * v[q][j].x + v[q][j].y * v[q][j].y + v[q][j].z * v[q][j].z + v[q][j].w * v[q][j].w;
            s = wave_sum(s);
            if (lane == 0) rstd[rr] = rsqrtf(s * (1.f / D) + EPS);
            u32x2* o8 = (u32x2*)(O + (size_t)rr * D) + lane;
#pragma unroll
            for (int j = 0; j < 4; ++j) { u32x2 w; w.x = pk2(v[q][j].x, v[q][j].y); w.y = pk2(v[q][j].z, v[q][j].w); o8[64 * j] = w; } } }
}
__device__ __forceinline__ void row_to_bf16(const float* __restrict__ xrow, bf16* __restrict__ orow, float* __restrict__ rstd, int lane) {
    const float4* xr = (const float4*)xrow + lane;
    float4 v[4]; float s = 0.f;
#pragma unroll
    for (int j = 0; j < 4; ++j) { v[j] = xr[64 * j]; s += v[j].x * v[j].x + v[j].y * v[j].y + v[j].z * v[j].z + v[j].w * v[j].w; }
    s = wave_sum(s);
    if (lane == 0) *rstd = rsqrtf(s * (1.f / D) + EPS);
    u32x2* o8 = (u32x2*)orow + lane;
#pragma unroll
    for (int j = 0; j < 4; ++j) { u32x2 w; w.x = pk2(v[j].x, v[j].y); w.y = pk2(v[j].z, v[j].w); o8[64 * j] = w; }
}

__device__ __forceinline__ float bperm(int idx4, float v) { return __builtin_bit_cast(float, __builtin_amdgcn_ds_bpermute(idx4, __builtin_bit_cast(int, v))); }
template <bool APPLY>
__device__ __forceinline__ void scan_pass(const bf16* __restrict__ P, const float* __restrict__ conv_w, const float* __restrict__ conv_b, const bf16* __restrict__ WGF,
                                          const float* __restrict__ SGC  , float* __restrict__ AGG, bf16* __restrict__ AIN, unsigned char* ldsw  , int tid) {
    typedef short bf16x8 __attribute__((ext_vector_type(8)));
    typedef float f32x4 __attribute__((ext_vector_type(4)));
    const int lane = tid & 63, gw = blockIdx.x * (NTHR / 64) + (tid >> 6), ngw = gridDim.x * (NTHR / 64);
    const int c16 = lane & 15, g4 = lane >> 4;
    bf16* Xt = (bf16*)ldsw; bf16* Yt = (bf16*)(ldsw + 9648);
    const int up16 = ((lane - 16) & 63) << 2, up32 = ((lane - 32) & 63) << 2, last = (c16 + 48) << 2;
    for (int item = gw; item < NB * NCHUNK * NBLK; item += ngw) {
        const int n = item % NBLK, ci = (item / NBLK) % NCHUNK, b = item / (NBLK * NCHUNK);
        const int s0 = ci * CHL;
        {
            const bf16* xp = P + ((size_t)b * S + s0 - 3) * PP + n * 64;
#pragma unroll
            for (int j = 0; j < 9; ++j) { const int row = 8 * j + (lane >> 3), c8 = lane & 7;
                if (row < 67) { u32x4 v = (u32x4){0u, 0u, 0u, 0u}; if (s0 + row >= 3) v = *(const u32x4*)(xp + (size_t)row * PP + 8 * c8); *(u32x4*)(Xt + row * 72 + 8 * c8) = v; } }
            if (APPLY) {
                const bf16* yp = P + ((size_t)b * S + s0) * PP + 768 + n * 64;
#pragma unroll
                for (int j = 0; j < 8; ++j) { const int row = 8 * j + (lane >> 3), c8 = lane & 7; *(u32x4*)(Yt + row * 72 + 8 * c8) = *(const u32x4*)(yp + (size_t)row * PP + 8 * c8); }
            }
            const int c = n * 64 + lane;
            const float cw0 = conv_w[0 * LRUW + c], cw1 = conv_w[1 * LRUW + c], cw2 = conv_w[2 * LRUW + c], cw3 = conv_w[3 * LRUW + c], cb = conv_b[c];
            __builtin_amdgcn_s_waitcnt(0); __builtin_amdgcn_wave_barrier();
            float xin[CHL + 3];
#pragma unroll
            for (int i = 0; i < CHL + 3; ++i) xin[i] = ldbf(Xt + i * 72 + lane);
            __builtin_amdgcn_wave_barrier();
#pragma unroll
            for (int tt = 0; tt < CHL; tt += 2) {
                const float o0 = cb + cw0 * xin[tt] + cw1 * xin[tt + 1] + cw2 * xin[tt + 2] + cw3 * xin[tt + 3];
                const float o1 = cb + cw0 * xin[tt + 1] + cw1 * xin[tt + 2] + cw2 * xin[tt + 3] + cw3 * xin[tt + 4];
                const unsigned w = pk2(o0, o1);
                Xt[tt * 72 + lane] = (bf16)(w & 0xffffu); Xt[(tt + 1) * 72 + lane] = (bf16)(w >> 16);
            }
        }
        bf16x8 bfr[2][8];
#pragma unroll
        for (int ks = 0; ks < 2; ++ks)
#pragma unroll
            for (int ct = 0; ct < 8; ++ct) bfr[ks][ct] = *(const bf16x8*)(WGF + ((size_t)((n * 2 + ks) * 8 + ct) * 64 + lane) * 8);
        float brr[4], bii[4], sp8[4];
#pragma unroll
        for (int ch = 0; ch < 4; ++ch) { const int c = n * 64 + 16 * ch + c16; brr[ch] = SGC[c]; bii[ch] = SGC[LRUW + c]; sp8[ch] = SGC[2 * LRUW + c]; }
        float hA[4], hH[4];
#pragma unroll
        for (int ch = 0; ch < 4; ++ch) { hA[ch] = 1.f; hH[ch] = 0.f; }
        if (APPLY) {
            const int q0 = (ci * g4) >> 2, q1 = (ci * (g4 + 1)) >> 2;
#pragma unroll
            for (int ch = 0; ch < 4; ++ch) {
                const float* ap = AGG + (((size_t)b * NCHUNK) * LRUW + n * 64 + 16 * ch + c16) * 2;
                float A = 1.f, H = 0.f;
                for (int k = q0; k < q1; ++k) { const float2 ah = *(const float2*)(ap + (size_t)k * LRUW * 2); H = ah.x * H + ah.y; A *= ah.x; }
                float Ap = bperm(up16, A), Hp = bperm(up16, H);
                if (g4 >= 1) { H = A * Hp + H; A *= Ap; }
                Ap = bperm(up32, A); Hp = bperm(up32, H);
                if (g4 >= 2) { H = A * Hp + H; A *= Ap; }
                hH[ch] = bperm(last, H);
            }
        }
        __builtin_amdgcn_s_waitcnt(0); __builtin_amdgcn_wave_barrier();
#pragma unroll 1
        for (int tt4 = 0; tt4 < 4; ++tt4) {
            const bf16x8 a0 = *(const bf16x8*)(Xt + (16 * tt4 + c16) * 72 + 8 * g4), a1 = *(const bf16x8*)(Xt + (16 * tt4 + c16) * 72 + 32 + 8 * g4);
            f32x4 acc[8];
#pragma unroll
            for (int ct = 0; ct < 8; ++ct) { f32x4 z = {0.f, 0.f, 0.f, 0.f};
                z = __builtin_amdgcn_mfma_f32_16x16x32_bf16(a0, bfr[0][ct], z, 0, 0, 0);
                acc[ct] = __builtin_amdgcn_mfma_f32_16x16x32_bf16(a1, bfr[1][ct], z, 0, 0, 0); }
#pragma unroll
            for (int ch = 0; ch < 4; ++ch) {
                const int cidx = 16 * ch + c16;
                float av[4], uv[4], A = 1.f, H = 0.f;
#pragma unroll
                for (int jj = 0; jj < 4; ++jj) {
                    const int tt = 16 * tt4 + 4 * g4 + jj;
                    const float rg = __builtin_amdgcn_rcpf(1.f + __builtin_amdgcn_exp2f(acc[ch][jj] + brr[ch])), ig = __builtin_amdgcn_rcpf(1.f + __builtin_amdgcn_exp2f(acc[4 + ch][jj] + bii[ch]));
                    const float a = __builtin_amdgcn_exp2f(sp8[ch] * rg);
                    const float mult = __builtin_amdgcn_sqrtf(fmaxf(1.f - a * a, 0.f));
                    const float u = mult * (ig * ldbf(Xt + tt * 72 + cidx));
                    av[jj] = a; uv[jj] = u; H = a * H + u; A *= a;
                }
                float Ap = bperm(up16, A), Hp = bperm(up16, H);
                if (g4 >= 1) { H = A * Hp + H; A *= Ap; }
                Ap = bperm(up32, A); Hp = bperm(up32, H);
                if (g4 >= 2) { H = A * Hp + H; A *= Ap; }
                const float AT = bperm(last, A), HT = bperm(last, H);
                if (APPLY) {
                    float AE = bperm(up16, A), HE = bperm(up16, H);
                    if (g4 == 0) { AE = 1.f; HE = 0.f; }
                    float h = AE * hH[ch] + HE;
#pragma unroll
                    for (int jj = 0; jj < 4; ++jj) {
                        const int tt = 16 * tt4 + 4 * g4 + jj;
                        h = av[jj] * h + uv[jj];
                        Xt[tt * 72 + cidx] = (bf16)f2bf(h * gelu_tanh(ldbf(Yt + tt * 72 + cidx)));
                    }
                    hH[ch] = AT * hH[ch] + HT;
                } else { hH[ch] = AT * hH[ch] + HT; hA[ch] *= AT; }
            }
        }
        if (APPLY) {
            __builtin_amdgcn_s_waitcnt(0); __builtin_amdgcn_wave_barrier();
            bf16* op = AIN + ((size_t)b * S + s0) * D + n * 64;
#pragma unroll
            for (int j = 0; j < 8; ++j) { const int row = 8 * j + (lane >> 3), c8 = lane & 7; *(u32x4*)(op + (size_t)row * D + 8 * c8) = *(const u32x4*)(Xt + row * 72 + 8 * c8); }
        } else if (g4 == 0) {
#pragma unroll
            for (int ch = 0; ch < 4; ++ch) *(float2*)(AGG + (((size_t)b * NCHUNK + ci) * LRUW + n * 64 + 16 * ch + c16) * 2) = make_float2(hA[ch], hH[ch]);
        }
        __builtin_amdgcn_s_waitcnt(0); __builtin_amdgcn_wave_barrier();
    }
}

__device__ __forceinline__ void peer_gather(float* __restrict__ out, bf16* __restrict__ XB, const float* __restrict__ sumsq, const bf16* __restrict__ UT, const bf16* __restrict__ VT,
                                            const int* __restrict__ E, const float* __restrict__ Gt, float* __restrict__ rstd_next, float* actbuf  , bool dry, int tid) {
    const int lane = tid & 63, gw = blockIdx.x * (NTHR / 64) + (tid >> 6), ngw = gridDim.x * (NTHR / 64);
    const int g4 = lane >> 4, li = lane & 15;
    for (int t = gw; t < T; t += ngw) {
        const float rs = rstd_from_parts(sumsq + (size_t)t * 16);
        bf16x8_t hx[8];
#pragma unroll
        for (int j = 0; j < 8; ++j) hx[j] = __builtin_nontemporal_load((const bf16x8_t*)(XB + (size_t)t * D + li * 8 + 128 * j));
        const int* ep = E + (size_t)t * 128; const float* gp = Gt + (size_t)t * 128;
#pragma unroll 2
        for (int step = 0; step < 32; ++step) {
            const int e = ep[4 * step + g4];
            const bf16* up = UT + (size_t)e * D + li * 8;
            bf16x8_t u[8];
#pragma unroll
            for (int j = 0; j < 8; ++j) u[j] = *(const bf16x8_t*)(up + 128 * j);
            float d = 0.f;
#pragma unroll
            for (int j = 0; j < 8; ++j) {
                d = __builtin_amdgcn_fdot2_f32_bf16(__builtin_shufflevector(u[j], u[j], 0, 1), __builtin_shufflevector(hx[j], hx[j], 0, 1), d, false);
                d = __builtin_amdgcn_fdot2_f32_bf16(__builtin_shufflevector(u[j], u[j], 2, 3), __builtin_shufflevector(hx[j], hx[j], 2, 3), d, false);
                d = __builtin_amdgcn_fdot2_f32_bf16(__builtin_shufflevector(u[j], u[j], 4, 5), __builtin_shufflevector(hx[j], hx[j], 4, 5), d, false);
                d = __builtin_amdgcn_fdot2_f32_bf16(__builtin_shufflevector(u[j], u[j], 6, 7), __builtin_shufflevector(hx[j], hx[j], 6, 7), d, false);
            }
            d += sxor<1>(d); d += sxor<2>(d); d += sxor<4>(d); d += sxor<8>(d);
            const float a = gelu_tanh(d * rs) * gp[4 * step + g4];
            if (li == 0) actbuf[4 * step + g4] = a;
        }
        __builtin_amdgcn_s_waitcnt(0); __builtin_amdgcn_wave_barrier();
        float acc[16];
#pragma unroll
        for (int i = 0; i < 16; ++i) acc[i] = 0.f;
        const int e_lo = ep[lane], e_hi = ep[64 + lane];
#pragma unroll 4
        for (int idx = 0; idx < 128; ++idx) {
            const int e = __builtin_amdgcn_readlane(idx < 64 ? e_lo : e_hi, idx & 63);
            const bf16* vp = VT + (size_t)e * D + lane * 8;
            const u32x4 va = *(const u32x4*)vp, vb = *(const u32x4*)(vp + 512);
            const float a = actbuf[idx];
            acc[0] += a * bflo(va.x); acc[1] += a * bfhi(va.x); acc[2] += a * bflo(va.y); acc[3] += a * bfhi(va.y);
            acc[4] += a * bflo(va.z); acc[5] += a * bfhi(va.z); acc[6] += a * bflo(va.w); acc[7] += a * bfhi(va.w);
            acc[8] += a * bflo(vb.x); acc[9] += a * bfhi(vb.x); acc[10] += a * bflo(vb.y); acc[11] += a * bfhi(vb.y);
            acc[12] += a * bflo(vb.z); acc[13] += a * bfhi(vb.z); acc[14] += a * bflo(vb.w); acc[15] += a * bfhi(vb.w);
        }
        float ss = 0.f;
#pragma unroll
        for (int hf = 0; hf < 2; ++hf) {
            float* op = out + (size_t)t * D + hf * 512 + lane * 8;
            const pg8::f32x4 x0v = __builtin_nontemporal_load((const pg8::f32x4*)op), x1v = __builtin_nontemporal_load((const pg8::f32x4*)(op + 4));
            const float4 x0 = make_float4(x0v[0], x0v[1], x0v[2], x0v[3]), x1 = make_float4(x1v[0], x1v[1], x1v[2], x1v[3]);
            float4 r0 = make_float4(x0.x + acc[8 * hf + 0], x0.y + acc[8 * hf + 1], x0.z + acc[8 * hf + 2], x0.w + acc[8 * hf + 3]);
            float4 r1 = make_float4(x1.x + acc[8 * hf + 4], x1.y + acc[8 * hf + 5], x1.z + acc[8 * hf + 6], x1.w + acc[8 * hf + 7]);
            if (dry) { r0 = x0; r1 = x1; }
            __builtin_nontemporal_store((pg8::f32x4){r0.x, r0.y, r0.z, r0.w}, (pg8::f32x4*)op); __builtin_nontemporal_store((pg8::f32x4){r1.x, r1.y, r1.z, r1.w}, (pg8::f32x4*)(op + 4));
            u32x4 w; w.x = pk2(r0.x, r0.y); w.y = pk2(r0.z, r0.w); w.z = pk2(r1.x, r1.y); w.w = pk2(r1.z, r1.w);
            __builtin_nontemporal_store(w, (u32x4*)(XB + (size_t)t * D + hf * 512 + lane * 8));
            ss += r0.x * r0.x + r0.y * r0.y + r0.z * r0.z + r0.w * r0.w + r1.x * r1.x + r1.y * r1.y + r1.z * r1.z + r1.w * r1.w;
        }
        ss = wave_sum(ss);
        if (lane == 0 && rstd_next) rstd_next[t] = rsqrtf(ss * (1.f / D) + EPS);
        __builtin_amdgcn_s_waitcnt(0); __builtin_amdgcn_wave_barrier();
    }
}


typedef float f32x2_t __attribute__((ext_vector_type(2)));
__device__ __forceinline__ void fp8x16_to_f32(const u32x4 w, float (&f)[16]) {
    const unsigned ww[4] = {w.x, w.y, w.z, w.w};
#pragma unroll
    for (int q = 0; q < 4; ++q) { const f32x2_t lo = __builtin_amdgcn_cvt_pk_f32_fp8((int)ww[q], false), hi = __builtin_amdgcn_cvt_pk_f32_fp8((int)ww[q], true);
        f[4 * q] = lo[0]; f[4 * q + 1] = lo[1]; f[4 * q + 2] = hi[0]; f[4 * q + 3] = hi[1]; }
}
__device__ __forceinline__ void g1_ev(int (&ev)[16], const int* __restrict__ E, int t, int rg) {
    const int4* ep = (const int4*)(E + (size_t)t * 128 + 16 * rg);
#pragma unroll
    for (int q = 0; q < 4; ++q) { const int4 v = ep[q]; ev[4 * q] = v.x; ev[4 * q + 1] = v.y; ev[4 * q + 2] = v.z; ev[4 * q + 3] = v.w; }
}
template <int H> __device__ __forceinline__ void rows8(u32x4 (&w)[8], const int (&ev)[16], const unsigned char* __restrict__ T8, int col0) {
#pragma unroll
    for (int i = 0; i < 8; ++i) w[i] = *(const u32x4*)(T8 + (size_t)ev[8 * H + i] * 1024 + col0);
}
__device__ __forceinline__ float g1_math8(const u32x4 (&w)[8], const f32x2_t (&xf)[8], int cl) {
    float d[8];
#pragma unroll
    for (int i = 0; i < 8; ++i) {
        const unsigned ww[4] = {w[i].x, w[i].y, w[i].z, w[i].w};
        f32x2_t d2 = {0.f, 0.f};
#pragma unroll
        for (int q = 0; q < 4; ++q) { const f32x2_t lo = __builtin_amdgcn_cvt_pk_f32_fp8((int)ww[q], false), hi = __builtin_amdgcn_cvt_pk_f32_fp8((int)ww[q], true);
            d2 = lo * xf[2 * q] + d2; d2 = hi * xf[2 * q + 1] + d2; }
        d[i] = d2[0] + d2[1];
        if ((i & 1) == 1) __builtin_amdgcn_sched_barrier(0);
    }
    const bool b4 = cl & 4, b2 = cl & 2, b1 = cl & 1;
    float e[4];
#pragma unroll
    for (int k = 0; k < 4; ++k) { const float keep = b4 ? d[k + 4] : d[k], send = b4 ? d[k] : d[k + 4]; e[k] = keep + sxor<4>(send); }
    float f[2];
#pragma unroll
    for (int k = 0; k < 2; ++k) { const float keep = b2 ? e[k + 2] : e[k], send = b2 ? e[k] : e[k + 2]; f[k] = keep + sxor<2>(send); }
    const float keep = b1 ? f[1] : f[0], send = b1 ? f[0] : f[1];
    return keep + sxor<1>(send);
}
__device__ __forceinline__ void unpack_x(f32x2_t (&xf)[8], const u32x4 xa, const u32x4 xb2) {
    xf[0] = (f32x2_t){bflo(xa.x), bfhi(xa.x)}; xf[1] = (f32x2_t){bflo(xa.y), bfhi(xa.y)}; xf[2] = (f32x2_t){bflo(xa.z), bfhi(xa.z)}; xf[3] = (f32x2_t){bflo(xa.w), bfhi(xa.w)};
    xf[4] = (f32x2_t){bflo(xb2.x), bfhi(xb2.x)}; xf[5] = (f32x2_t){bflo(xb2.y), bfhi(xb2.y)}; xf[6] = (f32x2_t){bflo(xb2.z), bfhi(xb2.z)}; xf[7] = (f32x2_t){bflo(xb2.w), bfhi(xb2.w)};
}
constexpr int G_SLOTS = 8, G_NPRE = 5;
__device__ __forceinline__ void g_dma(const void* gsrc, unsigned char* slot) {
    __builtin_amdgcn_global_load_lds((const __attribute__((address_space(1))) unsigned*)gsrc, (__attribute__((address_space(3))) unsigned*)slot, 16, 0, 0);
}
__device__ __forceinline__ void lds_ev(int (&ev)[16], const unsigned char* slot, int rg) {
#pragma unroll
    for (int q = 0; q < 4; ++q) { const int4 v = *(const int4*)(slot + rg * 64 + 16 * q); ev[4 * q] = v.x; ev[4 * q + 1] = v.y; ev[4 * q + 2] = v.z; ev[4 * q + 3] = v.w; }
}
template <int N> __device__ __forceinline__ void rowsN(u32x4 (&w)[N], const int (&ev)[16], int off, const unsigned char* __restrict__ T8, int col0) {
#pragma unroll
    for (int i = 0; i < N; ++i) w[i] = *gptr((const u32x4*)(T8 + (size_t)ev[off + i] * 128 + col0));
}
#define G_WAIT_IDS() asm volatile("s_waitcnt vmcnt(30)" ::: "memory")
__device__ __forceinline__ void peer_u_partial(const bf16* __restrict__ XB, const unsigned char* __restrict__ UT8, const int* __restrict__ E, float* __restrict__ PART, unsigned char* ring, int tid,
                                               const int xs, const int r, const int nr) {
    const int lane = tid & 63, wv = tid >> 6, rg = lane >> 3, cl = lane & 7;
    const int col0 = xs * (16384 * 128) + 16 * cl, step = nr * 8;
    float* pb = PART + (size_t)xs * T * 128 + 16 * rg + cl;
    const int t0 = r * 8 + wv;
    const int ntok = (t0 < T) ? (T - 1 - t0) / step + 1 : 0;
    if (ntok == 0) return;
    const size_t src_lane_off = (lane < 32) ? (size_t)lane * 16 : (size_t)((lane & 15) * 16);
    auto dma = [&](int k) { const int t = t0 + k * step;
        const unsigned char* src = (lane < 32) ? (const unsigned char*)(E + (size_t)t * 128) : (const unsigned char*)(XB + (size_t)t * D + 128 * xs);
        g_dma(src + src_lane_off, ring + (k & (G_SLOTS - 1)) * 1024); };
#pragma unroll 1
    for (int k = 0; k < G_NPRE && k < ntok; ++k) dma(k);
    asm volatile("s_waitcnt vmcnt(0)" ::: "memory");
    int ev[16]; u32x4 wA[16], wB[16];
    lds_ev(ev, ring, rg); rowsN<16>(wA, ev, 0, UT8, col0);
#pragma unroll 1
    for (int k = 0; k < ntok; k += 2) {
        if (k + G_NPRE < ntok) dma(k + G_NPRE);
        if (k + 1 < ntok) { G_WAIT_IDS(); lds_ev(ev, ring + ((k + 1) & (G_SLOTS - 1)) * 1024, rg); rowsN<16>(wB, ev, 0, UT8, col0); }
        {
            const unsigned char* slot = ring + (k & (G_SLOTS - 1)) * 1024;
            const u32x4 xa = *(const u32x4*)(slot + 512 + cl * 32), xb2 = *(const u32x4*)(slot + 512 + cl * 32 + 16);
            f32x2_t xf[8]; unpack_x(xf, xa, xb2);
            const float res0 = g1_math8(*(const u32x4(*)[8])&wA[0], xf, cl), res1 = g1_math8(*(const u32x4(*)[8])&wA[8], xf, cl);
            float* po = pb + (size_t)(t0 + k * step) * 128; *gptr(po) = res0; *gptr(po + 8) = res1;
        }
        if (k + 1 >= ntok) break;
        if (k + 1 + G_NPRE < ntok) dma(k + 1 + G_NPRE);
        if (k + 2 < ntok) { G_WAIT_IDS(); lds_ev(ev, ring + ((k + 2) & (G_SLOTS - 1)) * 1024, rg); rowsN<16>(wA, ev, 0, UT8, col0); }
        {
            const unsigned char* slot = ring + ((k + 1) & (G_SLOTS - 1)) * 1024;
            const u32x4 xa = *(const u32x4*)(slot + 512 + cl * 32), xb2 = *(const u32x4*)(slot + 512 + cl * 32 + 16);
            f32x2_t xf[8]; unpack_x(xf, xa, xb2);
            const float res0 = g1_math8(*(const u32x4(*)[8])&wB[0], xf, cl), res1 = g1_math8(*(const u32x4(*)[8])&wB[8], xf, cl);
            float* po = pb + (size_t)(t0 + (k + 1) * step) * 128; *gptr(po) = res0; *gptr(po + 8) = res1;
        }
    }
    asm volatile("s_waitcnt vmcnt(0)" ::: "memory");
}
__device__ __forceinline__ void peer_act(const float* __restrict__ PART, const float* __restrict__ ssq, float* __restrict__ Gt, int tid) {
    const int lane = tid & 63, gw = blockIdx.x * (NTHR / 64) + (tid >> 6), ngw = gridDim.x * (NTHR / 64);
    for (int t = gw; t < T; t += ngw) {
        const float rs = rstd_from_parts(ssq + (size_t)t * 16) * (1.f / 64.f);
        float d0 = 0.f, d1 = 0.f;
#pragma unroll
        for (int s = 0; s < 8; ++s) { const float2 v = *(const float2*)(PART + ((size_t)s * T + t) * 128 + 2 * lane); d0 += v.x; d1 += v.y; }
        float2* gp = (float2*)(Gt + (size_t)t * 128 + 2 * lane);
        const float2 g = *gp;
        *gp = make_float2(gelu_tanh(d0 * rs) * g.x, gelu_tanh(d1 * rs) * g.y);
    }
}
__device__ __forceinline__ void g3_act(float (&av)[16], const float* __restrict__ ACT, int t, int rg) {
    const float4* ap = (const float4*)(ACT + (size_t)t * 128 + 16 * rg);
#pragma unroll
    for (int q = 0; q < 4; ++q) { const float4 a = ap[q]; av[4 * q] = a.x; av[4 * q + 1] = a.y; av[4 * q + 2] = a.z; av[4 * q + 3] = a.w; }
}
template <int H> __device__ __forceinline__ void g3_math8(const u32x4 (&w)[8], const float (&av)[16], f32x2_t (&acc)[8]) {
#pragma unroll
    for (int i = 0; i < 8; ++i) {
        const unsigned ww[4] = {w[i].x, w[i].y, w[i].z, w[i].w};
        const f32x2_t a2 = {av[8 * H + i], av[8 * H + i]};
#pragma unroll
        for (int q = 0; q < 4; ++q) { const f32x2_t lo = __builtin_amdgcn_cvt_pk_f32_fp8((int)ww[q], false), hi = __builtin_amdgcn_cvt_pk_f32_fp8((int)ww[q], true);
            acc[2 * q] = lo * a2 + acc[2 * q]; acc[2 * q + 1] = hi * a2 + acc[2 * q + 1]; }
        __builtin_amdgcn_sched_barrier(0);
    }
}
__device__ __forceinline__ void g3_finish(const f32x2_t (&acc)[8], float* __restrict__ out, bf16* __restrict__ XB, float* __restrict__ ssq_next, bool dry, int t, int xs, int rg, int cl, int lane) {
    const bool b4 = rg & 4, b2 = rg & 2, b1 = rg & 1;
    f32x2_t e[4];
#pragma unroll
    for (int k = 0; k < 4; ++k) { const f32x2_t keep = b4 ? acc[k + 4] : acc[k], send = b4 ? acc[k] : acc[k + 4];
        e[k] = (f32x2_t){keep[0] + sxor<32>(send[0]), keep[1] + sxor<32>(send[1])}; }
    f32x2_t f[2];
#pragma unroll
    for (int k = 0; k < 2; ++k) { const f32x2_t keep = b2 ? e[k + 2] : e[k], send = b2 ? e[k] : e[k + 2];
        f[k] = (f32x2_t){keep[0] + sxor<16>(send[0]), keep[1] + sxor<16>(send[1])}; }
    const f32x2_t keep = b1 ? f[1] : f[0], send = b1 ? f[0] : f[1];
    const float a0 = keep[0] + sxor<8>(send[0]), a1 = keep[1] + sxor<8>(send[1]);
    const int col = 128 * xs + 16 * cl + 2 * rg;
    unsigned* xp = (unsigned*)(XB + (size_t)t * D + col);
    const unsigned xw = *gptr(xp);
    const float2 x0 = make_float2(bflo(xw), bfhi(xw));
    float2 r0 = make_float2(x0.x + 0.125f * a0, x0.y + 0.125f * a1);
    if (dry) r0 = x0;
    if (out) *gptr((f32x2_t*)(out + (size_t)t * D + col)) = (f32x2_t){r0.x, r0.y};
    else *gptr(xp) = pk2(r0.x, r0.y);
    if (ssq_next) {
        const float ss = wave_sum(r0.x * r0.x + r0.y * r0.y);
        if (lane < 2) *gptr(ssq_next + (size_t)t * 16 + 8 * lane + xs) = lane ? 0.f : ss;
    }
}
__device__ __forceinline__ void lds_av(float (&av)[16], const unsigned char* slot, int rg) {
#pragma unroll
    for (int q = 0; q < 4; ++q) { const float4 a = *(const float4*)(slot + 512 + rg * 64 + 16 * q); av[4 * q] = a.x; av[4 * q + 1] = a.y; av[4 * q + 2] = a.z; av[4 * q + 3] = a.w; }
}
__device__ __forceinline__ void peer_v_slice(float* __restrict__ out, bf16* __restrict__ XB, const unsigned char* __restrict__ VT8, const int* __restrict__ E, const float* __restrict__ ACT,
                                             float* __restrict__ ssq_next, bool dry, unsigned char* ring, int tid, const int xs, const int r, const int nr) {
    const int lane = tid & 63, wv = tid >> 6, rg = lane >> 3, cl = lane & 7;
    const int col0 = xs * (16384 * 128) + 16 * cl, step = nr * 8;
    const int t0 = r * 8 + wv;
    const int ntok = (t0 < T) ? (T - 1 - t0) / step + 1 : 0;
    if (ntok == 0) return;
    const size_t src_lane_off = (size_t)(lane & 31) * 16;
    auto dma = [&](int k) { const int t = t0 + k * step;
        const unsigned char* src = (lane < 32) ? (const unsigned char*)(E + (size_t)t * 128) : (const unsigned char*)(ACT + (size_t)t * 128);
        g_dma(src + src_lane_off, ring + (k & (G_SLOTS - 1)) * 1024); };
#pragma unroll 1
    for (int k = 0; k < G_NPRE && k < ntok; ++k) dma(k);
    asm volatile("s_waitcnt vmcnt(0)" ::: "memory");
    int ev[16]; u32x4 wA[16], wB[16];
    lds_ev(ev, ring, rg); rowsN<16>(wA, ev, 0, VT8, col0);
#pragma unroll 1
    for (int k = 0; k < ntok; k += 2) {
        if (k + G_NPRE < ntok) dma(k + G_NPRE);
        if (k + 1 < ntok) { G_WAIT_IDS(); lds_ev(ev, ring + ((k + 1) & (G_SLOTS - 1)) * 1024, rg); rowsN<16>(wB, ev, 0, VT8, col0); }
        {
            float av[16]; lds_av(av, ring + (k & (G_SLOTS - 1)) * 1024, rg);
            f32x2_t acc[8];
#pragma unroll
            for (int j = 0; j < 8; ++j) acc[j] = (f32x2_t){0.f, 0.f};
            g3_math8<0>(*(const u32x4(*)[8])&wA[0], av, acc); g3_math8<1>(*(const u32x4(*)[8])&wA[8], av, acc);
            g3_finish(acc, out, XB, ssq_next, dry, t0 + k * step, xs, rg, cl, lane);
        }
        if (k + 1 >= ntok) break;
        if (k + 1 + G_NPRE < ntok) dma(k + 1 + G_NPRE);
        if (k + 2 < ntok) { G_WAIT_IDS(); lds_ev(ev, ring + ((k + 2) & (G_SLOTS - 1)) * 1024, rg); rowsN<16>(wA, ev, 0, VT8, col0); }
        {
            float av[16]; lds_av(av, ring + ((k + 1) & (G_SLOTS - 1)) * 1024, rg);
            f32x2_t acc[8];
#pragma unroll
            for (int j = 0; j < 8; ++j) acc[j] = (f32x2_t){0.f, 0.f};
            g3_math8<0>(*(const u32x4(*)[8])&wB[0], av, acc); g3_math8<1>(*(const u32x4(*)[8])&wB[8], av, acc);
            g3_finish(acc, out, XB, ssq_next, dry, t0 + (k + 1) * step, xs, rg, cl, lane);
        }
    }
    asm volatile("s_waitcnt vmcnt(0)" ::: "memory");
}

namespace att {
typedef short bf16x8 __attribute__((ext_vector_type(8)));
typedef short bf16x4 __attribute__((ext_vector_type(4)));
typedef float f32x4 __attribute__((ext_vector_type(4)));
constexpr int TROW = 144;
constexpr int TILE_B = 64 * TROW;
constexpr int OFF_K = 0, OFF_V = 2 * TILE_B, OFF_IMP = 4 * TILE_B  , OFF_SEL = OFF_IMP + 16384, OFF_ANY = OFF_SEL + 512, OFF_STAGE = OFF_ANY + 512;
constexpr int STAGE_ROW = 68;
constexpr int LDS_NEED = OFF_STAGE + 384 * STAGE_ROW * 4;
constexpr float QSCALE = 0.125f * 1.4426950408889634f;
constexpr float SBOUND = QSCALE * 64.0f * 1.02f;

typedef float f32x2_ __attribute__((ext_vector_type(2)));
__device__ __forceinline__ unsigned cvt_pk(float lo, float hi) { const f32x2_ v = {lo, hi}; return __builtin_bit_cast(unsigned, __builtin_convertvector(v, bf16x2_t)); }

__device__ __forceinline__ void load_qfrag(bf16x8 (&qf)[2], const bf16* __restrict__ rowp, const float* __restrict__ gain, const float* __restrict__ rope_row, int g4) {
    const u32x4 w0 = *(const u32x4*)(rowp + 8 * g4), w1 = *(const u32x4*)(rowp + 32 + 8 * g4);
    float f0[8] = {bflo(w0.x), bfhi(w0.x), bflo(w0.y), bfhi(w0.y), bflo(w0.z), bfhi(w0.z), bflo(w0.w), bfhi(w0.w)};
    float f1[8] = {bflo(w1.x), bfhi(w1.x), bflo(w1.y), bfhi(w1.y), bflo(w1.z), bfhi(w1.z), bflo(w1.w), bfhi(w1.w)};
    float ss = 0.f;
#pragma unroll
    for (int j = 0; j < 8; ++j) ss += f0[j] * f0[j] + f1[j] * f1[j];
    ss += sxor<16>(ss); ss += sxor<32>(ss);
    const float rs = rsqrtf(ss * (1.f / 64.f) + EPS);
#pragma unroll
    for (int j = 0; j < 8; ++j) { f0[j] *= rs * gain[8 * g4 + j]; f1[j] *= rs * gain[32 + 8 * g4 + j]; }
    if (rope_row) {
#pragma unroll
        for (int j = 0; j < 8; ++j) {
            const float partner = sxor<16>(f0[j]);
            const float cs = rope_row[j], sn = rope_row[8 + j];
            if (g4 == 0) f0[j] = f0[j] * cs - partner * sn;
            else if (g4 == 1) f0[j] = f0[j] * cs + partner * sn;
        }
    }
    u32x4 o0, o1;
    o0.x = cvt_pk(f0[0] * QSCALE, f0[1] * QSCALE); o0.y = cvt_pk(f0[2] * QSCALE, f0[3] * QSCALE); o0.z = cvt_pk(f0[4] * QSCALE, f0[5] * QSCALE); o0.w = cvt_pk(f0[6] * QSCALE, f0[7] * QSCALE);
    o1.x = cvt_pk(f1[0] * QSCALE, f1[1] * QSCALE); o1.y = cvt_pk(f1[2] * QSCALE, f1[3] * QSCALE); o1.z = cvt_pk(f1[4] * QSCALE, f1[5] * QSCALE); o1.w = cvt_pk(f1[6] * QSCALE, f1[7] * QSCALE);
    qf[0] = __builtin_bit_cast(bf16x8, o0); qf[1] = __builtin_bit_cast(bf16x8, o1);
}

template <int NU>
__device__ __forceinline__ void qk_tile(const unsigned char* Kt, const bf16x8 (&qf)[NU][2], f32x4 (&Sv)[NU][4], int c16, int g4, const float (&init)[NU]) {
#pragma unroll
    for (int rt = 0; rt < 4; ++rt) {
        const bf16x8 k0 = *(const bf16x8*)(Kt + (16 * rt + c16) * TROW + 16 * g4);
        const bf16x8 k1 = *(const bf16x8*)(Kt + (16 * rt + c16) * TROW + 64 + 16 * g4);
#pragma unroll
        for (int u = 0; u < NU; ++u) {
            f32x4 a = {init[u], init[u], init[u], init[u]};
            a = __builtin_amdgcn_mfma_f32_16x16x32_bf16(k0, qf[u][0], a, 0, 0, 0);
            a = __builtin_amdgcn_mfma_f32_16x16x32_bf16(k1, qf[u][1], a, 0, 0, 0);
            Sv[u][rt] = a;
        }
    }
}
template <int NU, bool SUML>
__device__ __forceinline__ void pv_tile(const unsigned char* Vt, const f32x4 (&Sv)[NU][4], f32x4 (&O)[NU][4], int c16, int g4, f32x4 (&Ol)[NU]) {
    bf16x8 pf[NU][2];
#pragma unroll
    for (int u = 0; u < NU; ++u)
#pragma unroll
        for (int kk = 0; kk < 2; ++kk) {
            u32x4 w; w.x = cvt_pk(Sv[u][2 * kk][0], Sv[u][2 * kk][1]); w.y = cvt_pk(Sv[u][2 * kk][2], Sv[u][2 * kk][3]);
            w.z = cvt_pk(Sv[u][2 * kk + 1][0], Sv[u][2 * kk + 1][1]); w.w = cvt_pk(Sv[u][2 * kk + 1][2], Sv[u][2 * kk + 1][3]);
            pf[u][kk] = __builtin_bit_cast(bf16x8, w);
        }
    if (SUML) {
        const u32x4 o1 = {0x3f803f80u, 0x3f803f80u, 0x3f803f80u, 0x3f803f80u};
        const bf16x8 ones = __builtin_bit_cast(bf16x8, o1);
#pragma unroll
        for (int u = 0; u < NU; ++u) { Ol[u] = __builtin_amdgcn_mfma_f32_16x16x32_bf16(ones, pf[u][0], Ol[u], 0, 0, 0); Ol[u] = __builtin_amdgcn_mfma_f32_16x16x32_bf16(ones, pf[u][1], Ol[u], 0, 0, 0); }
    }
#pragma unroll
    for (int dt = 0; dt < 4; ++dt)
#pragma unroll
        for (int kk = 0; kk < 2; ++kk) {
            const unsigned char* vr = Vt + (16 * dt + c16) * TROW + (32 * kk + 4 * g4) * 2;
            const u32x2 lo = *(const u32x2*)vr, hi = *(const u32x2*)(vr + 32);
            u32x4 w; w.x = lo.x; w.y = lo.y; w.z = hi.x; w.w = hi.y;
            const bf16x8 vf = __builtin_bit_cast(bf16x8, w);
#pragma unroll
            for (int u = 0; u < NU; ++u) O[u][dt] = __builtin_amdgcn_mfma_f32_16x16x32_bf16(vf, pf[u][kk], O[u][dt], 0, 0, 0);
        }
}
constexpr float LAZY = 8.0f;
template <int NU, bool COLMASK, bool FIXED, bool NOSUM = false>
__device__ __forceinline__ void softmax_update(f32x4 (&Sv)[NU][4], float (&m)[NU], float (&l)[NU], f32x4 (&O)[NU][4], bool scaleO, const bool (&colok)[NU]) {
    if (FIXED) {
#pragma unroll
        for (int u = 0; u < NU; ++u) {
            float ps = 0.f;
#pragma unroll
            for (int rt = 0; rt < 4; ++rt)
#pragma unroll
                for (int jj = 0; jj < 4; ++jj) { const float p = __builtin_amdgcn_exp2f(Sv[u][rt][jj]); Sv[u][rt][jj] = p; if (!NOSUM) ps += p; }
            if (!NOSUM) l[u] += ps;
        }
        return;
    }
    float mx[NU]; bool need = false;
#pragma unroll
    for (int u = 0; u < NU; ++u) {
        float v = -INFINITY;
#pragma unroll
        for (int rt = 0; rt < 4; ++rt) v = fmaxf(fmaxf(v, fmaxf(Sv[u][rt][0], Sv[u][rt][1])), fmaxf(Sv[u][rt][2], Sv[u][rt][3]));
        v = fmaxf(v, sxor<16>(v)); v = fmaxf(v, sxor<32>(v));
        if (COLMASK && !colok[u]) v = -INFINITY;
        mx[u] = v;
        need = need || (v > m[u] + LAZY);
    }
    if (__builtin_amdgcn_ballot_w64(need) != 0ull) {
#pragma unroll
        for (int u = 0; u < NU; ++u) {
            if (mx[u] > m[u] + LAZY) {
                const float alpha = __builtin_amdgcn_exp2f(m[u] - mx[u]);
                m[u] = mx[u];
                l[u] *= alpha;
                if (scaleO) {
#pragma unroll
                    for (int dt = 0; dt < 4; ++dt) O[u][dt] = O[u][dt] * alpha;
                }
            }
        }
    }
#pragma unroll
    for (int u = 0; u < NU; ++u) {
        float mu = (m[u] == -INFINITY) ? 0.f : m[u];
        if (COLMASK && !colok[u]) mu = INFINITY;
        float ps = 0.f;
#pragma unroll
        for (int rt = 0; rt < 4; ++rt)
#pragma unroll
            for (int jj = 0; jj < 4; ++jj) { const float p = __builtin_amdgcn_exp2f(Sv[u][rt][jj] - mu); Sv[u][rt][jj] = p; ps += p; }
        l[u] += ps;
    }
}

#define SGB(mask, n) __builtin_amdgcn_sched_group_barrier(mask, n, 0)
template <int NU>
__device__ __forceinline__ void tile_fixed(const unsigned char* Kt, const unsigned char* Vt, const bf16x8 (&qf)[NU][2], f32x4 (&O)[NU][4], float (&l)[NU], int c16, int g4, const float (&init)[NU]) {
    f32x4 Sv[NU][4];
    float ps[NU];
    const unsigned char* kp = Kt + c16 * TROW + 16 * g4;
    const unsigned char* vp = Vt + c16 * TROW + 8 * g4;
#define KRD(rt, h) (*(const bf16x8*)(kp + (16 * (rt)) * TROW + 64 * (h)))
#define VRD(dt, kk) ({ const unsigned char* vr__ = vp + (16 * (dt)) * TROW + 64 * (kk); const u32x2 lo__ = *(const u32x2*)vr__, hi__ = *(const u32x2*)(vr__ + 32); \
                       u32x4 w__; w__.x = lo__.x; w__.y = lo__.y; w__.z = hi__.x; w__.w = hi__.y; __builtin_bit_cast(bf16x8, w__); })
#define QK_RT(rt, K0, K1) { _Pragma("unroll") for (int u = 0; u < NU; ++u) { f32x4 a__ = {init[u], init[u], init[u], init[u]}; \
                              a__ = __builtin_amdgcn_mfma_f32_16x16x32_bf16(K0, qf[u][0], a__, 0, 0, 0); Sv[u][rt] = __builtin_amdgcn_mfma_f32_16x16x32_bf16(K1, qf[u][1], a__, 0, 0, 0); } }
#define EXP_RT(rt) { _Pragma("unroll") for (int u = 0; u < NU; ++u) _Pragma("unroll") for (int jj = 0; jj < 4; ++jj) Sv[u][rt][jj] = __builtin_amdgcn_exp2f(Sv[u][rt][jj]); }
#define SUM_RT(rt) { _Pragma("unroll") for (int jj = 0; jj < 4; ++jj) _Pragma("unroll") for (int u = 0; u < NU; ++u) { ps[u] += Sv[u][rt][jj]; asm("" : "+v"(ps[u])); } }
#define CVT_KK(kk, PF) { _Pragma("unroll") for (int u = 0; u < NU; ++u) { u32x4 w__; w__.x = cvt_pk(Sv[u][2 * (kk)][0], Sv[u][2 * (kk)][1]); w__.y = cvt_pk(Sv[u][2 * (kk)][2], Sv[u][2 * (kk)][3]); \
                           w__.z = cvt_pk(Sv[u][2 * (kk) + 1][0], Sv[u][2 * (kk) + 1][1]); w__.w = cvt_pk(Sv[u][2 * (kk) + 1][2], Sv[u][2 * (kk) + 1][3]); PF[u] = __builtin_bit_cast(bf16x8, w__); } }
#define PV_DT(dt, VF, PF) { _Pragma("unroll") for (int u = 0; u < NU; ++u) O[u][dt] = __builtin_amdgcn_mfma_f32_16x16x32_bf16(VF, PF[u], O[u][dt], 0, 0, 0); }
#pragma unroll
    for (int u = 0; u < NU; ++u) ps[u] = 0.f;
    __builtin_amdgcn_sched_barrier(0);
    bf16x8 ka0 = KRD(0, 0), ka1 = KRD(0, 1), kb0 = KRD(1, 0), kb1 = KRD(1, 1);
    QK_RT(0, ka0, ka1)
    __builtin_amdgcn_sched_barrier(0);
    ka0 = KRD(2, 0); ka1 = KRD(2, 1);
    QK_RT(1, kb0, kb1)
    EXP_RT(0)
    SGB(0x100, 2);
#pragma unroll
    for (int i = 0; i < 2 * NU; ++i) { SGB(0x008, 1); SGB(0x400, 2); }
    __builtin_amdgcn_sched_barrier(0);
    kb0 = KRD(3, 0); kb1 = KRD(3, 1);
    QK_RT(2, ka0, ka1)
    EXP_RT(1)
    SUM_RT(0)
    SGB(0x100, 2);
#pragma unroll
    for (int i = 0; i < 2 * NU; ++i) { SGB(0x008, 1); SGB(0x400, 2); SGB(0x002, 2); }
    __builtin_amdgcn_sched_barrier(0);
    QK_RT(3, kb0, kb1)
    EXP_RT(2)
    SUM_RT(1)
#pragma unroll
    for (int i = 0; i < 2 * NU; ++i) { SGB(0x008, 1); SGB(0x400, 2); SGB(0x002, 2); }
    __builtin_amdgcn_sched_barrier(0);
    bf16x8 pf[NU];
    bf16x8 va = VRD(0, 0), vb = VRD(1, 0);
    CVT_KK(0, pf)
    PV_DT(0, va, pf)
    va = VRD(2, 0);
    PV_DT(1, vb, pf)
    vb = VRD(3, 0);
    EXP_RT(3)
    SUM_RT(2)
    PV_DT(2, va, pf)
    va = VRD(0, 1);
    PV_DT(3, vb, pf)
    vb = VRD(1, 1);
    SGB(0x100, 4); SGB(0x002, 4 * NU);
#pragma unroll
    for (int i = 0; i < 4; ++i) { SGB(0x008, 1); SGB(0x400, 1); SGB(0x002, 1); SGB(0x100, 1); SGB(0x008, 1); SGB(0x400, 1); SGB(0x002, 1); SGB(0x100, 1); SGB(0x008, 1); SGB(0x400, 1); SGB(0x002, 1); }
    __builtin_amdgcn_sched_barrier(0);
    bf16x8 pg[NU];
    CVT_KK(1, pg)
    PV_DT(0, va, pg)
    va = VRD(2, 1);
    PV_DT(1, vb, pg)
    vb = VRD(3, 1);
    PV_DT(2, va, pg)
    PV_DT(3, vb, pg)
    SUM_RT(3)
    SGB(0x002, 4 * NU);
#pragma unroll
    for (int i = 0; i < 4 * NU; ++i) { SGB(0x008, 1); SGB(0x002, 1); }
    __builtin_amdgcn_sched_barrier(0);
#pragma unroll
    for (int u = 0; u < NU; ++u) l[u] += ps[u];
#undef KRD
#undef VRD
#undef QK_RT
#undef EXP_RT
#undef CVT_KK
#undef PV_DT
}

__device__ __forceinline__ u32x4 tile_ld(const bf16* __restrict__ g, int tl) { return *(const u32x4*)(g + tl * 8); }
__device__ __forceinline__ void tile_st(unsigned char* lds_tile, u32x4 v, int tl) { *(u32x4*)(lds_tile + (tl >> 3) * TROW + (tl & 7) * 16) = v; }

template <bool FIXED>
__device__ __forceinline__ void mem_attention_mfma(const bf16* __restrict__ P, int qoff, const bf16* __restrict__ MK, const bf16* __restrict__ MVT, const float* __restrict__ q_gain,
                                                   bf16* __restrict__ AIN, unsigned char* lds, int tid_in, const float Mref) {
    int tid = tid_in; asm volatile("" : "+v"(tid));
    const int lane = tid & 63, wv = tid >> 6, c16 = lane & 15, g4 = lane >> 4;
    for (int item = blockIdx.x; item < NB * 4 * 16; item += gridDim.x) {
        int tl = tid; asm volatile("" : "+v"(tl));
        const int qt = item & 15, h = (item >> 4) & 3, b = item >> 6;
        const bf16* kb = MK + (size_t)(b * 4 + h) * 256 * 64;
        const bf16* vb = MVT + (size_t)(b * 4 + h) * 256 * 64;
        bf16x8 qf[2][2];
        size_t rowq[2];
#pragma unroll
        for (int u = 0; u < 2; ++u) { rowq[u] = (size_t)b * S + qt * 256 + wv * 32 + u * 16 + c16; load_qfrag(qf[u], P + rowq[u] * PP + qoff + h * 64, q_gain, nullptr, g4); }
        f32x4 O[2][4], Ol[2]; float m[2], l[2];
        Ol[0] = (f32x4){0.f, 0.f, 0.f, 0.f}; Ol[1] = (f32x4){0.f, 0.f, 0.f, 0.f};
#pragma unroll
        for (int u = 0; u < 2; ++u) { m[u] = FIXED ? Mref : -INFINITY; l[u] = 0.f;
#pragma unroll
            for (int dt = 0; dt < 4; ++dt) O[u][dt] = (f32x4){0.f, 0.f, 0.f, 0.f}; }
        u32x4 kr = tile_ld(kb, tl), vr = tile_ld(vb, tl);
        __syncthreads();
        tile_st(lds + OFF_K, kr, tl); tile_st(lds + OFF_V, vr, tl);
        __syncthreads();
        for (int kt = 0; kt < 4; ++kt) {
            const int cur = kt & 1;
            if (kt + 1 < 4) { kr = tile_ld(kb + (size_t)(kt + 1) * 4096, tl); vr = tile_ld(vb + (size_t)(kt + 1) * 4096, tl); }
            f32x4 Sv[2][4];
            { const float ini[2] = {FIXED ? -Mref : 0.f, FIXED ? -Mref : 0.f}; qk_tile<2>(lds + OFF_K + cur * TILE_B, qf, Sv, c16, g4, ini); }
            { const bool allok[2] = {true, true}; softmax_update<2, false, FIXED, false>(Sv, m, l, O, true, allok); }
            pv_tile<2, false>(lds + OFF_V + cur * TILE_B, Sv, O, c16, g4, Ol);
            if (kt + 1 < 4) { tile_st(lds + OFF_K + (cur ^ 1) * TILE_B, kr, tl); tile_st(lds + OFF_V + (cur ^ 1) * TILE_B, vr, tl); }
            __syncthreads();
        }
#pragma unroll
        for (int u = 0; u < 2; ++u) {
            float lt = l[u]; lt += sxor<16>(lt); lt += sxor<32>(lt);
            const float inv = 1.f / lt;
#pragma unroll
            for (int dt = 0; dt < 4; ++dt) {
                u32x2 w; w.x = cvt_pk(O[u][dt][0] * inv, O[u][dt][1] * inv); w.y = cvt_pk(O[u][dt][2] * inv, O[u][dt][3] * inv);
                *(u32x2*)(AIN + rowq[u] * D + 768 + h * 64 + 16 * dt + 4 * g4) = w;
            }
        }
    }
}

#define STAGE_BASE() ({ int t__ = tid_in; asm volatile("" : "+v"(t__)); stage + ((3 * (t__ >> 6)) * 16 + (t__ & 15)) * STAGE_ROW + 4 * ((t__ >> 4) & 3); })
template <bool FIXED, int VAR = 0>
__device__ __forceinline__ void nsa_attention_mfma(const bf16* __restrict__ P, const bf16* __restrict__ KC, const bf16* __restrict__ VCT, const bf16* __restrict__ KS, const bf16* __restrict__ VST,
                                                   const bf16* __restrict__ KW, const bf16* __restrict__ VWT, const float* __restrict__ rope, const float* __restrict__ qgain,
                                                   const float* __restrict__ gate_b, bf16* __restrict__ AIN, unsigned char* lds, int tid_in, const float Mc, const float Ms, const float Mw) {
    int* imp = (int*)(lds + OFF_IMP);
    unsigned* selw = (unsigned*)(lds + OFF_SEL);
    unsigned* anyw = (unsigned*)(lds + OFF_ANY);
    float* stage = (float*)(lds + OFF_STAGE);
    const int nitems = NB * 2 * 64;
    for (int it = blockIdx.x; it < nitems; it += gridDim.x) {
        int tid = tid_in; asm volatile("" : "+v"(tid));
        const int lane = tid & 63, wv = tid >> 6, c16 = lane & 15, g4 = lane >> 4;
        int tl = tid; asm volatile("" : "+v"(tl));
        int b, g, c;
        if (gridDim.x == 256) { const int k = blockIdx.x, r = it >> 8, bg = 2 * (k & 7) + ((k >> 3) & 1), s = k >> 4;
            b = bg >> 1; g = bg & 1; c = (r == 0) ? s : (r == 1) ? 31 - s : (r == 2) ? 32 + s : 63 - s; }
        else { c = it & 63; g = (it >> 6) & 1; b = it >> 7; }
        const int bg2 = b * 2 + g;
        const bf16* kcb = KC + (size_t)(b * 2 + g) * 256 * 64;
        u32x4 kr0 = ((VAR == 1) ? (u32x4){0u, 0u, 0u, 0u} : tile_ld(kcb, tl));
        bf16x8 qf[3][2]; int qq[3], hq[3];
#pragma unroll
        for (int u = 0; u < 3; ++u) {
            const int U = 3 * wv + u; hq[u] = g * 6 + (U >> 2); qq[u] = (U & 3) * 16 + c16;
            const size_t row = (size_t)b * S + c * 64 + qq[u];
            load_qfrag(qf[u], P + row * PP + 768 + hq[u] * 64, qgain, rope + (size_t)(c * 64 + qq[u]) * 16, g4);
        }
        __syncthreads();
        for (int i = tid; i < 64 * 64; i += NTHR) imp[i] = 0;
        if (tid < 2) anyw[tid] = 0u;
        f32x4 O[3][4], Ol[3]; float m[3], l[3];
        Ol[0] = (f32x4){0.f, 0.f, 0.f, 0.f}; Ol[1] = Ol[0]; Ol[2] = Ol[0];
        const int ktmax = (VAR == 3) ? -1 : (((4 * c + 2) >> 6) > 3 ? 3 : ((4 * c + 2) >> 6));
        const bf16* vcb = VCT + (size_t)bg2 * 256 * 64;
#pragma unroll
        for (int u = 0; u < 3; ++u) { m[u] = FIXED ? Mc : -INFINITY; l[u] = 0.f; }
        const float inic[3] = {FIXED ? -Mc : 0.f, FIXED ? -Mc : 0.f, FIXED ? -Mc : 0.f};
        {
            u32x4 kr = kr0;
            __syncthreads();
            if (VAR != 1) tile_st(lds + OFF_K, kr, tl);
            __syncthreads();
            for (int kt = 0; kt <= ktmax; ++kt) {
                const int cur = kt & 1;
                if (kt + 1 <= ktmax) kr = ((VAR == 1) ? (u32x4){0u, 0u, 0u, 0u} : tile_ld(kcb + (size_t)(kt + 1) * 4096, tl));
                f32x4 Sv[3][4];
                if (VAR < 2) qk_tile<3>(lds + OFF_K + cur * TILE_B, qf, Sv, c16, g4, inic); else { _Pragma("unroll") for (int u = 0; u < 3; ++u) _Pragma("unroll") for (int rt = 0; rt < 4; ++rt) Sv[u][rt] = (f32x4){0.f, 0.f, 0.f, 0.f}; }
#pragma unroll
                for (int u = 0; u < 3; ++u) { const int t = c * 64 + qq[u];
#pragma unroll
                    for (int rt = 0; rt < 4; ++rt)
#pragma unroll
                        for (int jj = 0; jj < 4; ++jj) { const int n = 64 * kt + 16 * rt + 4 * g4 + jj; if (!(n < NCMP && 16 * n + 31 <= t)) Sv[u][rt][jj] = -INFINITY; } }
                { const bool allok[3] = {true, true, true}; softmax_update<3, false, FIXED>(Sv, m, l, O, false, allok); }
                if (kt + 1 <= ktmax) if (VAR != 1) tile_st(lds + OFF_K + (cur ^ 1) * TILE_B, kr, tl);
                __syncthreads();
            }
        }
        float invl[3], mu[3];
#pragma unroll
        for (int u = 0; u < 3; ++u) { float lt = l[u]; lt += sxor<16>(lt); lt += sxor<32>(lt); invl[u] = (lt > 0.f) ? 1.f / lt : 0.f; mu[u] = FIXED ? 0.f : ((m[u] == -INFINITY) ? 0.f : m[u]);
#pragma unroll
            for (int dt = 0; dt < 4; ++dt) O[u][dt] = (f32x4){0.f, 0.f, 0.f, 0.f}; }
        {
            u32x4 kr = ((VAR == 1) ? (u32x4){0u, 0u, 0u, 0u} : tile_ld(kcb, tl)), vr = ((VAR == 1) ? (u32x4){0u, 0u, 0u, 0u} : tile_ld(vcb, tl));
            if (VAR != 1) tile_st(lds + OFF_K, kr, tl); if (VAR != 1) tile_st(lds + OFF_V, vr, tl);
            __syncthreads();
            for (int kt = 0; kt <= ktmax; ++kt) {
                const int cur = kt & 1;
                if (kt + 1 <= ktmax) { kr = ((VAR == 1) ? (u32x4){0u, 0u, 0u, 0u} : tile_ld(kcb + (size_t)(kt + 1) * 4096, tl)); vr = ((VAR == 1) ? (u32x4){0u, 0u, 0u, 0u} : tile_ld(vcb + (size_t)(kt + 1) * 4096, tl)); }
                f32x4 Sv[3][4];
                if (VAR < 2) qk_tile<3>(lds + OFF_K + cur * TILE_B, qf, Sv, c16, g4, inic); else { _Pragma("unroll") for (int u = 0; u < 3; ++u) _Pragma("unroll") for (int rt = 0; rt < 4; ++rt) Sv[u][rt] = (f32x4){0.f, 0.f, 0.f, 0.f}; }
#pragma unroll
                for (int u = 0; u < 3; ++u) { const int t = c * 64 + qq[u];
#pragma unroll
                    for (int rt = 0; rt < 4; ++rt) {
#pragma unroll
                        for (int jj = 0; jj < 4; ++jj) { const int n = 64 * kt + 16 * rt + 4 * g4 + jj; const bool ok = (n < NCMP && 16 * n + 31 <= t);
                            Sv[u][rt][jj] = ok ? __builtin_amdgcn_exp2f(Sv[u][rt][jj] - mu[u]) * invl[u] : 0.f; }
                        const int j = 16 * kt + 4 * rt + g4;
                        const float mainv = Sv[u][rt][0] + Sv[u][rt][1] + Sv[u][rt][2] + 0.5f * Sv[u][rt][3], spill = 0.5f * Sv[u][rt][3];
                        atomicAdd(&imp[qq[u] * 64 + j], (int)(mainv * 16777216.f + 0.5f));
                        if (j + 1 < 64) atomicAdd(&imp[qq[u] * 64 + j + 1], (int)(spill * 16777216.f + 0.5f));
                    } }
                pv_tile<3, false>(lds + OFF_V + cur * TILE_B, Sv, O, c16, g4, Ol);
                if (kt + 1 <= ktmax) { if (VAR != 1) tile_st(lds + OFF_K + (cur ^ 1) * TILE_B, kr, tl); if (VAR != 1) tile_st(lds + OFF_V + (cur ^ 1) * TILE_B, vr, tl); }
                __syncthreads();
            }
        }
#pragma unroll
        for (int u = 0; u < 3; ++u) { const float gcmp = sigmoidf_(ldbf(P + ((size_t)b * S + c * 64 + qq[u]) * PP + 1536 + hq[u] * 3 + 0) + gate_b[hq[u] * 3 + 0]);
#pragma unroll
            for (int dt = 0; dt < 4; ++dt) *(f32x4*)(STAGE_BASE() + (u * 16) * STAGE_ROW + 16 * dt) = O[u][dt] * gcmp; }
        const bf16* ksb = KS + (size_t)bg2 * S * 64;
        const bf16* vsb = VST + (size_t)bg2 * S * 64;
        u32x4 kA = ((VAR == 1) ? (u32x4){0u, 0u, 0u, 0u} : tile_ld(ksb, tl)), vA = ((VAR == 1) ? (u32x4){0u, 0u, 0u, 0u} : tile_ld(vsb, tl)), kB, vB;
        {
#pragma unroll 1
            for (int i = 0; i < 8; ++i) {
                const int q = 8 * wv + i, j = lane;
                int v = imp[q * 64 + j];
                const bool valid = j <= c, forced = (j == 0) || (j == c) || (j == c - 1);
                v = forced ? 0x7fffffc0 : (v & ~63);
                v = valid ? (v | (63 - j)) : -1;
                int rank = 0;
#pragma unroll
                for (int jj = 0; jj < 64; ++jj) { const int o = __builtin_amdgcn_readlane(v, jj); rank += (o > v) ? 1 : 0; }
                const unsigned long long msk = __ballot(rank < 16 && v >= 0);
                if (lane == 0) { selw[2 * q] = (unsigned)msk; selw[2 * q + 1] = (unsigned)(msk >> 32); atomicOr(&anyw[0], (unsigned)msk); atomicOr(&anyw[1], (unsigned)(msk >> 32)); }
            }
        }
        __syncthreads();
        unsigned long long anym = (unsigned long long)anyw[0] | ((unsigned long long)anyw[1] << 32);
        unsigned long long selm[3];
#pragma unroll
        for (int u = 0; u < 3; ++u) selm[u] = (unsigned long long)selw[2 * qq[u]] | ((unsigned long long)selw[2 * qq[u] + 1] << 32);
        {
#pragma unroll
            for (int u = 0; u < 3; ++u) { m[u] = FIXED ? Ms : -INFINITY; l[u] = 0.f; Ol[u] = (f32x4){0.f, 0.f, 0.f, 0.f};
#pragma unroll
                for (int dt = 0; dt < 4; ++dt) O[u][dt] = (f32x4){0.f, 0.f, 0.f, 0.f}; }
            auto nextsel = [&](int jj) -> int { const unsigned long long rest = (jj < 63) ? (anym >> (jj + 1)) : 0ull; return rest ? (jj + 1 + __builtin_ctzll(rest)) : -1; };
            auto compute = [&](int jj, int cur, bool diag) {
                bool colok[3]; float inis[3];
#pragma unroll
                for (int u = 0; u < 3; ++u) { colok[u] = (selm[u] >> jj) & 1ull; inis[u] = FIXED ? (colok[u] ? -Ms : -INFINITY) : 0.f; }
                if (FIXED && VAR == 0 && !diag) { tile_fixed<3>(lds + OFF_K + cur * TILE_B, lds + OFF_V + cur * TILE_B, qf, O, l, c16, g4, inis); return; }
                f32x4 Sv[3][4];
                if (VAR < 2) qk_tile<3>(lds + OFF_K + cur * TILE_B, qf, Sv, c16, g4, inis); else { _Pragma("unroll") for (int u = 0; u < 3; ++u) _Pragma("unroll") for (int rt = 0; rt < 4; ++rt) Sv[u][rt] = (f32x4){0.f, 0.f, 0.f, 0.f}; }
                if (diag) {
#pragma unroll
                    for (int u = 0; u < 3; ++u) { int qo = qq[u] - 4 * g4; asm volatile("" : "+v"(qo));
#pragma unroll
                        for (int rt = 0; rt < 4; ++rt)
#pragma unroll
                            for (int e = 0; e < 4; ++e) { if (16 * rt + e > qo) Sv[u][rt][e] = -INFINITY; } }
                }
                if (VAR < 2) { softmax_update<3, true, FIXED, false>(Sv, m, l, O, true, colok);
                pv_tile<3, false>(lds + OFF_V + cur * TILE_B, Sv, O, c16, g4, Ol); }
            };
            int j = __builtin_ctzll(anym);
            if (VAR != 1) tile_st(lds + OFF_K, kA, tl); if (VAR != 1) tile_st(lds + OFF_V, vA, tl);
            __syncthreads();
            int jn = nextsel(j), jnn, cur = 0;
            if (jn >= 0) { kA = ((VAR == 1) ? (u32x4){0u, 0u, 0u, 0u} : tile_ld(ksb + (size_t)jn * 4096, tl)); vA = ((VAR == 1) ? (u32x4){0u, 0u, 0u, 0u} : tile_ld(vsb + (size_t)jn * 4096, tl)); }
            if (!FIXED) {
                for (;;) {
                    jnn = (jn >= 0) ? nextsel(jn) : -1;
                    if (jnn >= 0) { kB = tile_ld(ksb + (size_t)jnn * 4096, tl); vB = tile_ld(vsb + (size_t)jnn * 4096, tl); }
                    compute(j, cur, j == c);
                    if (jn >= 0) { tile_st(lds + OFF_K + (cur ^ 1) * TILE_B, kA, tl); tile_st(lds + OFF_V + (cur ^ 1) * TILE_B, vA, tl); }
                    __syncthreads();
                    if (jn < 0) break;
                    j = jn; jn = jnn; cur ^= 1;
                    jnn = (jn >= 0) ? nextsel(jn) : -1;
                    if (jnn >= 0) { kA = tile_ld(ksb + (size_t)jnn * 4096, tl); vA = tile_ld(vsb + (size_t)jnn * 4096, tl); }
                    compute(j, cur, j == c);
                    if (jn >= 0) { tile_st(lds + OFF_K + (cur ^ 1) * TILE_B, kB, tl); tile_st(lds + OFF_V + (cur ^ 1) * TILE_B, vB, tl); }
                    __syncthreads();
                    if (jn < 0) break;
                    j = jn; jn = jnn; cur ^= 1;
                }
            } else {
            while (jn >= 0) {
                jnn = nextsel(jn);
                if (jnn >= 0) { kB = ((VAR == 1) ? (u32x4){0u, 0u, 0u, 0u} : tile_ld(ksb + (size_t)jnn * 4096, tl)); vB = ((VAR == 1) ? (u32x4){0u, 0u, 0u, 0u} : tile_ld(vsb + (size_t)jnn * 4096, tl)); }
                compute(j, cur, false);
                if (VAR != 1) tile_st(lds + OFF_K + (cur ^ 1) * TILE_B, kA, tl); if (VAR != 1) tile_st(lds + OFF_V + (cur ^ 1) * TILE_B, vA, tl);
                __syncthreads();
                j = jn; jn = jnn; cur ^= 1;
                if (jn < 0) break;
                jnn = nextsel(jn);
                if (jnn >= 0) { kA = ((VAR == 1) ? (u32x4){0u, 0u, 0u, 0u} : tile_ld(ksb + (size_t)jnn * 4096, tl)); vA = ((VAR == 1) ? (u32x4){0u, 0u, 0u, 0u} : tile_ld(vsb + (size_t)jnn * 4096, tl)); }
                compute(j, cur, false);
                if (VAR != 1) tile_st(lds + OFF_K + (cur ^ 1) * TILE_B, kB, tl); if (VAR != 1) tile_st(lds + OFF_V + (cur ^ 1) * TILE_B, vB, tl);
                __syncthreads();
                j = jn; jn = jnn; cur ^= 1;
            }
            compute(j, cur, true);
            __syncthreads();
            }
#pragma unroll
            for (int u = 0; u < 3; ++u) { float lt = l[u]; lt += sxor<16>(lt); lt += sxor<32>(lt); const float sc = (lt > 0.f) ? sigmoidf_(ldbf(P + ((size_t)b * S + c * 64 + qq[u]) * PP + 1536 + hq[u] * 3 + 1) + gate_b[hq[u] * 3 + 1]) / lt : 0.f;
#pragma unroll
                for (int dt = 0; dt < 4; ++dt) { float* sp = STAGE_BASE() + (u * 16) * STAGE_ROW + 16 * dt; *(f32x4*)sp = *(f32x4*)sp + O[u][dt] * sc; } }
        }
        {
            const bf16* kwb = KW + (size_t)bg2 * S * 64;
            const bf16* vwb = VWT + (size_t)bg2 * S * 64;
#pragma unroll
            for (int u = 0; u < 3; ++u) { m[u] = FIXED ? Mw : -INFINITY; l[u] = 0.f; Ol[u] = (f32x4){0.f, 0.f, 0.f, 0.f};
#pragma unroll
                for (int dt = 0; dt < 4; ++dt) O[u][dt] = (f32x4){0.f, 0.f, 0.f, 0.f}; }
            const float iniw[3] = {FIXED ? -Mw : 0.f, FIXED ? -Mw : 0.f, FIXED ? -Mw : 0.f};
            const int j0 = (c >= 8) ? c - 8 : 0;
            u32x4 kr = ((VAR == 1) ? (u32x4){0u, 0u, 0u, 0u} : tile_ld(kwb + (size_t)j0 * 4096, tl)), vr = ((VAR == 1) ? (u32x4){0u, 0u, 0u, 0u} : tile_ld(vwb + (size_t)j0 * 4096, tl));
            if (VAR != 1) tile_st(lds + OFF_K, kr, tl); if (VAR != 1) tile_st(lds + OFF_V, vr, tl);
            __syncthreads();
            int cur = 0;
            auto wstep = [&](int j, bool fast) {
                if (j + 1 <= c) { kr = ((VAR == 1) ? (u32x4){0u, 0u, 0u, 0u} : tile_ld(kwb + (size_t)(j + 1) * 4096, tl)); vr = ((VAR == 1) ? (u32x4){0u, 0u, 0u, 0u} : tile_ld(vwb + (size_t)(j + 1) * 4096, tl)); }
                if (FIXED && VAR == 0 && fast) tile_fixed<3>(lds + OFF_K + cur * TILE_B, lds + OFF_V + cur * TILE_B, qf, O, l, c16, g4, iniw);
                else {
                    f32x4 Sv[3][4];
                    if (VAR < 2) qk_tile<3>(lds + OFF_K + cur * TILE_B, qf, Sv, c16, g4, iniw); else { _Pragma("unroll") for (int u = 0; u < 3; ++u) _Pragma("unroll") for (int rt = 0; rt < 4; ++rt) Sv[u][rt] = (f32x4){0.f, 0.f, 0.f, 0.f}; }
                    if (j == c || j == c - 8) {
#pragma unroll
                        for (int u = 0; u < 3; ++u) { int qo = qq[u] - 4 * g4; asm volatile("" : "+v"(qo));
#pragma unroll
                            for (int rt = 0; rt < 4; ++rt)
#pragma unroll
                                for (int jj = 0; jj < 4; ++jj) { const int kk = 16 * rt + jj; const bool ok = (j == c) ? (kk <= qo) : (kk > qo); if (!ok) Sv[u][rt][jj] = -INFINITY; } }
                    }
                    if (VAR < 2) { { const bool allok[3] = {true, true, true}; softmax_update<3, false, FIXED, false>(Sv, m, l, O, true, allok); }
                    pv_tile<3, false>(lds + OFF_V + cur * TILE_B, Sv, O, c16, g4, Ol); }
                }
                if (j + 1 <= c) { if (VAR != 1) tile_st(lds + OFF_K + (cur ^ 1) * TILE_B, kr, tl); if (VAR != 1) tile_st(lds + OFF_V + (cur ^ 1) * TILE_B, vr, tl); }
                __syncthreads();
                cur ^= 1;
            };
            if (!FIXED) { for (int j = j0; j <= c; ++j) wstep(j, false); }
            else {
                wstep(j0, false);
                for (int j = j0 + 1; j < c; ++j) wstep(j, true);
                if (c > j0) wstep(c, false);
            }
#pragma unroll
            for (int u = 0; u < 3; ++u) { float lt = l[u]; lt += sxor<16>(lt); lt += sxor<32>(lt); const float sc = (lt > 0.f) ? sigmoidf_(ldbf(P + ((size_t)b * S + c * 64 + qq[u]) * PP + 1536 + hq[u] * 3 + 2) + gate_b[hq[u] * 3 + 2]) / lt : 0.f;
#pragma unroll
                for (int dt = 0; dt < 4; ++dt) { float* sp = STAGE_BASE() + (u * 16) * STAGE_ROW + 16 * dt; *(f32x4*)sp = *(f32x4*)sp + O[u][dt] * sc; } }
        }
        __syncthreads();
        for (int i = tid; i < 384 * 8; i += NTHR) {
            const int d8 = i & 7, col = i >> 3, r = col >> 6, q = col & 63;
            const float* sp = stage + col * STAGE_ROW + d8 * 8;
            const f32x4 a = *(const f32x4*)sp, bb = *(const f32x4*)(sp + 4);
            u32x4 w; w.x = cvt_pk(a[0], a[1]); w.y = cvt_pk(a[2], a[3]); w.z = cvt_pk(bb[0], bb[1]); w.w = cvt_pk(bb[2], bb[3]);
            *(u32x4*)(AIN + ((size_t)b * S + c * 64 + q) * D + (g * 6 + r) * 64 + d8 * 8) = w;
        }
    }
}
}

#define XB_LAS __attribute__((address_space(3)))
#define XB_TMO      128
#define XB_XCNT(j)  (256  + 64 * (j))
#define XB_XSUB(j)  (1280 + 64 * (j))
#define XB_XGEN(j)  (2304 + 64 * (j))
#define XB_TOP      3328
#define XB_TOPGEN   3392
#define XCD_BAR_WORDS 3456
#define XB_SPIN_CAP (1u << 18)

__device__ __forceinline__ unsigned xb_ld(unsigned* p)              { return __hip_atomic_load(p, __ATOMIC_RELAXED, __HIP_MEMORY_SCOPE_AGENT); }
__device__ __forceinline__ unsigned xb_add(unsigned* p, unsigned v) { return __hip_atomic_fetch_add(p, v, __ATOMIC_RELAXED, __HIP_MEMORY_SCOPE_AGENT); }
__device__ __forceinline__ unsigned xb_xcc_id() { return (unsigned)__builtin_amdgcn_s_getreg((3 << 11) | 20) & 0xFu; }
#define XB_SPIN(cond, bar) do { unsigned _sp = 0; while (cond) { __builtin_amdgcn_s_sleep(1); \
    if ((++_sp & 255u) == 0u) { if (xb_ld(&(bar)[XB_TMO])) break; if (_sp > XB_SPIN_CAP) { atomicAdd(&(bar)[XB_TMO], 1u); break; } } } } while (0)

struct XcdBarrier {
    unsigned* bar; unsigned x;
    volatile XB_LAS unsigned* st;
};

__device__ __forceinline__ XcdBarrier xcd_barrier_post(unsigned* bar, volatile XB_LAS unsigned* st) {
    XcdBarrier b; b.bar = bar; b.x = xb_xcc_id(); b.st = st;
    if (threadIdx.x == 0) { const unsigned rank = xb_add(&bar[XB_XCNT(b.x)], 1u); st[2] = b.x; st[3] = rank; }
    return b;
}
__device__ __forceinline__ void xcd_barrier_complete(unsigned* bar, unsigned x, unsigned& nloc, unsigned& nx) {
    const unsigned G = gridDim.x * gridDim.y * gridDim.z;
    unsigned sum, cnt, mine, sp = 0u;
    for (;;) {
        sum = 0u; cnt = 0u; mine = 0u;
#pragma unroll
        for (unsigned j = 0; j < 16; ++j) { const unsigned c = xb_ld(&bar[XB_XCNT(j)]); sum += c; cnt += (c > 0u) ? 1u : 0u; mine = (j == x) ? c : mine; }
        if (sum == G) break;
        __builtin_amdgcn_s_sleep(1);
        if ((++sp & 255u) == 0u) { if (xb_ld(&bar[XB_TMO])) break; if (sp > XB_SPIN_CAP) { atomicAdd(&bar[XB_TMO], 1u); break; } }
    }
    nloc = mine > 0u ? mine : 1u; nx = cnt > 0u ? cnt : 1u;
}

__device__ __forceinline__ void xcd_barrier(const XcdBarrier& b, const bool leader_thread) {
    asm volatile("s_waitcnt vmcnt(0)" ::: "memory");
    __syncthreads();
    if (leader_thread) {
        unsigned* bar = b.bar;
        __builtin_amdgcn_s_waitcnt(0);
        unsigned nloc = b.st[0], nx = b.st[1];
        if (nloc == 0u) { xcd_barrier_complete(bar, b.x, nloc, nx); b.st[0] = nloc; b.st[1] = nx; }
        const unsigned old = xb_add(&bar[XB_XSUB(b.x)], 1u);
        const unsigned gen = old / nloc;
        if (old + 1u == (gen + 1u) * nloc) {
            __builtin_amdgcn_fence(__ATOMIC_RELEASE, "agent");
            asm volatile("s_waitcnt vmcnt(0)" ::: "memory");
            const unsigned og = xb_add(&bar[XB_TOP], 1u);
            const unsigned tg = og / nx;
            if (og + 1u == (tg + 1u) * nx) xb_add(&bar[XB_TOPGEN], 1u);
            else XB_SPIN(xb_ld(&bar[XB_TOPGEN]) == tg, bar);
            __builtin_amdgcn_fence(__ATOMIC_ACQUIRE, "agent");
            xb_add(&bar[XB_XGEN(b.x)], 1u);
            asm volatile("s_waitcnt vmcnt(0)" ::: "memory");
        } else {
            XB_SPIN(xb_ld(&bar[XB_XGEN(b.x)]) == gen, bar);
            __builtin_amdgcn_fence(__ATOMIC_ACQUIRE, "agent");
            asm volatile("s_waitcnt vmcnt(0)" ::: "memory");
        }
    }
    __syncthreads();
}

__device__ __forceinline__ void xcd_barrier_here(unsigned char* ws_ctl, volatile XB_LAS unsigned* st, const bool leader_thread) {
    XcdBarrier b; b.bar = (unsigned*)ws_ctl; b.x = xb_xcc_id(); b.st = st;
    xcd_barrier(b, leader_thread);
}

constexpr int N_PHASES = 18;
constexpr int LDS_BYTES = 163840;
static_assert((pg8::EpiTopK::LIST_OFF + 256 * 16) * 4 <= LDS_BYTES - 64 - 256, "top-k LDS map");
static_assert(att::LDS_NEED <= LDS_BYTES - 64 - 256, "attention LDS map (the last 64 B hold the grid barrier's set-up words)");
#define PG8_SP2_ON true

template <int LO, int HI>
__global__ void __launch_bounds__(NTHR) fwd_kernel(Params p) {
    cg::grid_group grid = cg::this_grid();
    extern __shared__ __attribute__((aligned(16))) unsigned char lds_raw[];
    float* smem = (float*)lds_raw;
    PG8_LAS unsigned char* ldsp = (PG8_LAS unsigned char*)lds_raw;
    constexpr int lo = LO, hi = HI;
    int ph = 0;
    const int wave_s__ = __builtin_amdgcn_readfirstlane(threadIdx.x >> 6);
    if (threadIdx.x < 30) ((const float* XB_LAS*)((XB_LAS unsigned char*)lds_raw + (LDS_BYTES - 64 - 256)))[threadIdx.x] = p.in[threadIdx.x];
    __syncthreads();
#define INP(i) ((const float*)lds_ptr_uniform((XB_LAS unsigned char*)lds_raw + (LDS_BYTES - 64 - 256) + 8 * (i)))
    if (hi - lo > 1) {
        if (threadIdx.x < 16) ((volatile XB_LAS unsigned*)((XB_LAS unsigned char*)lds_raw + (LDS_BYTES - 64)))[threadIdx.x] = 0u;
        __syncthreads();
        (void)xcd_barrier_post((unsigned*)(p.ws + WS_CTL), (volatile XB_LAS unsigned*)((XB_LAS unsigned char*)lds_raw + (LDS_BYTES - 64)));
    }
#define GRID_BAR() xcd_barrier_here(p.ws + WS_CTL, (volatile XB_LAS unsigned*)((XB_LAS unsigned char*)lds_raw + (LDS_BYTES - 64)), wave_s__ == 0 && lane_now() == 0)
#define PHASE_PROLOGUE \
    const int wv = wave_s__; \
    const int tid = wave_s__ * 64 + lane_now(); \
    const int lane = tid & 63; \
    const int gw = blockIdx.x * (NTHR / 64) + wv, ngw = gridDim.x * (NTHR / 64); \
    const int gtid = blockIdx.x * NTHR + tid, ngt = gridDim.x * NTHR; \
    const int G = gridDim.x; \
    const float* x = INP(0); const float* mem = INP(1); const int* positions = (const int*)INP(2); \
    const float* norm_mix = INP(3); const float* norm_ffn = INP(4); const float* norm_mem = INP(5); \
    const float* w_out = INP(6); const float* w_mem_kv = INP(7); const float* mem_q_gain = INP(8); const float* mem_k_gain = INP(9); \
    const float* a_w_in = INP(10); const float* a_conv_w = INP(11); const float* a_conv_b = INP(12); const float* a_gate_w = INP(13); \
    const float* a_gate_b = INP(14); const float* a_lambda = INP(15); const float* b_w_in = INP(16); const float* b_gate_b = INP(17); \
    const float* b_q_gain = INP(18); const float* kv_norm = INP(19); const float* w_kv_shared = INP(20); const float* k_gain_shared = INP(21); \
    const float* cmp_pos = INP(22); const float* cmp_w1 = INP(23); const float* cmp_b1 = INP(24); const float* cmp_w2 = INP(25); \
    const float* peer_wq = INP(26); const float* peer_subkeys = INP(27); const float* peer_u = INP(28); const float* peer_v = INP(29); \
    float* out = p.out; \
    unsigned char* ws = p.ws; asm volatile("" : "+s"(ws)); \
    float* RSTD = (float*)(ws + WS_RSTD); \
    float* rstd0 = RSTD, *rstd2 = RSTD + 2 * T, *rstdm = RSTD + 4 * T; \
    float* sumsq1 = (float*)(ws + WS_SSQ1), *sumsq3 = (float*)(ws + WS_SSQ3); \
    float* ROPE = (float*)(ws + WS_ROPE); float* BIAS2 = (float*)(ws + WS_BIAS2); bf16* WGF = (bf16*)(ws + WS_WGF); \
    bf16* WIN0 = (bf16*)(ws + WS_WIN0); bf16* WOUT = (bf16*)(ws + WS_WOUT); bf16* WFt = (bf16*)(ws + WS_WF); bf16* WKVB = (bf16*)(ws + WS_WKVB); \
    bf16* WMEM = (bf16*)(ws + WS_WMEM); bf16* WC1 = (bf16*)(ws + WS_WC1); bf16* MEMB = (bf16*)(ws + WS_MEMB); bf16* MEMKV = (bf16*)(ws + WS_MEMKV); \
    float* AGG = (float*)(ws + WS_SCAN); bf16* HID = (bf16*)(ws + WS_HID); bf16* KC = (bf16*)(ws + WS_KC); bf16* VC = (bf16*)(ws + WS_VC); \
    bf16* CA = (bf16*)(ws + WS_CA); int* E = (int*)(ws + WS_E); float* Gt = (float*)(ws + WS_GT); bf16* KS = (bf16*)(ws + WS_KS); bf16* KW = (bf16*)(ws + WS_KW); \
    bf16* XB = (bf16*)(ws + WS_XB); bf16* AIN = (bf16*)(ws + WS_AIN); bf16* P = (bf16*)(ws + WS_P); \
    unsigned char* UT8 = ws + WS_UT; unsigned char* VT8 = ws + WS_VT; float* PART = (float*)(ws + WS_P); float* sumsq2 = (float*)(ws + WS_SSQ2); \
    bf16* MEMK = (bf16*)(ws + WS_MEMK); bf16* MEMVT = (bf16*)(ws + WS_MEMVT); bf16* VST = (bf16*)(ws + WS_VST); bf16* VWT = (bf16*)(ws + WS_VWT); \
    (void)lane; (void)gw; (void)ngw; (void)gtid; (void)ngt; (void)G;

#define SLICE_COORDS() \
    int sl_xs, sl_r, sl_nr; { \
        const unsigned* ctlw = (const unsigned*)(ws + WS_CTL); \
        bool clean = (gridDim.x & 7) == 0; \
        _Pragma("unroll") for (int jx = 0; jx < 8; ++jx) clean = clean && (__hip_atomic_load(ctlw + XB_XCNT(jx), __ATOMIC_RELAXED, __HIP_MEMORY_SCOPE_AGENT) == gridDim.x / 8); \
        volatile XB_LAS unsigned* stw = (volatile XB_LAS unsigned*)((XB_LAS unsigned char*)lds_raw + (LDS_BYTES - 64)); \
        const int hx = (int)stw[2], hr = (int)stw[3]; \
        if (clean) { sl_xs = __builtin_amdgcn_readfirstlane(hx); sl_r = __builtin_amdgcn_readfirstlane(hr); sl_nr = gridDim.x / 8; } \
        else { sl_xs = blockIdx.x & 7; sl_r = blockIdx.x >> 3; sl_nr = (gridDim.x - sl_xs + 7) >> 3; } }
#ifndef PROBE_SUB
#define PROBE_SUB (-1)
#endif
#define SUBREP(id) for (int r2__ = 0; r2__ < ((PROBE_SUB == (id)) ? 2 : 1); ++r2__)
#ifndef PROBE_DUP
#define PROBE_DUP (-1)
#endif
#define PHASE_BEGIN if (ph >= lo && ph < hi) { for (int rep__ = (ph == PROBE_DUP ? 0 : 1); rep__ < 2; ++rep__) { PHASE_PROLOGUE
#define PHASE_END if (rep__ == 0) GRID_BAR(); } } ++ph; if (ph > lo && ph < hi) { if (ph == 1) grid.sync(); else GRID_BAR(); }

    PHASE_BEGIN
        SUBREP(1) for (int r = gw; r < T; r += ngw) row_to_bf16(x + (size_t)r * D, XB + (size_t)r * D, rstd0 + r, lane);
        for (int r = gw; r < NB * MEMN; r += ngw) row_to_bf16(mem + (size_t)r * D, MEMB + (size_t)r * D, rstdm + r, lane);
        for (int i = gtid; i < S * 8; i += ngt) {
            const int s = i >> 3, k = i & 7;
            const float freq = powf(500000.0f, -(float)k / 8.0f);
            const float ang = (float)positions[s] * freq;
            ROPE[s * 16 + k] = cosf(ang); ROPE[s * 16 + 8 + k] = sinf(ang);
        }
        SUBREP(2) {
            float* scr = smem + wv * (64 * 33);
            constexpr int I_IN0 = 16 * 56, I_OUT = 16 * 32, I_KV = 16 * 24, I_BIN = 16 * 34, I_MEM = 16 * 16, I_C1 = 32 * 8;
            constexpr int NIT = I_IN0 + 2 * I_OUT + I_KV + I_BIN + 2 * I_MEM + 2 * I_C1;
            for (int it = gw; it < NIT; it += ngw) {
                int r = it;
                if (r < I_IN0) { transpose_item(a_w_in, D, 1792, norm_mix, WIN0, 0, scr, r, lane); continue; } r -= I_IN0;
                if (r < I_OUT) { transpose_item(w_out, D, D, nullptr, WOUT, 0, scr, r, lane); continue; } r -= I_OUT;
                if (r < I_OUT) { transpose_item(w_out + (size_t)D * D, D, D, nullptr, WOUT + (size_t)D * D, 0, scr, r, lane); continue; } r -= I_OUT;
                if (r < I_KV) { transpose_item(w_kv_shared, D, 768, kv_norm, WKVB, 0, scr, r, lane); continue; } r -= I_KV;
                if (r < I_BIN) { transpose_item(b_w_in, D, 1060, norm_mix + D, WKVB, 768, scr, r, lane); continue; } r -= I_BIN;
                if (r < I_MEM) { transpose_item(w_mem_kv, D, 512, norm_mem, WMEM, 0, scr, r, lane); continue; } r -= I_MEM;
                if (r < I_MEM) { transpose_item(w_mem_kv + (size_t)D * 512, D, 512, norm_mem + D, WMEM, 512, scr, r, lane); continue; } r -= I_MEM;
                { const int j = r / I_C1, rq = r % I_C1, ks = rq >> 6;
                  transpose_item(cmp_w1 + ((size_t)j * 2048 + ks * 512) * 256, 512, 256, nullptr, WC1 + ((size_t)(j * 4 + ks) * 256) * 512, 0, scr, rq & 63, lane); }
            }
            for (int i = gtid; i < 220 * 1024 / 8; i += ngt) ((u32x4*)(WKVB + (size_t)1828 * 1024))[i] = (u32x4){0u, 0u, 0u, 0u};
        }
        SUBREP(3) for (int item = blockIdx.x; item < 2 * 16 * 2 * 4; item += gridDim.x) {
            const int nq = item & 3, kh = (item >> 2) & 1, hp = (item >> 3) & 15, l = item >> 7;
            const float* sk = peer_subkeys + (((size_t)l * 16 + hp) * 128 + nq * 32) * 128;
            __syncthreads();
            for (int i = tid; i < 32 * 128; i += NTHR) smem[i] = sk[i];
            __syncthreads();
            const int k = kh * 512 + tid;
            float* wst = smem + 4096 + wv * (64 * 36);
            const float* wqb = peer_wq + ((size_t)l * D + kh * 512 + wv * 64) * 2048 + hp * 128;
            float4 wr4[32];
#pragma unroll
            for (int c = 0; c < 4; ++c) {
                __builtin_amdgcn_wave_barrier();
#pragma unroll
                for (int j = 0; j < 8; ++j) { const float4 tq = *(const float4*)(wqb + (size_t)(8 * j + (lane >> 3)) * 2048 + 32 * c + 4 * (lane & 7));
                    *(float4*)(wst + (8 * j + (lane >> 3)) * 36 + 4 * (lane & 7)) = tq; }
                __builtin_amdgcn_wave_barrier();
#pragma unroll
                for (int i = 0; i < 8; ++i) wr4[8 * c + i] = *(const float4*)(wst + lane * 36 + 4 * i);
                __builtin_amdgcn_sched_barrier(0);
            }
            const float gk = norm_ffn[l * D + k];
#pragma unroll 1
            for (int n = 0; n < 32; ++n) {
                const float4* sr = (const float4*)(smem + n * 128);
                float acc = 0.f;
#pragma unroll
                for (int i = 0; i < 32; ++i) { const float4 s4 = sr[i]; acc += wr4[i].x * s4.x + wr4[i].y * s4.y + wr4[i].z * s4.z + wr4[i].w * s4.w;
                    if ((i & 7) == 7) __builtin_amdgcn_sched_barrier(0); }
                WFt[((size_t)l * 2048 + hp * 128 + nq * 32 + n) * 1024 + k] = (bf16)f2bf(acc * gk);
            }
        }
        for (int i = gtid; i < NBLK * 2 * 8 * 64; i += ngt) {
            const int ln = i & 63, ct = (i >> 6) & 7, ks = (i >> 9) & 1, n = i >> 10;
            const int col = 16 * ct + (ln & 15), gsel = col >> 6, e = col & 63;
            const float* wp = a_gate_w + ((size_t)(gsel * NBLK + n) * 64 + 32 * ks + 8 * (ln >> 4)) * 64 + e;
            const float nl2 = -1.4426950408889634f;
            u32x4 w; w.x = pk2(wp[0] * nl2, wp[64] * nl2); w.y = pk2(wp[128] * nl2, wp[192] * nl2); w.z = pk2(wp[256] * nl2, wp[320] * nl2); w.w = pk2(wp[384] * nl2, wp[448] * nl2);
            *(u32x4*)(WGF + (size_t)i * 8) = w;
        }
        for (int i = gtid; i < LRUW; i += ngt) {
            float* SGC = (float*)(ws + WS_SGC);
            const float lam = a_lambda[i];
            SGC[i] = -1.4426950408889634f * a_gate_b[i]; SGC[LRUW + i] = -1.4426950408889634f * a_gate_b[LRUW + i];
            SGC[2 * LRUW + i] = -8.0f * 1.4426950408889634f * ((-lam > 20.f) ? -lam : log1pf(expf(-lam)));
        }
        for (int i = gtid; i < 2 * 32 * 256; i += ngt) {
            const int c = i & 255, kc = (i >> 8) & 31, j = i >> 13;
            float acc = 0.f;
#pragma unroll 8
            for (int k = kc * 64; k < kc * 64 + 64; ++k) acc = fmaf(cmp_pos[j * 2048 + k], cmp_w1[((size_t)j * 2048 + k) * 256 + c], acc);
            BIAS2[1024 + i] = acc;
        }
        SUBREP(4) for (int l = 0; l < 2; ++l) {
            const int kk = (int)(((size_t)gtid * 16) & 1023);
            float4 gq[4];
#pragma unroll
            for (int q = 0; q < 4; ++q) gq[q] = *(const float4*)(norm_ffn + l * D + kk + 4 * q);
            const size_t lbase = (size_t)l * 16384 * 1024;
            for (size_t i = gtid; i < (size_t)16384 * 64; i += 2 * (size_t)ngt) {
                float4 a[2][4], v[2][4];
#pragma unroll
                for (int h = 0; h < 2; ++h) { const size_t e16 = lbase + (i + (size_t)h * ngt) * 16;
                    if (i + (size_t)h * ngt < (size_t)16384 * 64) {
#pragma unroll
                        for (int q = 0; q < 4; ++q) { a[h][q] = *(const float4*)(peer_u + e16 + 4 * q); v[h][q] = *(const float4*)(peer_v + e16 + 4 * q); } } }
#pragma unroll
                for (int h = 0; h < 2; ++h) { const size_t e16 = lbase + (i + (size_t)h * ngt) * 16;
                    if (i + (size_t)h * ngt < (size_t)16384 * 64) {
                        unsigned wu[4], wv4[4];
#pragma unroll
                        for (int q = 0; q < 4; ++q) { const float4 g = gq[q];
                            int w = 0; w = __builtin_amdgcn_cvt_pk_fp8_f32(a[h][q].x * g.x * 64.f, a[h][q].y * g.y * 64.f, w, false); w = __builtin_amdgcn_cvt_pk_fp8_f32(a[h][q].z * g.z * 64.f, a[h][q].w * g.w * 64.f, w, true); wu[q] = (unsigned)w;
                            int y = 0; y = __builtin_amdgcn_cvt_pk_fp8_f32(v[h][q].x * 8.f, v[h][q].y * 8.f, y, false); y = __builtin_amdgcn_cvt_pk_fp8_f32(v[h][q].z * 8.f, v[h][q].w * 8.f, y, true); wv4[q] = (unsigned)y; }
                        const size_t rel = e16 - lbase, dsto = lbase + ((rel & 1023) >> 7) * (size_t)(16384 * 128) + (rel >> 10) * 128 + (rel & 127);
                        *(u32x4*)(UT8 + dsto) = (u32x4){wu[0], wu[1], wu[2], wu[3]};
                        *(u32x4*)(VT8 + dsto) = (u32x4){wv4[0], wv4[1], wv4[2], wv4[3]}; } }
            }
        }
    PHASE_END

    PHASE_BEGIN
        { pg8::Gemm g{XB, WIN0, T, 1792, D}; pg8::StaticOrder So; So.init(T, 1792, G, (int)blockIdx.x);
          pg8::EpiRowScaleBf16 Ep{P, PP, rstd0, nullptr};
          pg8::gemm_phase<pg8::EpiRowScaleBf16, pg8::StaticOrder, true, PG8_SP2_ON>(ldsp, g, So, Ep, tid); }
        { pg8::Gemm g{MEMB, WMEM, NB * MEMN, 1024, D}; pg8::StaticOrder So; So.init(NB * MEMN, 1024, G, (int)((blockIdx.x + G / 2) % G));
          pg8::EpiRowScaleBf16 Ep{MEMKV, 1024, rstdm, nullptr};
          pg8::gemm_phase<pg8::EpiRowScaleBf16, pg8::StaticOrder, true, PG8_SP2_ON>(ldsp, g, So, Ep, tid); }
    PHASE_END

    PHASE_BEGIN
        scan_pass<false>(P, a_conv_w, a_conv_b, WGF, (const float*)(ws + WS_SGC), AGG, AIN, lds_raw + wv * 18864, tid);
        for (int item = gw; item < 2 * 4 * 256; item += ngw) {
            const int h = item & 3, grp = (item >> 2) & 255, l = item >> 10, row = grp * 8 + (lane >> 3), c8 = lane & 7, b = row >> 8, mm = row & 255;
            const u32x4 w = *(const u32x4*)(MEMKV + (size_t)row * 1024 + l * 512 + h * 64 + 8 * c8);
            const float4 ga = *(const float4*)(mem_k_gain + l * 64 + 8 * c8), gb = *(const float4*)(mem_k_gain + l * 64 + 8 * c8 + 4);
            float v[8] = {bflo(w.x), bfhi(w.x), bflo(w.y), bfhi(w.y), bflo(w.z), bfhi(w.z), bflo(w.w), bfhi(w.w)};
            float ss = 0.f;
#pragma unroll
            for (int i = 0; i < 8; ++i) ss += v[i] * v[i];
            ss += sxor<1>(ss); ss += sxor<2>(ss); ss += sxor<4>(ss);
            const float rs = rsqrtf(ss * (1.f / 64.f) + EPS);
            u32x4 o; o.x = pk2(v[0] * rs * ga.x, v[1] * rs * ga.y); o.y = pk2(v[2] * rs * ga.z, v[3] * rs * ga.w); o.z = pk2(v[4] * rs * gb.x, v[5] * rs * gb.y); o.w = pk2(v[6] * rs * gb.z, v[7] * rs * gb.w);
            *(u32x4*)(MEMK + ((size_t)((l * NB + b) * 4 + h) * 256 + mm) * 64 + 8 * c8) = o;
        }
        {
            bf16* tl = (bf16*)(lds_raw + wv * 18864);
            for (int item = gw; item < 2 * NB * 4 * 4; item += ngw) {
                const int kt = item & 3, h = (item >> 2) & 3, b = (item >> 4) & 7, l = item >> 7;
                const bf16* src = MEMKV + ((size_t)b * 256 + 64 * kt) * 1024 + l * 512 + 256 + h * 64;
#pragma unroll
                for (int i = 0; i < 8; ++i) {
                    const int key = 8 * i + (lane >> 3), c8 = lane & 7;
                    const u32x4 v = *(const u32x4*)(src + (size_t)key * 1024 + 8 * c8);
                    bf16* tp = tl + (8 * c8) * 72 + key;
                    tp[0 * 72] = (bf16)(v.x & 0xffffu); tp[1 * 72] = (bf16)(v.x >> 16); tp[2 * 72] = (bf16)(v.y & 0xffffu); tp[3 * 72] = (bf16)(v.y >> 16);
                    tp[4 * 72] = (bf16)(v.z & 0xffffu); tp[5 * 72] = (bf16)(v.z >> 16); tp[6 * 72] = (bf16)(v.w & 0xffffu); tp[7 * 72] = (bf16)(v.w >> 16);
                }
                __builtin_amdgcn_s_waitcnt(0); __builtin_amdgcn_wave_barrier();
                bf16* dst = MEMVT + ((size_t)(((l * NB + b) * 4 + h) * 4 + kt)) * 4096;
#pragma unroll
                for (int jq = 0; jq < 8; ++jq) {
                    const int d = 8 * jq + (lane >> 3), c8 = lane & 7;
                    *(u32x4*)(dst + d * 64 + 8 * c8) = *(const u32x4*)(tl + d * 72 + 8 * c8);
                }
                __builtin_amdgcn_s_waitcnt(0); __builtin_amdgcn_wave_barrier();
            }
        }
    PHASE_END

    PHASE_BEGIN
        scan_pass<true>(P, a_conv_w, a_conv_b, WGF, (const float*)(ws + WS_SGC), AGG, AIN, lds_raw + wv * 18864, tid);
        __syncthreads();
        {
            const float Mm = __builtin_bit_cast(float, __builtin_amdgcn_readfirstlane(__builtin_bit_cast(int, att::SBOUND * wave_max(fabsf(mem_q_gain[lane])) * wave_max(fabsf(mem_k_gain[lane])))));
            if (Mm <= 40.f) att::mem_attention_mfma<true>(P, 1536, MEMK, MEMVT, mem_q_gain, AIN, lds_raw, tid, Mm);
            else att::mem_attention_mfma<false>(P, 1536, MEMK, MEMVT, mem_q_gain, AIN, lds_raw, tid, 0.f);
        }
    PHASE_END

    PHASE_BEGIN
        { pg8::Gemm g{AIN, WOUT, T, D, D}; pg8::StaticOrder So; So.init(T, D, G, (int)blockIdx.x);
          pg8::EpiResidual Ep{XB, sumsq1};
          pg8::gemm_phase<pg8::EpiResidual, pg8::StaticOrder, true, PG8_SP2_ON>(ldsp, g, So, Ep, tid); }
    PHASE_END

    PHASE_BEGIN
        for (int tile = blockIdx.x; tile < (T / 256) * 8; tile += gridDim.x) {
            int pm, pn;
            if ((gridDim.x & 255) == 0) { const int rr = tile / (int)gridDim.x, bb = tile % (int)gridDim.x, xq = bb & 7, sl = bb >> 3, per = (int)gridDim.x >> 6;
                pm = (rr * 8 + xq) * per + (sl >> 3); pn = sl & 7; }
            else { pm = tile >> 3; pn = tile & 7; }
            const int tidt = wave_s__ * 64 + lane_now();
            pg8::Gemm g{XB, WFt, T, 2048, D}; pg8::OneUnit So; So.u.pm = pm; So.u.pn = pn;
            pg8::EpiTopK Ep{sumsq1, E, Gt};
            pg8::gemm_phase<pg8::EpiTopK, pg8::OneUnit, false, PG8_SP2_ON>(ldsp, g, So, Ep, tidt);
        }
    PHASE_END

    PHASE_BEGIN
        SLICE_COORDS(); peer_u_partial(XB, UT8, E, PART, lds_raw + wv * (G_SLOTS * 1024), tid, sl_xs, sl_r, sl_nr);
    PHASE_END
    PHASE_BEGIN
        peer_act(PART, sumsq1, Gt, tid);
    PHASE_END
    PHASE_BEGIN
        SLICE_COORDS(); peer_v_slice(nullptr, XB, VT8, E, Gt, sumsq2, rep__ == 0, lds_raw + wv * (G_SLOTS * 1024), tid, sl_xs, sl_r, sl_nr);
    PHASE_END

    PHASE_BEGIN
        for (int i = gtid; i < 512; i += ngt) {
            const int j = i >> 8, c = i & 255;
            float acc = cmp_b1[i];
            for (int kc = 0; kc < 32; ++kc) acc += BIAS2[1024 + (j * 32 + kc) * 256 + c];
            BIAS2[i] = acc;
        }
        { pg8::Gemm g{XB, WKVB, T, 2048, D}; pg8::StaticOrder So; So.init(T, 2048, G, (int)blockIdx.x);
          pg8::EpiRowScaleBf16 Ep{P, PP, nullptr, sumsq2};
          pg8::gemm_phase<pg8::EpiRowScaleBf16, pg8::StaticOrder, true, PG8_SP2_ON>(ldsp, g, So, Ep, tid); }
    PHASE_END

    PHASE_BEGIN
        if (blockIdx.x < 128) {
            const int j = blockIdx.x >> 6, ks = (blockIdx.x >> 4) & 3, pm = blockIdx.x & 15;
            bf16* CAq = CA + (size_t)(j * 4 + ks) * 4096 * 512;
            for (int i0 = tid; i0 < 256 * 64; i0 += 8 * NTHR) {
                u32x4 v[8];
#pragma unroll
                for (int q = 0; q < 8; ++q) { const int i = i0 + q * NTHR;
                    const int d8 = i & 7, l8 = (i >> 3) & 7, r = 256 * pm + (i >> 6);
                    v[q] = (u32x4){0u, 0u, 0u, 0u};
                    if (r < 4080) { const int g = r & 1, bn = r >> 1, b = bn / NCMP, n = bn % NCMP;
                        v[q] = *(const u32x4*)(P + (size_t)(b * S + 16 * n + 8 * ks + l8) * PP + j * 128 + g * 64 + d8 * 8); } }
#pragma unroll
                for (int q = 0; q < 8; ++q) { const int i = i0 + q * NTHR;
                    const int d8 = i & 7, l8 = (i >> 3) & 7, r = 256 * pm + (i >> 6);
                    *(u32x4*)(CAq + (size_t)r * 512 + l8 * 64 + d8 * 8) = v[q]; }
            }
            __syncthreads();
            pg8::Gemm g{CAq, WC1 + (size_t)(j * 4 + ks) * 256 * 512, 4096, 256, 512}; pg8::OneUnit So; So.u.pm = pm; So.u.pn = 0;
            pg8::EpiPartF32 Ep{(float*)(ws + WS_HP) + (size_t)(j * 4 + ks) * 4096 * 256, 256};
            pg8::gemm_phase<pg8::EpiPartF32, pg8::OneUnit, false, PG8_SP2_ON>(ldsp, g, So, Ep, tid);
        } else {
            const int b0 = 128;
            const int gw2 = (blockIdx.x - b0) * (NTHR / 64) + wv, ngw2 = (G - b0) * (NTHR / 64);
            for (int item0 = gw2; item0 < (T / 8) * 4; item0 += 2 * ngw2) {
                u32x4 wq[2];
#pragma unroll
                for (int hh = 0; hh < 2; ++hh) { const int item = item0 + hh * ngw2;
                    if (item < (T / 8) * 4) { const int g = item & 1, br = 1 + ((item >> 1) & 1), row = (item >> 2) * 8 + (lane >> 3), c8 = lane & 7;
                        wq[hh] = *(const u32x4*)(P + (size_t)row * PP + br * 256 + g * 64 + 8 * c8); } }
#pragma unroll
                for (int hh = 0; hh < 2; ++hh) { const int item = item0 + hh * ngw2;
                  if (item < (T / 8) * 4) {
                const int g = item & 1, br = 1 + ((item >> 1) & 1), row = (item >> 2) * 8 + (lane >> 3), c8 = lane & 7;
                const int b = row / S, s = row % S;
                const u32x4 w = wq[hh];
                const float4 ga = *(const float4*)(k_gain_shared + br * 64 + 8 * c8), gb = *(const float4*)(k_gain_shared + br * 64 + 8 * c8 + 4);
                const float4 csa = *(const float4*)(ROPE + s * 16), csb = *(const float4*)(ROPE + s * 16 + 4), sna = *(const float4*)(ROPE + s * 16 + 8), snb = *(const float4*)(ROPE + s * 16 + 12);
                float v[8] = {bflo(w.x), bfhi(w.x), bflo(w.y), bfhi(w.y), bflo(w.z), bfhi(w.z), bflo(w.w), bfhi(w.w)};
                float ss = 0.f;
#pragma unroll
                for (int i = 0; i < 8; ++i) ss += v[i] * v[i];
                ss += sxor<1>(ss); ss += sxor<2>(ss); ss += sxor<4>(ss);
                const float rs = rsqrtf(ss * (1.f / 64.f) + EPS);
                const float gg[8] = {ga.x, ga.y, ga.z, ga.w, gb.x, gb.y, gb.z, gb.w};
                const float cs[8] = {csa.x, csa.y, csa.z, csa.w, csb.x, csb.y, csb.z, csb.w}, sn[8] = {sna.x, sna.y, sna.z, sna.w, snb.x, snb.y, snb.z, snb.w};
#pragma unroll
                for (int i = 0; i < 8; ++i) {
                    v[i] = v[i] * rs * gg[i];
                    const float partner = sxor<1>(v[i]);
                    if (c8 == 0) v[i] = v[i] * cs[i] - partner * sn[i];
                    else if (c8 == 1) v[i] = v[i] * cs[i] + partner * sn[i];
                }
                bf16* dst = (br == 1) ? KS : KW;
                u32x4 o; o.x = pk2(v[0], v[1]); o.y = pk2(v[2], v[3]); o.z = pk2(v[4], v[5]); o.w = pk2(v[6], v[7]);
                *(u32x4*)(dst + ((size_t)(b * 2 + g) * S + s) * 64 + 8 * c8) = o;
                  } }
            }
            {
                bf16* tl = (bf16*)(lds_raw + wv * 9216);
                for (int item = gw2; item < 2 * NB * 2 * 64; item += ngw2) {
                    const int blk = item & 63, g = (item >> 6) & 1, b = (item >> 7) & 7, br = 1 + (item >> 10);
                    const bf16* src = P + ((size_t)b * S + 64 * blk) * PP + br * 256 + 128 + g * 64;
#pragma unroll
                    for (int i = 0; i < 8; ++i) {
                        const int key = 8 * i + (lane >> 3), c8 = lane & 7;
                        const u32x4 v = *(const u32x4*)(src + (size_t)key * PP + 8 * c8);
                        bf16* tp = tl + (8 * c8) * 72 + key;
                        tp[0 * 72] = (bf16)(v.x & 0xffffu); tp[1 * 72] = (bf16)(v.x >> 16); tp[2 * 72] = (bf16)(v.y & 0xffffu); tp[3 * 72] = (bf16)(v.y >> 16);
                        tp[4 * 72] = (bf16)(v.z & 0xffffu); tp[5 * 72] = (bf16)(v.z >> 16); tp[6 * 72] = (bf16)(v.w & 0xffffu); tp[7 * 72] = (bf16)(v.w >> 16);
                    }
                    __builtin_amdgcn_s_waitcnt(0); __builtin_amdgcn_wave_barrier();
                    bf16* dst = ((br == 1) ? VST : VWT) + ((size_t)((b * 2 + g) * 64 + blk)) * 4096;
#pragma unroll
                    for (int jq = 0; jq < 8; ++jq) {
                        const int d = 8 * jq + (lane >> 3), c8 = lane & 7;
                        *(u32x4*)(dst + d * 64 + 8 * c8) = *(const u32x4*)(tl + d * 72 + 8 * c8);
                    }
                    __builtin_amdgcn_s_waitcnt(0); __builtin_amdgcn_wave_barrier();
                }
            }
        }
    PHASE_END

    PHASE_BEGIN
        for (int i = gtid; i < NB * 2 * 64; i += ngt) VC[((size_t)((i >> 6) * 4 + 3)) * 4096 + (i & 63) * 64 + 63] = (bf16)0;
        for (int i0 = tid; i0 < 2 * 256 * 16; i0 += 8 * NTHR) {
            float4 v[8];
#pragma unroll
            for (int q = 0; q < 8; ++q) { const int i = i0 + q * NTHR, n4 = i & 15, cc = (i >> 4) & 255, j = i >> 12;
                v[q] = *(const float4*)(cmp_w2 + ((size_t)j * 256 + cc) * 64 + 4 * n4); }
#pragma unroll
            for (int q = 0; q < 8; ++q) { const int i = i0 + q * NTHR, n4 = i & 15, cc = (i >> 4) & 255, j = i >> 12;
                float* d = smem + ((j * 64 + (cc >> 2)) * 64 + 4 * n4) * 4 + (cc & 3);
                d[0] = v[q].x; d[4] = v[q].y; d[8] = v[q].z; d[12] = v[q].w; }
        }
        __syncthreads();
        for (int item = gw; item < 2 * 4080; item += ngw) {
            const int j = item / 4080, it = item % 4080, g = it & 1, bn = it >> 1, b = bn / NCMP, n = bn % NCMP;
            float* hb = smem + 32768 + wv * 256;
            { const float* hpp = (const float*)(ws + WS_HP) + ((size_t)(j * 4) * 4096 + it) * 256 + 4 * lane;
              const float4 p0 = *(const float4*)hpp, p1 = *(const float4*)(hpp + (size_t)4096 * 256), p2 = *(const float4*)(hpp + (size_t)2 * 4096 * 256), p3 = *(const float4*)(hpp + (size_t)3 * 4096 * 256);
              const float4 bb = *(const float4*)(BIAS2 + j * 256 + 4 * lane);
              __builtin_amdgcn_wave_barrier();
              *(float4*)(hb + 4 * lane) = make_float4(gelu_tanh(((p0.x + p1.x) + (p2.x + p3.x)) + bb.x), gelu_tanh(((p0.y + p1.y) + (p2.y + p3.y)) + bb.y),
                                                      gelu_tanh(((p0.z + p1.z) + (p2.z + p3.z)) + bb.z), gelu_tanh(((p0.w + p1.w) + (p2.w + p3.w)) + bb.w));
              __builtin_amdgcn_wave_barrier(); }
            const float* wj = smem + (size_t)j * 16384 + lane * 4;
            float a0 = 0.f, a1 = 0.f, a2 = 0.f, a3 = 0.f;
#pragma unroll 8
            for (int c4 = 0; c4 < 64; ++c4) { const float4 h4 = *(const float4*)(hb + 4 * c4), w4 = *(const float4*)(wj + c4 * 256);
                a0 = fmaf(h4.x, w4.x, a0); a1 = fmaf(h4.y, w4.y, a1); a2 = fmaf(h4.z, w4.z, a2); a3 = fmaf(h4.w, w4.w, a3); }
            const float acc = (a0 + a1) + (a2 + a3);
            if (j == 0) {
                const float ss = wave_sum(acc * acc);
                float v = acc * rsqrtf(ss * (1.f / 64.f) + EPS) * k_gain_shared[0 * 64 + lane];
                const float partner = sxor<8>(v);
                const int sp = 16 * n + 31;
                if (lane < 16) { const int i = lane & 7; const float cs = ROPE[sp * 16 + i], sn = ROPE[sp * 16 + 8 + i];
                    v = (lane < 8) ? (v * cs - partner * sn) : (v * cs + partner * sn); }
                KC[((size_t)(b * 2 + g) * 256 + n) * 64 + lane] = (bf16)f2bf(v);
            } else {
                VC[((size_t)((b * 2 + g) * 4 + (n >> 6))) * 4096 + lane * 64 + (n & 63)] = (bf16)f2bf(acc);
            }
        }
    PHASE_END

    PHASE_BEGIN
        {
#define UNIF(x) __builtin_bit_cast(float, __builtin_amdgcn_readfirstlane(__builtin_bit_cast(int, (x))))
            const float Gq = wave_max(fabsf(b_q_gain[lane]));
            const float Mc = UNIF(att::SBOUND * Gq * wave_max(fabsf(k_gain_shared[lane]))), Ms = UNIF(att::SBOUND * Gq * wave_max(fabsf(k_gain_shared[64 + lane]))), Mw = UNIF(att::SBOUND * Gq * wave_max(fabsf(k_gain_shared[128 + lane])));
#ifdef PROBE_VAR
            if (rep__ == 0) att::nsa_attention_mfma<true, PROBE_VAR>(P, KC, VC, KS, VST, KW, VWT, ROPE, b_q_gain, b_gate_b, AIN, lds_raw, tid, Mc, Ms, Mw); else
#endif
            if (fmaxf(Mc, fmaxf(Ms, Mw)) <= 40.f) att::nsa_attention_mfma<true>(P, KC, VC, KS, VST, KW, VWT, ROPE, b_q_gain, b_gate_b, AIN, lds_raw, tid, Mc, Ms, Mw);
            else att::nsa_attention_mfma<false>(P, KC, VC, KS, VST, KW, VWT, ROPE, b_q_gain, b_gate_b, AIN, lds_raw, tid, 0.f, 0.f, 0.f);
            const float Mm = UNIF(att::SBOUND * wave_max(fabsf(mem_q_gain[64 + lane])) * wave_max(fabsf(mem_k_gain[64 + lane])));
            SUBREP(5) {
                if (Mm <= 40.f) att::mem_attention_mfma<true>(P, 1572, MEMK + (size_t)NB * 4 * 256 * 64, MEMVT + (size_t)NB * 4 * 256 * 64, mem_q_gain + 64, AIN, lds_raw, tid, Mm);
                else att::mem_attention_mfma<false>(P, 1572, MEMK + (size_t)NB * 4 * 256 * 64, MEMVT + (size_t)NB * 4 * 256 * 64, mem_q_gain + 64, AIN, lds_raw, tid, 0.f);
            }
        }
    PHASE_END

    PHASE_BEGIN
        { pg8::Gemm g{AIN, WOUT + (size_t)D * D, T, D, D}; pg8::StaticOrder So; So.init(T, D, G, (int)blockIdx.x);
          pg8::EpiResidual Ep{XB, sumsq3};
          pg8::gemm_phase<pg8::EpiResidual, pg8::StaticOrder, true, PG8_SP2_ON>(ldsp, g, So, Ep, tid); }
    PHASE_END

    PHASE_BEGIN
        for (int tile = blockIdx.x; tile < (T / 256) * 8; tile += gridDim.x) {
            int pm, pn;
            if ((gridDim.x & 255) == 0) { const int rr = tile / (int)gridDim.x, bb = tile % (int)gridDim.x, xq = bb & 7, sl = bb >> 3, per = (int)gridDim.x >> 6;
                pm = (rr * 8 + xq) * per + (sl >> 3); pn = sl & 7; }
            else { pm = tile >> 3; pn = tile & 7; }
            const int tidt = wave_s__ * 64 + lane_now();
            pg8::Gemm g{XB, WFt + (size_t)2048 * 1024, T, 2048, D}; pg8::OneUnit So; So.u.pm = pm; So.u.pn = pn;
            pg8::EpiTopK Ep{sumsq3, E, Gt};
            pg8::gemm_phase<pg8::EpiTopK, pg8::OneUnit, false, PG8_SP2_ON>(ldsp, g, So, Ep, tidt);
        }
    PHASE_END

    PHASE_BEGIN
        SLICE_COORDS(); peer_u_partial(XB, UT8 + (size_t)16384 * 1024, E, PART, lds_raw + wv * (G_SLOTS * 1024), tid, sl_xs, sl_r, sl_nr);
    PHASE_END
    PHASE_BEGIN
        peer_act(PART, sumsq3, Gt, tid);
    PHASE_END
    PHASE_BEGIN
        SLICE_COORDS(); peer_v_slice(out, XB, VT8 + (size_t)16384 * 1024, E, Gt, nullptr, rep__ == 0, lds_raw + wv * (G_SLOTS * 1024), tid, sl_xs, sl_r, sl_nr);
    PHASE_END
#undef PHASE_BEGIN
#undef PHASE_END
}

#ifndef N_LAUNCH_MODE
#define N_LAUNCH_MODE 1
#endif
template <int PH>
static void launch_phases(const Params& p, int grid, hipStream_t stream) {
    if constexpr (PH < N_PHASES) {
        static bool attr_set = false;
        if (!attr_set) { (void)hipFuncSetAttribute((const void*)fwd_kernel<PH, PH + 1>, hipFuncAttributeMaxDynamicSharedMemorySize, LDS_BYTES); attr_set = true; }
        hipLaunchKernelGGL((fwd_kernel<PH, PH + 1>), dim3(grid), dim3(NTHR), LDS_BYTES, stream, p);
        launch_phases<PH + 1>(p, grid, stream);
    }
}

extern "C" void kernel_launch(void* const* d_in, const int* in_sizes, int n_in, void* d_out, int out_size, void* d_ws, size_t ws_size, hipStream_t stream) {
    static int grid = 0;
    if (grid == 0) {
        if (n_in != 30 || out_size != T * D || ws_size < WS_END) { fprintf(stderr, "kernel_launch: unexpected shapes n_in %d out %d ws %zu\n", n_in, out_size, ws_size); grid = -1; return; }
        int dev = 0, cus = 0, per_cu = 0;
        (void)hipGetDevice(&dev);
        (void)hipDeviceGetAttribute(&cus, hipDeviceAttributeMultiprocessorCount, dev);
#if N_LAUNCH_MODE == 1
        if (hipFuncSetAttribute((const void*)fwd_kernel<0, N_PHASES>, hipFuncAttributeMaxDynamicSharedMemorySize, LDS_BYTES) != hipSuccess) { fprintf(stderr, "kernel_launch: hipFuncSetAttribute failed\n"); grid = -1; return; }
        if (hipOccupancyMaxActiveBlocksPerMultiprocessor(&per_cu, (const void*)fwd_kernel<0, N_PHASES>, NTHR, LDS_BYTES) != hipSuccess || per_cu < 1) { fprintf(stderr, "kernel_launch: occupancy query says %d\n", per_cu); grid = -1; return; }
        if (cus < 160) { fprintf(stderr, "kernel_launch: this kernel needs at least 160 CUs (got %d)\n", cus); grid = -1; return; }
        grid = cus;
#else
        grid = cus > 0 ? cus : 256;
#endif
    }
    if (grid < 0) return;
    Params p{};
    for (int i = 0; i < 30; ++i) p.in[i] = (const float*)d_in[i];
    p.out = (float*)d_out; p.ws = (unsigned char*)d_ws; p.ph_lo = 0; p.ph_hi = N_PHASES;
#if N_LAUNCH_MODE == 1
    if (hipMemsetAsync((char*)d_ws + WS_CTL, 0, 65536, stream) != hipSuccess) { fprintf(stderr, "kernel_launch: hipMemsetAsync failed\n"); return; }
    void* args[] = {&p};
    hipError_t e = hipLaunchCooperativeKernel((const void*)fwd_kernel<0, N_PHASES>, dim3(grid), dim3(NTHR), args, LDS_BYTES, stream);
    if (e != hipSuccess) fprintf(stderr, "cooperative launch failed: %s (grid %d)\n", hipGetErrorString(e), grid);
#else
    launch_phases<0>(p, grid, stream);
#endif
}
```

```cpp
#include <hip/hip_runtime.h>
#include <hip/hip_cooperative_groups.h>
#include <cstdio>
#include <cstdint>
namespace cg = cooperative_groups;

constexpr int NB = 8, S = 4096, D = 1024, T = NB * S;
constexpr int MEMN = 256;
constexpr int LRUW = 768, NBLK = 12;
constexpr int NCMP = 255;
constexpr int PP = 2048;
constexpr int NTHR = 512;
constexpr float EPS = 1e-6f;
constexpr int NCHUNK = 64, CHL = 64;

typedef unsigned short bf16;
typedef unsigned u32x4 __attribute__((ext_vector_type(4)));
typedef unsigned u32x2 __attribute__((ext_vector_type(2)));
typedef __bf16 bf16x2_t __attribute__((ext_vector_type(2)));
typedef __bf16 bf16x8_t __attribute__((ext_vector_type(8)));
#define LAS __attribute__((address_space(3)))

constexpr size_t MiB = 1ull << 20;
constexpr size_t WS_CTL = 0;
constexpr size_t WS_RSTD = 1 * MiB;
constexpr size_t WS_ROPE = 2 * MiB;
constexpr size_t WS_BIAS2 = 2 * MiB + 512 * 1024;
constexpr size_t WS_WGF = 2 * MiB + 768 * 1024;
constexpr size_t WS_SGC = 2 * MiB + 968 * 1024;
constexpr size_t WS_WIN0 = 3 * MiB;
constexpr size_t WS_WOUT = 7 * MiB;
constexpr size_t WS_WF = 11 * MiB;
constexpr size_t WS_WKVB = 19 * MiB;
constexpr size_t WS_WMEM = 23 * MiB;
constexpr size_t WS_WC1 = 25 * MiB;
constexpr size_t WS_MEMB = 27 * MiB;
constexpr size_t WS_MEMKV = 31 * MiB;
constexpr size_t WS_SSQ1 = 35 * MiB;
constexpr size_t WS_SSQ3 = 37 * MiB;
constexpr size_t WS_SCAN = 39 * MiB;
constexpr size_t WS_HID = 42 * MiB;
constexpr size_t WS_KC = 46 * MiB;
constexpr size_t WS_VC = 47 * MiB;
constexpr size_t WS_CA = 48 * MiB;
constexpr size_t WS_E = 80 * MiB;
constexpr size_t WS_GT = 96 * MiB;
constexpr size_t WS_KS = 80 * MiB;
constexpr size_t WS_KW = 88 * MiB;
constexpr size_t WS_VST = 96 * MiB;
constexpr size_t WS_VWT = 104 * MiB;
constexpr size_t WS_XB = 112 * MiB;
constexpr size_t WS_HP = 176 * MiB;
constexpr size_t WS_AIN = 176 * MiB;
constexpr size_t WS_P = 240 * MiB;
constexpr size_t WS_UT = 368 * MiB;
constexpr size_t WS_VT = 400 * MiB;
constexpr size_t WS_SSQ2 = 432 * MiB;
constexpr size_t WS_MEMK = 496 * MiB;
constexpr size_t WS_MEMVT = 498 * MiB;
constexpr size_t WS_END = 500 * MiB;

struct Params {
    const float* in[30];
    float* out;
    unsigned char* ws;
    int ph_lo, ph_hi;
};

#define AS1 __attribute__((address_space(1)))
template <typename TT> __device__ __forceinline__ const AS1 TT* gptr(const TT* p) { return (const AS1 TT*)p; }
template <typename TT> __device__ __forceinline__ AS1 TT* gptr(TT* p) { return (AS1 TT*)p; }
__device__ __forceinline__ int lane_now() { int l; asm volatile("v_mbcnt_lo_u32_b32 %0, -1, 0\n\tv_mbcnt_hi_u32_b32 %0, -1, %0" : "=v"(l)); return l; }
template <int M> __device__ __forceinline__ float sxor(float v) {
    if constexpr (M == 1) return __builtin_bit_cast(float, __builtin_amdgcn_update_dpp(0, __builtin_bit_cast(int, v), 0xB1  , 0xf, 0xf, true));
    else if constexpr (M == 2) return __builtin_bit_cast(float, __builtin_amdgcn_update_dpp(0, __builtin_bit_cast(int, v), 0x4E  , 0xf, 0xf, true));
    else if constexpr (M == 8) return __builtin_bit_cast(float, __builtin_amdgcn_update_dpp(0, __builtin_bit_cast(int, v), 0x128  , 0xf, 0xf, true));
    else if constexpr (M < 32) return __builtin_bit_cast(float, __builtin_amdgcn_ds_swizzle(__builtin_bit_cast(int, v), (M << 10) | 0x1f));
    else { const int l = lane_now();
           return __builtin_bit_cast(float, __builtin_amdgcn_ds_bpermute((l ^ 32) << 2, __builtin_bit_cast(int, v))); }
}
__device__ __forceinline__ float smirror8(float v) { return __builtin_bit_cast(float, __builtin_amdgcn_update_dpp(0, __builtin_bit_cast(int, v), 0x141  , 0xf, 0xf, true)); }
__device__ __forceinline__ float half_sum(float v) { v += sxor<1>(v); v += sxor<2>(v); v += sxor<4>(v); v += sxor<8>(v); v += sxor<16>(v); return v; }
__device__ __forceinline__ float half_max(float v) { v = fmaxf(v, sxor<1>(v)); v = fmaxf(v, sxor<2>(v)); v = fmaxf(v, sxor<4>(v)); v = fmaxf(v, sxor<8>(v)); v = fmaxf(v, sxor<16>(v)); return v; }
__device__ __forceinline__ float wave_sum(float v) { v = half_sum(v); v += sxor<32>(v); return v; }
__device__ __forceinline__ float wave_max(float v) { v = half_max(v); v = fmaxf(v, sxor<32>(v)); return v; }
__device__ __forceinline__ float gelu_tanh(float x) {
    const float c0 = -2.f * 0.7978845608028654f * 1.4426950408889634f, c1 = c0 * 0.044715f;
    const float e = __builtin_amdgcn_exp2f(x * (c0 + c1 * x * x));
    return x * __builtin_amdgcn_rcpf(1.f + e);
}
__device__ __forceinline__ float sigmoidf_(float x) { return __builtin_amdgcn_rcpf(1.f + __builtin_amdgcn_exp2f(x * -1.4426950408889634f)); }
typedef float f32x2_t __attribute__((ext_vector_type(2)));
__device__ __forceinline__ unsigned pk2(float lo, float hi) { const f32x2_t v = {lo, hi}; return __builtin_bit_cast(unsigned, __builtin_convertvector(v, bf16x2_t)); }
__device__ __forceinline__ unsigned f2bf(float f) { return pk2(f, f) & 0xffffu; }
__device__ __forceinline__ float bf2f(unsigned h) { return __builtin_bit_cast(float, h << 16); }
__device__ __forceinline__ float bflo(unsigned w) { return __builtin_bit_cast(float, w << 16); }
__device__ __forceinline__ float bfhi(unsigned w) { return __builtin_bit_cast(float, w & 0xffff0000u); }
__device__ __forceinline__ float ldbf(const bf16* p) { return bf2f((unsigned)*p); }
__device__ __forceinline__ const void* lds_ptr_uniform(const __attribute__((address_space(3))) unsigned char* a) {
    const u32x2 w = *(const __attribute__((address_space(3))) u32x2*)a;
    const unsigned lo = __builtin_amdgcn_readfirstlane(w.x), hi = __builtin_amdgcn_readfirstlane(w.y);
    return (const void*)(((unsigned long long)hi << 32) | lo);
}
__device__ __forceinline__ float rstd_from_parts(const float* ssq16) {
    const float4 a = ((const float4*)ssq16)[0], b = ((const float4*)ssq16)[1], c = ((const float4*)ssq16)[2], d = ((const float4*)ssq16)[3];
    const float s = ((a.x + a.y) + (a.z + a.w)) + ((b.x + b.y) + (b.z + b.w)) + ((c.x + c.y) + (c.z + c.w)) + ((d.x + d.y) + (d.z + d.w));
    return rsqrtf(s * (1.f / 1024.f) + EPS);
}
namespace pg8 {
#define PG8_LAS __attribute__((address_space(3)))
typedef unsigned short bf16_t;
typedef short bf16x8 __attribute__((ext_vector_type(8)));
typedef float f32x4 __attribute__((ext_vector_type(4)));
typedef unsigned u32x4 __attribute__((ext_vector_type(4)));
constexpr int BM = 256, BK = 64, HALF = 128, HTB = HALF * BK * 2  , STAGE_BYTES = 8 * HTB, NXCD = 8, WGM = 8;

__host__ __device__ __forceinline__ int lds_byte(int r, int c) { const int st = (r >> 4) * 2 + (c >> 5), rr = r & 15, cc = c & 31, ob = rr * 64 + cc * 2; return st * 1024 + (ob ^ (((ob >> 9) & 1) << 5)); }
__host__ __device__ __forceinline__ void stage_rc(int b, int& R, int& C) { const int st = b / 1024, sb = b % 1024, swz = sb ^ (((sb >> 9) & 1) << 5); R = (st >> 1) * 16 + swz / 64; C = (st & 1) * 32 + (swz % 64) / 2; }
__host__ __device__ __forceinline__ int perm32(int rho) { const int n = rho >> 4, i = rho & 15; return 8 * (i >> 2) + 4 * n + (i & 3); }

struct Unit { int pm, pn; };
struct Gemm { const bf16_t* A; const bf16_t* Bt; int M, N, K; };

struct StaticOrder {
    int nM, nN, nwg, G, c;
    __host__ __device__ void init(int M, int N, int G_, int c_) { nM = M / BM; nN = N / BM; nwg = nM * nN; G = G_; c = c_; }
    __host__ __device__ bool next(int i, Unit& u) const {
        const long L = (long)i * G + c; if (L >= nwg) return false;
        int wgid = (int)L; { const int q = nwg / NXCD, r = nwg % NXCD, xcd = wgid % NXCD, off = wgid / NXCD; wgid = (xcd < r ? xcd * (q + 1) : r * (q + 1) + (xcd - r) * q) + off; }
        const int nig = WGM * nN, gid = wgid / nig, fm = gid * WGM, gsz = (nM - fm) < WGM ? (nM - fm) : WGM;
        u.pm = fm + ((wgid % nig) % gsz); u.pn = (wgid % nig) / gsz; return true;
    }
    __device__ __forceinline__ void a_ready(const Unit&) const {}
    __device__ __forceinline__ void done(const Unit&) const {}
};

__device__ __forceinline__ unsigned cvt_pk_bf16(float lo, float hi) { return ::pk2(lo, hi); }
typedef float f32x2 __attribute__((ext_vector_type(2)));
template <class Epi, class Sched, bool ALIGN_EPI = false, bool SP2 = false>
__device__ __forceinline__ void gemm_phase(PG8_LAS unsigned char* lds, const Gemm g, const Sched& S, const Epi& E, const int tid) {
    const int wid = __builtin_amdgcn_readfirstlane(tid >> 6), lane = tid & 63, wr = wid >> 2, wc = wid & 3, fr = lane & 15, fq = lane >> 4;
    const int K = g.K, nt = K / BK;
    unsigned voffA[2], voffB[2];
#pragma unroll
    for (int i = 0; i < 2; ++i) { int R, C; stage_rc(tid * 16 + i * 8192, R, C); const int Rb = Epi::PERM ? ((R & ~31) + perm32(R & 31)) : R;
        voffA[i] = (unsigned)(R * K + C) * 2u; voffB[i] = (unsigned)(Rb * K + C) * 2u; }
    const size_t kstep = (size_t)(BK * 2);
    const size_t hstep = (size_t)HALF * K * 2;
    const size_t tstep = 2 * hstep;
    const unsigned ldsw = (unsigned)wid * 1024u;
    const int aoff = lds_byte(wr * 64 + fr, fq * 8), boff = lds_byte(wc * 32 + fr, fq * 8);
#define PG8_SA(b, h) (((b) * 2 + (h)) * HTB)
#define PG8_SB(b, h) ((4 + (b) * 2 + (h)) * HTB)
#define PG8_STAGE(bufoff, gbase, voff) do { _Pragma("unroll") for (int _i = 0; _i < 2; ++_i) \
        __builtin_amdgcn_global_load_lds((const unsigned*)((const char*)(gbase) + (voff)[_i]), (PG8_LAS unsigned*)(lds + (bufoff) + ldsw + _i * 8192), 16, 0, 0); } while (0)
#define PG8_LDA(dst, b, h) do { _Pragma("unroll") for (int m = 0; m < 4; ++m) _Pragma("unroll") for (int k = 0; k < 2; ++k) dst[m][k] = *(const PG8_LAS bf16x8*)(lds + PG8_SA(b, h) + aoff + m * 2048 + k * 1024); } while (0)
#define PG8_LDB(dst, b, h) do { _Pragma("unroll") for (int n = 0; n < 2; ++n) _Pragma("unroll") for (int k = 0; k < 2; ++k) dst[n][k] = *(const PG8_LAS bf16x8*)(lds + PG8_SB(b, h) + boff + n * 2048 + k * 1024); } while (0)
#define PG8_MMA(ai, bj, At, Bt) do { __builtin_amdgcn_s_setprio(1); _Pragma("unroll") for (int m = 0; m < 4; ++m) _Pragma("unroll") for (int n = 0; n < 2; ++n) _Pragma("unroll") for (int k = 0; k < 2; ++k) \
        acc[ai][bj][m][n] = __builtin_amdgcn_mfma_f32_16x16x32_bf16(Bt[n][k], At[m][k], acc[ai][bj][m][n], 0, 0, 0); __builtin_amdgcn_s_setprio(0); } while (0)
#define PG8_WAIT_V(n) asm volatile("s_waitcnt vmcnt(" #n ")" ::: "memory")
#define PG8_WAIT_L(n) asm volatile("s_waitcnt lgkmcnt(" #n ")" ::: "memory")
#define PG8_BAR __builtin_amdgcn_s_barrier()
#define PG8_SCHED __builtin_amdgcn_sched_barrier(0)
    Unit cur, nxt; int ui = 0;
    if (!S.next(0, cur)) return;
    f32x4 acc[2][2][4][2];
#pragma unroll
    for (int a = 0; a < 2; ++a)
#pragma unroll
        for (int b = 0; b < 2; ++b)
#pragma unroll
            for (int m = 0; m < 4; ++m)
#pragma unroll
                for (int n = 0; n < 2; ++n) acc[a][b][m][n] = (f32x4){0.f, 0.f, 0.f, 0.f};
    bf16x8 At[4][2], B0[2][2], B1[2][2];
    const char* cA = (const char*)g.A + (size_t)cur.pm * tstep; const char* cB = (const char*)g.Bt + (size_t)cur.pn * tstep;
    S.a_ready(cur);
    if constexpr (SP2) {
        PG8_STAGE(PG8_SB(0, 0), cB, voffB); PG8_STAGE(PG8_SB(0, 1), cB + hstep, voffB); PG8_STAGE(PG8_SA(0, 0), cA, voffA); PG8_STAGE(PG8_SA(0, 1), cA + hstep, voffA);
        if (wr == 1) PG8_BAR;
        PG8_WAIT_V(2); PG8_BAR;
        PG8_STAGE(PG8_SB(1, 0), cB + kstep, voffB); PG8_STAGE(PG8_SA(1, 0), cA + kstep, voffA); PG8_STAGE(PG8_SB(1, 1), cB + hstep + kstep, voffB);
        PG8_WAIT_V(6); PG8_BAR;
    } else {
        PG8_STAGE(PG8_SB(0, 0), cB, voffB); PG8_STAGE(PG8_SA(0, 0), cA, voffA); PG8_STAGE(PG8_SB(0, 1), cB + hstep, voffB); PG8_STAGE(PG8_SA(0, 1), cA + hstep, voffA);
        if (wr == 1) PG8_BAR;
        PG8_WAIT_V(4); PG8_BAR;
        PG8_STAGE(PG8_SB(1, 0), cB + kstep, voffB); PG8_STAGE(PG8_SA(1, 0), cA + kstep, voffA); PG8_STAGE(PG8_SB(1, 1), cB + hstep + kstep, voffB);
        PG8_WAIT_V(6); PG8_BAR;
    }
    for (;;) {
        const bool has_next = S.next(ui + 1, nxt);
        const char* nA = has_next ? (const char*)g.A + (size_t)nxt.pm * tstep : cA; const char* nB = has_next ? (const char*)g.Bt + (size_t)nxt.pn * tstep : cB;
        for (int t = 0; t < nt; t += 2) {
            const bool last = (t == nt - 2);
            const char* a1 = cA + (size_t)(t + 1) * kstep;
            const char* a2 = last ? nA : cA + (size_t)(t + 2) * kstep; const char* b2 = last ? nB : cB + (size_t)(t + 2) * kstep;
            const char* a3 = a2 + kstep; const char* b3 = b2 + kstep;
            if (last && has_next) S.a_ready(nxt);
            if constexpr (SP2) {
            PG8_LDB(B0, 0, 0); PG8_LDB(B1, 0, 1); PG8_SCHED; PG8_LDA(At, 0, 0); PG8_STAGE(PG8_SA(1, 1), a1 + hstep, voffA);
            PG8_WAIT_V(8); PG8_WAIT_L(0); PG8_BAR; PG8_MMA(0, 0, At, B0); PG8_MMA(0, 1, At, B1); PG8_BAR; PG8_SCHED;
            PG8_LDA(At, 0, 1); PG8_STAGE(PG8_SB(0, 0), b2, voffB); PG8_STAGE(PG8_SB(0, 1), b2 + hstep, voffB); PG8_STAGE(PG8_SA(0, 0), a2, voffA);
            PG8_WAIT_V(8); PG8_WAIT_L(0); PG8_BAR; PG8_MMA(1, 0, At, B0); PG8_MMA(1, 1, At, B1); PG8_BAR; PG8_SCHED;
            PG8_LDB(B0, 1, 0); PG8_LDB(B1, 1, 1); PG8_SCHED; PG8_LDA(At, 1, 0); PG8_STAGE(PG8_SA(0, 1), a2 + hstep, voffA);
            PG8_WAIT_V(8); PG8_WAIT_L(0); PG8_BAR; PG8_MMA(0, 0, At, B0); PG8_MMA(0, 1, At, B1); PG8_BAR; PG8_SCHED;
            PG8_LDA(At, 1, 1); PG8_STAGE(PG8_SB(1, 0), b3, voffB); PG8_STAGE(PG8_SB(1, 1), b3 + hstep, voffB); PG8_STAGE(PG8_SA(1, 0), a3, voffA);
            PG8_WAIT_V(8); PG8_WAIT_L(0); PG8_BAR; PG8_MMA(1, 0, At, B0); PG8_MMA(1, 1, At, B1); PG8_BAR; PG8_SCHED;
            } else {
            PG8_LDB(B0, 0, 0); PG8_SCHED; PG8_LDA(At, 0, 0); PG8_STAGE(PG8_SA(1, 1), a1 + hstep, voffA);
            PG8_WAIT_L(8); PG8_BAR; PG8_WAIT_L(0); PG8_MMA(0, 0, At, B0); PG8_BAR; PG8_SCHED;
            PG8_LDB(B1, 0, 1); PG8_STAGE(PG8_SB(0, 0), b2, voffB);
            PG8_BAR; PG8_WAIT_L(0); PG8_MMA(0, 1, At, B1); PG8_BAR;
            PG8_LDA(At, 0, 1); PG8_STAGE(PG8_SA(0, 0), a2, voffA);
            PG8_BAR; PG8_WAIT_L(0); PG8_MMA(1, 0, At, B0); PG8_BAR; PG8_SCHED;
            PG8_STAGE(PG8_SB(0, 1), b2 + hstep, voffB);
            PG8_WAIT_V(6); PG8_BAR; PG8_MMA(1, 1, At, B1); PG8_BAR;
            PG8_LDB(B0, 1, 0); PG8_SCHED; PG8_LDA(At, 1, 0); PG8_STAGE(PG8_SA(0, 1), a2 + hstep, voffA);
            PG8_WAIT_L(8); PG8_BAR; PG8_WAIT_L(0); PG8_MMA(0, 0, At, B0); PG8_BAR; PG8_SCHED;
            PG8_LDB(B1, 1, 1); PG8_STAGE(PG8_SB(1, 0), b3, voffB);
            PG8_BAR; PG8_WAIT_L(0); PG8_MMA(0, 1, At, B1); PG8_BAR;
            PG8_LDA(At, 1, 1); PG8_STAGE(PG8_SA(1, 0), a3, voffA);
            PG8_BAR; PG8_WAIT_L(0); PG8_MMA(1, 0, At, B0); PG8_BAR; PG8_SCHED;
            PG8_STAGE(PG8_SB(1, 1), b3 + hstep, voffB);
            PG8_WAIT_V(6); PG8_BAR; PG8_MMA(1, 1, At, B1); PG8_BAR;
            }
        }
        if constexpr (ALIGN_EPI) { if (wr == 0) PG8_BAR; }
        if constexpr (!Epi::AFTER_DRAIN) { E(acc, cur, wr, wc, fr, fq); S.done(cur); }
        if (!has_next) break;
#pragma unroll
        for (int a = 0; a < 2; ++a)
#pragma unroll
            for (int b = 0; b < 2; ++b)
#pragma unroll
                for (int m = 0; m < 4; ++m)
#pragma unroll
                    for (int n = 0; n < 2; ++n) acc[a][b][m][n] = (f32x4){0.f, 0.f, 0.f, 0.f};
        cur = nxt; cA = nA; cB = nB; ++ui;
        if constexpr (ALIGN_EPI) { if (wr == 1) PG8_BAR; }
    }
    PG8_WAIT_V(0);
    if constexpr (!ALIGN_EPI) { if (wr == 0) PG8_BAR; }
    PG8_BAR;
    if constexpr (Epi::AFTER_DRAIN) { E.fused(acc, cur, wr, wc, fr, fq, lds, wid, lane); S.done(cur); }
#undef PG8_SA
#undef PG8_SB
#undef PG8_STAGE
#undef PG8_LDA
#undef PG8_LDB
#undef PG8_MMA
#undef PG8_WAIT_V
#undef PG8_WAIT_L
#undef PG8_BAR
#undef PG8_SCHED
}
}

namespace pg8 {
struct OneUnit {
    Unit u;
    __device__ __forceinline__ bool next(int i, Unit& o) const { if (i > 0) return false; o = u; return true; }
    __device__ __forceinline__ void a_ready(const Unit&) const {}
    __device__ __forceinline__ void done(const Unit&) const {}
};
struct EpiRowScaleBf16 {
    static constexpr bool PERM = true, AFTER_DRAIN = false;
    bf16_t* O; int ldc; const float* rs; const float* ssq;
    __device__ __forceinline__ void operator()(const f32x4 (&acc)[2][2][4][2], const Unit& u, int wr, int wc, int fr, int fq) const {
        const int row0 = u.pm * BM + wr * 64 + fr, col0 = u.pn * BM + wc * 32 + 8 * fq;
#pragma unroll
        for (int ai = 0; ai < 2; ++ai)
#pragma unroll
            for (int m = 0; m < 4; ++m) {
                const int row = row0 + ai * HALF + m * 16;
                const float sc = ssq ? rstd_from_parts(ssq + (size_t)row * 16) : (rs ? rs[row] : 1.f);
                bf16_t* rowp = O + (size_t)row * ldc + col0;
#pragma unroll
                for (int bj = 0; bj < 2; ++bj) {
                    const f32x4 v0 = acc[ai][bj][m][0] * sc, v1 = acc[ai][bj][m][1] * sc;
                    u32x4 w; w.x = cvt_pk_bf16(v0[0], v0[1]); w.y = cvt_pk_bf16(v0[2], v0[3]); w.z = cvt_pk_bf16(v1[0], v1[1]); w.w = cvt_pk_bf16(v1[2], v1[3]);
                    *(u32x4*)(rowp + bj * HALF) = w;
                }
            }
    }
};
struct EpiGeluBiasBf16 {
    static constexpr bool PERM = true, AFTER_DRAIN = false;
    bf16_t* O; int ldc; const float* bias;
    __device__ __forceinline__ void operator()(const f32x4 (&acc)[2][2][4][2], const Unit& u, int wr, int wc, int fr, int fq) const {
        const int row0 = u.pm * BM + wr * 64 + fr, col0 = u.pn * BM + wc * 32 + 8 * fq;
#pragma unroll
        for (int bj = 0; bj < 2; ++bj) {
            const f32x4 b0 = *(const f32x4*)(bias + col0 + bj * HALF), b1 = *(const f32x4*)(bias + col0 + bj * HALF + 4);
#pragma unroll
            for (int ai = 0; ai < 2; ++ai)
#pragma unroll
                for (int m = 0; m < 4; ++m) {
                    bf16_t* rowp = O + (size_t)(row0 + ai * HALF + m * 16) * ldc + col0 + bj * HALF;
                    const f32x4 v0 = acc[ai][bj][m][0] + b0, v1 = acc[ai][bj][m][1] + b1;
                    u32x4 w; w.x = cvt_pk_bf16(gelu_tanh(v0[0]), gelu_tanh(v0[1])); w.y = cvt_pk_bf16(gelu_tanh(v0[2]), gelu_tanh(v0[3]));
                    w.z = cvt_pk_bf16(gelu_tanh(v1[0]), gelu_tanh(v1[1])); w.w = cvt_pk_bf16(gelu_tanh(v1[2]), gelu_tanh(v1[3]));
                    *(u32x4*)rowp = w;
                }
        }
    }
};
struct EpiPartF32 {
    static constexpr bool PERM = true, AFTER_DRAIN = false;
    float* O; int ldc;
    __device__ __forceinline__ void operator()(const f32x4 (&acc)[2][2][4][2], const Unit& u, int wr, int wc, int fr, int fq) const {
        const int row0 = u.pm * BM + wr * 64 + fr, col0 = u.pn * BM + wc * 32 + 8 * fq;
#pragma unroll
        for (int bj = 0; bj < 2; ++bj)
#pragma unroll
            for (int ai = 0; ai < 2; ++ai)
#pragma unroll
                for (int m = 0; m < 4; ++m) {
                    float* rowp = O + (size_t)(row0 + ai * HALF + m * 16) * ldc + col0 + bj * HALF;
                    *(f32x4*)rowp = acc[ai][bj][m][0]; *(f32x4*)(rowp + 4) = acc[ai][bj][m][1];
                }
    }
};
struct EpiResidual {
    static constexpr bool PERM = true, AFTER_DRAIN = false;
    bf16_t* xb; float* sumsq;
    __device__ __forceinline__ void operator()(const f32x4 (&acc)[2][2][4][2], const Unit& u, int wr, int wc, int fr, int fq) const {
        const int row0 = u.pm * BM + wr * 64 + fr, col0 = u.pn * BM + wc * 32 + 8 * fq;
#pragma unroll
        for (int ai = 0; ai < 2; ++ai)
#pragma unroll
            for (int m = 0; m < 4; ++m) {
                const int row = row0 + ai * HALF + m * 16;
                float ss = 0.f;
#pragma unroll
                for (int bj = 0; bj < 2; ++bj) {
                    const size_t off = (size_t)row * 1024 + col0 + bj * HALF;
                    const u32x4 r = *(const u32x4*)(xb + off);
                    const f32x4 r0 = {bflo(r.x), bfhi(r.x), bflo(r.y), bfhi(r.y)}, r1 = {bflo(r.z), bfhi(r.z), bflo(r.w), bfhi(r.w)};
                    const f32x4 v0 = acc[ai][bj][m][0] + r0, v1 = acc[ai][bj][m][1] + r1;
                    u32x4 w; w.x = cvt_pk_bf16(v0[0], v0[1]); w.y = cvt_pk_bf16(v0[2], v0[3]); w.z = cvt_pk_bf16(v1[0], v1[1]); w.w = cvt_pk_bf16(v1[2], v1[3]);
                    *(u32x4*)(xb + off) = w;
                    ss += v0[0] * v0[0] + v0[1] * v0[1] + v0[2] * v0[2] + v0[3] * v0[3] + v1[0] * v1[0] + v1[1] * v1[1] + v1[2] * v1[2] + v1[3] * v1[3];
                }
                ss += sxor<16>(ss); ss += sxor<32>(ss);
                if (fq == 0) sumsq[(size_t)row * 16 + u.pn * 4 + wc] = ss;
            }
    }
};

__device__ __forceinline__ float tk_pack(float v, unsigned idx, unsigned mask) {
    unsigned u = __builtin_bit_cast(unsigned, v);
    const unsigned tag = (u >> 31) ? idx : (mask - idx);
    u = (u & ~mask) | tag;
    return __builtin_bit_cast(float, u);
}
__device__ __forceinline__ unsigned tk_tag(float pv, unsigned mask) { const unsigned u = __builtin_bit_cast(unsigned, pv); return (u >> 31) ? (u & mask) : (mask - (u & mask)); }
__device__ __forceinline__ void tk_insert(float (&L)[16], float x) {
#pragma unroll
    for (int i = 0; i < 16; ++i) { const float hi = fmaxf(L[i], x); x = fminf(L[i], x); L[i] = hi; }
}
template <int N> __device__ __forceinline__ void tk_sort_desc(float (&v)[N]) {
#pragma unroll
    for (int k = 2; k <= N; k <<= 1)
#pragma unroll
        for (int j = k >> 1; j > 0; j >>= 1)
#pragma unroll
            for (int i = 0; i < N; ++i) { const int l = i ^ j;
                if (l > i) { const float hi = fmaxf(v[i], v[l]), lo = fminf(v[i], v[l]); const bool desc = ((i & k) == 0); v[i] = desc ? hi : lo; v[l] = desc ? lo : hi; } }
}
__device__ __forceinline__ void tk_clean16(float (&v)[16]) {
#pragma unroll
    for (int j = 8; j > 0; j >>= 1)
#pragma unroll
        for (int i = 0; i < 16; ++i) { const int l = i ^ j; if (l > i) { const float hi = fmaxf(v[i], v[l]), lo = fminf(v[i], v[l]); v[i] = hi; v[l] = lo; } }
}
__device__ __forceinline__ void tk_merge16(float (&a)[16], const float (&b)[16]) {
#pragma unroll
    for (int i = 0; i < 16; ++i) a[i] = fmaxf(a[i], b[15 - i]);
    tk_clean16(a);
}
#define TK_CE(i, j) { const float hi__ = fmaxf(v[i], v[j]), lo__ = fminf(v[i], v[j]); v[i] = hi__; v[j] = lo__; }
__device__ __forceinline__ void tk_sort16_desc(float (&v)[16]) {
    TK_CE(0,13) TK_CE(1,12) TK_CE(2,15) TK_CE(3,14) TK_CE(4,8) TK_CE(5,6) TK_CE(7,11) TK_CE(9,10)
    TK_CE(0,5) TK_CE(1,7) TK_CE(2,9) TK_CE(3,4) TK_CE(6,13) TK_CE(8,14) TK_CE(10,15) TK_CE(11,12)
    TK_CE(0,1) TK_CE(2,3) TK_CE(4,5) TK_CE(6,8) TK_CE(7,9) TK_CE(10,11) TK_CE(12,13) TK_CE(14,15)
    TK_CE(0,2) TK_CE(1,3) TK_CE(4,10) TK_CE(5,11) TK_CE(6,7) TK_CE(8,9) TK_CE(12,14) TK_CE(13,15)
    TK_CE(1,2) TK_CE(3,12) TK_CE(4,6) TK_CE(5,7) TK_CE(8,10) TK_CE(9,11) TK_CE(13,14)
    TK_CE(1,4) TK_CE(2,6) TK_CE(5,8) TK_CE(7,10) TK_CE(9,13) TK_CE(11,14)
    TK_CE(2,4) TK_CE(3,6) TK_CE(9,12) TK_CE(11,13)
    TK_CE(3,5) TK_CE(6,8) TK_CE(7,9) TK_CE(10,12)
    TK_CE(3,4) TK_CE(5,6) TK_CE(7,8) TK_CE(9,10) TK_CE(11,12)
    TK_CE(6,7) TK_CE(8,9)
}
__device__ __forceinline__ void tk_top16_of_64(float (&g0)[16], float (&g1)[16], float (&g2)[16], float (&g3)[16]) {
    tk_sort16_desc(g0); tk_sort16_desc(g1); tk_sort16_desc(g2); tk_sort16_desc(g3);
    tk_merge16(g0, g1); tk_merge16(g2, g3); tk_merge16(g0, g2);
}
struct EpiTopK {
    static constexpr bool PERM = true, AFTER_DRAIN = true;
    static constexpr int SROW = 260, LIST_OFF = 128 * SROW;
    const float* sumsq; int* E; float* Gt;
    __device__ __forceinline__ void fused(const f32x4 (&acc)[2][2][4][2], const Unit& u, int wr, int wc, int fr, int fq, PG8_LAS unsigned char* lds, int wid, int lane) const {
        PG8_LAS float* Sl = (PG8_LAS float*)lds;
        PG8_LAS float* Ls = Sl + LIST_OFF;
        const int tid = wid * 64 + lane;
#pragma unroll 1
        for (int ai = 0; ai < 2; ++ai) {
#pragma unroll
            for (int m = 0; m < 4; ++m) {
                const int rl = wr * 64 + m * 16 + fr;
                const float sc = rstd_from_parts(sumsq + (size_t)(u.pm * BM + ai * HALF + rl) * 16);
#pragma unroll
                for (int bj = 0; bj < 2; ++bj) {
                    PG8_LAS float* sp = Sl + rl * SROW + bj * HALF + wc * 32 + 8 * fq;
                    const f32x4 a0 = ai ? acc[1][bj][m][0] : acc[0][bj][m][0], a1 = ai ? acc[1][bj][m][1] : acc[0][bj][m][1];
                    *(PG8_LAS f32x4*)sp = a0 * sc; *(PG8_LAS f32x4*)(sp + 4) = a1 * sc;
                }
            }
            __syncthreads();
            const int row = tid & 127, p = (tid >> 7) & 1, half = tid >> 8;
            float L[16];
            {
                const PG8_LAS float* sp = Sl + row * SROW + p * 128 + half * 64;
                float G1[16], G2[16], G3[16];
#pragma unroll
                for (int k = 0; k < 4; ++k) {
                    const f32x4 v0 = *(const PG8_LAS f32x4*)(sp + 4 * k), v1 = *(const PG8_LAS f32x4*)(sp + 16 + 4 * k), v2 = *(const PG8_LAS f32x4*)(sp + 32 + 4 * k), v3 = *(const PG8_LAS f32x4*)(sp + 48 + 4 * k);
                    const unsigned base = half * 64 + 4 * k;
#pragma unroll
                    for (int e = 0; e < 4; ++e) { L[4 * k + e] = tk_pack(v0[e], base + e, 127u); G1[4 * k + e] = tk_pack(v1[e], base + 16 + e, 127u);
                        G2[4 * k + e] = tk_pack(v2[e], base + 32 + e, 127u); G3[4 * k + e] = tk_pack(v3[e], base + 48 + e, 127u); }
                }
                tk_top16_of_64(L, G1, G2, G3);
            }
            if (ai == 1) __syncthreads();
            PG8_LAS float* mine = (ai ? Sl : Ls) + (row * 2 + p) * 16;
            if (half == 1) {
#pragma unroll
                for (int i = 0; i < 4; ++i) *(PG8_LAS f32x4*)(mine + 4 * i) = (f32x4){L[4 * i], L[4 * i + 1], L[4 * i + 2], L[4 * i + 3]};
            }
            __syncthreads();
            if (half == 0) {
                f32x4 o[4];
#pragma unroll
                for (int i = 0; i < 4; ++i) o[i] = *(const PG8_LAS f32x4*)(mine + 4 * i);
                float ob[16];
#pragma unroll
                for (int i = 0; i < 4; ++i) { ob[4 * i] = o[i][0]; ob[4 * i + 1] = o[i][1]; ob[4 * i + 2] = o[i][2]; ob[4 * i + 3] = o[i][3]; }
                tk_merge16(L, ob);
#pragma unroll
                for (int i = 0; i < 4; ++i) *(PG8_LAS f32x4*)(mine + 4 * i) = (f32x4){L[4 * i], L[4 * i + 1], L[4 * i + 2], L[4 * i + 3]};
            }
            __syncthreads();
        }
        if (tid < 256) {
            {
                const int ai = tid >> 7, tr = tid & 127;
                const PG8_LAS float* lb = ai ? Sl : Ls;
                const PG8_LAS float* s1 = lb + (tr * 2 + 0) * 16, *s2 = lb + (tr * 2 + 1) * 16;
                float v1[16], v2[16];
#pragma unroll
                for (int i = 0; i < 4; ++i) { const f32x4 a = *(const PG8_LAS f32x4*)(s1 + 4 * i), b = *(const PG8_LAS f32x4*)(s2 + 4 * i);
                    v1[4 * i] = a[0]; v1[4 * i + 1] = a[1]; v1[4 * i + 2] = a[2]; v1[4 * i + 3] = a[3]; v2[4 * i] = b[0]; v2[4 * i + 1] = b[1]; v2[4 * i + 2] = b[2]; v2[4 * i + 3] = b[3]; }
#define TK_CAND(a, b) tk_pack(v1[a] + v2[b], (a) * 16 + (b), 255u)
                float C[16], D1[16], D2[16], D3[16];
#pragma unroll
                for (int i = 0; i < 16; ++i) C[i] = TK_CAND(0, i);
#pragma unroll
                for (int i = 0; i < 8; ++i) { D1[i] = TK_CAND(1, i); D1[8 + i] = TK_CAND(15 - i, 0); }
                D2[0] = TK_CAND(2, 0); D2[1] = TK_CAND(2, 1); D2[2] = TK_CAND(2, 2); D2[3] = TK_CAND(2, 3); D2[4] = TK_CAND(2, 4);
                D2[5] = TK_CAND(3, 0); D2[6] = TK_CAND(3, 1); D2[7] = TK_CAND(3, 2); D2[8] = TK_CAND(3, 3);
                D2[9] = TK_CAND(4, 0); D2[10] = TK_CAND(4, 1); D2[11] = TK_CAND(4, 2);
                D2[12] = TK_CAND(5, 0); D2[13] = TK_CAND(5, 1); D2[14] = -INFINITY; D2[15] = -INFINITY;
                { const float q = TK_CAND(6, 1), r = TK_CAND(7, 0);
                  D3[0] = TK_CAND(6, 0); D3[1] = fmaxf(q, r); D3[2] = fminf(q, r); D3[3] = TK_CAND(7, 1); }
#pragma unroll
                for (int i = 4; i < 16; ++i) D3[i] = -INFINITY;
#undef TK_CAND
                tk_clean16(D1); tk_sort16_desc(D2);
                tk_merge16(C, D1); tk_merge16(D2, D3); tk_merge16(C, D2);
                float sm = 0.f, ex[16];
#pragma unroll
                for (int i = 0; i < 16; ++i) { ex[i] = __expf(C[i] - C[0]); sm += ex[i]; }
                const float inv = 1.f / sm;
                const size_t t = (size_t)u.pm * BM + ai * HALF + tr;
                int* eo = E + t * 128 + u.pn * 16; float* go = Gt + t * 128 + u.pn * 16;
                int ev[16];
#pragma unroll
                for (int i = 0; i < 16; ++i) { const unsigned ci = tk_tag(C[i], 255u); ev[i] = (int)(tk_tag(s1[ci >> 4], 127u) * 128u + tk_tag(s2[ci & 15], 127u)); }
#pragma unroll
                for (int i = 0; i < 4; ++i) { *(int4*)(eo + 4 * i) = make_int4(ev[4 * i], ev[4 * i + 1], ev[4 * i + 2], ev[4 * i + 3]);
                    *(float4*)(go + 4 * i) = make_float4(ex[4 * i] * inv, ex[4 * i + 1] * inv, ex[4 * i + 2] * inv, ex[4 * i + 3] * inv); }
            }
        }
        __syncthreads();
    }
};
}

__device__ __forceinline__ void transpose_item(const float* __restrict__ W, int K, int N, const float* __restrict__ gain, bf16* __restrict__ WT, int row_off, float* scr, int item, int lane) {
    const int nblk = (N + 31) / 32, kb = item / nblk, nb = item % nblk, k0 = 64 * kb, n0 = 32 * nb;
    const int nn = n0 + (lane & 31);
    float tv[32];
#pragma unroll
    for (int i = 0; i < 32; ++i) { const int kk = 2 * i + (lane >> 5);
        float v = 0.f; if (nn < N) { v = W[(size_t)(k0 + kk) * N + nn]; if (gain) v *= gain[k0 + kk]; }
        tv[i] = v; }
#pragma unroll
    for (int i = 0; i < 32; ++i) scr[(2 * i + (lane >> 5)) * 33 + (lane & 31)] = tv[i];
    __builtin_amdgcn_s_waitcnt(0); __builtin_amdgcn_wave_barrier();
    const int c = lane & 7;
#pragma unroll
    for (int j = 0; j < 4; ++j) { const int n = (lane >> 3) + 8 * j; const float* s = scr + (8 * c) * 33 + n;
        if (n0 + n < N) { u32x4 o; o.x = pk2(s[0 * 33], s[1 * 33]); o.y = pk2(s[2 * 33], s[3 * 33]); o.z = pk2(s[4 * 33], s[5 * 33]); o.w = pk2(s[6 * 33], s[7 * 33]);
            *(u32x4*)(WT + (size_t)(row_off + n0 + n) * K + k0 + 8 * c) = o; } }
    __builtin_amdgcn_s_waitcnt(0); __builtin_amdgcn_wave_barrier();
}
__device__ __forceinline__ void rows4_to_bf16(const float* __restrict__ X, bf16* __restrict__ O, float* __restrict__ rstd, int r, int stride, int lane) {
    float4 v[4][4];
#pragma unroll
    for (int q = 0; q < 4; ++q) { const int rr = r + q * stride;
        if (rr < T) { const float4* xr = (const float4*)(X + (size_t)rr * D) + lane;
#pragma unroll
            for (int j = 0; j < 4; ++j) v[q][j] = xr[64 * j]; } }
#pragma unroll
    for (int q = 0; q < 4; ++q) { const int rr = r + q * stride;
        if (rr < T) {
            float s = 0.f;
#pragma unroll
            for (int j = 0; j < 4; ++j) s += v[q][j].x * v[q][j].x + v[q][j].y * v[q][j].y + v[q][j].z * v[q][j].z + v[q][j].w * v[q][j].w;
            s = wave_sum(s);
            if (lane == 0) rstd[rr] = rsqrtf(s * (1.f / D) + EPS);
            u32x2* o8 = (u32x2*)(O + (size_t)rr * D) + lane;
#pragma unroll
            for (int j = 0; j < 4; ++j) { u32x2 w; w.x = pk2(v[q][j].x, v[q][j].y); w.y = pk2(v[q][j].z, v[q][j].w); o8[64 * j] = w; } } }
}
__device__ __forceinline__ void row_to_bf16(const float* __restrict__ xrow, bf16* __restrict__ orow, float* __restrict__ rstd, int lane) {
    const float4* xr = (const float4*)xrow + lane;
    float4 v[4]; float s = 0.f;
#pragma unroll
    for (int j = 0; j < 4; ++j) { v[j] = xr[64 * j]; s += v[j].x * v[j].x + v[j].y * v[j].y + v[j].z * v[j].z + v[j].w * v[j].w; }
    s = wave_sum(s);
    if (lane == 0) *rstd = rsqrtf(s * (1.f / D) + EPS);
    u32x2* o8 = (u32x2*)orow + lane;
#pragma unroll
    for (int j = 0; j < 4; ++j) { u32x2 w; w.x = pk2(v[j].x, v[j].y); w.y = pk2(v[j].z, v[j].w); o8[64 * j] = w; }
}

__device__ __forceinline__ float bperm(int idx4, float v) { return __builtin_bit_cast(float, __builtin_amdgcn_ds_bpermute(idx4, __builtin_bit_cast(int, v))); }
template <bool APPLY>
__device__ __forceinline__ void scan_pass(const bf16* __restrict__ P, const float* __restrict__ conv_w, const float* __restrict__ conv_b, const bf16* __restrict__ WGF,
                                          const float* __restrict__ SGC  , float* __restrict__ AGG, bf16* __restrict__ AIN, unsigned char* ldsw  , int tid) {
    typedef short bf16x8 __attribute__((ext_vector_type(8)));
    typedef float f32x4 __attribute__((ext_vector_type(4)));
    const int lane = tid & 63, gw = blockIdx.x * (NTHR / 64) + (tid >> 6), ngw = gridDim.x * (NTHR / 64);
    const int c16 = lane & 15, g4 = lane >> 4;
    bf16* Xt = (bf16*)ldsw; bf16* Yt = (bf16*)(ldsw + 9648);
    const int up16 = ((lane - 16) & 63) << 2, up32 = ((lane - 32) & 63) << 2, last = (c16 + 48) << 2;
    u32x4 pre[9];
    auto fetch_rows = [&](int item) {
        const int n = item % NBLK, ci = (item / NBLK) % NCHUNK, b = item / (NBLK * NCHUNK), s0 = ci * CHL;
        const bf16* xp = P + ((size_t)b * S + s0 - 3) * PP + n * 64;
#pragma unroll
        for (int j = 0; j < 9; ++j) { const int row = 8 * j + (lane >> 3), c8 = lane & 7;
            pre[j] = (u32x4){0u, 0u, 0u, 0u}; if (row < 67 && s0 + row >= 3) pre[j] = *(const u32x4*)(xp + (size_t)row * PP + 8 * c8); } };
    if (gw < NB * NCHUNK * NBLK) fetch_rows(gw);
    for (int item = gw; item < NB * NCHUNK * NBLK; item += ngw) {
        const int n = item % NBLK, ci = (item / NBLK) % NCHUNK, b = item / (NBLK * NCHUNK);
        const int s0 = ci * CHL;
        {
#pragma unroll
            for (int j = 0; j < 9; ++j) { const int row = 8 * j + (lane >> 3), c8 = lane & 7;
                if (row < 67) *(u32x4*)(Xt + row * 72 + 8 * c8) = pre[j]; }
            if (APPLY) {
                const bf16* yp = P + ((size_t)b * S + s0) * PP + 768 + n * 64;
#pragma unroll
                for (int j = 0; j < 8; ++j) { const int row = 8 * j + (lane >> 3), c8 = lane & 7; *(u32x4*)(Yt + row * 72 + 8 * c8) = *(const u32x4*)(yp + (size_t)row * PP + 8 * c8); }
            }
            const int c = n * 64 + lane;
            const float cw0 = conv_w[0 * LRUW + c], cw1 = conv_w[1 * LRUW + c], cw2 = conv_w[2 * LRUW + c], cw3 = conv_w[3 * LRUW + c], cb = conv_b[c];
            __builtin_amdgcn_s_waitcnt(0); __builtin_amdgcn_wave_barrier();
            float xin[CHL + 3];
#pragma unroll
            for (int i = 0; i < CHL + 3; ++i) xin[i] = ldbf(Xt + i * 72 + lane);
            __builtin_amdgcn_wave_barrier();
#pragma unroll
            for (int tt = 0; tt < CHL; tt += 2) {
                const float o0 = cb + cw0 * xin[tt] + cw1 * xin[tt + 1] + cw2 * xin[tt + 2] + cw3 * xin[tt + 3];
                const float o1 = cb + cw0 * xin[tt + 1] + cw1 * xin[tt + 2] + cw2 * xin[tt + 3] + cw3 * xin[tt + 4];
                const unsigned w = pk2(o0, o1);
                Xt[tt * 72 + lane] = (bf16)(w & 0xffffu); Xt[(tt + 1) * 72 + lane] = (bf16)(w >> 16);
            }
        }
        bf16x8 bfr[2][8];
#pragma unroll
        for (int ks = 0; ks < 2; ++ks)
#pragma unroll
            for (int ct = 0; ct < 8; ++ct) bfr[ks][ct] = *(const bf16x8*)(WGF + ((size_t)((n * 2 + ks) * 8 + ct) * 64 + lane) * 8);
        float brr[4], bii[4], sp8[4];
#pragma unroll
        for (int ch = 0; ch < 4; ++ch) { const int c = n * 64 + 16 * ch + c16; brr[ch] = SGC[c]; bii[ch] = SGC[LRUW + c]; sp8[ch] = SGC[2 * LRUW + c]; }
        float hA[4], hH[4];
#pragma unroll
        for (int ch = 0; ch < 4; ++ch) { hA[ch] = 1.f; hH[ch] = 0.f; }
        if (APPLY) {
            const int q0 = (ci * g4) >> 2, q1 = (ci * (g4 + 1)) >> 2;
#pragma unroll
            for (int ch = 0; ch < 4; ++ch) {
                const float* ap = AGG + (((size_t)b * NCHUNK) * LRUW + n * 64 + 16 * ch + c16) * 2;
                float A = 1.f, H = 0.f;
                for (int k = q0; k < q1; ++k) { const float2 ah = *(const float2*)(ap + (size_t)k * LRUW * 2); H = ah.x * H + ah.y; A *= ah.x; }
                float Ap = bperm(up16, A), Hp = bperm(up16, H);
                if (g4 >= 1) { H = A * Hp + H; A *= Ap; }
                Ap = bperm(up32, A); Hp = bperm(up32, H);
                if (g4 >= 2) { H = A * Hp + H; A *= Ap; }
                hH[ch] = bperm(last, H);
            }
        }
        __builtin_amdgcn_s_waitcnt(0); __builtin_amdgcn_wave_barrier();
        if (item + ngw < NB * NCHUNK * NBLK) fetch_rows(item + ngw);
#pragma unroll 1
        for (int tt4 = 0; tt4 < 4; ++tt4) {
            const bf16x8 a0 = *(const bf16x8*)(Xt + (16 * tt4 + c16) * 72 + 8 * g4), a1 = *(const bf16x8*)(Xt + (16 * tt4 + c16) * 72 + 32 + 8 * g4);
            f32x4 acc[8];
#pragma unroll
            for (int ct = 0; ct < 8; ++ct) { f32x4 z = {0.f, 0.f, 0.f, 0.f};
                z = __builtin_amdgcn_mfma_f32_16x16x32_bf16(a0, bfr[0][ct], z, 0, 0, 0);
                acc[ct] = __builtin_amdgcn_mfma_f32_16x16x32_bf16(a1, bfr[1][ct], z, 0, 0, 0); }
#pragma unroll
            for (int ch = 0; ch < 4; ++ch) {
                const int cidx = 16 * ch + c16;
                float av[4], uv[4], A = 1.f, H = 0.f;
#pragma unroll
                for (int jj = 0; jj < 4; ++jj) {
                    const int tt = 16 * tt4 + 4 * g4 + jj;
                    const float rg = __builtin_amdgcn_rcpf(1.f + __builtin_amdgcn_exp2f(acc[ch][jj] + brr[ch])), ig = __builtin_amdgcn_rcpf(1.f + __builtin_amdgcn_exp2f(acc[4 + ch][jj] + bii[ch]));
                    const float a = __builtin_amdgcn_exp2f(sp8[ch] * rg);
                    const float mult = __builtin_amdgcn_sqrtf(fmaxf(1.f - a * a, 0.f));
                    const float u = mult * (ig * ldbf(Xt + tt * 72 + cidx));
                    av[jj] = a; uv[jj] = u; H = a * H + u; A *= a;
                }
                float Ap = bperm(up16, A), Hp = bperm(up16, H);
                if (g4 >= 1) { H = A * Hp + H; A *= Ap; }
                Ap = bperm(up32, A); Hp = bperm(up32, H);
                if (g4 >= 2) { H = A * Hp + H; A *= Ap; }
                const float AT = bperm(last, A), HT = bperm(last, H);
                if (APPLY) {
                    float AE = bperm(up16, A), HE = bperm(up16, H);
                    if (g4 == 0) { AE = 1.f; HE = 0.f; }
                    float h = AE * hH[ch] + HE;
#pragma unroll
                    for (int jj = 0; jj < 4; ++jj) {
                        const int tt = 16 * tt4 + 4 * g4 + jj;
                        h = av[jj] * h + uv[jj];
                        Xt[tt * 72 + cidx] = (bf16)f2bf(h * gelu_tanh(ldbf(Yt + tt * 72 + cidx)));
                    }
                    hH[ch] = AT * hH[ch] + HT;
                } else { hH[ch] = AT * hH[ch] + HT; hA[ch] *= AT; }
            }
        }
        if (APPLY) {
            __builtin_amdgcn_s_waitcnt(0); __builtin_amdgcn_wave_barrier();
            bf16* op = AIN + ((size_t)b * S + s0) * D + n * 64;
#pragma unroll
            for (int j = 0; j < 8; ++j) { const int row = 8 * j + (lane >> 3), c8 = lane & 7; *(u32x4*)(op + (size_t)row * D + 8 * c8) = *(const u32x4*)(Xt + row * 72 + 8 * c8); }
        } else if (g4 == 0) {
#pragma unroll
            for (int ch = 0; ch < 4; ++ch) *(float2*)(AGG + (((size_t)b * NCHUNK + ci) * LRUW + n * 64 + 16 * ch + c16) * 2) = make_float2(hA[ch], hH[ch]);
        }
        __builtin_amdgcn_s_waitcnt(0); __builtin_amdgcn_wave_barrier();
    }
}

__device__ __forceinline__ void peer_gather(float* __restrict__ out, bf16* __restrict__ XB, const float* __restrict__ sumsq, const bf16* __restrict__ UT, const bf16* __restrict__ VT,
                                            const int* __restrict__ E, const float* __restrict__ Gt, float* __restrict__ rstd_next, float* actbuf  , bool dry, int tid) {
    const int lane = tid & 63, gw = blockIdx.x * (NTHR / 64) + (tid >> 6), ngw = gridDim.x * (NTHR / 64);
    const int g4 = lane >> 4, li = lane & 15;
    for (int t = gw; t < T; t += ngw) {
        const float rs = rstd_from_parts(sumsq + (size_t)t * 16);
        bf16x8_t hx[8];
#pragma unroll
        for (int j = 0; j < 8; ++j) hx[j] = __builtin_nontemporal_load((const bf16x8_t*)(XB + (size_t)t * D + li * 8 + 128 * j));
        const int* ep = E + (size_t)t * 128; const float* gp = Gt + (size_t)t * 128;
#pragma unroll 2
        for (int step = 0; step < 32; ++step) {
            const int e = ep[4 * step + g4];
            const bf16* up = UT + (size_t)e * D + li * 8;
            bf16x8_t u[8];
#pragma unroll
            for (int j = 0; j < 8; ++j) u[j] = *(const bf16x8_t*)(up + 128 * j);
            float d = 0.f;
#pragma unroll
            for (int j = 0; j < 8; ++j) {
                d = __builtin_amdgcn_fdot2_f32_bf16(__builtin_shufflevector(u[j], u[j], 0, 1), __builtin_shufflevector(hx[j], hx[j], 0, 1), d, false);
                d = __builtin_amdgcn_fdot2_f32_bf16(__builtin_shufflevector(u[j], u[j], 2, 3), __builtin_shufflevector(hx[j], hx[j], 2, 3), d, false);
                d = __builtin_amdgcn_fdot2_f32_bf16(__builtin_shufflevector(u[j], u[j], 4, 5), __builtin_shufflevector(hx[j], hx[j], 4, 5), d, false);
                d = __builtin_amdgcn_fdot2_f32_bf16(__builtin_shufflevector(u[j], u[j], 6, 7), __builtin_shufflevector(hx[j], hx[j], 6, 7), d, false);
            }
            d += sxor<1>(d); d += sxor<2>(d); d += sxor<4>(d); d += sxor<8>(d);
            const float a = gelu_tanh(d * rs) * gp[4 * step + g4];
            if (li == 0) actbuf[4 * step + g4] = a;
        }
        __builtin_amdgcn_s_waitcnt(0); __builtin_amdgcn_wave_barrier();
        float acc[16];
#pragma unroll
        for (int i = 0; i < 16; ++i) acc[i] = 0.f;
        const int e_lo = ep[lane], e_hi = ep[64 + lane];
#pragma unroll 4
        for (int idx = 0; idx < 128; ++idx) {
            const int e = __builtin_amdgcn_readlane(idx < 64 ? e_lo : e_hi, idx & 63);
            const bf16* vp = VT + (size_t)e * D + lane * 8;
            const u32x4 va = *(const u32x4*)vp, vb = *(const u32x4*)(vp + 512);
            const float a = actbuf[idx];
            acc[0] += a * bflo(va.x); acc[1] += a * bfhi(va.x); acc[2] += a * bflo(va.y); acc[3] += a * bfhi(va.y);
            acc[4] += a * bflo(va.z); acc[5] += a * bfhi(va.z); acc[6] += a * bflo(va.w); acc[7] += a * bfhi(va.w);
            acc[8] += a * bflo(vb.x); acc[9] += a * bfhi(vb.x); acc[10] += a * bflo(vb.y); acc[11] += a * bfhi(vb.y);
            acc[12] += a * bflo(vb.z); acc[13] += a * bfhi(vb.z); acc[14] += a * bflo(vb.w); acc[15] += a * bfhi(vb.w);
        }
        float ss = 0.f;
#pragma unroll
        for (int hf = 0; hf < 2; ++hf) {
            float* op = out + (size_t)t * D + hf * 512 + lane * 8;
            const pg8::f32x4 x0v = __builtin_nontemporal_load((const pg8::f32x4*)op), x1v = __builtin_nontemporal_load((const pg8::f32x4*)(op + 4));
            const float4 x0 = make_float4(x0v[0], x0v[1], x0v[2], x0v[3]), x1 = make_float4(x1v[0], x1v[1], x1v[2], x1v[3]);
            float4 r0 = make_float4(x0.x + acc[8 * hf + 0], x0.y + acc[8 * hf + 1], x0.z + acc[8 * hf + 2], x0.w + acc[8 * hf + 3]);
            float4 r1 = make_float4(x1.x + acc[8 * hf + 4], x1.y + acc[8 * hf + 5], x1.z + acc[8 * hf + 6], x1.w + acc[8 * hf + 7]);
            if (dry) { r0 = x0; r1 = x1; }
            __builtin_nontemporal_store((pg8::f32x4){r0.x, r0.y, r0.z, r0.w}, (pg8::f32x4*)op); __builtin_nontemporal_store((pg8::f32x4){r1.x, r1.y, r1.z, r1.w}, (pg8::f32x4*)(op + 4));
            u32x4 w; w.x = pk2(r0.x, r0.y); w.y = pk2(r0.z, r0.w); w.z = pk2(r1.x, r1.y); w.w = pk2(r1.z, r1.w);
            __builtin_nontemporal_store(w, (u32x4*)(XB + (size_t)t * D + hf * 512 + lane * 8));
            ss += r0.x * r0.x + r0.y * r0.y + r0.z * r0.z + r0.w * r0.w + r1.x * r1.x + r1.y * r1.y + r1.z * r1.z + r1.w * r1.w;
        }
        ss = wave_sum(ss);
        if (lane == 0 && rstd_next) rstd_next[t] = rsqrtf(ss * (1.f / D) + EPS);
        __builtin_amdgcn_s_waitcnt(0); __builtin_amdgcn_wave_barrier();
    }
}


typedef float f32x2_t __attribute__((ext_vector_type(2)));
__device__ __forceinline__ void fp8x16_to_f32(const u32x4 w, float (&f)[16]) {
    const unsigned ww[4] = {w.x, w.y, w.z, w.w};
#pragma unroll
    for (int q = 0; q < 4; ++q) { const f32x2_t lo = __builtin_amdgcn_cvt_pk_f32_fp8((int)ww[q], false), hi = __builtin_amdgcn_cvt_pk_f32_fp8((int)ww[q], true);
        f[4 * q] = lo[0]; f[4 * q + 1] = lo[1]; f[4 * q + 2] = hi[0]; f[4 * q + 3] = hi[1]; }
}
__device__ __forceinline__ void g1_ev(int (&ev)[16], const int* __restrict__ E, int t, int rg) {
    const int4* ep = (const int4*)(E + (size_t)t * 128 + 16 * rg);
#pragma unroll
    for (int q = 0; q < 4; ++q) { const int4 v = ep[q]; ev[4 * q] = v.x; ev[4 * q + 1] = v.y; ev[4 * q + 2] = v.z; ev[4 * q + 3] = v.w; }
}
template <int H> __device__ __forceinline__ void rows8(u32x4 (&w)[8], const int (&ev)[16], const unsigned char* __restrict__ T8, int col0) {
#pragma unroll
    for (int i = 0; i < 8; ++i) w[i] = *(const u32x4*)(T8 + (size_t)ev[8 * H + i] * 1024 + col0);
}
__device__ __forceinline__ float g1_math8(const u32x4 (&w)[8], const f32x2_t (&xf)[8], int cl) {
    float d[8];
#pragma unroll
    for (int i = 0; i < 8; ++i) {
        const unsigned ww[4] = {w[i].x, w[i].y, w[i].z, w[i].w};
        f32x2_t d2 = {0.f, 0.f};
#pragma unroll
        for (int q = 0; q < 4; ++q) { const f32x2_t lo = __builtin_amdgcn_cvt_pk_f32_fp8((int)ww[q], false), hi = __builtin_amdgcn_cvt_pk_f32_fp8((int)ww[q], true);
            d2 = lo * xf[2 * q] + d2; d2 = hi * xf[2 * q + 1] + d2; }
        d[i] = d2[0] + d2[1];
        if ((i & 1) == 1) __builtin_amdgcn_sched_barrier(0);
    }
    const bool b4 = cl & 4, b2 = cl & 2, b1 = cl & 1;
    float e[4];
#pragma unroll
    for (int k = 0; k < 4; ++k) { const float keep = b4 ? d[k + 4] : d[k], send = b4 ? d[k] : d[k + 4]; e[k] = keep + smirror8(send); }
    float f[2];
#pragma unroll
    for (int k = 0; k < 2; ++k) { const float keep = b2 ? e[k + 2] : e[k], send = b2 ? e[k] : e[k + 2]; f[k] = keep + sxor<2>(send); }
    const float keep = b1 ? f[1] : f[0], send = b1 ? f[0] : f[1];
    return keep + sxor<1>(send);
}
__device__ __forceinline__ void unpack_x(f32x2_t (&xf)[8], const u32x4 xa, const u32x4 xb2) {
    xf[0] = (f32x2_t){bflo(xa.x), bfhi(xa.x)}; xf[1] = (f32x2_t){bflo(xa.y), bfhi(xa.y)}; xf[2] = (f32x2_t){bflo(xa.z), bfhi(xa.z)}; xf[3] = (f32x2_t){bflo(xa.w), bfhi(xa.w)};
    xf[4] = (f32x2_t){bflo(xb2.x), bfhi(xb2.x)}; xf[5] = (f32x2_t){bflo(xb2.y), bfhi(xb2.y)}; xf[6] = (f32x2_t){bflo(xb2.z), bfhi(xb2.z)}; xf[7] = (f32x2_t){bflo(xb2.w), bfhi(xb2.w)};
}
constexpr int G_SLOTS = 8, G_NPRE = 5;
__device__ __forceinline__ void g_dma(const void* gsrc, unsigned char* slot) {
    __builtin_amdgcn_global_load_lds((const __attribute__((address_space(1))) unsigned*)gsrc, (__attribute__((address_space(3))) unsigned*)slot, 16, 0, 0);
}
__device__ __forceinline__ void lds_ev(int (&ev)[16], const unsigned char* slot, int rg) {
#pragma unroll
    for (int q = 0; q < 4; ++q) { const int4 v = *(const int4*)(slot + rg * 64 + 16 * q); ev[4 * q] = v.x; ev[4 * q + 1] = v.y; ev[4 * q + 2] = v.z; ev[4 * q + 3] = v.w; }
}
template <int N> __device__ __forceinline__ void rowsN(u32x4 (&w)[N], const int (&ev)[16], int off, const unsigned char* __restrict__ T8, int col0) {
#pragma unroll
    for (int i = 0; i < N; ++i) w[i] = *gptr((const u32x4*)(T8 + (size_t)ev[off + i] * 128 + col0));
}
#define G_WAIT_IDS() asm volatile("s_waitcnt vmcnt(30)" ::: "memory")
__device__ __forceinline__ void peer_u_partial(const bf16* __restrict__ XB, const unsigned char* __restrict__ UT8, const int* __restrict__ E, float* __restrict__ PART, unsigned char* ring, int tid,
                                               const int xs, const int r, const int nr) {
    const int lane = tid & 63, wv = tid >> 6, rg = lane >> 3, cl = lane & 7;
    const int col0 = xs * (16384 * 128) + 16 * cl, step = nr * 8;
    float* pb = PART + (size_t)xs * T * 128 + 16 * rg + cl;
    const int t0 = r * 8 + wv;
    const int ntok = (t0 < T) ? (T - 1 - t0) / step + 1 : 0;
    if (ntok == 0) return;
    const size_t src_lane_off = (lane < 32) ? (size_t)lane * 16 : (size_t)((lane & 15) * 16);
    auto dma = [&](int k) { const int t = t0 + k * step;
        const unsigned char* src = (lane < 32) ? (const unsigned char*)(E + (size_t)t * 128) : (const unsigned char*)(XB + (size_t)t * D + 128 * xs);
        g_dma(src + src_lane_off, ring + (k & (G_SLOTS - 1)) * 1024); };
#pragma unroll 1
    for (int k = 0; k < G_NPRE && k < ntok; ++k) dma(k);
    asm volatile("s_waitcnt vmcnt(0)" ::: "memory");
    int ev[16]; u32x4 wA[16], wB[16];
    lds_ev(ev, ring, rg); rowsN<16>(wA, ev, 0, UT8, col0);
#pragma unroll 1
    for (int k = 0; k < ntok; k += 2) {
        if (k + G_NPRE < ntok) dma(k + G_NPRE);
        if (k + 1 < ntok) { G_WAIT_IDS(); lds_ev(ev, ring + ((k + 1) & (G_SLOTS - 1)) * 1024, rg); rowsN<16>(wB, ev, 0, UT8, col0); }
        {
            const unsigned char* slot = ring + (k & (G_SLOTS - 1)) * 1024;
            const u32x4 xa = *(const u32x4*)(slot + 512 + cl * 32), xb2 = *(const u32x4*)(slot + 512 + cl * 32 + 16);
            f32x2_t xf[8]; unpack_x(xf, xa, xb2);
            const float res0 = g1_math8(*(const u32x4(*)[8])&wA[0], xf, cl), res1 = g1_math8(*(const u32x4(*)[8])&wA[8], xf, cl);
            float* po = pb + (size_t)(t0 + k * step) * 128; *gptr(po) = res0; *gptr(po + 8) = res1;
        }
        if (k + 1 >= ntok) break;
        if (k + 1 + G_NPRE < ntok) dma(k + 1 + G_NPRE);
        if (k + 2 < ntok) { G_WAIT_IDS(); lds_ev(ev, ring + ((k + 2) & (G_SLOTS - 1)) * 1024, rg); rowsN<16>(wA, ev, 0, UT8, col0); }
        {
            const unsigned char* slot = ring + ((k + 1) & (G_SLOTS - 1)) * 1024;
            const u32x4 xa = *(const u32x4*)(slot + 512 + cl * 32), xb2 = *(const u32x4*)(slot + 512 + cl * 32 + 16);
            f32x2_t xf[8]; unpack_x(xf, xa, xb2);
            const float res0 = g1_math8(*(const u32x4(*)[8])&wB[0], xf, cl), res1 = g1_math8(*(const u32x4(*)[8])&wB[8], xf, cl);
            float* po = pb + (size_t)(t0 + (k + 1) * step) * 128; *gptr(po) = res0; *gptr(po + 8) = res1;
        }
    }
    asm volatile("s_waitcnt vmcnt(0)" ::: "memory");
}
__device__ __forceinline__ void peer_act(const float* __restrict__ PART, const float* __restrict__ ssq, float* __restrict__ Gt, int tid) {
    const int lane = tid & 63, gw = blockIdx.x * (NTHR / 64) + (tid >> 6), ngw = gridDim.x * (NTHR / 64);
    for (int t = gw; t < T; t += ngw) {
        const float rs = rstd_from_parts(ssq + (size_t)t * 16) * (1.f / 64.f);
        float d0 = 0.f, d1 = 0.f;
#pragma unroll
        for (int s = 0; s < 8; ++s) { const float2 v = *(const float2*)(PART + ((size_t)s * T + t) * 128 + 2 * lane); d0 += v.x; d1 += v.y; }
        float2* gp = (float2*)(Gt + (size_t)t * 128 + 2 * lane);
        const float2 g = *gp;
        *gp = make_float2(gelu_tanh(d0 * rs) * g.x, gelu_tanh(d1 * rs) * g.y);
    }
}
__device__ __forceinline__ void g3_act(float (&av)[16], const float* __restrict__ ACT, int t, int rg) {
    const float4* ap = (const float4*)(ACT + (size_t)t * 128 + 16 * rg);
#pragma unroll
    for (int q = 0; q < 4; ++q) { const float4 a = ap[q]; av[4 * q] = a.x; av[4 * q + 1] = a.y; av[4 * q + 2] = a.z; av[4 * q + 3] = a.w; }
}
template <int H> __device__ __forceinline__ void g3_math8(const u32x4 (&w)[8], const float (&av)[16], f32x2_t (&acc)[8]) {
#pragma unroll
    for (int i = 0; i < 8; ++i) {
        const unsigned ww[4] = {w[i].x, w[i].y, w[i].z, w[i].w};
        const f32x2_t a2 = {av[8 * H + i], av[8 * H + i]};
#pragma unroll
        for (int q = 0; q < 4; ++q) { const f32x2_t lo = __builtin_amdgcn_cvt_pk_f32_fp8((int)ww[q], false), hi = __builtin_amdgcn_cvt_pk_f32_fp8((int)ww[q], true);
            acc[2 * q] = lo * a2 + acc[2 * q]; acc[2 * q + 1] = hi * a2 + acc[2 * q + 1]; }
        __builtin_amdgcn_sched_barrier(0);
    }
}
__device__ __forceinline__ void g3_finish(const f32x2_t (&acc)[8], float* __restrict__ out, bf16* __restrict__ XB, float* __restrict__ ssq_next, bool dry, int t, int xs, int rg, int cl, int lane) {
    const bool b4 = rg & 4, b2 = rg & 2, b1 = rg & 1;
    f32x2_t e[4];
#pragma unroll
    for (int k = 0; k < 4; ++k) { const f32x2_t keep = b4 ? acc[k + 4] : acc[k], send = b4 ? acc[k] : acc[k + 4];
        e[k] = (f32x2_t){keep[0] + sxor<32>(send[0]), keep[1] + sxor<32>(send[1])}; }
    f32x2_t f[2];
#pragma unroll
    for (int k = 0; k < 2; ++k) { const f32x2_t keep = b2 ? e[k + 2] : e[k], send = b2 ? e[k] : e[k + 2];
        f[k] = (f32x2_t){keep[0] + sxor<16>(send[0]), keep[1] + sxor<16>(send[1])}; }
    const f32x2_t keep = b1 ? f[1] : f[0], send = b1 ? f[0] : f[1];
    const float a0 = keep[0] + sxor<8>(send[0]), a1 = keep[1] + sxor<8>(send[1]);
    const int col = 128 * xs + 16 * cl + 2 * rg;
    unsigned* xp = (unsigned*)(XB + (size_t)t * D + col);
    const unsigned xw = *gptr(xp);
    const float2 x0 = make_float2(bflo(xw), bfhi(xw));
    float2 r0 = make_float2(x0.x + 0.125f * a0, x0.y + 0.125f * a1);
    if (dry) r0 = x0;
    if (out) *gptr((f32x2_t*)(out + (size_t)t * D + col)) = (f32x2_t){r0.x, r0.y};
    else *gptr(xp) = pk2(r0.x, r0.y);
    if (ssq_next) {
        const float ss = wave_sum(r0.x * r0.x + r0.y * r0.y);
        if (lane < 2) *gptr(ssq_next + (size_t)t * 16 + 8 * lane + xs) = lane ? 0.f : ss;
    }
}
__device__ __forceinline__ void lds_av(float (&av)[16], const unsigned char* slot, int rg) {
#pragma unroll
    for (int q = 0; q < 4; ++q) { const float4 a = *(const float4*)(slot + 512 + rg * 64 + 16 * q); av[4 * q] = a.x; av[4 * q + 1] = a.y; av[4 * q + 2] = a.z; av[4 * q + 3] = a.w; }
}
__device__ __forceinline__ void peer_v_slice(float* __restrict__ out, bf16* __restrict__ XB, const unsigned char* __restrict__ VT8, const int* __restrict__ E, const float* __restrict__ ACT,
                                             float* __restrict__ ssq_next, bool dry, unsigned char* ring, int tid, const int xs, const int r, const int nr) {
    const int lane = tid & 63, wv = tid >> 6, rg = lane >> 3, cl = lane & 7;
    const int col0 = xs * (16384 * 128) + 16 * cl, step = nr * 8;
    const int t0 = r * 8 + wv;
    const int ntok = (t0 < T) ? (T - 1 - t0) / step + 1 : 0;
    if (ntok == 0) return;
    const size_t src_lane_off = (size_t)(lane & 31) * 16;
    auto dma = [&](int k) { const int t = t0 + k * step;
        const unsigned char* src = (lane < 32) ? (const unsigned char*)(E + (size_t)t * 128) : (const unsigned char*)(ACT + (size_t)t * 128);
        g_dma(src + src_lane_off, ring + (k & (G_SLOTS - 1)) * 1024); };
#pragma unroll 1
    for (int k = 0; k < G_NPRE && k < ntok; ++k) dma(k);
    asm volatile("s_waitcnt vmcnt(0)" ::: "memory");
    int ev[16]; u32x4 wA[16], wB[16];
    lds_ev(ev, ring, rg); rowsN<16>(wA, ev, 0, VT8, col0);
#pragma unroll 1
    for (int k = 0; k < ntok; k += 2) {
        if (k + G_NPRE < ntok) dma(k + G_NPRE);
        if (k + 1 < ntok) { G_WAIT_IDS(); lds_ev(ev, ring + ((k + 1) & (G_SLOTS - 1)) * 1024, rg); rowsN<16>(wB, ev, 0, VT8, col0); }
        {
            float av[16]; lds_av(av, ring + (k & (G_SLOTS - 1)) * 1024, rg);
            f32x2_t acc[8];
#pragma unroll
            for (int j = 0; j < 8; ++j) acc[j] = (f32x2_t){0.f, 0.f};
            g3_math8<0>(*(const u32x4(*)[8])&wA[0], av, acc); g3_math8<1>(*(const u32x4(*)[8])&wA[8], av, acc);
            g3_finish(acc, out, XB, ssq_next, dry, t0 + k * step, xs, rg, cl, lane);
        }
        if (k + 1 >= ntok) break;
        if (k + 1 + G_NPRE < ntok) dma(k + 1 + G_NPRE);
        if (k + 2 < ntok) { G_WAIT_IDS(); lds_ev(ev, ring + ((k + 2) & (G_SLOTS - 1)) * 1024, rg); rowsN<16>(wA, ev, 0, VT8, col0); }
        {
            float av[16]; lds_av(av, ring + ((k + 1) & (G_SLOTS - 1)) * 1024, rg);
            f32x2_t acc[8];
#pragma unroll
            for (int j = 0; j < 8; ++j) acc[j] = (f32x2_t){0.f, 0.f};
            g3_math8<0>(*(const u32x4(*)[8])&wB[0], av, acc); g3_math8<1>(*(const u32x4(*)[8])&wB[8], av, acc);
            g3_finish(acc, out, XB, ssq_next, dry, t0 + (k + 1) * step, xs, rg, cl, lane);
        }
    }
    asm volatile("s_waitcnt vmcnt(0)" ::: "memory");
}

namespace att {
typedef short bf16x8 __attribute__((ext_vector_type(8)));
typedef short bf16x4 __attribute__((ext_vector_type(4)));
typedef float f32x4 __attribute__((ext_vector_type(4)));
constexpr int TROW = 144;
constexpr int TILE_B = 64 * TROW;
constexpr int OFF_K = 0, OFF_V = 2 * TILE_B, OFF_IMP = 4 * TILE_B  , OFF_SEL = OFF_IMP + 16384, OFF_ANY = OFF_SEL + 512, OFF_STAGE = OFF_ANY + 512;
constexpr int STAGE_ROW = 68;
constexpr int LDS_NEED = OFF_STAGE + 384 * STAGE_ROW * 4;
constexpr float QSCALE = 0.125f * 1.4426950408889634f;
constexpr float SBOUND = QSCALE * 64.0f * 1.02f;

typedef float f32x2_ __attribute__((ext_vector_type(2)));
__device__ __forceinline__ unsigned cvt_pk(float lo, float hi) { const f32x2_ v = {lo, hi}; return __builtin_bit_cast(unsigned, __builtin_convertvector(v, bf16x2_t)); }

__device__ __forceinline__ void load_qfrag(bf16x8 (&qf)[2], const bf16* __restrict__ rowp, const float* __restrict__ gain, const float* __restrict__ rope_row, int g4) {
    const u32x4 w0 = *(const u32x4*)(rowp + 8 * g4), w1 = *(const u32x4*)(rowp + 32 + 8 * g4);
    float f0[8] = {bflo(w0.x), bfhi(w0.x), bflo(w0.y), bfhi(w0.y), bflo(w0.z), bfhi(w0.z), bflo(w0.w), bfhi(w0.w)};
    float f1[8] = {bflo(w1.x), bfhi(w1.x), bflo(w1.y), bfhi(w1.y), bflo(w1.z), bfhi(w1.z), bflo(w1.w), bfhi(w1.w)};
    float ss = 0.f;
#pragma unroll
    for (int j = 0; j < 8; ++j) ss += f0[j] * f0[j] + f1[j] * f1[j];
    ss += sxor<16>(ss); ss += sxor<32>(ss);
    const float rs = rsqrtf(ss * (1.f / 64.f) + EPS);
#pragma unroll
    for (int j = 0; j < 8; ++j) { f0[j] *= rs * gain[8 * g4 + j]; f1[j] *= rs * gain[32 + 8 * g4 + j]; }
    if (rope_row) {
#pragma unroll
        for (int j = 0; j < 8; ++j) {
            const float partner = sxor<16>(f0[j]);
            const float cs = rope_row[j], sn = rope_row[8 + j];
            if (g4 == 0) f0[j] = f0[j] * cs - partner * sn;
            else if (g4 == 1) f0[j] = f0[j] * cs + partner * sn;
        }
    }
    u32x4 o0, o1;
    o0.x = cvt_pk(f0[0] * QSCALE, f0[1] * QSCALE); o0.y = cvt_pk(f0[2] * QSCALE, f0[3] * QSCALE); o0.z = cvt_pk(f0[4] * QSCALE, f0[5] * QSCALE); o0.w = cvt_pk(f0[6] * QSCALE, f0[7] * QSCALE);
    o1.x = cvt_pk(f1[0] * QSCALE, f1[1] * QSCALE); o1.y = cvt_pk(f1[2] * QSCALE, f1[3] * QSCALE); o1.z = cvt_pk(f1[4] * QSCALE, f1[5] * QSCALE); o1.w = cvt_pk(f1[6] * QSCALE, f1[7] * QSCALE);
    qf[0] = __builtin_bit_cast(bf16x8, o0); qf[1] = __builtin_bit_cast(bf16x8, o1);
}

template <int NU>
__device__ __forceinline__ void qk_tile(const unsigned char* Kt, const bf16x8 (&qf)[NU][2], f32x4 (&Sv)[NU][4], int c16, int g4, const float (&init)[NU]) {
#pragma unroll
    for (int rt = 0; rt < 4; ++rt) {
        const bf16x8 k0 = *(const bf16x8*)(Kt + (16 * rt + c16) * TROW + 16 * g4);
        const bf16x8 k1 = *(const bf16x8*)(Kt + (16 * rt + c16) * TROW + 64 + 16 * g4);
#pragma unroll
        for (int u = 0; u < NU; ++u) {
            f32x4 a = {init[u], init[u], init[u], init[u]};
            a = __builtin_amdgcn_mfma_f32_16x16x32_bf16(k0, qf[u][0], a, 0, 0, 0);
            a = __builtin_amdgcn_mfma_f32_16x16x32_bf16(k1, qf[u][1], a, 0, 0, 0);
            Sv[u][rt] = a;
        }
    }
}
template <int NU, bool SUML>
__device__ __forceinline__ void pv_tile(const unsigned char* Vt, const f32x4 (&Sv)[NU][4], f32x4 (&O)[NU][4], int c16, int g4, f32x4 (&Ol)[NU]) {
    bf16x8 pf[NU][2];
#pragma unroll
    for (int u = 0; u < NU; ++u)
#pragma unroll
        for (int kk = 0; kk < 2; ++kk) {
            u32x4 w; w.x = cvt_pk(Sv[u][2 * kk][0], Sv[u][2 * kk][1]); w.y = cvt_pk(Sv[u][2 * kk][2], Sv[u][2 * kk][3]);
            w.z = cvt_pk(Sv[u][2 * kk + 1][0], Sv[u][2 * kk + 1][1]); w.w = cvt_pk(Sv[u][2 * kk + 1][2], Sv[u][2 * kk + 1][3]);
            pf[u][kk] = __builtin_bit_cast(bf16x8, w);
        }
    if (SUML) {
        const u32x4 o1 = {0x3f803f80u, 0x3f803f80u, 0x3f803f80u, 0x3f803f80u};
        const bf16x8 ones = __builtin_bit_cast(bf16x8, o1);
#pragma unroll
        for (int u = 0; u < NU; ++u) { Ol[u] = __builtin_amdgcn_mfma_f32_16x16x32_bf16(ones, pf[u][0], Ol[u], 0, 0, 0); Ol[u] = __builtin_amdgcn_mfma_f32_16x16x32_bf16(ones, pf[u][1], Ol[u], 0, 0, 0); }
    }
#pragma unroll
    for (int dt = 0; dt < 4; ++dt)
#pragma unroll
        for (int kk = 0; kk < 2; ++kk) {
            const unsigned char* vr = Vt + (16 * dt + c16) * TROW + (32 * kk + 4 * g4) * 2;
            const u32x2 lo = *(const u32x2*)vr, hi = *(const u32x2*)(vr + 32);
            u32x4 w; w.x = lo.x; w.y = lo.y; w.z = hi.x; w.w = hi.y;
            const bf16x8 vf = __builtin_bit_cast(bf16x8, w);
#pragma unroll
            for (int u = 0; u < NU; ++u) O[u][dt] = __builtin_amdgcn_mfma_f32_16x16x32_bf16(vf, pf[u][kk], O[u][dt], 0, 0, 0);
        }
}
constexpr float LAZY = 8.0f;
template <int NU, bool COLMASK, bool FIXED, bool NOSUM = false>
__device__ __forceinline__ void softmax_update(f32x4 (&Sv)[NU][4], float (&m)[NU], float (&l)[NU], f32x4 (&O)[NU][4], bool scaleO, const bool (&colok)[NU]) {
    if (FIXED) {
#pragma unroll
        for (int u = 0; u < NU; ++u) {
            float ps = 0.f;
#pragma unroll
            for (int rt = 0; rt < 4; ++rt)
#pragma unroll
                for (int jj = 0; jj < 4; ++jj) { const float p = __builtin_amdgcn_exp2f(Sv[u][rt][jj]); Sv[u][rt][jj] = p; if (!NOSUM) ps += p; }
            if (!NOSUM) l[u] += ps;
        }
        return;
    }
    float mx[NU]; bool need = false;
#pragma unroll
    for (int u = 0; u < NU; ++u) {
        float v = -INFINITY;
#pragma unroll
        for (int rt = 0; rt < 4; ++rt) v = fmaxf(fmaxf(v, fmaxf(Sv[u][rt][0], Sv[u][rt][1])), fmaxf(Sv[u][rt][2], Sv[u][rt][3]));
        v = fmaxf(v, sxor<16>(v)); v = fmaxf(v, sxor<32>(v));
        if (COLMASK && !colok[u]) v = -INFINITY;
        mx[u] = v;
        need = need || (v > m[u] + LAZY);
    }
    if (__builtin_amdgcn_ballot_w64(need) != 0ull) {
#pragma unroll
        for (int u = 0; u < NU; ++u) {
            if (mx[u] > m[u] + LAZY) {
                const float alpha = __builtin_amdgcn_exp2f(m[u] - mx[u]);
                m[u] = mx[u];
                l[u] *= alpha;
                if (scaleO) {
#pragma unroll
                    for (int dt = 0; dt < 4; ++dt) O[u][dt] = O[u][dt] * alpha;
                }
            }
        }
    }
#pragma unroll
    for (int u = 0; u < NU; ++u) {
        float mu = (m[u] == -INFINITY) ? 0.f : m[u];
        if (COLMASK && !colok[u]) mu = INFINITY;
        float ps = 0.f;
#pragma unroll
        for (int rt = 0; rt < 4; ++rt)
#pragma unroll
            for (int jj = 0; jj < 4; ++jj) { const float p = __builtin_amdgcn_exp2f(Sv[u][rt][jj] - mu); Sv[u][rt][jj] = p; ps += p; }
        l[u] += ps;
    }
}

#define SGB(mask, n) __builtin_amdgcn_sched_group_barrier(mask, n, 0)
template <int NU>
__device__ __forceinline__ void tile_fixed(const unsigned char* Kt, const unsigned char* Vt, const bf16x8 (&qf)[NU][2], f32x4 (&O)[NU][4], float (&l)[NU], int c16, int g4, const float (&init)[NU]) {
    f32x4 Sv[NU][4];
    float ps[NU];
    const unsigned char* kp = Kt + c16 * TROW + 16 * g4;
    const unsigned char* vp = Vt + c16 * TROW + 8 * g4;
#define KRD(rt, h) (*(const bf16x8*)(kp + (16 * (rt)) * TROW + 64 * (h)))
#define VRD(dt, kk) ({ const unsigned char* vr__ = vp + (16 * (dt)) * TROW + 64 * (kk); const u32x2 lo__ = *(const u32x2*)vr__, hi__ = *(const u32x2*)(vr__ + 32); \
                       u32x4 w__; w__.x = lo__.x; w__.y = lo__.y; w__.z = hi__.x; w__.w = hi__.y; __builtin_bit_cast(bf16x8, w__); })
#define QK_RT(rt, K0, K1) { _Pragma("unroll") for (int u = 0; u < NU; ++u) { f32x4 a__ = {init[u], init[u], init[u], init[u]}; \
                              a__ = __builtin_amdgcn_mfma_f32_16x16x32_bf16(K0, qf[u][0], a__, 0, 0, 0); Sv[u][rt] = __builtin_amdgcn_mfma_f32_16x16x32_bf16(K1, qf[u][1], a__, 0, 0, 0); } }
#define EXP_RT(rt) { _Pragma("unroll") for (int u = 0; u < NU; ++u) _Pragma("unroll") for (int jj = 0; jj < 4; ++jj) Sv[u][rt][jj] = __builtin_amdgcn_exp2f(Sv[u][rt][jj]); }
#define SUM_RT(rt) { _Pragma("unroll") for (int jj = 0; jj < 4; ++jj) _Pragma("unroll") for (int u = 0; u < NU; ++u) { ps[u] += Sv[u][rt][jj]; asm("" : "+v"(ps[u])); } }
#define CVT_KK(kk, PF) { _Pragma("unroll") for (int u = 0; u < NU; ++u) { u32x4 w__; w__.x = cvt_pk(Sv[u][2 * (kk)][0], Sv[u][2 * (kk)][1]); w__.y = cvt_pk(Sv[u][2 * (kk)][2], Sv[u][2 * (kk)][3]); \
                           w__.z = cvt_pk(Sv[u][2 * (kk) + 1][0], Sv[u][2 * (kk) + 1][1]); w__.w = cvt_pk(Sv[u][2 * (kk) + 1][2], Sv[u][2 * (kk) + 1][3]); PF[u] = __builtin_bit_cast(bf16x8, w__); } }
#define PV_DT(dt, VF, PF) { _Pragma("unroll") for (int u = 0; u < NU; ++u) O[u][dt] = __builtin_amdgcn_mfma_f32_16x16x32_bf16(VF, PF[u], O[u][dt], 0, 0, 0); }
#pragma unroll
    for (int u = 0; u < NU; ++u) ps[u] = 0.f;
    __builtin_amdgcn_sched_barrier(0);
    bf16x8 ka0 = KRD(0, 0), ka1 = KRD(0, 1), kb0 = KRD(1, 0), kb1 = KRD(1, 1);
    QK_RT(0, ka0, ka1)
    __builtin_amdgcn_sched_barrier(0);
    ka0 = KRD(2, 0); ka1 = KRD(2, 1);
    QK_RT(1, kb0, kb1)
    EXP_RT(0)
    SGB(0x100, 2);
#pragma unroll
    for (int i = 0; i < 2 * NU; ++i) { SGB(0x008, 1); SGB(0x400, 2); }
    __builtin_amdgcn_sched_barrier(0);
    kb0 = KRD(3, 0); kb1 = KRD(3, 1);
    QK_RT(2, ka0, ka1)
    EXP_RT(1)
    SUM_RT(0)
    SGB(0x100, 2);
#pragma unroll
    for (int i = 0; i < 2 * NU; ++i) { SGB(0x008, 1); SGB(0x400, 2); SGB(0x002, 2); }
    __builtin_amdgcn_sched_barrier(0);
    QK_RT(3, kb0, kb1)
    EXP_RT(2)
    SUM_RT(1)
#pragma unroll
    for (int i = 0; i < 2 * NU; ++i) { SGB(0x008, 1); SGB(0x400, 2); SGB(0x002, 2); }
    __builtin_amdgcn_sched_barrier(0);
    bf16x8 pf[NU];
    bf16x8 va = VRD(0, 0), vb = VRD(1, 0);
    CVT_KK(0, pf)
    PV_DT(0, va, pf)
    va = VRD(2, 0);
    PV_DT(1, vb, pf)
    vb = VRD(3, 0);
    EXP_RT(3)
    SUM_RT(2)
    PV_DT(2, va, pf)
    va = VRD(0, 1);
    PV_DT(3, vb, pf)
    vb = VRD(1, 1);
    SGB(0x100, 4); SGB(0x002, 4 * NU);
#pragma unroll
    for (int i = 0; i < 4; ++i) { SGB(0x008, 1); SGB(0x400, 1); SGB(0x002, 1); SGB(0x100, 1); SGB(0x008, 1); SGB(0x400, 1); SGB(0x002, 1); SGB(0x100, 1); SGB(0x008, 1); SGB(0x400, 1); SGB(0x002, 1); }
    __builtin_amdgcn_sched_barrier(0);
    bf16x8 pg[NU];
    CVT_KK(1, pg)
    PV_DT(0, va, pg)
    va = VRD(2, 1);
    PV_DT(1, vb, pg)
    vb = VRD(3, 1);
    PV_DT(2, va, pg)
    PV_DT(3, vb, pg)
    SUM_RT(3)
    SGB(0x002, 4 * NU);
#pragma unroll
    for (int i = 0; i < 4 * NU; ++i) { SGB(0x008, 1); SGB(0x002, 1); }
    __builtin_amdgcn_sched_barrier(0);
#pragma unroll
    for (int u = 0; u < NU; ++u) l[u] += ps[u];
#undef KRD
#undef VRD
#undef QK_RT
#undef EXP_RT
#undef CVT_KK
#undef PV_DT
}

__device__ __forceinline__ u32x4 tile_ld(const bf16* __restrict__ g, int tl) { return *(const u32x4*)(g + tl * 8); }
__device__ __forceinline__ void tile_st(unsigned char* lds_tile, u32x4 v, int tl) { *(u32x4*)(lds_tile + (tl >> 3) * TROW + (tl & 7) * 16) = v; }

template <bool FIXED>
__device__ __forceinline__ void mem_attention_mfma(const bf16* __restrict__ P, int qoff, const bf16* __restrict__ MK, const bf16* __restrict__ MVT, const float* __restrict__ q_gain,
                                                   bf16* __restrict__ AIN, unsigned char* lds, int tid_in, const float Mref) {
    int tid = tid_in; asm volatile("" : "+v"(tid));
    const int lane = tid & 63, wv = tid >> 6, c16 = lane & 15, g4 = lane >> 4;
    for (int item = blockIdx.x; item < NB * 4 * 16; item += gridDim.x) {
        int tl = tid; asm volatile("" : "+v"(tl));
        const int qt = item & 15, h = (item >> 4) & 3, b = item >> 6;
        const bf16* kb = MK + (size_t)(b * 4 + h) * 256 * 64;
        const bf16* vb = MVT + (size_t)(b * 4 + h) * 256 * 64;
        bf16x8 qf[2][2];
        size_t rowq[2];
#pragma unroll
        for (int u = 0; u < 2; ++u) { rowq[u] = (size_t)b * S + qt * 256 + wv * 32 + u * 16 + c16; load_qfrag(qf[u], P + rowq[u] * PP + qoff + h * 64, q_gain, nullptr, g4); }
        f32x4 O[2][4], Ol[2]; float m[2], l[2];
        Ol[0] = (f32x4){0.f, 0.f, 0.f, 0.f}; Ol[1] = (f32x4){0.f, 0.f, 0.f, 0.f};
#pragma unroll
        for (int u = 0; u < 2; ++u) { m[u] = FIXED ? Mref : -INFINITY; l[u] = 0.f;
#pragma unroll
            for (int dt = 0; dt < 4; ++dt) O[u][dt] = (f32x4){0.f, 0.f, 0.f, 0.f}; }
        u32x4 kr = tile_ld(kb, tl), vr = tile_ld(vb, tl);
        __syncthreads();
        tile_st(lds + OFF_K, kr, tl); tile_st(lds + OFF_V, vr, tl);
        __syncthreads();
        for (int kt = 0; kt < 4; ++kt) {
            const int cur = kt & 1;
            if (kt + 1 < 4) { kr = tile_ld(kb + (size_t)(kt + 1) * 4096, tl); vr = tile_ld(vb + (size_t)(kt + 1) * 4096, tl); }
            const float ini[2] = {FIXED ? -Mref : 0.f, FIXED ? -Mref : 0.f};
            if (FIXED) tile_fixed<2>(lds + OFF_K + cur * TILE_B, lds + OFF_V + cur * TILE_B, qf, O, l, c16, g4, ini);
            else {
                f32x4 Sv[2][4];
                qk_tile<2>(lds + OFF_K + cur * TILE_B, qf, Sv, c16, g4, ini);
                { const bool allok[2] = {true, true}; softmax_update<2, false, FIXED, false>(Sv, m, l, O, true, allok); }
                pv_tile<2, false>(lds + OFF_V + cur * TILE_B, Sv, O, c16, g4, Ol);
            }
            if (kt + 1 < 4) { tile_st(lds + OFF_K + (cur ^ 1) * TILE_B, kr, tl); tile_st(lds + OFF_V + (cur ^ 1) * TILE_B, vr, tl); }
            __syncthreads();
        }
#pragma unroll
        for (int u = 0; u < 2; ++u) {
            float lt = l[u]; lt += sxor<16>(lt); lt += sxor<32>(lt);
            const float inv = 1.f / lt;
#pragma unroll
            for (int dt = 0; dt < 4; ++dt) {
                u32x2 w; w.x = cvt_pk(O[u][dt][0] * inv, O[u][dt][1] * inv); w.y = cvt_pk(O[u][dt][2] * inv, O[u][dt][3] * inv);
                *(u32x2*)(AIN + rowq[u] * D + 768 + h * 64 + 16 * dt + 4 * g4) = w;
            }
        }
    }
}

#define STAGE_BASE() ({ int t__ = tid_in; asm volatile("" : "+v"(t__)); stage + ((3 * (t__ >> 6)) * 16 + (t__ & 15)) * STAGE_ROW + 4 * ((t__ >> 4) & 3); })
template <bool FIXED, int VAR = 0>
__device__ __forceinline__ void nsa_attention_mfma(const bf16* __restrict__ P, const bf16* __restrict__ KC, const bf16* __restrict__ VCT, const bf16* __restrict__ KS, const bf16* __restrict__ VST,
                                                   const bf16* __restrict__ KW, const bf16* __restrict__ VWT, const float* __restrict__ rope, const float* __restrict__ qgain,
                                                   const float* __restrict__ gate_b, bf16* __restrict__ AIN, unsigned char* lds, int tid_in, const float Mc, const float Ms, const float Mw) {
    int* imp = (int*)(lds + OFF_IMP);
    unsigned* selw = (unsigned*)(lds + OFF_SEL);
    unsigned* anyw = (unsigned*)(lds + OFF_ANY);
    float* stage = (float*)(lds + OFF_STAGE);
    const int nitems = NB * 2 * 64;
    for (int it = blockIdx.x; it < nitems; it += gridDim.x) {
        int tid = tid_in; asm volatile("" : "+v"(tid));
        const int lane = tid & 63, wv = tid >> 6, c16 = lane & 15, g4 = lane >> 4;
        int tl = tid; asm volatile("" : "+v"(tl));
        int b, g, c;
        if (gridDim.x == 256) { const int k = blockIdx.x, r = it >> 8, bg = 2 * (k & 7) + ((k >> 3) & 1), s = k >> 4;
            b = bg >> 1; g = bg & 1; c = (r == 0) ? s : (r == 1) ? 31 - s : (r == 2) ? 32 + s : 63 - s; }
        else { c = it & 63; g = (it >> 6) & 1; b = it >> 7; }
        const int bg2 = b * 2 + g;
        const bf16* kcb = KC + (size_t)(b * 2 + g) * 256 * 64;
        u32x4 kr0 = ((VAR == 1) ? (u32x4){0u, 0u, 0u, 0u} : tile_ld(kcb, tl));
        bf16x8 qf[3][2]; int qq[3], hq[3];
#pragma unroll
        for (int u = 0; u < 3; ++u) {
            const int U = 3 * wv + u; hq[u] = g * 6 + (U >> 2); qq[u] = (U & 3) * 16 + c16;
            const size_t row = (size_t)b * S + c * 64 + qq[u];
            load_qfrag(qf[u], P + row * PP + 768 + hq[u] * 64, qgain, rope + (size_t)(c * 64 + qq[u]) * 16, g4);
        }
        __syncthreads();
        for (int i = tid; i < 64 * 64; i += NTHR) imp[i] = 0;
        if (tid < 2) anyw[tid] = 0u;
        f32x4 O[3][4], Ol[3]; float m[3], l[3];
        Ol[0] = (f32x4){0.f, 0.f, 0.f, 0.f}; Ol[1] = Ol[0]; Ol[2] = Ol[0];
        const int ktmax = (VAR == 3) ? -1 : (((4 * c + 2) >> 6) > 3 ? 3 : ((4 * c + 2) >> 6));
        const bf16* vcb = VCT + (size_t)bg2 * 256 * 64;
#pragma unroll
        for (int u = 0; u < 3; ++u) { m[u] = FIXED ? Mc : -INFINITY; l[u] = 0.f; }
        const float inic[3] = {FIXED ? -Mc : 0.f, FIXED ? -Mc : 0.f, FIXED ? -Mc : 0.f};
        {
            u32x4 kr = kr0;
            __syncthreads();
            if (VAR != 1) tile_st(lds + OFF_K, kr, tl);
            __syncthreads();
            for (int kt = 0; kt <= ktmax; ++kt) {
                const int cur = kt & 1;
                if (kt + 1 <= ktmax) kr = ((VAR == 1) ? (u32x4){0u, 0u, 0u, 0u} : tile_ld(kcb + (size_t)(kt + 1) * 4096, tl));
                f32x4 Sv[3][4];
                if (VAR < 2) qk_tile<3>(lds + OFF_K + cur * TILE_B, qf, Sv, c16, g4, inic); else { _Pragma("unroll") for (int u = 0; u < 3; ++u) _Pragma("unroll") for (int rt = 0; rt < 4; ++rt) Sv[u][rt] = (f32x4){0.f, 0.f, 0.f, 0.f}; }
#pragma unroll
                for (int u = 0; u < 3; ++u) { const int t = c * 64 + qq[u];
#pragma unroll
                    for (int rt = 0; rt < 4; ++rt)
#pragma unroll
                        for (int jj = 0; jj < 4; ++jj) { const int n = 64 * kt + 16 * rt + 4 * g4 + jj; if (!(n < NCMP && 16 * n + 31 <= t)) Sv[u][rt][jj] = -INFINITY; } }
                { const bool allok[3] = {true, true, true}; softmax_update<3, false, FIXED>(Sv, m, l, O, false, allok); }
                if (kt + 1 <= ktmax) if (VAR != 1) tile_st(lds + OFF_K + (cur ^ 1) * TILE_B, kr, tl);
                __syncthreads();
            }
        }
        float invl[3], mu[3];
#pragma unroll
        for (int u = 0; u < 3; ++u) { float lt = l[u]; lt += sxor<16>(lt); lt += sxor<32>(lt); invl[u] = (lt > 0.f) ? 1.f / lt : 0.f; mu[u] = FIXED ? 0.f : ((m[u] == -INFINITY) ? 0.f : m[u]);
#pragma unroll
            for (int dt = 0; dt < 4; ++dt) O[u][dt] = (f32x4){0.f, 0.f, 0.f, 0.f}; }
        {
            u32x4 kr = ((VAR == 1) ? (u32x4){0u, 0u, 0u, 0u} : tile_ld(kcb, tl)), vr = ((VAR == 1) ? (u32x4){0u, 0u, 0u, 0u} : tile_ld(vcb, tl));
            if (VAR != 1) tile_st(lds + OFF_K, kr, tl); if (VAR != 1) tile_st(lds + OFF_V, vr, tl);
            __syncthreads();
            for (int kt = 0; kt <= ktmax; ++kt) {
                const int cur = kt & 1;
                if (kt + 1 <= ktmax) { kr = ((VAR == 1) ? (u32x4){0u, 0u, 0u, 0u} : tile_ld(kcb + (size_t)(kt + 1) * 4096, tl)); vr = ((VAR == 1) ? (u32x4){0u, 0u, 0u, 0u} : tile_ld(vcb + (size_t)(kt + 1) * 4096, tl)); }
                f32x4 Sv[3][4];
                if (VAR < 2) qk_tile<3>(lds + OFF_K + cur * TILE_B, qf, Sv, c16, g4, inic); else { _Pragma("unroll") for (int u = 0; u < 3; ++u) _Pragma("unroll") for (int rt = 0; rt < 4; ++rt) Sv[u][rt] = (f32x4){0.f, 0.f, 0.f, 0.f}; }
#pragma unroll
                for (int u = 0; u < 3; ++u) { const int t = c * 64 + qq[u];
#pragma unroll
                    for (int rt = 0; rt < 4; ++rt) {
#pragma unroll
                        for (int jj = 0; jj < 4; ++jj) { const int n = 64 * kt + 16 * rt + 4 * g4 + jj; const bool ok = (n < NCMP && 16 * n + 31 <= t);
                            Sv[u][rt][jj] = ok ? __builtin_amdgcn_exp2f(Sv[u][rt][jj] - mu[u]) * invl[u] : 0.f; }
                        const int j = 16 * kt + 4 * rt + g4;
                        const float mainv = Sv[u][rt][0] + Sv[u][rt][1] + Sv[u][rt][2] + 0.5f * Sv[u][rt][3], spill = 0.5f * Sv[u][rt][3];
                        atomicAdd(&imp[qq[u] * 64 + j], (int)(mainv * 16777216.f + 0.5f));
                        if (j + 1 < 64) atomicAdd(&imp[qq[u] * 64 + j + 1], (int)(spill * 16777216.f + 0.5f));
                    } }
                pv_tile<3, false>(lds + OFF_V + cur * TILE_B, Sv, O, c16, g4, Ol);
                if (kt + 1 <= ktmax) { if (VAR != 1) tile_st(lds + OFF_K + (cur ^ 1) * TILE_B, kr, tl); if (VAR != 1) tile_st(lds + OFF_V + (cur ^ 1) * TILE_B, vr, tl); }
                __syncthreads();
            }
        }
#pragma unroll
        for (int u = 0; u < 3; ++u) { const float gcmp = sigmoidf_(ldbf(P + ((size_t)b * S + c * 64 + qq[u]) * PP + 1536 + hq[u] * 3 + 0) + gate_b[hq[u] * 3 + 0]);
#pragma unroll
            for (int dt = 0; dt < 4; ++dt) *(f32x4*)(STAGE_BASE() + (u * 16) * STAGE_ROW + 16 * dt) = O[u][dt] * gcmp; }
        const bf16* ksb = KS + (size_t)bg2 * S * 64;
        const bf16* vsb = VST + (size_t)bg2 * S * 64;
        u32x4 kA = ((VAR == 1) ? (u32x4){0u, 0u, 0u, 0u} : tile_ld(ksb, tl)), vA = ((VAR == 1) ? (u32x4){0u, 0u, 0u, 0u} : tile_ld(vsb, tl)), kB, vB;
        {
#pragma unroll 1
            for (int i = 0; i < 8; ++i) {
                const int q = 8 * wv + i, j = lane;
                int v = imp[q * 64 + j];
                const bool valid = j <= c, forced = (j == 0) || (j == c) || (j == c - 1);
                v = forced ? 0x7fffffc0 : (v & ~63);
                v = valid ? (v | (63 - j)) : -1;
                int rank = 0;
#pragma unroll
                for (int jj = 0; jj < 64; ++jj) { const int o = __builtin_amdgcn_readlane(v, jj); rank += (o > v) ? 1 : 0; }
                const unsigned long long msk = __ballot(rank < 16 && v >= 0);
                if (lane == 0) { selw[2 * q] = (unsigned)msk; selw[2 * q + 1] = (unsigned)(msk >> 32); atomicOr(&anyw[0], (unsigned)msk); atomicOr(&anyw[1], (unsigned)(msk >> 32)); }
            }
        }
        __syncthreads();
        unsigned long long anym = (unsigned long long)anyw[0] | ((unsigned long long)anyw[1] << 32);
        unsigned long long selm[3];
#pragma unroll
        for (int u = 0; u < 3; ++u) selm[u] = (unsigned long long)selw[2 * qq[u]] | ((unsigned long long)selw[2 * qq[u] + 1] << 32);
        {
#pragma unroll
            for (int u = 0; u < 3; ++u) { m[u] = FIXED ? Ms : -INFINITY; l[u] = 0.f; Ol[u] = (f32x4){0.f, 0.f, 0.f, 0.f};
#pragma unroll
                for (int dt = 0; dt < 4; ++dt) O[u][dt] = (f32x4){0.f, 0.f, 0.f, 0.f}; }
            auto nextsel = [&](int jj) -> int { const unsigned long long rest = (jj < 63) ? (anym >> (jj + 1)) : 0ull; return rest ? (jj + 1 + __builtin_ctzll(rest)) : -1; };
            auto compute = [&](int jj, int cur, bool diag) {
                bool colok[3]; float inis[3];
#pragma unroll
                for (int u = 0; u < 3; ++u) { colok[u] = (selm[u] >> jj) & 1ull; inis[u] = FIXED ? (colok[u] ? -Ms : -INFINITY) : 0.f; }
                if (FIXED && VAR == 0 && !diag) { tile_fixed<3>(lds + OFF_K + cur * TILE_B, lds + OFF_V + cur * TILE_B, qf, O, l, c16, g4, inis); return; }
                f32x4 Sv[3][4];
                if (VAR < 2) qk_tile<3>(lds + OFF_K + cur * TILE_B, qf, Sv, c16, g4, inis); else { _Pragma("unroll") for (int u = 0; u < 3; ++u) _Pragma("unroll") for (int rt = 0; rt < 4; ++rt) Sv[u][rt] = (f32x4){0.f, 0.f, 0.f, 0.f}; }
                if (diag) {
#pragma unroll
                    for (int u = 0; u < 3; ++u) { int qo = qq[u] - 4 * g4; asm volatile("" : "+v"(qo));
#pragma unroll
                        for (int rt = 0; rt < 4; ++rt)
#pragma unroll
                            for (int e = 0; e < 4; ++e) { if (16 * rt + e > qo) Sv[u][rt][e] = -INFINITY; } }
                }
                if (VAR < 2) { softmax_update<3, true, FIXED, false>(Sv, m, l, O, true, colok);
                pv_tile<3, false>(lds + OFF_V + cur * TILE_B, Sv, O, c16, g4, Ol); }
            };
            int j = __builtin_ctzll(anym);
            if (VAR != 1) tile_st(lds + OFF_K, kA, tl); if (VAR != 1) tile_st(lds + OFF_V, vA, tl);
            __syncthreads();
            int jn = nextsel(j), jnn, cur = 0;
            if (jn >= 0) { kA = ((VAR == 1) ? (u32x4){0u, 0u, 0u, 0u} : tile_ld(ksb + (size_t)jn * 4096, tl)); vA = ((VAR == 1) ? (u32x4){0u, 0u, 0u, 0u} : tile_ld(vsb + (size_t)jn * 4096, tl)); }
            if (!FIXED) {
                for (;;) {
                    jnn = (jn >= 0) ? nextsel(jn) : -1;
                    if (jnn >= 0) { kB = tile_ld(ksb + (size_t)jnn * 4096, tl); vB = tile_ld(vsb + (size_t)jnn * 4096, tl); }
                    compute(j, cur, j == c);
                    if (jn >= 0) { tile_st(lds + OFF_K + (cur ^ 1) * TILE_B, kA, tl); tile_st(lds + OFF_V + (cur ^ 1) * TILE_B, vA, tl); }
                    __syncthreads();
                    if (jn < 0) break;
                    j = jn; jn = jnn; cur ^= 1;
                    jnn = (jn >= 0) ? nextsel(jn) : -1;
                    if (jnn >= 0) { kA = tile_ld(ksb + (size_t)jnn * 4096, tl); vA = tile_ld(vsb + (size_t)jnn * 4096, tl); }
                    compute(j, cur, j == c);
                    if (jn >= 0) { tile_st(lds + OFF_K + (cur ^ 1) * TILE_B, kB, tl); tile_st(lds + OFF_V + (cur ^ 1) * TILE_B, vB, tl); }
                    __syncthreads();
                    if (jn < 0) break;
                    j = jn; jn = jnn; cur ^= 1;
                }
            } else {
            while (jn >= 0) {
                jnn = nextsel(jn);
                if (jnn >= 0) { kB = ((VAR == 1) ? (u32x4){0u, 0u, 0u, 0u} : tile_ld(ksb + (size_t)jnn * 4096, tl)); vB = ((VAR == 1) ? (u32x4){0u, 0u, 0u, 0u} : tile_ld(vsb + (size_t)jnn * 4096, tl)); }
                compute(j, cur, false);
                if (VAR != 1) tile_st(lds + OFF_K + (cur ^ 1) * TILE_B, kA, tl); if (VAR != 1) tile_st(lds + OFF_V + (cur ^ 1) * TILE_B, vA, tl);
                __syncthreads();
                j = jn; jn = jnn; cur ^= 1;
                if (jn < 0) break;
                jnn = nextsel(jn);
                if (jnn >= 0) { kA = ((VAR == 1) ? (u32x4){0u, 0u, 0u, 0u} : tile_ld(ksb + (size_t)jnn * 4096, tl)); vA = ((VAR == 1) ? (u32x4){0u, 0u, 0u, 0u} : tile_ld(vsb + (size_t)jnn * 4096, tl)); }
                compute(j, cur, false);
                if (VAR != 1) tile_st(lds + OFF_K + (cur ^ 1) * TILE_B, kB, tl); if (VAR != 1) tile_st(lds + OFF_V + (cur ^ 1) * TILE_B, vB, tl);
                __syncthreads();
                j = jn; jn = jnn; cur ^= 1;
            }
            compute(j, cur, true);
            __syncthreads();
            }
#pragma unroll
            for (int u = 0; u < 3; ++u) { float lt = l[u]; lt += sxor<16>(lt); lt += sxor<32>(lt); const float sc = (lt > 0.f) ? sigmoidf_(ldbf(P + ((size_t)b * S + c * 64 + qq[u]) * PP + 1536 + hq[u] * 3 + 1) + gate_b[hq[u] * 3 + 1]) / lt : 0.f;
#pragma unroll
                for (int dt = 0; dt < 4; ++dt) { float* sp = STAGE_BASE() + (u * 16) * STAGE_ROW + 16 * dt; *(f32x4*)sp = *(f32x4*)sp + O[u][dt] * sc; } }
        }
        {
            const bf16* kwb = KW + (size_t)bg2 * S * 64;
            const bf16* vwb = VWT + (size_t)bg2 * S * 64;
#pragma unroll
            for (int u = 0; u < 3; ++u) { m[u] = FIXED ? Mw : -INFINITY; l[u] = 0.f; Ol[u] = (f32x4){0.f, 0.f, 0.f, 0.f};
#pragma unroll
                for (int dt = 0; dt < 4; ++dt) O[u][dt] = (f32x4){0.f, 0.f, 0.f, 0.f}; }
            const float iniw[3] = {FIXED ? -Mw : 0.f, FIXED ? -Mw : 0.f, FIXED ? -Mw : 0.f};
            const int j0 = (c >= 8) ? c - 8 : 0;
            u32x4 kr = ((VAR == 1) ? (u32x4){0u, 0u, 0u, 0u} : tile_ld(kwb + (size_t)j0 * 4096, tl)), vr = ((VAR == 1) ? (u32x4){0u, 0u, 0u, 0u} : tile_ld(vwb + (size_t)j0 * 4096, tl));
            if (VAR != 1) tile_st(lds + OFF_K, kr, tl); if (VAR != 1) tile_st(lds + OFF_V, vr, tl);
            __syncthreads();
            int cur = 0;
            auto wstep = [&](int j, bool fast) {
                if (j + 1 <= c) { kr = ((VAR == 1) ? (u32x4){0u, 0u, 0u, 0u} : tile_ld(kwb + (size_t)(j + 1) * 4096, tl)); vr = ((VAR == 1) ? (u32x4){0u, 0u, 0u, 0u} : tile_ld(vwb + (size_t)(j + 1) * 4096, tl)); }
                if (FIXED && VAR == 0 && fast) tile_fixed<3>(lds + OFF_K + cur * TILE_B, lds + OFF_V + cur * TILE_B, qf, O, l, c16, g4, iniw);
                else {
                    f32x4 Sv[3][4];
                    if (VAR < 2) qk_tile<3>(lds + OFF_K + cur * TILE_B, qf, Sv, c16, g4, iniw); else { _Pragma("unroll") for (int u = 0; u < 3; ++u) _Pragma("unroll") for (int rt = 0; rt < 4; ++rt) Sv[u][rt] = (f32x4){0.f, 0.f, 0.f, 0.f}; }
                    if (j == c || j == c - 8) {
#pragma unroll
                        for (int u = 0; u < 3; ++u) { int qo = qq[u] - 4 * g4; asm volatile("" : "+v"(qo));
#pragma unroll
                            for (int rt = 0; rt < 4; ++rt)
#pragma unroll
                                for (int jj = 0; jj < 4; ++jj) { const int kk = 16 * rt + jj; const bool ok = (j == c) ? (kk <= qo) : (kk > qo); if (!ok) Sv[u][rt][jj] = -INFINITY; } }
                    }
                    if (VAR < 2) { { const bool allok[3] = {true, true, true}; softmax_update<3, false, FIXED, false>(Sv, m, l, O, true, allok); }
                    pv_tile<3, false>(lds + OFF_V + cur * TILE_B, Sv, O, c16, g4, Ol); }
                }
                if (j + 1 <= c) { if (VAR != 1) tile_st(lds + OFF_K + (cur ^ 1) * TILE_B, kr, tl); if (VAR != 1) tile_st(lds + OFF_V + (cur ^ 1) * TILE_B, vr, tl); }
                __syncthreads();
                cur ^= 1;
            };
            if (!FIXED) { for (int j = j0; j <= c; ++j) wstep(j, false); }
            else {
                wstep(j0, false);
                for (int j = j0 + 1; j < c; ++j) wstep(j, true);
                if (c > j0) wstep(c, false);
            }
#pragma unroll
            for (int u = 0; u < 3; ++u) { float lt = l[u]; lt += sxor<16>(lt); lt += sxor<32>(lt); const float sc = (lt > 0.f) ? sigmoidf_(ldbf(P + ((size_t)b * S + c * 64 + qq[u]) * PP + 1536 + hq[u] * 3 + 2) + gate_b[hq[u] * 3 + 2]) / lt : 0.f;
#pragma unroll
                for (int dt = 0; dt < 4; ++dt) { float* sp = STAGE_BASE() + (u * 16) * STAGE_ROW + 16 * dt; *(f32x4*)sp = *(f32x4*)sp + O[u][dt] * sc; } }
        }
        __syncthreads();
        for (int i = tid; i < 384 * 8; i += NTHR) {
            const int d8 = i & 7, col = i >> 3, r = col >> 6, q = col & 63;
            const float* sp = stage + col * STAGE_ROW + d8 * 8;
            const f32x4 a = *(const f32x4*)sp, bb = *(const f32x4*)(sp + 4);
            u32x4 w; w.x = cvt_pk(a[0], a[1]); w.y = cvt_pk(a[2], a[3]); w.z = cvt_pk(bb[0], bb[1]); w.w = cvt_pk(bb[2], bb[3]);
            *(u32x4*)(AIN + ((size_t)b * S + c * 64 + q) * D + (g * 6 + r) * 64 + d8 * 8) = w;
        }
    }
}
}

#define XB_LAS __attribute__((address_space(3)))
#define XB_TMO      128
#define XB_XCNT(j)  (256  + 64 * (j))
#define XB_XSUB(j)  (1280 + 64 * (j))
#define XB_XGEN(j)  (2304 + 64 * (j))
#define XB_TOP      3328
#define XB_TOPGEN   3392
#define XCD_BAR_WORDS 3456
#define XB_SPIN_CAP (1u << 18)

__device__ __forceinline__ unsigned xb_ld(unsigned* p)              { return __hip_atomic_load(p, __ATOMIC_RELAXED, __HIP_MEMORY_SCOPE_AGENT); }
__device__ __forceinline__ unsigned xb_add(unsigned* p, unsigned v) { return __hip_atomic_fetch_add(p, v, __ATOMIC_RELAXED, __HIP_MEMORY_SCOPE_AGENT); }
__device__ __forceinline__ unsigned xb_xcc_id() { return (unsigned)__builtin_amdgcn_s_getreg((3 << 11) | 20) & 0xFu; }
#define XB_SPIN(cond, bar) do { unsigned _sp = 0; while (cond) { __builtin_amdgcn_s_sleep(1); \
    if ((++_sp & 255u) == 0u) { if (xb_ld(&(bar)[XB_TMO])) break; if (_sp > XB_SPIN_CAP) { atomicAdd(&(bar)[XB_TMO], 1u); break; } } } } while (0)

struct XcdBarrier {
    unsigned* bar; unsigned x;
    volatile XB_LAS unsigned* st;
};

__device__ __forceinline__ XcdBarrier xcd_barrier_post(unsigned* bar, volatile XB_LAS unsigned* st) {
    XcdBarrier b; b.bar = bar; b.x = xb_xcc_id(); b.st = st;
    if (threadIdx.x == 0) { const unsigned rank = xb_add(&bar[XB_XCNT(b.x)], 1u); st[2] = b.x; st[3] = rank; }
    return b;
}
__device__ __forceinline__ void xcd_barrier_complete(unsigned* bar, unsigned x, unsigned& nloc, unsigned& nx) {
    const unsigned G = gridDim.x * gridDim.y * gridDim.z;
    unsigned sum, cnt, mine, sp = 0u;
    for (;;) {
        sum = 0u; cnt = 0u; mine = 0u;
#pragma unroll
        for (unsigned j = 0; j < 16; ++j) { const unsigned c = xb_ld(&bar[XB_XCNT(j)]); sum += c; cnt += (c > 0u) ? 1u : 0u; mine = (j == x) ? c : mine; }
        if (sum == G) break;
        __builtin_amdgcn_s_sleep(1);
        if ((++sp & 255u) == 0u) { if (xb_ld(&bar[XB_TMO])) break; if (sp > XB_SPIN_CAP) { atomicAdd(&bar[XB_TMO], 1u); break; } }
    }
    nloc = mine > 0u ? mine : 1u; nx = cnt > 0u ? cnt : 1u;
}

__device__ __forceinline__ void xcd_barrier(const XcdBarrier& b, const bool leader_thread) {
    asm volatile("s_waitcnt vmcnt(0)" ::: "memory");
    __syncthreads();
    if (leader_thread) {
        unsigned* bar = b.bar;
        __builtin_amdgcn_s_waitcnt(0);
        unsigned nloc = b.st[0], nx = b.st[1];
        if (nloc == 0u) { xcd_barrier_complete(bar, b.x, nloc, nx); b.st[0] = nloc; b.st[1] = nx; }
        const unsigned old = xb_add(&bar[XB_XSUB(b.x)], 1u);
        const unsigned gen = old / nloc;
        if (old + 1u == (gen + 1u) * nloc) {
            __builtin_amdgcn_fence(__ATOMIC_RELEASE, "agent");
            asm volatile("s_waitcnt vmcnt(0)" ::: "memory");
            const unsigned og = xb_add(&bar[XB_TOP], 1u);
            const unsigned tg = og / nx;
            if (og + 1u == (tg + 1u) * nx) xb_add(&bar[XB_TOPGEN], 1u);
            else XB_SPIN(xb_ld(&bar[XB_TOPGEN]) == tg, bar);
            __builtin_amdgcn_fence(__ATOMIC_ACQUIRE, "agent");
            xb_add(&bar[XB_XGEN(b.x)], 1u);
            asm volatile("s_waitcnt vmcnt(0)" ::: "memory");
        } else {
            XB_SPIN(xb_ld(&bar[XB_XGEN(b.x)]) == gen, bar);
            __builtin_amdgcn_fence(__ATOMIC_ACQUIRE, "agent");
            asm volatile("s_waitcnt vmcnt(0)" ::: "memory");
        }
    }
    __syncthreads();
}

__device__ __forceinline__ void xcd_barrier_here(unsigned char* ws_ctl, volatile XB_LAS unsigned* st, const bool leader_thread) {
    XcdBarrier b; b.bar = (unsigned*)ws_ctl; b.x = xb_xcc_id(); b.st = st;
    xcd_barrier(b, leader_thread);
}

constexpr int N_PHASES = 18;
constexpr int LDS_BYTES = 163840;
static_assert((pg8::EpiTopK::LIST_OFF + 256 * 16) * 4 <= LDS_BYTES - 64 - 256, "top-k LDS map");
static_assert(att::LDS_NEED <= LDS_BYTES - 64 - 256, "attention LDS map (the last 64 B hold the grid barrier's set-up words)");
#define PG8_SP2_ON true

template <int LO, int HI>
__global__ void __launch_bounds__(NTHR) fwd_kernel(Params p) {
    cg::grid_group grid = cg::this_grid();
    extern __shared__ __attribute__((aligned(16))) unsigned char lds_raw[];
    float* smem = (float*)lds_raw;
    PG8_LAS unsigned char* ldsp = (PG8_LAS unsigned char*)lds_raw;
    constexpr int lo = LO, hi = HI;
    int ph = 0;
    const int wave_s__ = __builtin_amdgcn_readfirstlane(threadIdx.x >> 6);
    if (threadIdx.x < 30) ((const float* XB_LAS*)((XB_LAS unsigned char*)lds_raw + (LDS_BYTES - 64 - 256)))[threadIdx.x] = p.in[threadIdx.x];
    __syncthreads();
#define INP(i) ((const float*)lds_ptr_uniform((XB_LAS unsigned char*)lds_raw + (LDS_BYTES - 64 - 256) + 8 * (i)))
    if (hi - lo > 1) {
        if (threadIdx.x < 16) ((volatile XB_LAS unsigned*)((XB_LAS unsigned char*)lds_raw + (LDS_BYTES - 64)))[threadIdx.x] = 0u;
        __syncthreads();
        (void)xcd_barrier_post((unsigned*)(p.ws + WS_CTL), (volatile XB_LAS unsigned*)((XB_LAS unsigned char*)lds_raw + (LDS_BYTES - 64)));
    }
#define GRID_BAR() xcd_barrier_here(p.ws + WS_CTL, (volatile XB_LAS unsigned*)((XB_LAS unsigned char*)lds_raw + (LDS_BYTES - 64)), wave_s__ == 0 && lane_now() == 0)
#define PHASE_PROLOGUE \
    const int wv = wave_s__; \
    const int tid = wave_s__ * 64 + lane_now(); \
    const int lane = tid & 63; \
    const int gw = blockIdx.x * (NTHR / 64) + wv, ngw = gridDim.x * (NTHR / 64); \
    const int gtid = blockIdx.x * NTHR + tid, ngt = gridDim.x * NTHR; \
    const int G = gridDim.x; \
    const float* x = INP(0); const float* mem = INP(1); const int* positions = (const int*)INP(2); \
    const float* norm_mix = INP(3); const float* norm_ffn = INP(4); const float* norm_mem = INP(5); \
    const float* w_out = INP(6); const float* w_mem_kv = INP(7); const float* mem_q_gain = INP(8); const float* mem_k_gain = INP(9); \
    const float* a_w_in = INP(10); const float* a_conv_w = INP(11); const float* a_conv_b = INP(12); const float* a_gate_w = INP(13); \
    const float* a_gate_b = INP(14); const float* a_lambda = INP(15); const float* b_w_in = INP(16); const float* b_gate_b = INP(17); \
    const float* b_q_gain = INP(18); const float* kv_norm = INP(19); const float* w_kv_shared = INP(20); const float* k_gain_shared = INP(21); \
    const float* cmp_pos = INP(22); const float* cmp_w1 = INP(23); const float* cmp_b1 = INP(24); const float* cmp_w2 = INP(25); \
    const float* peer_wq = INP(26); const float* peer_subkeys = INP(27); const float* peer_u = INP(28); const float* peer_v = INP(29); \
    float* out = p.out; \
    unsigned char* ws = p.ws; asm volatile("" : "+s"(ws)); \
    float* RSTD = (float*)(ws + WS_RSTD); \
    float* rstd0 = RSTD, *rstd2 = RSTD + 2 * T, *rstdm = RSTD + 4 * T; \
    float* sumsq1 = (float*)(ws + WS_SSQ1), *sumsq3 = (float*)(ws + WS_SSQ3); \
    float* ROPE = (float*)(ws + WS_ROPE); float* BIAS2 = (float*)(ws + WS_BIAS2); bf16* WGF = (bf16*)(ws + WS_WGF); \
    bf16* WIN0 = (bf16*)(ws + WS_WIN0); bf16* WOUT = (bf16*)(ws + WS_WOUT); bf16* WFt = (bf16*)(ws + WS_WF); bf16* WKVB = (bf16*)(ws + WS_WKVB); \
    bf16* WMEM = (bf16*)(ws + WS_WMEM); bf16* WC1 = (bf16*)(ws + WS_WC1); bf16* MEMB = (bf16*)(ws + WS_MEMB); bf16* MEMKV = (bf16*)(ws + WS_MEMKV); \
    float* AGG = (float*)(ws + WS_SCAN); bf16* HID = (bf16*)(ws + WS_HID); bf16* KC = (bf16*)(ws + WS_KC); bf16* VC = (bf16*)(ws + WS_VC); \
    bf16* CA = (bf16*)(ws + WS_CA); int* E = (int*)(ws + WS_E); float* Gt = (float*)(ws + WS_GT); bf16* KS = (bf16*)(ws + WS_KS); bf16* KW = (bf16*)(ws + WS_KW); \
    bf16* XB = (bf16*)(ws + WS_XB); bf16* AIN = (bf16*)(ws + WS_AIN); bf16* P = (bf16*)(ws + WS_P); \
    unsigned char* UT8 = ws + WS_UT; unsigned char* VT8 = ws + WS_VT; float* PART = (float*)(ws + WS_P); float* sumsq2 = (float*)(ws + WS_SSQ2); \
    bf16* MEMK = (bf16*)(ws + WS_MEMK); bf16* MEMVT = (bf16*)(ws + WS_MEMVT); bf16* VST = (bf16*)(ws + WS_VST); bf16* VWT = (bf16*)(ws + WS_VWT); \
    (void)lane; (void)gw; (void)ngw; (void)gtid; (void)ngt; (void)G;

#define SLICE_COORDS() \
    int sl_xs, sl_r, sl_nr; { \
        const unsigned* ctlw = (const unsigned*)(ws + WS_CTL); \
        bool clean = (gridDim.x & 7) == 0; \
        _Pragma("unroll") for (int jx = 0; jx < 8; ++jx) clean = clean && (__hip_atomic_load(ctlw + XB_XCNT(jx), __ATOMIC_RELAXED, __HIP_MEMORY_SCOPE_AGENT) == gridDim.x / 8); \
        volatile XB_LAS unsigned* stw = (volatile XB_LAS unsigned*)((XB_LAS unsigned char*)lds_raw + (LDS_BYTES - 64)); \
        const int hx = (int)stw[2], hr = (int)stw[3]; \
        if (clean) { sl_xs = __builtin_amdgcn_readfirstlane(hx); sl_r = __builtin_amdgcn_readfirstlane(hr); sl_nr = gridDim.x / 8; } \
        else { sl_xs = blockIdx.x & 7; sl_r = blockIdx.x >> 3; sl_nr = (gridDim.x - sl_xs + 7) >> 3; } }
#ifndef PROBE_SUB
#define PROBE_SUB (-1)
#endif
#define SUBREP(id) for (int r2__ = 0; r2__ < ((PROBE_SUB == (id)) ? 2 : 1); ++r2__)
#ifndef PROBE_DUP
#define PROBE_DUP (-1)
#endif
#define PHASE_BEGIN if (ph >= lo && ph < hi) { for (int rep__ = (ph == PROBE_DUP ? 0 : 1); rep__ < 2; ++rep__) { PHASE_PROLOGUE
#define PHASE_END if (rep__ == 0) GRID_BAR(); } } ++ph; if (ph > lo && ph < hi) { if (ph == 1) grid.sync(); else GRID_BAR(); }

    PHASE_BEGIN
        SUBREP(1) for (int r = gw; r < T; r += ngw) row_to_bf16(x + (size_t)r * D, XB + (size_t)r * D, rstd0 + r, lane);
        for (int r = gw; r < NB * MEMN; r += ngw) row_to_bf16(mem + (size_t)r * D, MEMB + (size_t)r * D, rstdm + r, lane);
        for (int i = gtid; i < S * 8; i += ngt) {
            const int s = i >> 3, k = i & 7;
            const float freq = powf(500000.0f, -(float)k / 8.0f);
            const float ang = (float)positions[s] * freq;
            ROPE[s * 16 + k] = cosf(ang); ROPE[s * 16 + 8 + k] = sinf(ang);
        }
        SUBREP(2) {
            float* scr = smem + wv * (64 * 33);
            constexpr int I_IN0 = 16 * 56, I_OUT = 16 * 32, I_KV = 16 * 24, I_BIN = 16 * 34, I_MEM = 16 * 16, I_C1 = 32 * 8;
            constexpr int NIT = I_IN0 + 2 * I_OUT + I_KV + I_BIN + 2 * I_MEM + 2 * I_C1;
            for (int it = gw; it < NIT; it += ngw) {
                int r = it;
                if (r < I_IN0) { transpose_item(a_w_in, D, 1792, norm_mix, WIN0, 0, scr, r, lane); continue; } r -= I_IN0;
                if (r < I_OUT) { transpose_item(w_out, D, D, nullptr, WOUT, 0, scr, r, lane); continue; } r -= I_OUT;
                if (r < I_OUT) { transpose_item(w_out + (size_t)D * D, D, D, nullptr, WOUT + (size_t)D * D, 0, scr, r, lane); continue; } r -= I_OUT;
                if (r < I_KV) { transpose_item(w_kv_shared, D, 768, kv_norm, WKVB, 0, scr, r, lane); continue; } r -= I_KV;
                if (r < I_BIN) { transpose_item(b_w_in, D, 1060, norm_mix + D, WKVB, 768, scr, r, lane); continue; } r -= I_BIN;
                if (r < I_MEM) { transpose_item(w_mem_kv, D, 512, norm_mem, WMEM, 0, scr, r, lane); continue; } r -= I_MEM;
                if (r < I_MEM) { transpose_item(w_mem_kv + (size_t)D * 512, D, 512, norm_mem + D, WMEM, 512, scr, r, lane); continue; } r -= I_MEM;
                { const int j = r / I_C1, rq = r % I_C1, ks = rq >> 6;
                  transpose_item(cmp_w1 + ((size_t)j * 2048 + ks * 512) * 256, 512, 256, nullptr, WC1 + ((size_t)(j * 4 + ks) * 256) * 512, 0, scr, rq & 63, lane); }
            }
            for (int i = gtid; i < 220 * 1024 / 8; i += ngt) ((u32x4*)(WKVB + (size_t)1828 * 1024))[i] = (u32x4){0u, 0u, 0u, 0u};
        }
        SUBREP(3) for (int item = blockIdx.x; item < 2 * 16 * 2 * 4; item += gridDim.x) {
            const int nq = item & 3, kh = (item >> 2) & 1, hp = (item >> 3) & 15, l = item >> 7;
            const float* sk = peer_subkeys + (((size_t)l * 16 + hp) * 128 + nq * 32) * 128;
            __syncthreads();
            for (int i = tid; i < 32 * 128; i += NTHR) smem[i] = sk[i];
            __syncthreads();
            const int k = kh * 512 + tid;
            float* wst = smem + 4096 + wv * (64 * 36);
            const float* wqb = peer_wq + ((size_t)l * D + kh * 512 + wv * 64) * 2048 + hp * 128;
            float4 wr4[32];
#pragma unroll
            for (int c = 0; c < 4; ++c) {
                __builtin_amdgcn_wave_barrier();
#pragma unroll
                for (int j = 0; j < 8; ++j) { const float4 tq = *(const float4*)(wqb + (size_t)(8 * j + (lane >> 3)) * 2048 + 32 * c + 4 * (lane & 7));
                    *(float4*)(wst + (8 * j + (lane >> 3)) * 36 + 4 * (lane & 7)) = tq; }
                __builtin_amdgcn_wave_barrier();
#pragma unroll
                for (int i = 0; i < 8; ++i) wr4[8 * c + i] = *(const float4*)(wst + lane * 36 + 4 * i);
                __builtin_amdgcn_sched_barrier(0);
            }
            const float gk = norm_ffn[l * D + k];
#pragma unroll 1
            for (int n = 0; n < 32; ++n) {
                const float4* sr = (const float4*)(smem + n * 128);
                float acc = 0.f;
#pragma unroll
                for (int i = 0; i < 32; ++i) { const float4 s4 = sr[i]; acc += wr4[i].x * s4.x + wr4[i].y * s4.y + wr4[i].z * s4.z + wr4[i].w * s4.w;
                    if ((i & 7) == 7) __builtin_amdgcn_sched_barrier(0); }
                WFt[((size_t)l * 2048 + hp * 128 + nq * 32 + n) * 1024 + k] = (bf16)f2bf(acc * gk);
            }
        }
        for (int i = gtid; i < NBLK * 2 * 8 * 64; i += ngt) {
            const int ln = i & 63, ct = (i >> 6) & 7, ks = (i >> 9) & 1, n = i >> 10;
            const int col = 16 * ct + (ln & 15), gsel = col >> 6, e = col & 63;
            const float* wp = a_gate_w + ((size_t)(gsel * NBLK + n) * 64 + 32 * ks + 8 * (ln >> 4)) * 64 + e;
            const float nl2 = -1.4426950408889634f;
            u32x4 w; w.x = pk2(wp[0] * nl2, wp[64] * nl2); w.y = pk2(wp[128] * nl2, wp[192] * nl2); w.z = pk2(wp[256] * nl2, wp[320] * nl2); w.w = pk2(wp[384] * nl2, wp[448] * nl2);
            *(u32x4*)(WGF + (size_t)i * 8) = w;
        }
        for (int i = gtid; i < LRUW; i += ngt) {
            float* SGC = (float*)(ws + WS_SGC);
            const float lam = a_lambda[i];
            SGC[i] = -1.4426950408889634f * a_gate_b[i]; SGC[LRUW + i] = -1.4426950408889634f * a_gate_b[LRUW + i];
            SGC[2 * LRUW + i] = -8.0f * 1.4426950408889634f * ((-lam > 20.f) ? -lam : log1pf(expf(-lam)));
        }
        for (int i = gtid; i < 2 * 32 * 256; i += ngt) {
            const int c = i & 255, kc = (i >> 8) & 31, j = i >> 13;
            float acc = 0.f;
#pragma unroll 8
            for (int k = kc * 64; k < kc * 64 + 64; ++k) acc = fmaf(cmp_pos[j * 2048 + k], cmp_w1[((size_t)j * 2048 + k) * 256 + c], acc);
            BIAS2[1024 + i] = acc;
        }
        SUBREP(4) for (int l = 0; l < 2; ++l) {
            const int kk = (int)(((size_t)gtid * 16) & 1023);
            float4 gq[4];
#pragma unroll
            for (int q = 0; q < 4; ++q) gq[q] = *(const float4*)(norm_ffn + l * D + kk + 4 * q);
            const size_t lbase = (size_t)l * 16384 * 1024;
            for (size_t i = gtid; i < (size_t)16384 * 64; i += 2 * (size_t)ngt) {
                float4 a[2][4], v[2][4];
#pragma unroll
                for (int h = 0; h < 2; ++h) { const size_t e16 = lbase + (i + (size_t)h * ngt) * 16;
                    if (i + (size_t)h * ngt < (size_t)16384 * 64) {
#pragma unroll
                        for (int q = 0; q < 4; ++q) { a[h][q] = *(const float4*)(peer_u + e16 + 4 * q); v[h][q] = *(const float4*)(peer_v + e16 + 4 * q); } } }
#pragma unroll
                for (int h = 0; h < 2; ++h) { const size_t e16 = lbase + (i + (size_t)h * ngt) * 16;
                    if (i + (size_t)h * ngt < (size_t)16384 * 64) {
                        unsigned wu[4], wv4[4];
#pragma unroll
                        for (int q = 0; q < 4; ++q) { const float4 g = gq[q];
                            int w = 0; w = __builtin_amdgcn_cvt_pk_fp8_f32(a[h][q].x * g.x * 64.f, a[h][q].y * g.y * 64.f, w, false); w = __builtin_amdgcn_cvt_pk_fp8_f32(a[h][q].z * g.z * 64.f, a[h][q].w * g.w * 64.f, w, true); wu[q] = (unsigned)w;
                            int y = 0; y = __builtin_amdgcn_cvt_pk_fp8_f32(v[h][q].x * 8.f, v[h][q].y * 8.f, y, false); y = __builtin_amdgcn_cvt_pk_fp8_f32(v[h][q].z * 8.f, v[h][q].w * 8.f, y, true); wv4[q] = (unsigned)y; }
                        const size_t rel = e16 - lbase, dsto = lbase + ((rel & 1023) >> 7) * (size_t)(16384 * 128) + (rel >> 10) * 128 + (rel & 127);
                        *(u32x4*)(UT8 + dsto) = (u32x4){wu[0], wu[1], wu[2], wu[3]};
                        *(u32x4*)(VT8 + dsto) = (u32x4){wv4[0], wv4[1], wv4[2], wv4[3]}; } }
            }
        }
    PHASE_END

    PHASE_BEGIN
        { pg8::Gemm g{XB, WIN0, T, 1792, D}; pg8::StaticOrder So; So.init(T, 1792, G, (int)blockIdx.x);
          pg8::EpiRowScaleBf16 Ep{P, PP, rstd0, nullptr};
          pg8::gemm_phase<pg8::EpiRowScaleBf16, pg8::StaticOrder, true, PG8_SP2_ON>(ldsp, g, So, Ep, tid); }
        { pg8::Gemm g{MEMB, WMEM, NB * MEMN, 1024, D}; pg8::StaticOrder So; So.init(NB * MEMN, 1024, G, (int)((blockIdx.x + G / 2) % G));
          pg8::EpiRowScaleBf16 Ep{MEMKV, 1024, rstdm, nullptr};
          pg8::gemm_phase<pg8::EpiRowScaleBf16, pg8::StaticOrder, true, PG8_SP2_ON>(ldsp, g, So, Ep, tid); }
    PHASE_END

    PHASE_BEGIN
        scan_pass<false>(P, a_conv_w, a_conv_b, WGF, (const float*)(ws + WS_SGC), AGG, AIN, lds_raw + wv * 18864, tid);
        for (int item = gw; item < 2 * 4 * 256; item += ngw) {
            const int h = item & 3, grp = (item >> 2) & 255, l = item >> 10, row = grp * 8 + (lane >> 3), c8 = lane & 7, b = row >> 8, mm = row & 255;
            const u32x4 w = *(const u32x4*)(MEMKV + (size_t)row * 1024 + l * 512 + h * 64 + 8 * c8);
            const float4 ga = *(const float4*)(mem_k_gain + l * 64 + 8 * c8), gb = *(const float4*)(mem_k_gain + l * 64 + 8 * c8 + 4);
            float v[8] = {bflo(w.x), bfhi(w.x), bflo(w.y), bfhi(w.y), bflo(w.z), bfhi(w.z), bflo(w.w), bfhi(w.w)};
            float ss = 0.f;
#pragma unroll
            for (int i = 0; i < 8; ++i) ss += v[i] * v[i];
            ss += sxor<1>(ss); ss += sxor<2>(ss); ss += sxor<4>(ss);
            const float rs = rsqrtf(ss * (1.f / 64.f) + EPS);
            u32x4 o; o.x = pk2(v[0] * rs * ga.x, v[1] * rs * ga.y); o.y = pk2(v[2] * rs * ga.z, v[3] * rs * ga.w); o.z = pk2(v[4] * rs * gb.x, v[5] * rs * gb.y); o.w = pk2(v[6] * rs * gb.z, v[7] * rs * gb.w);
            *(u32x4*)(MEMK + ((size_t)((l * NB + b) * 4 + h) * 256 + mm) * 64 + 8 * c8) = o;
        }
        {
            bf16* tl = (bf16*)(lds_raw + wv * 18864);
            for (int item = gw; item < 2 * NB * 4 * 4; item += ngw) {
                const int kt = item & 3, h = (item >> 2) & 3, b = (item >> 4) & 7, l = item >> 7;
                const bf16* src = MEMKV + ((size_t)b * 256 + 64 * kt) * 1024 + l * 512 + 256 + h * 64;
#pragma unroll
                for (int i = 0; i < 8; ++i) {
                    const int key = 8 * i + (lane >> 3), c8 = lane & 7;
                    const u32x4 v = *(const u32x4*)(src + (size_t)key * 1024 + 8 * c8);
                    bf16* tp = tl + (8 * c8) * 72 + key;
                    tp[0 * 72] = (bf16)(v.x & 0xffffu); tp[1 * 72] = (bf16)(v.x >> 16); tp[2 * 72] = (bf16)(v.y & 0xffffu); tp[3 * 72] = (bf16)(v.y >> 16);
                    tp[4 * 72] = (bf16)(v.z & 0xffffu); tp[5 * 72] = (bf16)(v.z >> 16); tp[6 * 72] = (bf16)(v.w & 0xffffu); tp[7 * 72] = (bf16)(v.w >> 16);
                }
                __builtin_amdgcn_s_waitcnt(0); __builtin_amdgcn_wave_barrier();
                bf16* dst = MEMVT + ((size_t)(((l * NB + b) * 4 + h) * 4 + kt)) * 4096;
#pragma unroll
                for (int jq = 0; jq < 8; ++jq) {
                    const int d = 8 * jq + (lane >> 3), c8 = lane & 7;
                    *(u32x4*)(dst + d * 64 + 8 * c8) = *(const u32x4*)(tl + d * 72 + 8 * c8);
                }
                __builtin_amdgcn_s_waitcnt(0); __builtin_amdgcn_wave_barrier();
            }
        }
    PHASE_END

    PHASE_BEGIN
        scan_pass<true>(P, a_conv_w, a_conv_b, WGF, (const float*)(ws + WS_SGC), AGG, AIN, lds_raw + wv * 18864, tid);
        __syncthreads();
        {
            const float Mm = __builtin_bit_cast(float, __builtin_amdgcn_readfirstlane(__builtin_bit_cast(int, att::SBOUND * wave_max(fabsf(mem_q_gain[lane])) * wave_max(fabsf(mem_k_gain[lane])))));
            if (Mm <= 40.f) att::mem_attention_mfma<true>(P, 1536, MEMK, MEMVT, mem_q_gain, AIN, lds_raw, tid, Mm);
            else att::mem_attention_mfma<false>(P, 1536, MEMK, MEMVT, mem_q_gain, AIN, lds_raw, tid, 0.f);
        }
    PHASE_END

    PHASE_BEGIN
        { pg8::Gemm g{AIN, WOUT, T, D, D}; pg8::StaticOrder So; So.init(T, D, G, (int)blockIdx.x);
          pg8::EpiResidual Ep{XB, sumsq1};
          pg8::gemm_phase<pg8::EpiResidual, pg8::StaticOrder, true, PG8_SP2_ON>(ldsp, g, So, Ep, tid); }
    PHASE_END

    PHASE_BEGIN
        for (int tile = blockIdx.x; tile < (T / 256) * 8; tile += gridDim.x) {
            int pm, pn;
            if ((gridDim.x & 255) == 0) { const int rr = tile / (int)gridDim.x, bb = tile % (int)gridDim.x, xq = bb & 7, sl = bb >> 3, per = (int)gridDim.x >> 6;
                pm = (rr * 8 + xq) * per + (sl >> 3); pn = sl & 7; }
            else { pm = tile >> 3; pn = tile & 7; }
            const int tidt = wave_s__ * 64 + lane_now();
            pg8::Gemm g{XB, WFt, T, 2048, D}; pg8::OneUnit So; So.u.pm = pm; So.u.pn = pn;
            pg8::EpiTopK Ep{sumsq1, E, Gt};
            pg8::gemm_phase<pg8::EpiTopK, pg8::OneUnit, false, PG8_SP2_ON>(ldsp, g, So, Ep, tidt);
        }
    PHASE_END

    PHASE_BEGIN
        SLICE_COORDS(); peer_u_partial(XB, UT8, E, PART, lds_raw + wv * (G_SLOTS * 1024), tid, sl_xs, sl_r, sl_nr);
    PHASE_END
    PHASE_BEGIN
        peer_act(PART, sumsq1, Gt, tid);
    PHASE_END
    PHASE_BEGIN
        SLICE_COORDS(); peer_v_slice(nullptr, XB, VT8, E, Gt, sumsq2, rep__ == 0, lds_raw + wv * (G_SLOTS * 1024), tid, sl_xs, sl_r, sl_nr);
    PHASE_END

    PHASE_BEGIN
        for (int i = gtid; i < 512; i += ngt) {
            const int j = i >> 8, c = i & 255;
            float acc = cmp_b1[i];
            for (int kc = 0; kc < 32; ++kc) acc += BIAS2[1024 + (j * 32 + kc) * 256 + c];
            BIAS2[i] = acc;
        }
        { pg8::Gemm g{XB, WKVB, T, 2048, D}; pg8::StaticOrder So; So.init(T, 2048, G, (int)blockIdx.x);
          pg8::EpiRowScaleBf16 Ep{P, PP, nullptr, sumsq2};
          pg8::gemm_phase<pg8::EpiRowScaleBf16, pg8::StaticOrder, true, PG8_SP2_ON>(ldsp, g, So, Ep, tid); }
    PHASE_END

    PHASE_BEGIN
        if (blockIdx.x < 128) {
            const int j = blockIdx.x >> 6, ks = (blockIdx.x >> 4) & 3, pm = blockIdx.x & 15;
            bf16* CAq = CA + (size_t)(j * 4 + ks) * 4096 * 512;
            for (int i0 = tid; i0 < 256 * 64; i0 += 8 * NTHR) {
                u32x4 v[8];
#pragma unroll
                for (int q = 0; q < 8; ++q) { const int i = i0 + q * NTHR;
                    const int d8 = i & 7, l8 = (i >> 3) & 7, r = 256 * pm + (i >> 6);
                    v[q] = (u32x4){0u, 0u, 0u, 0u};
                    if (r < 4080) { const int g = r & 1, bn = r >> 1, b = bn / NCMP, n = bn % NCMP;
                        v[q] = *(const u32x4*)(P + (size_t)(b * S + 16 * n + 8 * ks + l8) * PP + j * 128 + g * 64 + d8 * 8); } }
#pragma unroll
                for (int q = 0; q < 8; ++q) { const int i = i0 + q * NTHR;
                    const int d8 = i & 7, l8 = (i >> 3) & 7, r = 256 * pm + (i >> 6);
                    *(u32x4*)(CAq + (size_t)r * 512 + l8 * 64 + d8 * 8) = v[q]; }
            }
            __syncthreads();
            pg8::Gemm g{CAq, WC1 + (size_t)(j * 4 + ks) * 256 * 512, 4096, 256, 512}; pg8::OneUnit So; So.u.pm = pm; So.u.pn = 0;
            pg8::EpiPartF32 Ep{(float*)(ws + WS_HP) + (size_t)(j * 4 + ks) * 4096 * 256, 256};
            pg8::gemm_phase<pg8::EpiPartF32, pg8::OneUnit, false, PG8_SP2_ON>(ldsp, g, So, Ep, tid);
        } else {
            const int b0 = 128;
            const int gw2 = (blockIdx.x - b0) * (NTHR / 64) + wv, ngw2 = (G - b0) * (NTHR / 64);
            for (int item0 = gw2; item0 < (T / 8) * 4; item0 += 2 * ngw2) {
                u32x4 wq[2];
#pragma unroll
                for (int hh = 0; hh < 2; ++hh) { const int item = item0 + hh * ngw2;
                    if (item < (T / 8) * 4) { const int g = item & 1, br = 1 + ((item >> 1) & 1), row = (item >> 2) * 8 + (lane >> 3), c8 = lane & 7;
                        wq[hh] = *(const u32x4*)(P + (size_t)row * PP + br * 256 + g * 64 + 8 * c8); } }
#pragma unroll
                for (int hh = 0; hh < 2; ++hh) { const int item = item0 + hh * ngw2;
                  if (item < (T / 8) * 4) {
                const int g = item & 1, br = 1 + ((item >> 1) & 1), row = (item >> 2) * 8 + (lane >> 3), c8 = lane & 7;
                const int b = row / S, s = row % S;
                const u32x4 w = wq[hh];
                const float4 ga = *(const float4*)(k_gain_shared + br * 64 + 8 * c8), gb = *(const float4*)(k_gain_shared + br * 64 + 8 * c8 + 4);
                const float4 csa = *(const float4*)(ROPE + s * 16), csb = *(const float4*)(ROPE + s * 16 + 4), sna = *(const float4*)(ROPE + s * 16 + 8), snb = *(const float4*)(ROPE + s * 16 + 12);
                float v[8] = {bflo(w.x), bfhi(w.x), bflo(w.y), bfhi(w.y), bflo(w.z), bfhi(w.z), bflo(w.w), bfhi(w.w)};
                float ss = 0.f;
#pragma unroll
                for (int i = 0; i < 8; ++i) ss += v[i] * v[i];
                ss += sxor<1>(ss); ss += sxor<2>(ss); ss += sxor<4>(ss);
                const float rs = rsqrtf(ss * (1.f / 64.f) + EPS);
                const float gg[8] = {ga.x, ga.y, ga.z, ga.w, gb.x, gb.y, gb.z, gb.w};
                const float cs[8] = {csa.x, csa.y, csa.z, csa.w, csb.x, csb.y, csb.z, csb.w}, sn[8] = {sna.x, sna.y, sna.z, sna.w, snb.x, snb.y, snb.z, snb.w};
#pragma unroll
                for (int i = 0; i < 8; ++i) {
                    v[i] = v[i] * rs * gg[i];
                    const float partner = sxor<1>(v[i]);
                    if (c8 == 0) v[i] = v[i] * cs[i] - partner * sn[i];
                    else if (c8 == 1) v[i] = v[i] * cs[i] + partner * sn[i];
                }
                bf16* dst = (br == 1) ? KS : KW;
                u32x4 o; o.x = pk2(v[0], v[1]); o.y = pk2(v[2], v[3]); o.z = pk2(v[4], v[5]); o.w = pk2(v[6], v[7]);
                *(u32x4*)(dst + ((size_t)(b * 2 + g) * S + s) * 64 + 8 * c8) = o;
                  } }
            }
            {
                bf16* tl = (bf16*)(lds_raw + wv * 9216);
                for (int item = gw2; item < 2 * NB * 2 * 64; item += ngw2) {
                    const int blk = item & 63, g = (item >> 6) & 1, b = (item >> 7) & 7, br = 1 + (item >> 10);
                    const bf16* src = P + ((size_t)b * S + 64 * blk) * PP + br * 256 + 128 + g * 64;
#pragma unroll
                    for (int i = 0; i < 8; ++i) {
                        const int key = 8 * i + (lane >> 3), c8 = lane & 7;
                        const u32x4 v = *(const u32x4*)(src + (size_t)key * PP + 8 * c8);
                        bf16* tp = tl + (8 * c8) * 72 + key;
                        tp[0 * 72] = (bf16)(v.x & 0xffffu); tp[1 * 72] = (bf16)(v.x >> 16); tp[2 * 72] = (bf16)(v.y & 0xffffu); tp[3 * 72] = (bf16)(v.y >> 16);
                        tp[4 * 72] = (bf16)(v.z & 0xffffu); tp[5 * 72] = (bf16)(v.z >> 16); tp[6 * 72] = (bf16)(v.w & 0xffffu); tp[7 * 72] = (bf16)(v.w >> 16);
                    }
                    __builtin_amdgcn_s_waitcnt(0); __builtin_amdgcn_wave_barrier();
                    bf16* dst = ((br == 1) ? VST : VWT) + ((size_t)((b * 2 + g) * 64 + blk)) * 4096;
#pragma unroll
                    for (int jq = 0; jq < 8; ++jq) {
                        const int d = 8 * jq + (lane >> 3), c8 = lane & 7;
                        *(u32x4*)(dst + d * 64 + 8 * c8) = *(const u32x4*)(tl + d * 72 + 8 * c8);
                    }
                    __builtin_amdgcn_s_waitcnt(0); __builtin_amdgcn_wave_barrier();
                }
            }
        }
    PHASE_END

    PHASE_BEGIN
        for (int i = gtid; i < NB * 2 * 64; i += ngt) VC[((size_t)((i >> 6) * 4 + 3)) * 4096 + (i & 63) * 64 + 63] = (bf16)0;
        const int jb = (int)blockIdx.x & 1;
        for (int i0 = tid; i0 < 256 * 16; i0 += 8 * NTHR) {
            float4 v[8];
#pragma unroll
            for (int q = 0; q < 8; ++q) { const int i = i0 + q * NTHR, n4 = i & 15, cc = (i >> 4) & 255;
                v[q] = *(const float4*)(cmp_w2 + ((size_t)jb * 256 + cc) * 64 + 4 * n4); }
#pragma unroll
            for (int q = 0; q < 8; ++q) { const int i = i0 + q * NTHR, n4 = i & 15, cc = (i >> 4) & 255;
                float* d = smem + (((cc >> 2)) * 64 + 4 * n4) * 4 + (cc & 3);
                d[0] = v[q].x; d[4] = v[q].y; d[8] = v[q].z; d[12] = v[q].w; }
        }
        __syncthreads();
        for (int it = ((int)blockIdx.x >> 1) * (NTHR / 64) + wv; it < 4080; it += ((int)gridDim.x >> 1) * (NTHR / 64)) {
            const int j = jb, g = it & 1, bn = it >> 1, b = bn / NCMP, n = bn % NCMP;
            float* hb = smem + 32768 + wv * 256;
            { const float* hpp = (const float*)(ws + WS_HP) + ((size_t)(j * 4) * 4096 + it) * 256 + 4 * lane;
              const float4 p0 = *(const float4*)hpp, p1 = *(const float4*)(hpp + (size_t)4096 * 256), p2 = *(const float4*)(hpp + (size_t)2 * 4096 * 256), p3 = *(const float4*)(hpp + (size_t)3 * 4096 * 256);
              const float4 bb = *(const float4*)(BIAS2 + j * 256 + 4 * lane);
              __builtin_amdgcn_wave_barrier();
              *(float4*)(hb + 4 * lane) = make_float4(gelu_tanh(((p0.x + p1.x) + (p2.x + p3.x)) + bb.x), gelu_tanh(((p0.y + p1.y) + (p2.y + p3.y)) + bb.y),
                                                      gelu_tanh(((p0.z + p1.z) + (p2.z + p3.z)) + bb.z), gelu_tanh(((p0.w + p1.w) + (p2.w + p3.w)) + bb.w));
              __builtin_amdgcn_wave_barrier(); }
            const float* wj = smem + lane * 4;
            float a0 = 0.f, a1 = 0.f, a2 = 0.f, a3 = 0.f;
#pragma unroll 8
            for (int c4 = 0; c4 < 64; ++c4) { const float4 h4 = *(const float4*)(hb + 4 * c4), w4 = *(const float4*)(wj + c4 * 256);
                a0 = fmaf(h4.x, w4.x, a0); a1 = fmaf(h4.y, w4.y, a1); a2 = fmaf(h4.z, w4.z, a2); a3 = fmaf(h4.w, w4.w, a3); }
            const float acc = (a0 + a1) + (a2 + a3);
            if (j == 0) {
                const float ss = wave_sum(acc * acc);
                float v = acc * rsqrtf(ss * (1.f / 64.f) + EPS) * k_gain_shared[0 * 64 + lane];
                const float partner = sxor<8>(v);
                const int sp = 16 * n + 31;
                if (lane < 16) { const int i = lane & 7; const float cs = ROPE[sp * 16 + i], sn = ROPE[sp * 16 + 8 + i];
                    v = (lane < 8) ? (v * cs - partner * sn) : (v * cs + partner * sn); }
                KC[((size_t)(b * 2 + g) * 256 + n) * 64 + lane] = (bf16)f2bf(v);
            } else {
                VC[((size_t)((b * 2 + g) * 4 + (n >> 6))) * 4096 + lane * 64 + (n & 63)] = (bf16)f2bf(acc);
            }
        }
    PHASE_END

    PHASE_BEGIN
        {
#define UNIF(x) __builtin_bit_cast(float, __builtin_amdgcn_readfirstlane(__builtin_bit_cast(int, (x))))
            const float Gq = wave_max(fabsf(b_q_gain[lane]));
            const float Mc = UNIF(att::SBOUND * Gq * wave_max(fabsf(k_gain_shared[lane]))), Ms = UNIF(att::SBOUND * Gq * wave_max(fabsf(k_gain_shared[64 + lane]))), Mw = UNIF(att::SBOUND * Gq * wave_max(fabsf(k_gain_shared[128 + lane])));
#ifdef PROBE_VAR
            if (rep__ == 0) att::nsa_attention_mfma<true, PROBE_VAR>(P, KC, VC, KS, VST, KW, VWT, ROPE, b_q_gain, b_gate_b, AIN, lds_raw, tid, Mc, Ms, Mw); else
#endif
            if (fmaxf(Mc, fmaxf(Ms, Mw)) <= 40.f) att::nsa_attention_mfma<true>(P, KC, VC, KS, VST, KW, VWT, ROPE, b_q_gain, b_gate_b, AIN, lds_raw, tid, Mc, Ms, Mw);
            else att::nsa_attention_mfma<false>(P, KC, VC, KS, VST, KW, VWT, ROPE, b_q_gain, b_gate_b, AIN, lds_raw, tid, 0.f, 0.f, 0.f);
            const float Mm = UNIF(att::SBOUND * wave_max(fabsf(mem_q_gain[64 + lane])) * wave_max(fabsf(mem_k_gain[64 + lane])));
            SUBREP(5) {
                if (Mm <= 40.f) att::mem_attention_mfma<true>(P, 1572, MEMK + (size_t)NB * 4 * 256 * 64, MEMVT + (size_t)NB * 4 * 256 * 64, mem_q_gain + 64, AIN, lds_raw, tid, Mm);
                else att::mem_attention_mfma<false>(P, 1572, MEMK + (size_t)NB * 4 * 256 * 64, MEMVT + (size_t)NB * 4 * 256 * 64, mem_q_gain + 64, AIN, lds_raw, tid, 0.f);
            }
        }
    PHASE_END

    PHASE_BEGIN
        { pg8::Gemm g{AIN, WOUT + (size_t)D * D, T, D, D}; pg8::StaticOrder So; So.init(T, D, G, (int)blockIdx.x);
          pg8::EpiResidual Ep{XB, sumsq3};
          pg8::gemm_phase<pg8::EpiResidual, pg8::StaticOrder, true, PG8_SP2_ON>(ldsp, g, So, Ep, tid); }
    PHASE_END

    PHASE_BEGIN
        for (int tile = blockIdx.x; tile < (T / 256) * 8; tile += gridDim.x) {
            int pm, pn;
            if ((gridDim.x & 255) == 0) { const int rr = tile / (int)gridDim.x, bb = tile % (int)gridDim.x, xq = bb & 7, sl = bb >> 3, per = (int)gridDim.x >> 6;
                pm = (rr * 8 + xq) * per + (sl >> 3); pn = sl & 7; }
            else { pm = tile >> 3; pn = tile & 7; }
            const int tidt = wave_s__ * 64 + lane_now();
            pg8::Gemm g{XB, WFt + (size_t)2048 * 1024, T, 2048, D}; pg8::OneUnit So; So.u.pm = pm; So.u.pn = pn;
            pg8::EpiTopK Ep{sumsq3, E, Gt};
            pg8::gemm_phase<pg8::EpiTopK, pg8::OneUnit, false, PG8_SP2_ON>(ldsp, g, So, Ep, tidt);
        }
    PHASE_END

    PHASE_BEGIN
        SLICE_COORDS(); peer_u_partial(XB, UT8 + (size_t)16384 * 1024, E, PART, lds_raw + wv * (G_SLOTS * 1024), tid, sl_xs, sl_r, sl_nr);
    PHASE_END
    PHASE_BEGIN
        peer_act(PART, sumsq3, Gt, tid);
    PHASE_END
    PHASE_BEGIN
        SLICE_COORDS(); peer_v_slice(out, XB, VT8 + (size_t)16384 * 1024, E, Gt, nullptr, rep__ == 0, lds_raw + wv * (G_SLOTS * 1024), tid, sl_xs, sl_r, sl_nr);
    PHASE_END
#undef PHASE_BEGIN
#undef PHASE_END
}

#ifndef N_LAUNCH_MODE
#define N_LAUNCH_MODE 1
#endif
template <int PH>
static void launch_phases(const Params& p, int grid, hipStream_t stream) {
    if constexpr (PH < N_PHASES) {
        static bool attr_set = false;
        if (!attr_set) { (void)hipFuncSetAttribute((const void*)fwd_kernel<PH, PH + 1>, hipFuncAttributeMaxDynamicSharedMemorySize, LDS_BYTES); attr_set = true; }
        hipLaunchKernelGGL((fwd_kernel<PH, PH + 1>), dim3(grid), dim3(NTHR), LDS_BYTES, stream, p);
        launch_phases<PH + 1>(p, grid, stream);
    }
}

extern "C" void kernel_launch(void* const* d_in, const int* in_sizes, int n_in, void* d_out, int out_size, void* d_ws, size_t ws_size, hipStream_t stream) {
    static int grid = 0;
    if (grid == 0) {
        if (n_in != 30 || out_size != T * D || ws_size < WS_END) { fprintf(stderr, "kernel_launch: unexpected shapes n_in %d out %d ws %zu\n", n_in, out_size, ws_size); grid = -1; return; }
        int dev = 0, cus = 0, per_cu = 0;
        (void)hipGetDevice(&dev);
        (void)hipDeviceGetAttribute(&cus, hipDeviceAttributeMultiprocessorCount, dev);
#if N_LAUNCH_MODE == 1
        if (hipFuncSetAttribute((const void*)fwd_kernel<0, N_PHASES>, hipFuncAttributeMaxDynamicSharedMemorySize, LDS_BYTES) != hipSuccess) { fprintf(stderr, "kernel_launch: hipFuncSetAttribute failed\n"); grid = -1; return; }
        if (hipOccupancyMaxActiveBlocksPerMultiprocessor(&per_cu, (const void*)fwd_kernel<0, N_PHASES>, NTHR, LDS_BYTES) != hipSuccess || per_cu < 1) { fprintf(stderr, "kernel_launch: occupancy query says %d\n", per_cu); grid = -1; return; }
        if (cus < 160) { fprintf(stderr, "kernel_launch: this kernel needs at least 160 CUs (got %d)\n", cus); grid = -1; return; }
        grid = cus;
#else
        grid = cus > 0 ? cus : 256;
#endif
    }
    if (grid < 0) return;
    Params p{};
    for (int i = 0; i < 30; ++i) p.in[i] = (const float*)d_in[i];
    p.out = (float*)d_out; p.ws = (unsigned char*)d_ws; p.ph_lo = 0; p.ph_hi = N_PHASES;
#if N_LAUNCH_MODE == 1
    if (hipMemsetAsync((char*)d_ws + WS_CTL, 0, 65536, stream) != hipSuccess) { fprintf(stderr, "kernel_launch: hipMemsetAsync failed\n"); return; }
    void* args[] = {&p};
    hipError_t e = hipLaunchCooperativeKernel((const void*)fwd_kernel<0, N_PHASES>, dim3(grid), dim3(NTHR), args, LDS_BYTES, stream);
    if (e != hipSuccess) fprintf(stderr, "cooperative launch failed: %s (grid %d)\n", hipGetErrorString(e), grid);
#else
    launch_phases<0>(p, grid, stream);
#endif
}
```
